# Optimizing an MI355X kernel written in HIP

```python
import jax, jax.numpy as jnp
from jax import lax
import numpy as np

D_MODEL = 1024
BATCH = 8
SEQ = 2048
DEPTH = 1
DEC_BATCH = 128
DEC_SEQ = 4
PAST_LEN = 16384
PAGE_SIZE = 128

RET_HEADS = 4
RET_DK = D_MODEL // 8
RET_DV = 2 * RET_DK
RET_QK = RET_HEADS * RET_DK
RET_V = RET_HEADS * RET_DV
RET_CHUNK = 128
ROPE_BASE = 10000.0
SG_GROUPS = 4
SG_GW = D_MODEL // 8
SG_W = SG_GROUPS * SG_GW
SG_CHUNK = 128
X_HEADS = 4
X_DH = D_MODEL // 8
X_W = X_HEADS * X_DH
MEM_LEN = 256
N_BRANCH = 3
D_FF = 2816
CONV_W = 3
EPS = 1e-6
IN_WIDTHS = (RET_QK, RET_QK, RET_V, RET_V, SG_W, SG_W, X_W, N_BRANCH * D_MODEL)
IN_COLS = sum(IN_WIDTHS)

kernel_name = "retention_sgu_memxattn_convffn_step"

F32 = jnp.float32


def _rmsnorm(x, g):
    xf = x.astype(F32)
    y = xf * lax.rsqrt(jnp.mean(xf * xf, axis=-1, keepdims=True) + EPS)
    return (y * g.astype(F32)).astype(x.dtype)


def _stdnorm(xf):
    mu = jnp.mean(xf, axis=-1, keepdims=True)
    var = jnp.mean(jnp.square(xf - mu), axis=-1, keepdims=True)
    return (xf - mu) * lax.rsqrt(var + EPS)


def _rope(x, pos):
    d = x.shape[-1]
    inv = ROPE_BASE ** (-jnp.arange(0, d, 2, dtype=F32) / d)
    ang = pos.astype(F32)[:, None] * inv[None, :]
    cos = jnp.cos(ang)[None, :, None, :]
    sin = jnp.sin(ang)[None, :, None, :]
    x1, x2 = x[..., : d // 2], x[..., d // 2:]
    return jnp.concatenate([x1 * cos - x2 * sin, x1 * sin + x2 * cos], axis=-1)


def _retention_chunk(S, qkv, lg):
    q, k, v = qkv
    C = q.shape[1]
    n = jnp.arange(C, dtype=F32)
    diff = n[:, None] - n[None, :]
    causal = diff >= 0
    dmat = jnp.where(causal[None], jnp.exp(jnp.where(causal, diff, 0.0)[None] * lg[:, None, None]), 0.0)
    scores = jnp.einsum('bchd,bshd->bhcs', q, k) * dmat[None]
    inner = jnp.einsum('bhcs,bshe->bche', scores, v)
    q_decay = jnp.exp((n + 1.0)[:, None] * lg[None, :])
    cross = jnp.einsum('bchd,bhde->bche', q, S) * q_decay[None, :, :, None]
    k_decay = jnp.exp((C - 1.0 - n)[:, None] * lg[None, :])
    S_new = jnp.exp(C * lg)[None, :, None, None] * S + jnp.einsum('bchd,bche->bhde', k * k_decay[None, :, :, None], v)
    return S_new, inner + cross


def _retention_branch(q, k, v, g, pos, S0, gn_g, chunk):
    B, L = q.shape[:2]
    lg = jnp.log1p(-jnp.exp2(-5.0 - jnp.arange(RET_HEADS, dtype=F32)))
    qh = _rope(q.astype(F32).reshape(B, L, RET_HEADS, RET_DK), pos)
    kh = _rope(k.astype(F32).reshape(B, L, RET_HEADS, RET_DK), pos) * (RET_DK ** -0.5)
    vh = v.astype(F32).reshape(B, L, RET_HEADS, RET_DV)
    nc = L // chunk
    to_chunks = lambda t: jnp.swapaxes(t.reshape(B, nc, chunk, *t.shape[2:]), 0, 1)
    S_fin, o = lax.scan(lambda S, c: _retention_chunk(S, c, lg), S0.astype(F32),
                        (to_chunks(qh), to_chunks(kh), to_chunks(vh)))
    o = jnp.swapaxes(o, 0, 1).reshape(B, L, RET_HEADS, RET_DV)
    o = _stdnorm(o) * gn_g.astype(F32)
    out = jax.nn.silu(g.astype(F32)) * o.reshape(B, L, RET_V)
    return out.astype(q.dtype), S_fin


def _sgu_branch(u, v, ln_g, ws, bs):
    B, L, _ = u.shape
    C = min(SG_CHUNK, L)
    nc = L // C
    vn = _stdnorm(v.astype(F32)) * ln_g.astype(F32)
    vg = vn.reshape(B, nc, C, SG_GROUPS, SG_GW)
    w = jnp.tril(ws[:, :C, :C].astype(F32))
    bias = jnp.swapaxes(bs[:, :C].astype(F32), 0, 1)
    mixed = jnp.einsum('gts,bnsgc->bntgc', w, vg) + bias[None, None, :, :, None]
    out = u.astype(F32) * mixed.reshape(B, L, SG_W)
    return out.astype(u.dtype), vn.astype(u.dtype)


def _mem_kv(mem, g, w):
    B, M, _ = mem.shape
    kv = _rmsnorm(mem, g) @ w
    k, v = jnp.split(kv, 2, axis=-1)
    return k.reshape(B, M, X_HEADS, X_DH), v.reshape(B, M, X_HEADS, X_DH)


def _xattn(q, mk, mv):
    B, L, _ = q.shape
    qh = q.astype(F32).reshape(B, L, X_HEADS, X_DH)
    s = jnp.einsum('blhd,bmhd->bhlm', qh, mk.astype(F32)) * (X_DH ** -0.5)
    p = jax.nn.softmax(s, axis=-1)
    o = jnp.einsum('bhlm,bmhd->blhd', p, mv.astype(F32))
    return o.reshape(B, L, X_W).astype(q.dtype)


def _mixer_block(x, pos, S0, mk, mv, norm_g, w_in, b_gate, ret_gn_g, sg_ln_g, sg_ws, sg_bs,
                 w_br_ret, w_br_sg, w_br_x, w_o, ret_chunk):
    B, L, _ = x.shape
    h = _rmsnorm(x, norm_g)
    p = h @ w_in
    cuts = np.cumsum(IN_WIDTHS)[:-1].tolist()
    q, k, v, g, su, sv, xq, gt = jnp.split(p, cuts, axis=-1)
    o_ret, S_new = _retention_branch(q, k, v, g, pos, S0, ret_gn_g, ret_chunk)
    o_sg, v_rows = _sgu_branch(jax.nn.gelu(su), jax.nn.gelu(sv), sg_ln_g, sg_ws, sg_bs)
    o_x = _xattn(xq, mk, mv)
    g_ret, g_sg, g_x = jnp.split(jax.nn.sigmoid(gt + b_gate), N_BRANCH, axis=-1)
    merged = g_ret * (o_ret @ w_br_ret) + g_sg * (o_sg @ w_br_sg) + g_x * (o_x @ w_br_x)
    return x + merged @ w_o, S_new, v_rows


def _ffn_block(x, prev, norm_g, w_up, conv_w, conv_b, w_down):
    L = x.shape[1]
    z = _rmsnorm(x, norm_g) @ w_up
    zp = jnp.concatenate([prev.astype(z.dtype), z], axis=1)
    zc = conv_b + sum(conv_w[j] * zp[:, j:j + L] for j in range(CONV_W))
    a, b = jnp.split(zc, 2, axis=-1)
    return x + (jax.nn.gelu(a) * b) @ w_down, zp[:, L:]


def setup_inputs(seed: int = 0) -> dict:
    key = jax.random.key(seed)
    ks = jax.random.split(key, 32)
    nrm = lambda i, shape, s: jax.random.normal(ks[i], shape, F32) * s
    return {
        "x_prompt": nrm(0, (BATCH, SEQ, D_MODEL), 1.0),
        "x_sample": nrm(1, (DEC_BATCH, DEC_SEQ, D_MODEL), 1.0),
        "mem_prompt": nrm(2, (BATCH, MEM_LEN, D_MODEL), 1.0),
        "state_ret": nrm(3, (DEPTH, DEC_BATCH, RET_HEADS, RET_DK, RET_DV), 0.1),
        "state_conv": nrm(4, (DEPTH, DEC_BATCH, CONV_W - 1, 2 * D_FF), 1.0),
        "cache_mem_k": nrm(5, (DEPTH, DEC_BATCH, MEM_LEN, X_HEADS, X_DH), 1.0),
        "cache_mem_v": nrm(6, (DEPTH, DEC_BATCH, MEM_LEN, X_HEADS, X_DH), 1.0),
        "norm_mix_g": 1.0 + nrm(7, (DEPTH, D_MODEL), 0.02),
        "w_in": nrm(8, (DEPTH, D_MODEL, IN_COLS), D_MODEL ** -0.5),
        "b_gate": nrm(9, (DEPTH, N_BRANCH * D_MODEL), 0.01),
        "ret_gn_g": 1.0 + nrm(10, (DEPTH, RET_HEADS, RET_DV), 0.02),
        "sg_ln_g": 1.0 + nrm(11, (DEPTH, SG_W), 0.02),
        "sg_ws": nrm(12, (DEPTH, SG_GROUPS, SG_CHUNK, SG_CHUNK), SG_CHUNK ** -0.5),
        "sg_bs": 1.0 + nrm(13, (DEPTH, SG_GROUPS, SG_CHUNK), 0.01),
        "mem_norm_g": 1.0 + nrm(14, (DEPTH, D_MODEL), 0.02),
        "w_mem_kv": nrm(15, (DEPTH, D_MODEL, 2 * X_W), D_MODEL ** -0.5),
        "w_br_ret": nrm(16, (DEPTH, RET_V, D_MODEL), RET_V ** -0.5),
        "w_br_sg": nrm(17, (DEPTH, SG_W, D_MODEL), SG_W ** -0.5),
        "w_br_x": nrm(18, (DEPTH, X_W, D_MODEL), X_W ** -0.5),
        "w_o": nrm(19, (DEPTH, D_MODEL, D_MODEL), D_MODEL ** -0.5),
        "norm_ffn_g": 1.0 + nrm(20, (DEPTH, D_MODEL), 0.02),
        "w_up": nrm(21, (DEPTH, D_MODEL, 2 * D_FF), D_MODEL ** -0.5),
        "conv_w": nrm(22, (DEPTH, CONV_W, 2 * D_FF), CONV_W ** -0.5),
        "conv_b": nrm(23, (DEPTH, 2 * D_FF), 0.01),
        "w_down": nrm(24, (DEPTH, D_FF, D_MODEL), D_FF ** -0.5),
        "norm_final_g": 1.0 + nrm(25, (D_MODEL,), 0.02),
    }


def reference(x_prompt, x_sample, mem_prompt, state_ret, state_conv, cache_mem_k, cache_mem_v,
              norm_mix_g, w_in, b_gate, ret_gn_g, sg_ln_g, sg_ws, sg_bs, mem_norm_g, w_mem_kv,
              w_br_ret, w_br_sg, w_br_x, w_o, norm_ffn_g, w_up, conv_w, conv_b, w_down, norm_final_g):
    Bp, Lp, _ = x_prompt.shape
    Bs, Ls, _ = x_sample.shape
    pos_p = jnp.arange(Lp, dtype=jnp.int32)
    pos_s = PAST_LEN + jnp.arange(Ls, dtype=jnp.int32)
    xp, xs = x_prompt, x_sample
    ret_p, conv_p, mk_p_l, mv_p_l, ret_s, conv_s, sgv_s = [], [], [], [], [], [], []
    for l in range(DEPTH):
        mk_p, mv_p = _mem_kv(mem_prompt, mem_norm_g[l], w_mem_kv[l])
        S0 = jnp.zeros((Bp, RET_HEADS, RET_DK, RET_DV), F32)
        xp, Sp, _ = _mixer_block(xp, pos_p, S0, mk_p, mv_p, norm_mix_g[l], w_in[l], b_gate[l],
                                 ret_gn_g[l], sg_ln_g[l], sg_ws[l], sg_bs[l], w_br_ret[l],
                                 w_br_sg[l], w_br_x[l], w_o[l], min(RET_CHUNK, Lp))
        c0 = jnp.zeros((Bp, CONV_W - 1, 2 * D_FF), xp.dtype)
        xp, cp = _ffn_block(xp, c0, norm_ffn_g[l], w_up[l], conv_w[l], conv_b[l], w_down[l])
        xs, Ss, vs = _mixer_block(xs, pos_s, state_ret[l], cache_mem_k[l], cache_mem_v[l],
                                  norm_mix_g[l], w_in[l], b_gate[l], ret_gn_g[l], sg_ln_g[l],
                                  sg_ws[l], sg_bs[l], w_br_ret[l], w_br_sg[l], w_br_x[l], w_o[l], Ls)
        xs, cs = _ffn_block(xs, state_conv[l], norm_ffn_g[l], w_up[l], conv_w[l], conv_b[l], w_down[l])
        ret_p.append(Sp.astype(x_prompt.dtype))
        conv_p.append(cp)
        mk_p_l.append(mk_p)
        mv_p_l.append(mv_p)
        ret_s.append(Ss.astype(x_sample.dtype))
        conv_s.append(cs)
        sgv_s.append(vs)
    y_prompt = _rmsnorm(xp, norm_final_g)
    y_sample = _rmsnorm(xs, norm_final_g)
    return (y_prompt, y_sample, jnp.stack(ret_p), jnp.stack(conv_p), jnp.stack(mk_p_l),
            jnp.stack(mv_p_l), jnp.stack(ret_s), jnp.stack(conv_s), jnp.stack(sgv_s))
```

```cpp
#include <hip/hip_runtime.h>
#include <hip/hip_cooperative_groups.h>
#include <cstdio>
#include <cstdint>
namespace cg = cooperative_groups;

#define LAS __attribute__((address_space(3)))
#define DEV __device__ __forceinline__
typedef unsigned short bf16_t;
typedef short bf16x8 __attribute__((ext_vector_type(8)));
typedef short s16x4 __attribute__((ext_vector_type(4)));
typedef float f32x4 __attribute__((ext_vector_type(4)));
typedef unsigned u32x4 __attribute__((ext_vector_type(4)));
typedef unsigned u32x2 __attribute__((ext_vector_type(2)));

constexpr int NP = 16384, NS = 512, MT = 16896, INC = 7680, FF = 2816, FF2 = 5632;
constexpr int C_Q = 0, C_K = 512, C_V = 1024, C_G = 2048, C_SU = 3072, C_XQ = 3584, C_SV = 4096, C_GT = 4608;
constexpr float EPS = 1e-6f;
constexpr size_t OFF_BTIN = 0;
constexpr size_t OFF_BTKV = OFF_BTIN + 15728640;
constexpr size_t OFF_BTMG = OFF_BTKV + 2097152;
constexpr size_t OFF_BTO = OFF_BTMG + 4194304;
constexpr size_t OFF_BTUP = OFF_BTO + 2097152;
constexpr size_t OFF_BTDN = OFF_BTUP + 11534336;
constexpr size_t OFF_ROPEC = OFF_BTDN + 5767168;
constexpr size_t OFF_ROPES = OFF_ROPEC + 525312;
constexpr size_t OFF_WTRIL = OFF_ROPES + 525312;
constexpr size_t OFF_HM = OFF_WTRIL + 131072;
constexpr size_t OFF_MKB = OFF_HM + 4194304;
constexpr size_t OFF_P = OFF_MKB + 4194304;
constexpr size_t OFF_R2 = OFF_P + 259522560;
constexpr size_t WS_END = OFF_R2 + 34603008;
constexpr size_t OFF_Z = OFF_P;
constexpr size_t OFF_ACT = OFF_P + 190316544;
constexpr size_t O_Y = 0, O_RETP = 17301504, O_CONVP = 18350080, O_MK = 18440192, O_MV = 19488768, O_RETS = 20537344, O_CONVS = 37314560, O_SGV = 38756352;
constexpr int LDS_BYTES = 147456;
constexpr int NPHASE = 12;
#ifndef DBG_XA
#define DBG_XA 3
#endif
#ifndef ONLY_PH
#define ONLY_PH -1
#endif
#define PHON(n) (ONLY_PH < 0 || ONLY_PH == (n))

struct Params {
    const float *x_prompt, *x_sample, *mem_prompt, *state_ret, *state_conv, *cache_k, *cache_v, *norm_mix_g, *w_in, *b_gate, *ret_gn_g, *sg_ln_g, *sg_ws, *sg_bs,
        *mem_norm_g, *w_mem_kv, *w_br_ret, *w_br_sg, *w_br_x, *w_o, *norm_ffn_g, *w_up, *conv_w, *conv_b, *w_down, *norm_final_g;
    float* out; unsigned char* ws;
};

typedef __bf16 bf16v2_t __attribute__((ext_vector_type(2)));
typedef float f32x2_t __attribute__((ext_vector_type(2)));
DEV unsigned pk2(float lo, float hi) { const f32x2_t f = {lo, hi}; const bf16v2_t v = __builtin_convertvector(f, bf16v2_t); return __builtin_bit_cast(unsigned, v); }
DEV bf16_t f2bf(float v) { return (bf16_t)(pk2(v, 0.f) & 0xffffu); }
DEV float bf_lo(unsigned u) { return __uint_as_float(u << 16); }
DEV float bf_hi(unsigned u) { return __uint_as_float(u & 0xffff0000u); }
DEV float bf2f(bf16_t b) { return __uint_as_float(((unsigned)b) << 16); }
DEV float wave_sum(float v) {
#pragma unroll
    for (int o = 1; o < 64; o <<= 1) v += __shfl_xor(v, o);
    return v; }
DEV float wave_max(float v) {
#pragma unroll
    for (int o = 1; o < 64; o <<= 1) v = fmaxf(v, __shfl_xor(v, o));
    return v; }
DEV float g16_sum(float v) {
#pragma unroll
    for (int o = 1; o < 16; o <<= 1) v += __shfl_xor(v, o);
    return v; }
DEV float g16_max(float v) {
#pragma unroll
    for (int o = 1; o < 16; o <<= 1) v = fmaxf(v, __shfl_xor(v, o));
    return v; }
DEV float gelu_t(float x) { const float u = 1.5957691216057308f * (x + 0.044715f * x * x * x); return x / (1.f + __expf(-u)); }
DEV float silu_f(float x) { return x / (1.f + __expf(-x)); }
DEV float sigm_f(float x) { return 1.f / (1.f + __expf(-x)); }
DEV float log_gamma(int h) { return log1pf(-exp2f(-5.f - (float)h)); }
DEV int otid() { int t = threadIdx.x; asm volatile("" : "+v"(t)); return t; }
DEV int obid() { int t = blockIdx.x; asm volatile("" : "+s"(t)); return t; }
DEV unsigned ldsaddr(LAS const void* p) { return (unsigned)(uintptr_t)p; }
DEV f32x4 mfma16(bf16x8 a, bf16x8 b, f32x4 c) { return __builtin_amdgcn_mfma_f32_16x16x32_bf16(a, b, c, 0, 0, 0); }
DEV bf16x8 lds_frag(LAS const unsigned char* base, int pitch, int row0, int k0, int lane) {
    return *(LAS const bf16x8*)(base + (row0 + (lane & 15)) * pitch + (k0 + 8 * (lane >> 4)) * 2); }
DEV LAS const unsigned char* tr_lane_base(LAS const unsigned char* base, int pitch, int lane) { const int g = lane >> 4, q = (lane & 15) >> 2, pp = lane & 3; return base + ((8 * g + q) * pitch + 8 * pp); }
template <int PITCH, int KB, int X0> DEV void tr_read4(LAS const unsigned char* a, bf16x8 (&f)[4]) {
    constexpr int o0 = KB * PITCH + X0 * 2;
    static_assert(o0 + 100 * PITCH < 65536, "ds offset field");
#pragma unroll
    for (int ks = 0; ks < 4; ++ks) {
        const s16x4 lo = __builtin_amdgcn_ds_read_tr16_b64_v4i16((LAS s16x4*)(a + o0 + ks * 32 * PITCH));
        const s16x4 hi = __builtin_amdgcn_ds_read_tr16_b64_v4i16((LAS s16x4*)(a + o0 + ks * 32 * PITCH + 4 * PITCH));
        f[ks] = (bf16x8){lo[0], lo[1], lo[2], lo[3], hi[0], hi[1], hi[2], hi[3]}; } }
template <int V> struct IC { static constexpr int value = V; };
template <int I, int N, class F> DEV void static_for(F&& f) { if constexpr (I < N) { f(IC<I>{}); static_for<I + 1, N>(f); } }
#define SCHEDB __builtin_amdgcn_sched_barrier(0)

namespace pg8 {
constexpr int BM = 256, BK = 64, HALF = 128, HTB = HALF * BK * 2, NXCD = 8, WGM = 8;
DEV int lds_byte(int r, int c) { const int st = (r >> 4) * 2 + (c >> 5), rr = r & 15, cc = c & 31, ob = rr * 64 + cc * 2; return st * 1024 + (ob ^ (((ob >> 9) & 1) << 5)); }
DEV void stage_rc(int b, int& R, int& C) { const int st = b / 1024, sb = b % 1024, swz = sb ^ (((sb >> 9) & 1) << 5); R = (st >> 1) * 16 + swz / 64; C = (st & 1) * 32 + (swz % 64) / 2; }
DEV int perm32(int rho) { const int n = rho >> 4, i = rho & 15; return 8 * (i >> 2) + 4 * n + (i & 3); }
struct Unit { int pm, pn, kind, nt; const char* A; const char* B; };
DEV void tile_map(int L, int nM, int nN, int& pm, int& pn) {
    const int nwg = nM * nN; int wgid = L; { const int q = nwg / NXCD, r = nwg % NXCD, xcd = wgid % NXCD, off = wgid / NXCD; wgid = (xcd < r ? xcd * (q + 1) : r * (q + 1) + (xcd - r) * q) + off; }
    const int nig = WGM * nN, gid = wgid / nig, fm = gid * WGM, gsz = (nM - fm) < WGM ? (nM - fm) : WGM;
    pm = fm + ((wgid % nig) % gsz); pn = (wgid % nig) / gsz; }

template <class Epi, class Sched>
DEV void gemm_phase(LAS unsigned char* lds, int lda, int ldb, const Sched& S, const Epi& E) {
    const int tid = otid(), wid = __builtin_amdgcn_readfirstlane(tid >> 6), lane = tid & 63, wr = wid >> 2, wc = wid & 3, fr = lane & 15, fq = lane >> 4;
    unsigned voffA[2], voffB[2];
#pragma unroll
    for (int i = 0; i < 2; ++i) { int R, C; stage_rc(tid * 16 + i * 8192, R, C); const int Rb = (R & ~31) + perm32(R & 31);
        voffA[i] = (unsigned)(R * lda + C) * 2u; voffB[i] = (unsigned)(Rb * ldb + C) * 2u; }
    const size_t kstep = (size_t)(BK * 2);
    const size_t hstepA = (size_t)HALF * lda * 2, hstepB = (size_t)HALF * ldb * 2;
    const unsigned ldsw = (unsigned)wid * 1024u;
    const int aoff = lds_byte(wr * 64 + fr, fq * 8), boff = lds_byte(wc * 32 + fr, fq * 8);
#define PG8_SA(b, h) (((b) * 2 + (h)) * HTB)
#define PG8_SB(b, h) ((4 + (b) * 2 + (h)) * HTB)
#define PG8_STAGE(bufoff, gbase, voff) do { _Pragma("unroll") for (int _i = 0; _i < 2; ++_i) \
        __builtin_amdgcn_global_load_lds((const unsigned*)((const char*)(gbase) + (voff)[_i]), (LAS unsigned*)(lds + (bufoff) + ldsw + _i * 8192), 16, 0, 0); } while (0)
#define PG8_LDA(dst, b, h) do { _Pragma("unroll") for (int m = 0; m < 4; ++m) _Pragma("unroll") for (int k = 0; k < 2; ++k) dst[m][k] = *(const LAS bf16x8*)(lds + PG8_SA(b, h) + aoff + m * 2048 + k * 1024); } while (0)
#define PG8_LDB(dst, b, h) do { _Pragma("unroll") for (int n = 0; n < 2; ++n) _Pragma("unroll") for (int k = 0; k < 2; ++k) dst[n][k] = *(const LAS bf16x8*)(lds + PG8_SB(b, h) + boff + n * 2048 + k * 1024); } while (0)
#define PG8_MMA(ai, bj, At, Bt) do { __builtin_amdgcn_s_setprio(1); _Pragma("unroll") for (int m = 0; m < 4; ++m) _Pragma("unroll") for (int n = 0; n < 2; ++n) _Pragma("unroll") for (int k = 0; k < 2; ++k) \
        acc[ai][bj][m][n] = __builtin_amdgcn_mfma_f32_16x16x32_bf16(Bt[n][k], At[m][k], acc[ai][bj][m][n], 0, 0, 0); __builtin_amdgcn_s_setprio(0); } while (0)
#define PG8_WAIT_V(n) asm volatile("s_waitcnt vmcnt(" #n ")" ::: "memory")
#define PG8_WAIT_L(n) asm volatile("s_waitcnt lgkmcnt(" #n ")" ::: "memory")
#define PG8_BAR __builtin_amdgcn_s_barrier()
#define PG8_SCHED __builtin_amdgcn_sched_barrier(0)
    Unit cur, nxt; int ui = 0;
    if (!S.next(0, cur)) return;
    f32x4 acc[2][2][4][2];
#pragma unroll
    for (int a = 0; a < 2; ++a)
#pragma unroll
        for (int b = 0; b < 2; ++b)
#pragma unroll
            for (int m = 0; m < 4; ++m)
#pragma unroll
                for (int n = 0; n < 2; ++n) acc[a][b][m][n] = (f32x4){0.f, 0.f, 0.f, 0.f};
    bf16x8 At[4][2], B0[2][2], B1[2][2];
    const char* cA = cur.A; const char* cB = cur.B;
    PG8_STAGE(PG8_SB(0, 0), cB, voffB); PG8_STAGE(PG8_SA(0, 0), cA, voffA); PG8_STAGE(PG8_SB(0, 1), cB + hstepB, voffB); PG8_STAGE(PG8_SA(0, 1), cA + hstepA, voffA);
    if (wr == 1) PG8_BAR;
    PG8_WAIT_V(4); PG8_BAR;
    PG8_STAGE(PG8_SB(1, 0), cB + kstep, voffB); PG8_STAGE(PG8_SA(1, 0), cA + kstep, voffA); PG8_STAGE(PG8_SB(1, 1), cB + hstepB + kstep, voffB);
    PG8_WAIT_V(6); PG8_BAR;
    for (;;) {
        const bool has_next = S.next(ui + 1, nxt);
        const char* nA = has_next ? nxt.A : cA; const char* nB = has_next ? nxt.B : cB;
        const int nt = cur.nt;
        for (int t = 0; t < nt; t += 2) {
            const bool last = (t == nt - 2);
            const char* a1 = cA + (size_t)(t + 1) * kstep;
            const char* a2 = last ? nA : cA + (size_t)(t + 2) * kstep; const char* b2 = last ? nB : cB + (size_t)(t + 2) * kstep;
            const char* a3 = a2 + kstep; const char* b3 = b2 + kstep;
            PG8_LDB(B0, 0, 0); PG8_SCHED; PG8_LDA(At, 0, 0); PG8_STAGE(PG8_SA(1, 1), a1 + hstepA, voffA);
            PG8_WAIT_L(8); PG8_BAR; PG8_WAIT_L(0); PG8_MMA(0, 0, At, B0); PG8_BAR; PG8_SCHED;
            PG8_LDB(B1, 0, 1); PG8_STAGE(PG8_SB(0, 0), b2, voffB);
            PG8_BAR; PG8_WAIT_L(0); PG8_MMA(0, 1, At, B1); PG8_BAR;
            PG8_LDA(At, 0, 1); PG8_STAGE(PG8_SA(0, 0), a2, voffA);
            PG8_BAR; PG8_WAIT_L(0); PG8_MMA(1, 0, At, B0); PG8_BAR; PG8_SCHED;
            PG8_STAGE(PG8_SB(0, 1), b2 + hstepB, voffB);
            PG8_WAIT_V(6); PG8_BAR; PG8_MMA(1, 1, At, B1); PG8_BAR;
            PG8_LDB(B0, 1, 0); PG8_SCHED; PG8_LDA(At, 1, 0); PG8_STAGE(PG8_SA(0, 1), a2 + hstepA, voffA);
            PG8_WAIT_L(8); PG8_BAR; PG8_WAIT_L(0); PG8_MMA(0, 0, At, B0); PG8_BAR; PG8_SCHED;
            PG8_LDB(B1, 1, 1); PG8_STAGE(PG8_SB(1, 0), b3, voffB);
            PG8_BAR; PG8_WAIT_L(0); PG8_MMA(0, 1, At, B1); PG8_BAR;
            PG8_LDA(At, 1, 1); PG8_STAGE(PG8_SA(1, 0), a3, voffA);
            PG8_BAR; PG8_WAIT_L(0); PG8_MMA(1, 0, At, B0); PG8_BAR; PG8_SCHED;
            PG8_STAGE(PG8_SB(1, 1), b3 + hstepB, voffB);
            PG8_WAIT_V(6); PG8_BAR; PG8_MMA(1, 1, At, B1); PG8_BAR;
        }
        E(acc, cur, wr, wc, fr, fq);
        if (!has_next) break;
#pragma unroll
        for (int a = 0; a < 2; ++a)
#pragma unroll
            for (int b = 0; b < 2; ++b)
#pragma unroll
                for (int m = 0; m < 4; ++m)
#pragma unroll
                    for (int n = 0; n < 2; ++n) acc[a][b][m][n] = (f32x4){0.f, 0.f, 0.f, 0.f};
        cur = nxt; cA = nA; cB = nB; ++ui;
    }
    PG8_WAIT_V(0);
    if (wr == 0) PG8_BAR;
    PG8_BAR;
#undef PG8_SA
#undef PG8_SB
#undef PG8_STAGE
#undef PG8_LDA
#undef PG8_LDB
#undef PG8_MMA
#undef PG8_WAIT_V
#undef PG8_WAIT_L
#undef PG8_BAR
#undef PG8_SCHED
}
#define EPI_LOOP_BEGIN \
    _Pragma("unroll") for (int ai = 0; ai < 2; ++ai) _Pragma("unroll") for (int m = 0; m < 4; ++m) { const int row = u.pm * 256 + ai * 128 + wr * 64 + m * 16 + fr; \
    _Pragma("unroll") for (int bj = 0; bj < 2; ++bj) { const int col0 = u.pn * 256 + bj * 128 + wc * 32 + fq * 8; const f32x4 v0 = acc[ai][bj][m][0], v1 = acc[ai][bj][m][1];
#define EPI_LOOP_END } }
}
using pg8::Unit;
typedef f32x4 AccT[2][2][4][2];

struct Sched1 { int G, c; const char *h, *hm, *btin, *btkv;
    DEV bool next(int i, Unit& u) const {
        long L = (long)i * G + c;
        if (L < 1980) { pg8::tile_map((int)L, 66, 30, u.pm, u.pn); u.kind = 0; u.nt = 16; u.A = h + (size_t)u.pm * 524288; u.B = btin + (size_t)u.pn * 524288; return true; }
        L -= 1980; if (L < 32) { u.pm = (int)(L & 7); u.pn = (int)(L >> 3); u.kind = 1; u.nt = 16; u.A = hm + (size_t)u.pm * 524288; u.B = btkv + (size_t)u.pn * 524288; return true; }
        return false; } };
struct Epi1 { bf16_t* P; bf16_t* mkb; float* out; const float *ropeC, *ropeS, *b_gate;
    DEV void operator()(const AccT& acc, const Unit& u, int wr, int wc, int fr, int fq) const {
        if (u.kind == 1) {
            EPI_LOOP_BEGIN
                float* o = (col0 < 512) ? out + O_MK + (size_t)row * 512 + col0 : out + O_MV + (size_t)row * 512 + (col0 - 512);
                *(f32x4*)o = v0; *(f32x4*)(o + 4) = v1;
                u32x4 pk; pk.x = pk2(v0.x, v0.y); pk.y = pk2(v0.z, v0.w); pk.z = pk2(v1.x, v1.y); pk.w = pk2(v1.z, v1.w);
                *(u32x4*)(mkb + (size_t)row * 1024 + col0) = pk;
            EPI_LOOP_END
            return; }
        const int pn = u.pn;
        if (pn < 4) {
            const float sc = (pn >= 2) ? 0.08838834764831845f : 1.f;
            EPI_LOOP_BEGIN
                const int pidx = row < NP ? (row & 2047) : 2048 + ((row - NP) & 3);
                const int uu = (col0 & 127) >> 3, hb = col0 & ~127;
                const f32x4 cs = *(const f32x4*)(ropeC + pidx * 64 + 4 * uu), sn = *(const f32x4*)(ropeS + pidx * 64 + 4 * uu);
                const f32x4 o1 = (v0 * cs - v1 * sn) * sc, o2 = (v0 * sn + v1 * cs) * sc;
                u32x2 a; a.x = pk2(o1.x, o1.y); a.y = pk2(o1.z, o1.w); u32x2 b; b.x = pk2(o2.x, o2.y); b.y = pk2(o2.z, o2.w);
                *(u32x2*)(P + (size_t)row * INC + hb + 4 * uu) = a; *(u32x2*)(P + (size_t)row * INC + hb + 64 + 4 * uu) = b;
            EPI_LOOP_END
            return; }
        const int mode = pn < 8 ? 0 : pn < 12 ? 1 : pn < 14 ? 2 : pn < 16 ? 0 : pn < 18 ? 2 : 3;
        EPI_LOOP_BEGIN
            f32x4 a = v0, b = v1;
            if (mode == 1) { for (int i = 0; i < 4; ++i) { a[i] = silu_f(a[i]); b[i] = silu_f(b[i]); } }
            else if (mode == 2) { for (int i = 0; i < 4; ++i) { a[i] = gelu_t(a[i]); b[i] = gelu_t(b[i]); } }
            else if (mode == 3) { const f32x4 b0 = *(const f32x4*)(b_gate + col0 - C_GT), b1 = *(const f32x4*)(b_gate + col0 - C_GT + 4);
                for (int i = 0; i < 4; ++i) { a[i] = sigm_f(a[i] + b0[i]); b[i] = sigm_f(b[i] + b1[i]); } }
            u32x4 pk; pk.x = pk2(a.x, a.y); pk.y = pk2(a.z, a.w); pk.z = pk2(b.x, b.y); pk.w = pk2(b.z, b.w);
            *(u32x4*)(P + (size_t)row * INC + col0) = pk;
        EPI_LOOP_END
    } };

struct SchedMg { int G, c; const char *P, *bt;
    DEV bool next(int i, Unit& u) const {
        const int T = i / 3, br = i - 3 * T; const long L = (long)T * G + c; if (L >= 264) return false;
        pg8::tile_map((int)L, 66, 4, u.pm, u.pn); u.kind = br; u.nt = br == 0 ? 16 : 8;
        const int koff = br == 0 ? 0 : br == 1 ? 1024 : 1536;
        u.A = P + (size_t)u.pm * 256 * INC * 2 + (size_t)(C_G + koff) * 2; u.B = bt + (size_t)u.pn * 256 * 2048 * 2 + (size_t)koff * 2; return true; } };
struct EpiMg { const bf16_t* P; float* tmp; bf16_t* mg;
    DEV void operator()(const AccT& acc, const Unit& u, int wr, int wc, int fr, int fq) const {
        const int br = u.kind;
        EPI_LOOP_BEGIN
            const u32x4 g = *(const u32x4*)(P + (size_t)row * INC + C_GT + br * 1024 + col0);
            f32x4 a, b; a.x = bf_lo(g.x) * v0.x; a.y = bf_hi(g.x) * v0.y; a.z = bf_lo(g.y) * v0.z; a.w = bf_hi(g.y) * v0.w;
            b.x = bf_lo(g.z) * v1.x; b.y = bf_hi(g.z) * v1.y; b.z = bf_lo(g.w) * v1.z; b.w = bf_hi(g.w) * v1.w;
            float* t = tmp + (size_t)row * 1024 + col0;
            if (br > 0) { a += *(const f32x4*)t; b += *(const f32x4*)(t + 4); }
            if (br < 2) { *(f32x4*)t = a; *(f32x4*)(t + 4) = b; }
            else { u32x4 pk; pk.x = pk2(a.x, a.y); pk.y = pk2(a.z, a.w); pk.z = pk2(b.x, b.y); pk.w = pk2(b.z, b.w); *(u32x4*)(mg + (size_t)row * 1024 + col0) = pk; }
        EPI_LOOP_END
    } };

struct SchedPlain { int G, c, nM, nN, nt; const char *A, *B; size_t astep, bstep;
    DEV bool next(int i, Unit& u) const {
        const long L = (long)i * G + c; if (L >= (long)nM * nN) return false;
        pg8::tile_map((int)L, nM, nN, u.pm, u.pn); u.kind = 0; u.nt = nt; u.A = A + (size_t)u.pm * astep; u.B = B + (size_t)u.pn * bstep; return true; } };
struct EpiWo { const float *xp, *xs; float* out;
    DEV void operator()(const AccT& acc, const Unit& u, int wr, int wc, int fr, int fq) const {
        EPI_LOOP_BEGIN
            const float* x = (row < NP ? xp + (size_t)row * 1024 : xs + (size_t)(row - NP) * 1024) + col0;
            float* o = out + (size_t)row * 1024 + col0;
            *(f32x4*)o = *(const f32x4*)x + v0; *(f32x4*)(o + 4) = *(const f32x4*)(x + 4) + v1;
        EPI_LOOP_END
    } };
struct EpiUp { bf16_t* z; float* out;
    DEV void operator()(const AccT& acc, const Unit& u, int wr, int wc, int fr, int fq) const {
        EPI_LOOP_BEGIN
            u32x4 pk; pk.x = pk2(v0.x, v0.y); pk.y = pk2(v0.z, v0.w); pk.z = pk2(v1.x, v1.y); pk.w = pk2(v1.z, v1.w);
            *(u32x4*)(z + (size_t)row * FF2 + col0) = pk;
            float* o = nullptr;
            if (row < NP) { const int t = row & 2047; if (t >= 2046) o = out + O_CONVP + ((size_t)(row >> 11) * 2 + (t - 2046)) * FF2 + col0; }
            else { const int rs = row - NP, t = rs & 3; if (t >= 2) o = out + O_CONVS + ((size_t)(rs >> 2) * 2 + (t - 2)) * FF2 + col0; }
            if (o) { *(f32x4*)o = v0; *(f32x4*)(o + 4) = v1; }
        EPI_LOOP_END
    } };
struct EpiDn { float* out;
    DEV void operator()(const AccT& acc, const Unit& u, int wr, int wc, int fr, int fq) const {
        EPI_LOOP_BEGIN
            float* o = out + (size_t)row * 1024 + col0;
            *(f32x4*)o = *(const f32x4*)o + v0; *(f32x4*)(o + 4) = *(const f32x4*)(o + 4) + v1;
        EPI_LOOP_END
    } };

DEV int srccol_in(int p) {
    if (p < 1024) { const int hb = p & ~127, pp = p & 127, uu = pp >> 3, v = pp & 7; return hb + ((v < 4) ? 4 * uu + v : 64 + 4 * uu + (v - 4)); }
    if (p >= C_XQ && p < C_SV) return p + 512;
    if (p >= C_SV && p < C_GT) return p - 512;
    return p; }
DEV void transpose_item(const float* W, int N, bf16_t* WT, int ldk, int koff, LAS float* scr, int k0, int n0, int srccol, int lane) {
#pragma unroll 8
    for (int i = 0; i < 32; ++i) { const int kk = 2 * i + (lane >> 5); scr[kk * 33 + (lane & 31)] = W[(size_t)(k0 + kk) * N + srccol]; }
    const int c = lane & 7;
#pragma unroll
    for (int j = 0; j < 4; ++j) { const int n = (lane >> 3) + 8 * j; const LAS float* s = scr + (8 * c) * 33 + n;
        u32x4 o; o.x = pk2(s[0 * 33], s[1 * 33]); o.y = pk2(s[2 * 33], s[3 * 33]); o.z = pk2(s[4 * 33], s[5 * 33]); o.w = pk2(s[6 * 33], s[7 * 33]);
        *(u32x4*)(WT + (size_t)(n0 + n) * ldk + koff + k0 + 8 * c) = o; }
}
DEV void rms_row(const float* xrow, const float* g, bf16_t* orow, int lane) {
    f32x4 v[4]; float s = 0.f;
#pragma unroll
    for (int j = 0; j < 4; ++j) { v[j] = *(const f32x4*)(xrow + 4 * lane + 256 * j); s += v[j].x * v[j].x + v[j].y * v[j].y + v[j].z * v[j].z + v[j].w * v[j].w; }
    s = wave_sum(s); const float r = rsqrtf(s * (1.f / 1024.f) + EPS);
#pragma unroll
    for (int j = 0; j < 4; ++j) { const f32x4 gv = *(const f32x4*)(g + 4 * lane + 256 * j);
        u32x2 o; o.x = pk2(v[j].x * r * gv.x, v[j].y * r * gv.y); o.y = pk2(v[j].z * r * gv.z, v[j].w * r * gv.w);
        *(u32x2*)(orow + 4 * lane + 256 * j) = o; }
}
DEV void phase_prep(const Params& p, LAS unsigned char* lds) {
    const int tid = otid(), lane = tid & 63, wave = tid >> 6;
    const int gw = obid() * 8 + wave, NGW = gridDim.x * 8;
    LAS float* scr = (LAS float*)(lds + wave * 8448);
    unsigned char* ws = p.ws;
    constexpr int I_IN = 16 * 240, I_KV = 16 * 32, I_MR = 16 * 32, I_MS = 8 * 32, I_MX = 8 * 32, I_O = 16 * 32, I_UP = 16 * 176, I_DN = 44 * 32;
    constexpr int N_TR = I_IN + I_KV + I_MR + I_MS + I_MX + I_O + I_UP + I_DN;
    constexpr int N_RMS = MT + 2048, N_ROPE = 2052, N_TRIL = 512;
    constexpr int N_ALL = N_TR + N_RMS + N_ROPE + N_TRIL;
    for (int it = gw; it < N_ALL; it += NGW) {
        int r = it;
        if (r < N_TR) {
            const int l31 = lane & 31;
            if (r < I_IN) { const int kb = r / 240, nb = r % 240; transpose_item(p.w_in, INC, (bf16_t*)(ws + OFF_BTIN), 1024, 0, scr, 64 * kb, 32 * nb, srccol_in(32 * nb + l31), lane); continue; } r -= I_IN;
            if (r < I_KV) { const int kb = r / 32, nb = r % 32; transpose_item(p.w_mem_kv, 1024, (bf16_t*)(ws + OFF_BTKV), 1024, 0, scr, 64 * kb, 32 * nb, 32 * nb + l31, lane); continue; } r -= I_KV;
            if (r < I_MR) { const int kb = r / 32, nb = r % 32; transpose_item(p.w_br_ret, 1024, (bf16_t*)(ws + OFF_BTMG), 2048, 0, scr, 64 * kb, 32 * nb, 32 * nb + l31, lane); continue; } r -= I_MR;
            if (r < I_MS) { const int kb = r / 32, nb = r % 32; transpose_item(p.w_br_sg, 1024, (bf16_t*)(ws + OFF_BTMG), 2048, 1024, scr, 64 * kb, 32 * nb, 32 * nb + l31, lane); continue; } r -= I_MS;
            if (r < I_MX) { const int kb = r / 32, nb = r % 32; transpose_item(p.w_br_x, 1024, (bf16_t*)(ws + OFF_BTMG), 2048, 1536, scr, 64 * kb, 32 * nb, 32 * nb + l31, lane); continue; } r -= I_MX;
            if (r < I_O) { const int kb = r / 32, nb = r % 32; transpose_item(p.w_o, 1024, (bf16_t*)(ws + OFF_BTO), 1024, 0, scr, 64 * kb, 32 * nb, 32 * nb + l31, lane); continue; } r -= I_O;
            if (r < I_UP) { const int kb = r / 176, nb = r % 176; transpose_item(p.w_up, FF2, (bf16_t*)(ws + OFF_BTUP), 1024, 0, scr, 64 * kb, 32 * nb, 32 * nb + l31, lane); continue; } r -= I_UP;
            { const int kb = r / 32, nb = r % 32; transpose_item(p.w_down, 1024, (bf16_t*)(ws + OFF_BTDN), FF, 0, scr, 64 * kb, 32 * nb, 32 * nb + l31, lane); continue; }
        }
        r -= N_TR;
        if (r < N_RMS) {
            if (r < NP) rms_row(p.x_prompt + (size_t)r * 1024, p.norm_mix_g, (bf16_t*)(ws + OFF_R2) + (size_t)r * 1024, lane);
            else if (r < MT) rms_row(p.x_sample + (size_t)(r - NP) * 1024, p.norm_mix_g, (bf16_t*)(ws + OFF_R2) + (size_t)r * 1024, lane);
            else rms_row(p.mem_prompt + (size_t)(r - MT) * 1024, p.mem_norm_g, (bf16_t*)(ws + OFF_HM) + (size_t)(r - MT) * 1024, lane);
            continue; }
        r -= N_RMS;
        if (r < N_ROPE) {
            const int pos = r < 2048 ? r : 16384 + (r - 2048);
            double inv = 1.0;
            if (lane & 1) inv *= 0.8659643233600653; if (lane & 2) inv *= 0.7498942093324559; if (lane & 4) inv *= 0.5623413251903491;
            if (lane & 8) inv *= 0.31622776601683794; if (lane & 16) inv *= 0.1; if (lane & 32) inv *= 0.01;
            double t = (double)pos * inv * 0.15915494309189535; t -= __builtin_rint(t);
            const float tf = (float)t;
            ((float*)(ws + OFF_ROPEC))[r * 64 + lane] = __builtin_amdgcn_cosf(tf);
            ((float*)(ws + OFF_ROPES))[r * 64 + lane] = __builtin_amdgcn_sinf(tf);
            continue; }
        r -= N_ROPE;
        { const int t = r & 127; const float* src = p.sg_ws + (size_t)r * 128 + 2 * lane;
          const float a = (2 * lane <= t) ? src[0] : 0.f, b = (2 * lane + 1 <= t) ? src[1] : 0.f;
          *(unsigned*)((bf16_t*)(ws + OFF_WTRIL) + (size_t)r * 128 + 2 * lane) = pk2(a, b); }
    }
}

DEV void ret_A_item(const Params& p, LAS unsigned char* lds, int item) {
    const int tid = otid(), lane = tid & 63, w = tid >> 6;
    const int c = item & 15, bh = item >> 4, h = bh & 3, b = bh >> 2;
    const size_t row0 = (size_t)b * 2048 + c * 128;
    const bf16_t* P = (const bf16_t*)(p.ws + OFF_P);
    const float lg = log_gamma(h);
    LAS unsigned char* Kt = lds; LAS unsigned char* Vt = lds + 34816;
    for (int i = tid; i < 2048; i += 512) { const int s = i >> 4, ch = i & 15;
        u32x4 v = *(const u32x4*)(P + (row0 + s) * INC + C_K + h * 128 + ch * 8);
        const float dec = __expf((float)(127 - s) * lg);
        v.x = pk2(bf_lo(v.x) * dec, bf_hi(v.x) * dec); v.y = pk2(bf_lo(v.y) * dec, bf_hi(v.y) * dec); v.z = pk2(bf_lo(v.z) * dec, bf_hi(v.z) * dec); v.w = pk2(bf_lo(v.w) * dec, bf_hi(v.w) * dec);
        *(LAS u32x4*)(Kt + s * 272 + ch * 16) = v; }
    for (int i = tid; i < 4096; i += 512) { const int s = i >> 5, ch = i & 31;
        *(LAS u32x4*)(Vt + s * 528 + ch * 16) = *(const u32x4*)(P + (row0 + s) * INC + C_V + h * 256 + ch * 8); }
    __syncthreads();
    f32x4 acc[16];
#pragma unroll
    for (int i = 0; i < 16; ++i) acc[i] = (f32x4){0.f, 0.f, 0.f, 0.f};
    LAS const unsigned char* kb = tr_lane_base(Kt, 272, lane) + 32 * w; LAS const unsigned char* vb = tr_lane_base(Vt, 528, lane);
    bf16x8 af[4]; tr_read4<272, 0, 0>(kb, af);
    static_for<0, 16>([&](auto et_) { constexpr int et = decltype(et_)::value; bf16x8 bf[4]; tr_read4<528, 0, 16 * et>(vb, bf);
#pragma unroll
        for (int ks = 0; ks < 4; ++ks) acc[et] = mfma16(af[ks], bf[ks], acc[et]); });
    float* U = p.out + (size_t)item * 32768;
    const int g = lane >> 4, col = lane & 15;
#pragma unroll
    for (int et = 0; et < 16; ++et)
#pragma unroll
        for (int j = 0; j < 4; ++j) U[(16 * w + 4 * g + j) * 256 + 16 * et + col] = acc[et][j];
    __syncthreads();
}
DEV void scan_phase(const Params& p) {
    const float* U = p.out; bf16_t* Sb = (bf16_t*)(p.ws + OFF_R2);
    for (int idx = obid() * 512 + otid(); idx < 131072; idx += gridDim.x * 512) {
        const int e8 = idx & 31, d = (idx >> 5) & 127, bh = idx >> 12, h = bh & 3;
        const float g128 = __expf(128.f * log_gamma(h));
        f32x4 s0 = (f32x4){0.f, 0.f, 0.f, 0.f}, s1 = s0;
#pragma unroll
        for (int c = 0; c < 16; ++c) {
            const size_t off = (((size_t)bh * 16 + c) * 128 + d) * 256 + e8 * 8;
            u32x4 pk; pk.x = pk2(s0.x, s0.y); pk.y = pk2(s0.z, s0.w); pk.z = pk2(s1.x, s1.y); pk.w = pk2(s1.z, s1.w);
            *(u32x4*)(Sb + off) = pk;
            const f32x4 u0 = *(const f32x4*)(U + off), u1 = *(const f32x4*)(U + off + 4);
            s0 = s0 * g128 + u0; s1 = s1 * g128 + u1; }
        float* o = p.out + O_RETP + ((size_t)bh * 128 + d) * 256 + e8 * 8;
        *(f32x4*)o = s0; *(f32x4*)(o + 4) = s1;
    }
}
DEV void ret_C_item(const Params& p, LAS unsigned char* lds, int item) {
    const int tid = otid(), lane = tid & 63, w = tid >> 6, g = lane >> 4, col = lane & 15;
    const int c = item & 15, bh = item >> 4, h = bh & 3, b = bh >> 2;
    const size_t row0 = (size_t)b * 2048 + c * 128;
    bf16_t* P = (bf16_t*)(p.ws + OFF_P);
    const bf16_t* Sb = (const bf16_t*)(p.ws + OFF_R2) + (size_t)item * 32768;
    const float lg = log_gamma(h);
    LAS unsigned char* Kt = lds; LAS unsigned char* Vh = lds + 34816; LAS unsigned char* Sh = lds + 69632; LAS unsigned char* Sc = lds + 104448 + w * 4352;
    for (int i = tid; i < 2048; i += 512) { const int s = i >> 4, ch = i & 15;
        *(LAS u32x4*)(Kt + s * 272 + ch * 16) = *(const u32x4*)(P + (row0 + s) * INC + C_K + h * 128 + ch * 8); }
    bf16x8 qf[4];
    { const bf16_t* qp = P + (row0 + 16 * w + col) * INC + C_Q + h * 128 + 8 * g;
#pragma unroll
      for (int ks = 0; ks < 4; ++ks) qf[ks] = *(const bf16x8*)(qp + 32 * ks); }
    f32x4 o[16];
    LAS const unsigned char* shb = tr_lane_base(Sh, 272, lane); LAS const unsigned char* vhb = tr_lane_base(Vh, 272, lane);
    bf16x8 scf[4];
    static_for<0, 2>([&](auto hh_) { constexpr int hh = decltype(hh_)::value;
        if (hh == 1) __syncthreads();
        for (int i = tid; i < 2048; i += 512) { const int s = i >> 4, ch = i & 15;
            *(LAS u32x4*)(Vh + s * 272 + ch * 16) = *(const u32x4*)(P + (row0 + s) * INC + C_V + h * 256 + hh * 128 + ch * 8);
            *(LAS u32x4*)(Sh + s * 272 + ch * 16) = *(const u32x4*)(Sb + s * 256 + hh * 128 + ch * 8); }
        __syncthreads();
        if (hh == 0) {
            static_for<0, 8>([&](auto st_) { constexpr int st = decltype(st_)::value; f32x4 a = (f32x4){0.f, 0.f, 0.f, 0.f};
#pragma unroll
                for (int ks = 0; ks < 4; ++ks) a = mfma16(qf[ks], lds_frag(Kt, 272, 16 * st, 32 * ks, lane), a);
#pragma unroll
                for (int j = 0; j < 4; ++j) { const int diff = (16 * w + 4 * g + j) - (16 * st + col);
                    const float v = diff >= 0 ? a[j] * __expf((float)diff * lg) : 0.f;
                    *(LAS bf16_t*)(Sc + (4 * g + j) * 272 + (16 * st + col) * 2) = f2bf(v); }
                SCHEDB; });
#pragma unroll
            for (int ks = 0; ks < 4; ++ks) scf[ks] = lds_frag(Sc, 272, 0, 32 * ks, lane);
        }
        static_for<0, 8>([&](auto et_) { constexpr int et = decltype(et_)::value; f32x4 a = (f32x4){0.f, 0.f, 0.f, 0.f};
            bf16x8 f[4]; tr_read4<272, 0, 16 * et>(shb, f);
#pragma unroll
            for (int ks = 0; ks < 4; ++ks) a = mfma16(qf[ks], f[ks], a);
#pragma unroll
            for (int j = 0; j < 4; ++j) a[j] *= __expf((float)(16 * w + 4 * g + j + 1) * lg);
            tr_read4<272, 0, 16 * et>(vhb, f);
#pragma unroll
            for (int ks = 0; ks < 4; ++ks) a = mfma16(scf[ks], f[ks], a);
            o[hh * 8 + et] = a; SCHEDB; });
    });
    const float* gn = p.ret_gn_g + h * 256;
#pragma unroll
    for (int j = 0; j < 4; ++j) {
        float s = 0.f;
#pragma unroll
        for (int t = 0; t < 16; ++t) s += o[t][j];
        const float mean = g16_sum(s) * (1.f / 256.f);
        float s2 = 0.f;
#pragma unroll
        for (int t = 0; t < 16; ++t) { const float dd = o[t][j] - mean; s2 += dd * dd; }
        const float rstd = rsqrtf(g16_sum(s2) * (1.f / 256.f) + EPS);
        bf16_t* gp = P + (row0 + 16 * w + 4 * g + j) * INC + C_G + h * 256;
#pragma unroll
        for (int t = 0; t < 16; ++t) { const int e = (t >> 3) * 128 + (t & 7) * 16 + col;
            gp[e] = f2bf((o[t][j] - mean) * rstd * gn[e] * bf2f(gp[e])); }
        SCHEDB;
    }
    __syncthreads();
}
DEV void sgu_item(const Params& p, LAS unsigned char* lds, int item) {
    const int tid = otid(), lane = tid & 63, w = tid >> 6, g = lane >> 4, col = lane & 15;
    const int gq = item & 3, bn = item >> 2; const size_t row0 = (size_t)bn * 128;
    bf16_t* P = (bf16_t*)(p.ws + OFF_P);
    LAS unsigned char* VN = lds;
    for (int rr = 0; rr < 16; ++rr) { const int s = 16 * w + rr;
        const u32x4 v = *(const u32x4*)(P + (row0 + s) * INC + C_SV + lane * 8);
        float x[8] = {bf_lo(v.x), bf_hi(v.x), bf_lo(v.y), bf_hi(v.y), bf_lo(v.z), bf_hi(v.z), bf_lo(v.w), bf_hi(v.w)};
        float sm = 0.f;
#pragma unroll
        for (int i = 0; i < 8; ++i) sm += x[i];
        const float mean = wave_sum(sm) * (1.f / 512.f); float s2 = 0.f;
#pragma unroll
        for (int i = 0; i < 8; ++i) { x[i] -= mean; s2 += x[i] * x[i]; }
        const float rstd = rsqrtf(wave_sum(s2) * (1.f / 512.f) + EPS);
        if (g == gq) { const float* lg = p.sg_ln_g + lane * 8; u32x4 o;
            o.x = pk2(x[0] * rstd * lg[0], x[1] * rstd * lg[1]); o.y = pk2(x[2] * rstd * lg[2], x[3] * rstd * lg[3]);
            o.z = pk2(x[4] * rstd * lg[4], x[5] * rstd * lg[5]); o.w = pk2(x[6] * rstd * lg[6], x[7] * rstd * lg[7]);
            *(LAS u32x4*)(VN + s * 272 + col * 16) = o; } }
    bf16x8 af[4];
    { const bf16_t* wp = (const bf16_t*)(p.ws + OFF_WTRIL) + (size_t)(gq * 128 + 16 * w + col) * 128 + 8 * g;
#pragma unroll
      for (int ks = 0; ks < 4; ++ks) af[ks] = *(const bf16x8*)(wp + 32 * ks); }
    __syncthreads();
    LAS const unsigned char* vnb = tr_lane_base(VN, 272, lane);
    static_for<0, 8>([&](auto ct_) { constexpr int ct = decltype(ct_)::value; f32x4 a = (f32x4){0.f, 0.f, 0.f, 0.f};
        bf16x8 f[4]; tr_read4<272, 0, 16 * ct>(vnb, f);
#pragma unroll
        for (int ks = 0; ks < 4; ++ks) a = mfma16(af[ks], f[ks], a);
#pragma unroll
        for (int j = 0; j < 4; ++j) { const int t = 16 * w + 4 * g + j; bf16_t* up = P + (row0 + t) * INC + C_SU + gq * 128 + 16 * ct + col;
            *up = f2bf(bf2f(*up) * (a[j] + p.sg_bs[gq * 128 + t])); } });
    __syncthreads();
}
DEV void xattn_item(const Params& p, LAS unsigned char* lds, int item) {
    const int tid = otid(), lane = tid & 63, w = tid >> 6, g = lane >> 4, col = lane & 15;
    const int qt = item & 15, bh = item >> 4, h = bh & 3, b = bh >> 2; const size_t row0 = (size_t)b * 2048 + qt * 128;
    bf16_t* P = (bf16_t*)(p.ws + OFF_P); const bf16_t* mkb = (const bf16_t*)(p.ws + OFF_MKB);
    LAS unsigned char* KV = lds; LAS unsigned char* Pw = lds + 69632 + w * 8448;
    for (int i = tid; i < 4096; i += 512) { const int m = i >> 4, ch = i & 15;
        *(LAS u32x4*)(KV + m * 272 + ch * 16) = *(const u32x4*)(mkb + (size_t)(b * 256 + m) * 1024 + h * 128 + ch * 8); }
    bf16x8 qf[4];
    { const bf16_t* qp = P + (row0 + 16 * w + col) * INC + C_XQ + h * 128 + 8 * g;
#pragma unroll
      for (int ks = 0; ks < 4; ++ks) qf[ks] = *(const bf16x8*)(qp + 32 * ks); }
    __syncthreads();
    f32x4 sc[16];
    static_for<0, 16>([&](auto mt_) { constexpr int mt = decltype(mt_)::value; f32x4 a = (f32x4){0.f, 0.f, 0.f, 0.f};
#pragma unroll
        for (int ks = 0; ks < 4; ++ks) a = mfma16(qf[ks], lds_frag(KV, 272, 16 * mt, 32 * ks, lane), a);
        sc[mt] = a * 0.08838834764831845f; SCHEDB; });
#pragma unroll
    for (int j = 0; j < 4; ++j) { float mx = -3.0e38f;
#pragma unroll
        for (int mt = 0; mt < 16; ++mt) mx = fmaxf(mx, sc[mt][j]);
        mx = g16_max(mx); float sm = 0.f;
#pragma unroll
        for (int mt = 0; mt < 16; ++mt) { const float e = __expf(sc[mt][j] - mx); sc[mt][j] = e; sm += e; }
        const float inv = 1.f / g16_sum(sm);
#pragma unroll
        for (int mt = 0; mt < 16; ++mt) *(LAS bf16_t*)(Pw + (4 * g + j) * 528 + (16 * mt + col) * 2) = f2bf(sc[mt][j] * inv); }
    __syncthreads();
    for (int i = tid; i < 4096; i += 512) { const int m = i >> 4, ch = i & 15;
        *(LAS u32x4*)(KV + m * 272 + ch * 16) = *(const u32x4*)(mkb + (size_t)(b * 256 + m) * 1024 + 512 + h * 128 + ch * 8); }
    __syncthreads();
    LAS const unsigned char* kvb = tr_lane_base(KV, 272, lane);
    bf16x8 pf[8];
#pragma unroll
    for (int ks = 0; ks < 8; ++ks) pf[ks] = lds_frag(Pw, 528, 0, 32 * ks, lane);
    static_for<0, 8>([&](auto dt_) { constexpr int dt = decltype(dt_)::value; f32x4 a = (f32x4){0.f, 0.f, 0.f, 0.f};
        bf16x8 f[4]; tr_read4<272, 0, 16 * dt>(kvb, f);
#pragma unroll
        for (int ks = 0; ks < 4; ++ks) a = mfma16(pf[ks], f[ks], a);
        tr_read4<272, 128, 16 * dt>(kvb, f);
#pragma unroll
        for (int ks = 0; ks < 4; ++ks) a = mfma16(pf[4 + ks], f[ks], a);
#pragma unroll
        for (int j = 0; j < 4; ++j) P[(row0 + 16 * w + 4 * g + j) * INC + C_XQ + h * 128 + 16 * dt + col] = f2bf(a[j]); });
    __syncthreads();
}
DEV void xattn_s_item(const Params& p, LAS unsigned char* lds, int item) {
    const int tid = otid(), lane = tid & 63, w = tid >> 6, l32 = lane & 31, slot = w * 2 + (lane >> 5);
    const int h = item & 3, b = item >> 2; const size_t rowb = (size_t)NP + b * 4;
    bf16_t* P = (bf16_t*)(p.ws + OFF_P);
    LAS float* sc = (LAS float*)lds; LAS float* red = (LAS float*)(lds + 4096);
    float q[4][4];
#pragma unroll
    for (int l = 0; l < 4; ++l) { const u32x2 v = *(const u32x2*)(P + (rowb + l) * INC + C_XQ + h * 128 + 4 * l32); q[l][0] = bf_lo(v.x); q[l][1] = bf_hi(v.x); q[l][2] = bf_lo(v.y); q[l][3] = bf_hi(v.y); }
    for (int it = 0; it < 16; ++it) { const int m = it * 16 + slot;
        const f32x4 kv = *(const f32x4*)(p.cache_k + (((size_t)b * 256 + m) * 4 + h) * 128 + 4 * l32);
#pragma unroll
        for (int l = 0; l < 4; ++l) { float d = q[l][0] * kv.x + q[l][1] * kv.y + q[l][2] * kv.z + q[l][3] * kv.w;
#pragma unroll
            for (int o = 1; o < 32; o <<= 1) d += __shfl_xor(d, o);
            if (l32 == 0) sc[l * 256 + m] = d * 0.08838834764831845f; } }
    __syncthreads();
    if (w < 4) { float v[4]; float mx = -3.0e38f;
#pragma unroll
        for (int i = 0; i < 4; ++i) { v[i] = sc[w * 256 + lane + 64 * i]; mx = fmaxf(mx, v[i]); }
        mx = wave_max(mx); float sm = 0.f;
#pragma unroll
        for (int i = 0; i < 4; ++i) { v[i] = __expf(v[i] - mx); sm += v[i]; }
        const float inv = 1.f / wave_sum(sm);
#pragma unroll
        for (int i = 0; i < 4; ++i) sc[w * 256 + lane + 64 * i] = v[i] * inv; }
    __syncthreads();
    f32x4 o[4];
#pragma unroll
    for (int l = 0; l < 4; ++l) o[l] = (f32x4){0.f, 0.f, 0.f, 0.f};
    for (int it = 0; it < 16; ++it) { const int m = it * 16 + slot;
        const f32x4 vv = *(const f32x4*)(p.cache_v + (((size_t)b * 256 + m) * 4 + h) * 128 + 4 * l32);
#pragma unroll
        for (int l = 0; l < 4; ++l) o[l] += vv * sc[l * 256 + m]; }
#pragma unroll
    for (int l = 0; l < 4; ++l) *(LAS f32x4*)(red + (slot * 4 + l) * 128 + 4 * l32) = o[l];
    __syncthreads();
    { const int l = tid >> 7, d = tid & 127; float s = 0.f;
#pragma unroll
      for (int k = 0; k < 16; ++k) s += red[(k * 4 + l) * 128 + d];
      P[(rowb + l) * INC + C_XQ + h * 128 + d] = f2bf(s); }
    __syncthreads();
}
DEV void ret_s_item(const Params& p, LAS unsigned char* lds, int item) {
    const int tid = otid(), lane = tid & 63, w = tid >> 6;
    const int h = item & 3, b = item >> 2; const size_t rowb = (size_t)NP + b * 4;
    bf16_t* P = (bf16_t*)(p.ws + OFF_P);
    const float lg = log_gamma(h);
    LAS float* qs = (LAS float*)lds;
    LAS float* kr = qs + 512;
    LAS float* vs = kr + 512;
    LAS float* ob = vs + 1024;
    LAS float* scm = ob + 1024;
    LAS float* red = scm + 16;
    { const int t = tid >> 7, d = tid & 127;
      qs[t * 128 + d] = bf2f(P[(rowb + t) * INC + C_Q + h * 128 + d]); kr[t * 128 + d] = bf2f(P[(rowb + t) * INC + C_K + h * 128 + d]);
      vs[t * 256 + d] = bf2f(P[(rowb + t) * INC + C_V + h * 256 + d]); vs[t * 256 + 128 + d] = bf2f(P[(rowb + t) * INC + C_V + h * 256 + 128 + d]); }
    __syncthreads();
    if (tid < 16) { const int t = tid >> 2, s = tid & 3; float d = 0.f;
        for (int k = 0; k < 128; ++k) d += qs[t * 128 + k] * kr[s * 128 + k];
        scm[tid] = (t >= s) ? d * __expf((float)(t - s) * lg) : 0.f; }
    f32x4 v[4], cr[4];
#pragma unroll
    for (int s = 0; s < 4; ++s) { v[s] = *(LAS f32x4*)(vs + s * 256 + 4 * lane); cr[s] = (f32x4){0.f, 0.f, 0.f, 0.f}; }
    const float g4 = __expf(4.f * lg), kd0 = __expf(3.f * lg), kd1 = __expf(2.f * lg), kd2 = __expf(lg);
    const float* S0 = p.state_ret + ((size_t)item * 128) * 256; float* Sn = p.out + O_RETS + ((size_t)item * 128) * 256;
#pragma unroll 4
    for (int dd = 0; dd < 16; ++dd) { const int d = 16 * w + dd;
        const f32x4 s0 = *(const f32x4*)(S0 + d * 256 + 4 * lane);
#pragma unroll
        for (int t = 0; t < 4; ++t) cr[t] += s0 * qs[t * 128 + d];
        f32x4 sn = s0 * g4 + v[0] * (kr[d] * kd0) + v[1] * (kr[128 + d] * kd1) + v[2] * (kr[256 + d] * kd2) + v[3] * kr[384 + d];
        *(f32x4*)(Sn + d * 256 + 4 * lane) = sn; }
#pragma unroll
    for (int t = 0; t < 4; ++t) *(LAS f32x4*)(red + (w * 4 + t) * 256 + 4 * lane) = cr[t];
    __syncthreads();
    { const int t = tid >> 7, e2 = (tid & 127) * 2; const float qd = __expf((float)(t + 1) * lg);
#pragma unroll
      for (int i = 0; i < 2; ++i) { const int e = e2 + i; float c = 0.f;
#pragma unroll
          for (int k = 0; k < 8; ++k) c += red[(k * 4 + t) * 256 + e];
          float in = 0.f;
#pragma unroll
          for (int s = 0; s < 4; ++s) in += scm[t * 4 + s] * vs[s * 256 + e];
          ob[t * 256 + e] = in + c * qd; } }
    __syncthreads();
    if (w < 4) { float x[4]; float sm = 0.f;
#pragma unroll
        for (int i = 0; i < 4; ++i) { x[i] = ob[w * 256 + lane + 64 * i]; sm += x[i]; }
        const float mean = wave_sum(sm) * (1.f / 256.f); float s2 = 0.f;
#pragma unroll
        for (int i = 0; i < 4; ++i) { x[i] -= mean; s2 += x[i] * x[i]; }
        const float rstd = rsqrtf(wave_sum(s2) * (1.f / 256.f) + EPS);
        bf16_t* gp = P + (rowb + w) * INC + C_G + h * 256;
#pragma unroll
        for (int i = 0; i < 4; ++i) { const int e = lane + 64 * i; gp[e] = f2bf(x[i] * rstd * p.ret_gn_g[h * 256 + e] * bf2f(gp[e])); } }
    __syncthreads();
}
DEV void sgu_s_item(const Params& p, LAS unsigned char* lds, int b) {
    const int tid = otid(), lane = tid & 63, w = tid >> 6;
    const size_t rowb = (size_t)NP + b * 4;
    bf16_t* P = (bf16_t*)(p.ws + OFF_P);
    LAS float* part = (LAS float*)lds;
    float x[4];
#pragma unroll
    for (int r = 0; r < 4; ++r) { x[r] = bf2f(P[(rowb + r) * INC + C_SV + tid]); const float s = wave_sum(x[r]); if (lane == 0) part[w * 4 + r] = s; }
    __syncthreads();
    float mean[4];
#pragma unroll
    for (int r = 0; r < 4; ++r) { float s = 0.f;
#pragma unroll
        for (int k = 0; k < 8; ++k) s += part[k * 4 + r];
        mean[r] = s * (1.f / 512.f); }
    __syncthreads();
#pragma unroll
    for (int r = 0; r < 4; ++r) { x[r] -= mean[r]; const float s = wave_sum(x[r] * x[r]); if (lane == 0) part[w * 4 + r] = s; }
    __syncthreads();
    const float lng = p.sg_ln_g[tid]; const int gq = tid >> 7;
    float vn[4];
#pragma unroll
    for (int r = 0; r < 4; ++r) { float s = 0.f;
#pragma unroll
        for (int k = 0; k < 8; ++k) s += part[k * 4 + r];
        vn[r] = x[r] * rsqrtf(s * (1.f / 512.f) + EPS) * lng;
        p.out[O_SGV + ((size_t)b * 4 + r) * 512 + tid] = vn[r]; }
#pragma unroll
    for (int t = 0; t < 4; ++t) { float mx = p.sg_bs[gq * 128 + t];
#pragma unroll
        for (int s = 0; s < 4; ++s) if (s <= t) mx += p.sg_ws[(size_t)(gq * 128 + t) * 128 + s] * vn[s];
        bf16_t* up = P + (rowb + t) * INC + C_SU + tid; *up = f2bf(bf2f(*up) * mx); }
    __syncthreads();
}

DEV void rms_phase(const Params& p, bool final_) {
    const int lane = otid() & 63, gw = obid() * 8 + (otid() >> 6), NGW = gridDim.x * 8;
    for (int r = gw; r < MT; r += NGW) {
        float* xr = p.out + (size_t)r * 1024;
        if (!final_) { rms_row(xr, p.norm_ffn_g, (bf16_t*)(p.ws + OFF_R2) + (size_t)r * 1024, lane); continue; }
        f32x4 v[4]; float s = 0.f;
#pragma unroll
        for (int j = 0; j < 4; ++j) { v[j] = *(const f32x4*)(xr + 4 * lane + 256 * j); s += v[j].x * v[j].x + v[j].y * v[j].y + v[j].z * v[j].z + v[j].w * v[j].w; }
        s = wave_sum(s); const float rr = rsqrtf(s * (1.f / 1024.f) + EPS);
#pragma unroll
        for (int j = 0; j < 4; ++j) { const f32x4 gv = *(const f32x4*)(p.norm_final_g + 4 * lane + 256 * j); *(f32x4*)(xr + 4 * lane + 256 * j) = v[j] * rr * gv; }
    }
}
DEV void conv_phase(const Params& p) {
    const bf16_t* z = (const bf16_t*)(p.ws + OFF_Z); bf16_t* act = (bf16_t*)(p.ws + OFF_ACT);
    const long total = (long)MT * 352;
    for (long idx = (long)obid() * 512 + otid(); idx < total; idx += (long)gridDim.x * 512) {
        const int r = (int)(idx / 352), ch = (int)(idx % 352), c = ch * 8;
        const int tpos = r < NP ? (r & 2047) : ((r - NP) & 3);
        float za[8], zb[8];
#pragma unroll
        for (int i = 0; i < 8; ++i) { za[i] = p.conv_b[c + i]; zb[i] = p.conv_b[FF + c + i]; }
#pragma unroll
        for (int j = 0; j < 3; ++j) {
            const int tp = tpos - 2 + j;
            float xa[8], xb[8];
            if (tp >= 0) { const u32x4 a = *(const u32x4*)(z + (size_t)(r - 2 + j) * FF2 + c), bq = *(const u32x4*)(z + (size_t)(r - 2 + j) * FF2 + FF + c);
                xa[0] = bf_lo(a.x); xa[1] = bf_hi(a.x); xa[2] = bf_lo(a.y); xa[3] = bf_hi(a.y); xa[4] = bf_lo(a.z); xa[5] = bf_hi(a.z); xa[6] = bf_lo(a.w); xa[7] = bf_hi(a.w);
                xb[0] = bf_lo(bq.x); xb[1] = bf_hi(bq.x); xb[2] = bf_lo(bq.y); xb[3] = bf_hi(bq.y); xb[4] = bf_lo(bq.z); xb[5] = bf_hi(bq.z); xb[6] = bf_lo(bq.w); xb[7] = bf_hi(bq.w); }
            else if (r >= NP) { const float* sp = p.state_conv + ((size_t)((r - NP) >> 2) * 2 + (tp + 2)) * FF2;
#pragma unroll
                for (int i = 0; i < 8; ++i) { xa[i] = sp[c + i]; xb[i] = sp[FF + c + i]; } }
            else {
#pragma unroll
                for (int i = 0; i < 8; ++i) { xa[i] = 0.f; xb[i] = 0.f; } }
#pragma unroll
            for (int i = 0; i < 8; ++i) { za[i] += p.conv_w[j * FF2 + c + i] * xa[i]; zb[i] += p.conv_w[j * FF2 + FF + c + i] * xb[i]; }
        }
        u32x4 o; o.x = pk2(gelu_t(za[0]) * zb[0], gelu_t(za[1]) * zb[1]); o.y = pk2(gelu_t(za[2]) * zb[2], gelu_t(za[3]) * zb[3]);
        o.z = pk2(gelu_t(za[4]) * zb[4], gelu_t(za[5]) * zb[5]); o.w = pk2(gelu_t(za[6]) * zb[6], gelu_t(za[7]) * zb[7]);
        *(u32x4*)(act + (size_t)r * FF + c) = o;
    }
}

__global__ __launch_bounds__(512, 2) void mega(Params p, int ph0, int ph1) {
    extern __shared__ __attribute__((aligned(16))) unsigned char shm[];
    LAS unsigned char* lds = (LAS unsigned char*)shm;
    cg::grid_group grid = cg::this_grid();
    const int G = gridDim.x, c = obid();
    unsigned char* ws = p.ws;
    for (int ph = ph0; ph < ph1; ++ph) {
        if (ph == 0 && PHON(0)) phase_prep(p, lds);
        else if (ph == 1 && PHON(1)) {
            Sched1 S{G, c, (const char*)(ws + OFF_R2), (const char*)(ws + OFF_HM), (const char*)(ws + OFF_BTIN), (const char*)(ws + OFF_BTKV)};
            Epi1 E{(bf16_t*)(ws + OFF_P), (bf16_t*)(ws + OFF_MKB), p.out, (const float*)(ws + OFF_ROPEC), (const float*)(ws + OFF_ROPES), p.b_gate};
            pg8::gemm_phase(lds, 1024, 1024, S, E);
        } else if (ph == 2 && PHON(2)) {
            for (int it = c; it < 2688; it += G) {
                if (it < 512) ret_A_item(p, lds, it);
                else if (it < 1024) { if (DBG_XA & 1) xattn_item(p, lds, it - 512); }
                else if (it < 1536) sgu_item(p, lds, it - 1024);
                else if (it < 2048) ret_s_item(p, lds, it - 1536);
                else if (it < 2560) { if (DBG_XA & 2) xattn_s_item(p, lds, it - 2048); }
                else sgu_s_item(p, lds, it - 2560);
            }
        } else if (ph == 3 && PHON(3)) scan_phase(p);
        else if (ph == 4 && PHON(4)) { for (int it = c; it < 512; it += G) ret_C_item(p, lds, it); }
        else if (ph == 5 && PHON(5)) {
            SchedMg S{G, c, (const char*)(ws + OFF_P), (const char*)(ws + OFF_BTMG)};
            EpiMg E{(const bf16_t*)(ws + OFF_P), p.out, (bf16_t*)(ws + OFF_R2)};
            pg8::gemm_phase(lds, INC, 2048, S, E);
        } else if (ph == 6 && PHON(6)) {
            SchedPlain S{G, c, 66, 4, 16, (const char*)(ws + OFF_R2), (const char*)(ws + OFF_BTO), (size_t)524288, (size_t)524288};
            EpiWo E{p.x_prompt, p.x_sample, p.out};
            pg8::gemm_phase(lds, 1024, 1024, S, E);
        } else if (ph == 7 && PHON(7)) rms_phase(p, false);
        else if (ph == 8 && PHON(8)) {
            SchedPlain S{G, c, 66, 22, 16, (const char*)(ws + OFF_R2), (const char*)(ws + OFF_BTUP), (size_t)524288, (size_t)524288};
            EpiUp E{(bf16_t*)(ws + OFF_Z), p.out};
            pg8::gemm_phase(lds, 1024, 1024, S, E);
        } else if (ph == 9 && PHON(9)) conv_phase(p);
        else if (ph == 10 && PHON(10)) {
            SchedPlain S{G, c, 66, 4, 44, (const char*)(ws + OFF_ACT), (const char*)(ws + OFF_BTDN), (size_t)256 * FF * 2, (size_t)256 * FF * 2};
            EpiDn E{p.out};
            pg8::gemm_phase(lds, FF, FF, S, E);
        } else if (PHON(11)) rms_phase(p, true);
        if (ph + 1 < ph1) grid.sync();
    }
}

extern "C" void kernel_launch(void* const* d_in, const int* in_sizes, int n_in, void* d_out, int out_size, void* d_ws, size_t ws_size, hipStream_t stream) {
    static int grid = 0;
    if (grid == 0) {
        if (n_in != 26 || out_size != 39018496 || ws_size < WS_END) { fprintf(stderr, "kernel_launch: unexpected shapes n_in %d out %d ws %zu (need %zu)\n", n_in, out_size, ws_size, (size_t)WS_END); grid = -1; return; }
        int dev = 0, cus = 0, per_cu = 0;
        hipGetDevice(&dev); hipDeviceGetAttribute(&cus, hipDeviceAttributeMultiprocessorCount, dev);
        if (hipFuncSetAttribute((const void*)mega, hipFuncAttributeMaxDynamicSharedMemorySize, LDS_BYTES) != hipSuccess) { fprintf(stderr, "kernel_launch: hipFuncSetAttribute failed\n"); grid = -1; return; }
        if (hipOccupancyMaxActiveBlocksPerMultiprocessor(&per_cu, (const void*)mega, 512, LDS_BYTES) != hipSuccess || per_cu < 1) { fprintf(stderr, "kernel_launch: occupancy query gave %d\n", per_cu); grid = -1; return; }
        grid = cus;
    }
    if (grid < 0) return;
    Params p{};
    const float** f = (const float**)&p;
    for (int i = 0; i < 26; ++i) f[i] = (const float*)d_in[i];
    p.out = (float*)d_out; p.ws = (unsigned char*)d_ws;
#ifndef DBG_NPH
#define DBG_NPH 12
#endif
#ifndef MK_MULTI
#define MK_MULTI 0
#endif
#if MK_MULTI
    for (int ph = 0; ph < DBG_NPH; ++ph) hipLaunchKernelGGL(mega, dim3(grid), dim3(512), LDS_BYTES, stream, p, ph, ph + 1);
    hipError_t e = hipSuccess;
#else
    int ph0 = 0, ph1 = NPHASE;
    void* args[] = {&p, &ph0, &ph1};
    hipError_t e = hipLaunchCooperativeKernel((const void*)mega, dim3(grid), dim3(512), args, LDS_BYTES, stream);
#endif
    if (e != hipSuccess) fprintf(stderr, "cooperative launch failed: %s (grid %d)\n", hipGetErrorString(e), grid);
}
```

```cpp
#include <hip/hip_runtime.h>
#include <hip/hip_cooperative_groups.h>
#include <cstdio>
#include <cstdint>
namespace cg = cooperative_groups;

#define LAS __attribute__((address_space(3)))
#define DEV __device__ __forceinline__
typedef unsigned short bf16_t;
typedef short bf16x8 __attribute__((ext_vector_type(8)));
typedef short s16x4 __attribute__((ext_vector_type(4)));
typedef float f32x4 __attribute__((ext_vector_type(4)));
typedef unsigned u32x4 __attribute__((ext_vector_type(4)));
typedef unsigned u32x2 __attribute__((ext_vector_type(2)));

constexpr int NP = 16384, NS = 512, MT = 16896, INC = 7680, FF = 2816, FF2 = 5632;
constexpr int C_Q = 0, C_K = 512, C_V = 1024, C_G = 2048, C_SU = 3072, C_XQ = 3584, C_SV = 4096, C_GT = 4608;
constexpr float EPS = 1e-6f;
constexpr size_t OFF_BTIN = 0;
constexpr size_t OFF_BTKV = OFF_BTIN + 15728640;
constexpr size_t OFF_BTMG = OFF_BTKV + 2097152;
constexpr size_t OFF_BTO = OFF_BTMG + 4194304;
constexpr size_t OFF_BTUP = OFF_BTO + 2097152;
constexpr size_t OFF_BTDN = OFF_BTUP + 11534336;
constexpr size_t OFF_ROPEC = OFF_BTDN + 5767168;
constexpr size_t OFF_ROPES = OFF_ROPEC + 525312;
constexpr size_t OFF_WTRIL = OFF_ROPES + 525312;
constexpr size_t OFF_HM = OFF_WTRIL + 131072;
constexpr size_t OFF_MKB = OFF_HM + 4194304;
constexpr size_t OFF_P = OFF_MKB + 4194304;
constexpr size_t OFF_R2 = OFF_P + 259522560;
constexpr size_t OFF_MG32 = OFF_R2 + 34603008;
constexpr size_t WS_END = OFF_MG32 + 8 * 2097152;
constexpr size_t OFF_PART6 = OFF_P, OFF_PART10 = OFF_P;
constexpr int SROWS = 512 * 1024;
constexpr size_t OFF_Z = OFF_P;
constexpr size_t OFF_ACT = OFF_P + 190316544;
constexpr size_t O_Y = 0, O_RETP = 17301504, O_CONVP = 18350080, O_MK = 18440192, O_MV = 19488768, O_RETS = 20537344, O_CONVS = 37314560, O_SGV = 38756352;
constexpr int LDS_BYTES = 147456;
constexpr int NPHASE = 12;
#ifndef DBG_XA
#define DBG_XA 3
#endif
#ifndef ONLY_PH
#define ONLY_PH -1
#endif
#ifndef SKIP_PH
#define SKIP_PH -2
#endif
#define PHON(n) ((ONLY_PH < 0 || ONLY_PH == (n)) && SKIP_PH != (n))

struct Params {
    const float *x_prompt, *x_sample, *mem_prompt, *state_ret, *state_conv, *cache_k, *cache_v, *norm_mix_g, *w_in, *b_gate, *ret_gn_g, *sg_ln_g, *sg_ws, *sg_bs,
        *mem_norm_g, *w_mem_kv, *w_br_ret, *w_br_sg, *w_br_x, *w_o, *norm_ffn_g, *w_up, *conv_w, *conv_b, *w_down, *norm_final_g;
    float* out; unsigned char* ws;
};

typedef __bf16 bf16v2_t __attribute__((ext_vector_type(2)));
typedef float f32x2_t __attribute__((ext_vector_type(2)));
DEV unsigned pk2(float lo, float hi) { const f32x2_t f = {lo, hi}; const bf16v2_t v = __builtin_convertvector(f, bf16v2_t); return __builtin_bit_cast(unsigned, v); }
DEV bf16_t f2bf(float v) { return (bf16_t)(pk2(v, 0.f) & 0xffffu); }
DEV float bf_lo(unsigned u) { return __uint_as_float(u << 16); }
DEV float bf_hi(unsigned u) { return __uint_as_float(u & 0xffff0000u); }
DEV float bf2f(bf16_t b) { return __uint_as_float(((unsigned)b) << 16); }
DEV float wave_sum(float v) {
#pragma unroll
    for (int o = 1; o < 64; o <<= 1) v += __shfl_xor(v, o);
    return v; }
DEV float wave_max(float v) {
#pragma unroll
    for (int o = 1; o < 64; o <<= 1) v = fmaxf(v, __shfl_xor(v, o));
    return v; }
DEV float g16_sum(float v) {
#pragma unroll
    for (int o = 1; o < 16; o <<= 1) v += __shfl_xor(v, o);
    return v; }
DEV float g16_max(float v) {
#pragma unroll
    for (int o = 1; o < 16; o <<= 1) v = fmaxf(v, __shfl_xor(v, o));
    return v; }
DEV float gelu_t(float x) { const float u = 1.5957691216057308f * (x + 0.044715f * x * x * x); return x / (1.f + __expf(-u)); }
DEV float silu_f(float x) { return x / (1.f + __expf(-x)); }
DEV float sigm_f(float x) { return 1.f / (1.f + __expf(-x)); }
DEV float log_gamma(int h) { return log1pf(-exp2f(-5.f - (float)h)); }
DEV int otid() { int t = threadIdx.x; asm volatile("" : "+v"(t)); return t; }
DEV int obid() { int t = blockIdx.x; asm volatile("" : "+s"(t)); return t; }
DEV unsigned ldsaddr(LAS const void* p) { return (unsigned)(uintptr_t)p; }
DEV f32x4 mfma16(bf16x8 a, bf16x8 b, f32x4 c) { return __builtin_amdgcn_mfma_f32_16x16x32_bf16(a, b, c, 0, 0, 0); }
DEV bf16x8 lds_frag(LAS const unsigned char* base, int pitch, int row0, int k0, int lane) {
    return *(LAS const bf16x8*)(base + (row0 + (lane & 15)) * pitch + (k0 + 8 * (lane >> 4)) * 2); }
DEV LAS const unsigned char* tr_lane_base(LAS const unsigned char* base, int pitch, int lane) { const int g = lane >> 4, q = (lane & 15) >> 2, pp = lane & 3; return base + ((8 * g + q) * pitch + 8 * pp); }
template <int PITCH, int KB, int X0> DEV void tr_read4(LAS const unsigned char* a, bf16x8 (&f)[4]) {
    constexpr int o0 = KB * PITCH + X0 * 2;
    static_assert(o0 + 100 * PITCH < 65536, "ds offset field");
#pragma unroll
    for (int ks = 0; ks < 4; ++ks) {
        const s16x4 lo = __builtin_amdgcn_ds_read_tr16_b64_v4i16((LAS s16x4*)(a + o0 + ks * 32 * PITCH));
        const s16x4 hi = __builtin_amdgcn_ds_read_tr16_b64_v4i16((LAS s16x4*)(a + o0 + ks * 32 * PITCH + 4 * PITCH));
        f[ks] = (bf16x8){lo[0], lo[1], lo[2], lo[3], hi[0], hi[1], hi[2], hi[3]}; } }
template <int V> struct IC { static constexpr int value = V; };
template <int I, int N, class F> DEV void static_for(F&& f) { if constexpr (I < N) { f(IC<I>{}); static_for<I + 1, N>(f); } }
#define SCHEDB __builtin_amdgcn_sched_barrier(0)

namespace pg8 {
constexpr int BM = 256, BK = 64, HALF = 128, HTB = HALF * BK * 2, NXCD = 8, WGM = 8;
DEV int lds_byte(int r, int c) { const int st = (r >> 4) * 2 + (c >> 5), rr = r & 15, cc = c & 31, ob = rr * 64 + cc * 2; return st * 1024 + (ob ^ (((ob >> 9) & 1) << 5)); }
DEV void stage_rc(int b, int& R, int& C) { const int st = b / 1024, sb = b % 1024, swz = sb ^ (((sb >> 9) & 1) << 5); R = (st >> 1) * 16 + swz / 64; C = (st & 1) * 32 + (swz % 64) / 2; }
DEV int perm32(int rho) { const int n = rho >> 4, i = rho & 15; return 8 * (i >> 2) + 4 * n + (i & 3); }
struct Unit { int pm, pn, kind, nt; const char* A; const char* B; };
DEV void tile_map(int L, int nM, int nN, int& pm, int& pn) {
    const int nwg = nM * nN; int wgid = L; { const int q = nwg / NXCD, r = nwg % NXCD, xcd = wgid % NXCD, off = wgid / NXCD; wgid = (xcd < r ? xcd * (q + 1) : r * (q + 1) + (xcd - r) * q) + off; }
    const int nig = WGM * nN, gid = wgid / nig, fm = gid * WGM, gsz = (nM - fm) < WGM ? (nM - fm) : WGM;
    pm = fm + ((wgid % nig) % gsz); pn = (wgid % nig) / gsz; }

template <class Epi, class Sched>
DEV void gemm_phase(LAS unsigned char* lds, int lda, int ldb, const Sched& S, const Epi& E) {
    const int tid = otid(), wid = __builtin_amdgcn_readfirstlane(tid >> 6), lane = tid & 63, wr = wid >> 2, wc = wid & 3, fr = lane & 15, fq = lane >> 4;
    unsigned voffA[2], voffB[2];
#pragma unroll
    for (int i = 0; i < 2; ++i) { int R, C; stage_rc(tid * 16 + i * 8192, R, C); const int Rb = (R & ~31) + perm32(R & 31);
        voffA[i] = (unsigned)(R * lda + C) * 2u; voffB[i] = (unsigned)(Rb * ldb + C) * 2u; }
    const size_t kstep = (size_t)(BK * 2);
    const size_t hstepA = (size_t)HALF * lda * 2, hstepB = (size_t)HALF * ldb * 2;
    const unsigned ldsw = (unsigned)wid * 1024u;
    const int aoff = lds_byte(wr * 64 + fr, fq * 8), boff = lds_byte(wc * 32 + fr, fq * 8);
#define PG8_SA(b, h) (((b) * 2 + (h)) * HTB)
#define PG8_SB(b, h) ((4 + (b) * 2 + (h)) * HTB)
#define PG8_STAGE(bufoff, gbase, voff) do { _Pragma("unroll") for (int _i = 0; _i < 2; ++_i) \
        __builtin_amdgcn_global_load_lds((const unsigned*)((const char*)(gbase) + (voff)[_i]), (LAS unsigned*)(lds + (bufoff) + ldsw + _i * 8192), 16, 0, 0); } while (0)
#define PG8_LDA(dst, b, h) do { _Pragma("unroll") for (int m = 0; m < 4; ++m) _Pragma("unroll") for (int k = 0; k < 2; ++k) dst[m][k] = *(const LAS bf16x8*)(lds + PG8_SA(b, h) + aoff + m * 2048 + k * 1024); } while (0)
#define PG8_LDB(dst, b, h) do { _Pragma("unroll") for (int n = 0; n < 2; ++n) _Pragma("unroll") for (int k = 0; k < 2; ++k) dst[n][k] = *(const LAS bf16x8*)(lds + PG8_SB(b, h) + boff + n * 2048 + k * 1024); } while (0)
#define PG8_MMA(ai, bj, At, Bt) do { __builtin_amdgcn_s_setprio(1); _Pragma("unroll") for (int m = 0; m < 4; ++m) _Pragma("unroll") for (int n = 0; n < 2; ++n) _Pragma("unroll") for (int k = 0; k < 2; ++k) \
        acc[ai][bj][m][n] = __builtin_amdgcn_mfma_f32_16x16x32_bf16(Bt[n][k], At[m][k], acc[ai][bj][m][n], 0, 0, 0); __builtin_amdgcn_s_setprio(0); } while (0)
#define PG8_WAIT_V(n) asm volatile("s_waitcnt vmcnt(" #n ")" ::: "memory")
#define PG8_WAIT_L(n) asm volatile("s_waitcnt lgkmcnt(" #n ")" ::: "memory")
#define PG8_BAR __builtin_amdgcn_s_barrier()
#define PG8_SCHED __builtin_amdgcn_sched_barrier(0)
    Unit cur, nxt; int ui = 0;
    if (!S.next(0, cur)) return;
    f32x4 acc[2][2][4][2];
#pragma unroll
    for (int a = 0; a < 2; ++a)
#pragma unroll
        for (int b = 0; b < 2; ++b)
#pragma unroll
            for (int m = 0; m < 4; ++m)
#pragma unroll
                for (int n = 0; n < 2; ++n) acc[a][b][m][n] = (f32x4){0.f, 0.f, 0.f, 0.f};
    bf16x8 At[4][2], B0[2][2], B1[2][2];
    const char* cA = cur.A; const char* cB = cur.B;
    PG8_STAGE(PG8_SB(0, 0), cB, voffB); PG8_STAGE(PG8_SA(0, 0), cA, voffA); PG8_STAGE(PG8_SB(0, 1), cB + hstepB, voffB); PG8_STAGE(PG8_SA(0, 1), cA + hstepA, voffA);
    if (wr == 1) PG8_BAR;
    PG8_WAIT_V(4); PG8_BAR;
    PG8_STAGE(PG8_SB(1, 0), cB + kstep, voffB); PG8_STAGE(PG8_SA(1, 0), cA + kstep, voffA); PG8_STAGE(PG8_SB(1, 1), cB + hstepB + kstep, voffB);
    PG8_WAIT_V(6); PG8_BAR;
    for (;;) {
        const bool has_next = S.next(ui + 1, nxt);
        const char* nA = has_next ? nxt.A : cA; const char* nB = has_next ? nxt.B : cB;
        const int nt = cur.nt;
        for (int t = 0; t < nt; t += 2) {
            const bool last = (t == nt - 2);
            const char* a1 = cA + (size_t)(t + 1) * kstep;
            const char* a2 = last ? nA : cA + (size_t)(t + 2) * kstep; const char* b2 = last ? nB : cB + (size_t)(t + 2) * kstep;
            const char* a3 = a2 + kstep; const char* b3 = b2 + kstep;
            PG8_LDB(B0, 0, 0); PG8_SCHED; PG8_LDA(At, 0, 0); PG8_STAGE(PG8_SA(1, 1), a1 + hstepA, voffA);
            PG8_WAIT_L(8); PG8_BAR; PG8_WAIT_L(0); PG8_MMA(0, 0, At, B0); PG8_BAR; PG8_SCHED;
            PG8_LDB(B1, 0, 1); PG8_STAGE(PG8_SB(0, 0), b2, voffB);
            PG8_BAR; PG8_WAIT_L(0); PG8_MMA(0, 1, At, B1); PG8_BAR;
            PG8_LDA(At, 0, 1); PG8_STAGE(PG8_SA(0, 0), a2, voffA);
            PG8_BAR; PG8_WAIT_L(0); PG8_MMA(1, 0, At, B0); PG8_BAR; PG8_SCHED;
            PG8_STAGE(PG8_SB(0, 1), b2 + hstepB, voffB);
            PG8_WAIT_V(6); PG8_BAR; PG8_MMA(1, 1, At, B1); PG8_BAR;
            PG8_LDB(B0, 1, 0); PG8_SCHED; PG8_LDA(At, 1, 0); PG8_STAGE(PG8_SA(0, 1), a2 + hstepA, voffA);
            PG8_WAIT_L(8); PG8_BAR; PG8_WAIT_L(0); PG8_MMA(0, 0, At, B0); PG8_BAR; PG8_SCHED;
            PG8_LDB(B1, 1, 1); PG8_STAGE(PG8_SB(1, 0), b3, voffB);
            PG8_BAR; PG8_WAIT_L(0); PG8_MMA(0, 1, At, B1); PG8_BAR;
            PG8_LDA(At, 1, 1); PG8_STAGE(PG8_SA(1, 0), a3, voffA);
            PG8_BAR; PG8_WAIT_L(0); PG8_MMA(1, 0, At, B0); PG8_BAR; PG8_SCHED;
            PG8_STAGE(PG8_SB(1, 1), b3 + hstepB, voffB);
            PG8_WAIT_V(6); PG8_BAR; PG8_MMA(1, 1, At, B1); PG8_BAR;
        }
        E(acc, cur, wr, wc, fr, fq);
        if (!has_next) break;
#pragma unroll
        for (int a = 0; a < 2; ++a)
#pragma unroll
            for (int b = 0; b < 2; ++b)
#pragma unroll
                for (int m = 0; m < 4; ++m)
#pragma unroll
                    for (int n = 0; n < 2; ++n) acc[a][b][m][n] = (f32x4){0.f, 0.f, 0.f, 0.f};
        cur = nxt; cA = nA; cB = nB; ++ui;
    }
    PG8_WAIT_V(0);
    if (wr == 0) PG8_BAR;
    PG8_BAR;
#undef PG8_SA
#undef PG8_SB
#undef PG8_STAGE
#undef PG8_LDA
#undef PG8_LDB
#undef PG8_MMA
#undef PG8_WAIT_V
#undef PG8_WAIT_L
#undef PG8_BAR
#undef PG8_SCHED
}
#define EPI_LOOP_BEGIN \
    _Pragma("unroll") for (int ai = 0; ai < 2; ++ai) _Pragma("unroll") for (int m = 0; m < 4; ++m) { const int row = u.pm * 256 + ai * 128 + wr * 64 + m * 16 + fr; \
    _Pragma("unroll") for (int bj = 0; bj < 2; ++bj) { const int col0 = u.pn * 256 + bj * 128 + wc * 32 + fq * 8; const f32x4 v0 = acc[ai][bj][m][0], v1 = acc[ai][bj][m][1];
#define EPI_LOOP_END } }
}
using pg8::Unit;
typedef f32x4 AccT[2][2][4][2];

struct Sched1 { int G, c; const char *h, *hm, *btin, *btkv;
    DEV bool next(int i, Unit& u) const {
        long L = (long)i * G + c;
        if (L < 1980) { pg8::tile_map((int)L, 66, 30, u.pm, u.pn); u.kind = 0; u.nt = 16; u.A = h + (size_t)u.pm * 524288; u.B = btin + (size_t)u.pn * 524288; return true; }
        L -= 1980; if (L < 32) { u.pm = (int)(L & 7); u.pn = (int)(L >> 3); u.kind = 1; u.nt = 16; u.A = hm + (size_t)u.pm * 524288; u.B = btkv + (size_t)u.pn * 524288; return true; }
        return false; } };
struct Epi1 { bf16_t* P; bf16_t* mkb; float* out; const float *ropeC, *ropeS, *b_gate;
    DEV void operator()(const AccT& acc, const Unit& u, int wr, int wc, int fr, int fq) const {
        if (u.kind == 1) {
            EPI_LOOP_BEGIN
                float* o = (col0 < 512) ? out + O_MK + (size_t)row * 512 + col0 : out + O_MV + (size_t)row * 512 + (col0 - 512);
                *(f32x4*)o = v0; *(f32x4*)(o + 4) = v1;
                u32x4 pk; pk.x = pk2(v0.x, v0.y); pk.y = pk2(v0.z, v0.w); pk.z = pk2(v1.x, v1.y); pk.w = pk2(v1.z, v1.w);
                *(u32x4*)(mkb + (size_t)row * 1024 + col0) = pk;
            EPI_LOOP_END
            return; }
        const int pn = u.pn;
        if (pn < 4) {
            const float sc = (pn >= 2) ? 0.08838834764831845f : 1.f;
            EPI_LOOP_BEGIN
                const int pidx = row < NP ? (row & 2047) : 2048 + ((row - NP) & 3);
                const int uu = (col0 & 127) >> 3, hb = col0 & ~127;
                const f32x4 cs = *(const f32x4*)(ropeC + pidx * 64 + 4 * uu), sn = *(const f32x4*)(ropeS + pidx * 64 + 4 * uu);
                const f32x4 o1 = (v0 * cs - v1 * sn) * sc, o2 = (v0 * sn + v1 * cs) * sc;
                u32x2 a; a.x = pk2(o1.x, o1.y); a.y = pk2(o1.z, o1.w); u32x2 b; b.x = pk2(o2.x, o2.y); b.y = pk2(o2.z, o2.w);
                *(u32x2*)(P + (size_t)row * INC + hb + 4 * uu) = a; *(u32x2*)(P + (size_t)row * INC + hb + 64 + 4 * uu) = b;
            EPI_LOOP_END
            return; }
        const int mode = pn < 8 ? 0 : pn < 12 ? 1 : pn < 14 ? 2 : pn < 16 ? 0 : pn < 18 ? 2 : 3;
        EPI_LOOP_BEGIN
            f32x4 a = v0, b = v1;
            if (mode == 1) { for (int i = 0; i < 4; ++i) { a[i] = silu_f(a[i]); b[i] = silu_f(b[i]); } }
            else if (mode == 2) { for (int i = 0; i < 4; ++i) { a[i] = gelu_t(a[i]); b[i] = gelu_t(b[i]); } }
            else if (mode == 3) { const f32x4 b0 = *(const f32x4*)(b_gate + col0 - C_GT), b1 = *(const f32x4*)(b_gate + col0 - C_GT + 4);
                for (int i = 0; i < 4; ++i) { a[i] = sigm_f(a[i] + b0[i]); b[i] = sigm_f(b[i] + b1[i]); } }
            u32x4 pk; pk.x = pk2(a.x, a.y); pk.y = pk2(a.z, a.w); pk.z = pk2(b.x, b.y); pk.w = pk2(b.z, b.w);
            *(u32x4*)(P + (size_t)row * INC + col0) = pk;
        EPI_LOOP_END
    } };

struct SchedMg { int G, c; const char *P, *bt;
    DEV bool next(int i, Unit& u) const {
        const int T = i / 3, br = i - 3 * T; const long L = (long)T * G + c; if (L >= 256) return false;
        pg8::tile_map((int)L, 64, 4, u.pm, u.pn); u.kind = br; u.nt = br == 0 ? 16 : 8;
        const int koff = br == 0 ? 0 : br == 1 ? 1024 : 1536;
        u.A = P + (size_t)u.pm * 256 * INC * 2 + (size_t)(C_G + koff) * 2; u.B = bt + (size_t)u.pn * 256 * 2048 * 2 + (size_t)koff * 2; return true; } };
struct SchedMgS { int c; const char *P, *bt;
    DEV bool next(int i, Unit& u) const {
        if (i > 0 || c >= 64) return false;
        const int tile = c >> 3, ch = c & 7; u.pm = 64 + (tile >> 2); u.pn = tile & 3; u.kind = ch; u.nt = 4;
        const int koff = ch * 256;
        u.A = P + (size_t)u.pm * 256 * INC * 2 + (size_t)(C_G + koff) * 2; u.B = bt + (size_t)u.pn * 256 * 2048 * 2 + (size_t)koff * 2; return true; } };
struct EpiMg { const bf16_t* P; float* tmp; bf16_t* mg;
    DEV void operator()(const AccT& acc, const Unit& u, int wr, int wc, int fr, int fq) const {
        const int br = u.kind;
        EPI_LOOP_BEGIN
            const u32x4 g = *(const u32x4*)(P + (size_t)row * INC + C_GT + br * 1024 + col0);
            f32x4 a, b; a.x = bf_lo(g.x) * v0.x; a.y = bf_hi(g.x) * v0.y; a.z = bf_lo(g.y) * v0.z; a.w = bf_hi(g.y) * v0.w;
            b.x = bf_lo(g.z) * v1.x; b.y = bf_hi(g.z) * v1.y; b.z = bf_lo(g.w) * v1.z; b.w = bf_hi(g.w) * v1.w;
            float* t = tmp + (size_t)row * 1024 + col0;
            if (br > 0) { a += *(const f32x4*)t; b += *(const f32x4*)(t + 4); }
            if (br < 2) { *(f32x4*)t = a; *(f32x4*)(t + 4) = b; }
            else { u32x4 pk; pk.x = pk2(a.x, a.y); pk.y = pk2(a.z, a.w); pk.z = pk2(b.x, b.y); pk.w = pk2(b.z, b.w); *(u32x4*)(mg + (size_t)row * 1024 + col0) = pk; }
        EPI_LOOP_END
    } };
struct EpiMgS { const bf16_t* P; float* part;
    DEV void operator()(const AccT& acc, const Unit& u, int wr, int wc, int fr, int fq) const {
        const int ch = u.kind, br = ch < 4 ? 0 : ch < 6 ? 1 : 2;
        const bf16_t* gp = P + C_GT + br * 1024; float* tp = part + (size_t)ch * SROWS - (size_t)NP * 1024;
        EPI_LOOP_BEGIN
            const u32x4 g = *(const u32x4*)(gp + (size_t)row * INC + col0);
            float* t = tp + (size_t)row * 1024 + col0;
            f32x4 a, b; a.x = bf_lo(g.x) * v0.x; a.y = bf_hi(g.x) * v0.y; a.z = bf_lo(g.y) * v0.z; a.w = bf_hi(g.y) * v0.w;
            b.x = bf_lo(g.z) * v1.x; b.y = bf_hi(g.z) * v1.y; b.z = bf_lo(g.w) * v1.z; b.w = bf_hi(g.w) * v1.w;
            *(f32x4*)t = a; *(f32x4*)(t + 4) = b; SCHEDB;
        EPI_LOOP_END
    } };
template <int nt, int nsub, int nchunk, int astep, int bstep> struct SchedPS { int G, c; const char *A, *B;
    DEV bool next(int i, Unit& u) const {
        const long L = (long)i * G + c;
        if (L < 256) { pg8::tile_map((int)L, 64, 4, u.pm, u.pn); u.kind = 0; u.nt = nt; u.A = A + (size_t)u.pm * astep; u.B = B + (size_t)u.pn * bstep; return true; }
        const int s = (int)(L - 256); if (s >= nsub) return false;
        const int tile = s / nchunk, ch = s - tile * nchunk; u.pm = 64 + (tile >> 2); u.pn = tile & 3; u.kind = 1 + ch; u.nt = 2;
        u.A = A + (size_t)u.pm * astep + (size_t)ch * 256; u.B = B + (size_t)u.pn * bstep + (size_t)ch * 256; return true; } };
struct SchedPlain { int G, c, nM, nN, nt; const char *A, *B; size_t astep, bstep;
    DEV bool next(int i, Unit& u) const {
        const long L = (long)i * G + c; if (L >= (long)nM * nN) return false;
        pg8::tile_map((int)L, nM, nN, u.pm, u.pn); u.kind = 0; u.nt = nt; u.A = A + (size_t)u.pm * astep; u.B = B + (size_t)u.pn * bstep; return true; } };
struct EpiWo { const float *xp, *xs; float* out; float* part;
    DEV void operator()(const AccT& acc, const Unit& u, int wr, int wc, int fr, int fq) const {
        if (u.kind >= 1) {
            EPI_LOOP_BEGIN
                float* t = part + (size_t)(u.kind - 1) * SROWS + (size_t)(row - NP) * 1024 + col0; *(f32x4*)t = v0; *(f32x4*)(t + 4) = v1;
            EPI_LOOP_END
            return; }
        EPI_LOOP_BEGIN
            const float* x = (row < NP ? xp + (size_t)row * 1024 : xs + (size_t)(row - NP) * 1024) + col0;
            float* o = out + (size_t)row * 1024 + col0;
            *(f32x4*)o = *(const f32x4*)x + v0; *(f32x4*)(o + 4) = *(const f32x4*)(x + 4) + v1;
        EPI_LOOP_END
    } };
struct EpiUp { bf16_t* z; float* out;
    DEV void operator()(const AccT& acc, const Unit& u, int wr, int wc, int fr, int fq) const {
        EPI_LOOP_BEGIN
            u32x4 pk; pk.x = pk2(v0.x, v0.y); pk.y = pk2(v0.z, v0.w); pk.z = pk2(v1.x, v1.y); pk.w = pk2(v1.z, v1.w);
            *(u32x4*)(z + (size_t)row * FF2 + col0) = pk;
            float* o = nullptr;
            if (row < NP) { const int t = row & 2047; if (t >= 2046) o = out + O_CONVP + ((size_t)(row >> 11) * 2 + (t - 2046)) * FF2 + col0; }
            else { const int rs = row - NP, t = rs & 3; if (t >= 2) o = out + O_CONVS + ((size_t)(rs >> 2) * 2 + (t - 2)) * FF2 + col0; }
            if (o) { *(f32x4*)o = v0; *(f32x4*)(o + 4) = v1; }
        EPI_LOOP_END
    } };
struct EpiDn { float* out; float* part;
    DEV void operator()(const AccT& acc, const Unit& u, int wr, int wc, int fr, int fq) const {
        if (u.kind >= 1) {
            EPI_LOOP_BEGIN
                float* t = part + (size_t)(u.kind - 1) * SROWS + (size_t)(row - NP) * 1024 + col0; *(f32x4*)t = v0; *(f32x4*)(t + 4) = v1;
            EPI_LOOP_END
            return; }
        EPI_LOOP_BEGIN
            float* o = out + (size_t)row * 1024 + col0;
            *(f32x4*)o = *(const f32x4*)o + v0; *(f32x4*)(o + 4) = *(const f32x4*)(o + 4) + v1;
        EPI_LOOP_END
    } };

DEV int srccol_in(int p) {
    if (p < 1024) { const int hb = p & ~127, pp = p & 127, uu = pp >> 3, v = pp & 7; return hb + ((v < 4) ? 4 * uu + v : 64 + 4 * uu + (v - 4)); }
    if (p >= C_XQ && p < C_SV) return p + 512;
    if (p >= C_SV && p < C_GT) return p - 512;
    return p; }
DEV void transpose_item(const float* W, int N, bf16_t* WT, int ldk, int koff, LAS float* scr, int k0, int n0, int srccol, int lane) {
#pragma unroll 8
    for (int i = 0; i < 32; ++i) { const int kk = 2 * i + (lane >> 5); scr[kk * 33 + (lane & 31)] = W[(size_t)(k0 + kk) * N + srccol]; }
    const int c = lane & 7;
#pragma unroll
    for (int j = 0; j < 4; ++j) { const int n = (lane >> 3) + 8 * j; const LAS float* s = scr + (8 * c) * 33 + n;
        u32x4 o; o.x = pk2(s[0 * 33], s[1 * 33]); o.y = pk2(s[2 * 33], s[3 * 33]); o.z = pk2(s[4 * 33], s[5 * 33]); o.w = pk2(s[6 * 33], s[7 * 33]);
        *(u32x4*)(WT + (size_t)(n0 + n) * ldk + koff + k0 + 8 * c) = o; }
}
DEV void rms_row(const float* xrow, const float* g, bf16_t* orow, int lane) {
    f32x4 v[4]; float s = 0.f;
#pragma unroll
    for (int j = 0; j < 4; ++j) { v[j] = *(const f32x4*)(xrow + 4 * lane + 256 * j); s += v[j].x * v[j].x + v[j].y * v[j].y + v[j].z * v[j].z + v[j].w * v[j].w; }
    s = wave_sum(s); const float r = rsqrtf(s * (1.f / 1024.f) + EPS);
#pragma unroll
    for (int j = 0; j < 4; ++j) { const f32x4 gv = *(const f32x4*)(g + 4 * lane + 256 * j);
        u32x2 o; o.x = pk2(v[j].x * r * gv.x, v[j].y * r * gv.y); o.y = pk2(v[j].z * r * gv.z, v[j].w * r * gv.w);
        *(u32x2*)(orow + 4 * lane + 256 * j) = o; }
}
DEV void phase_prep(const Params& p, LAS unsigned char* lds) {
    const int tid = otid(), lane = tid & 63, wave = tid >> 6;
    const int gw = obid() * 8 + wave, NGW = gridDim.x * 8;
    LAS float* scr = (LAS float*)(lds + wave * 8448);
    unsigned char* ws = p.ws;
    constexpr int I_IN = 16 * 240, I_KV = 16 * 32, I_MR = 16 * 32, I_MS = 8 * 32, I_MX = 8 * 32, I_O = 16 * 32, I_UP = 16 * 176, I_DN = 44 * 32;
    constexpr int N_TR = I_IN + I_KV + I_MR + I_MS + I_MX + I_O + I_UP + I_DN;
    constexpr int N_RMS = MT + 2048, N_ROPE = 2052, N_TRIL = 512;
    constexpr int N_ALL = N_TR + N_RMS + N_ROPE + N_TRIL;
    for (int it = gw; it < N_ALL; it += NGW) {
        int r = it;
        if (r < N_TR) {
            const int l31 = lane & 31;
            if (r < I_IN) { const int kb = r / 240, nb = r % 240; transpose_item(p.w_in, INC, (bf16_t*)(ws + OFF_BTIN), 1024, 0, scr, 64 * kb, 32 * nb, srccol_in(32 * nb + l31), lane); continue; } r -= I_IN;
            if (r < I_KV) { const int kb = r / 32, nb = r % 32; transpose_item(p.w_mem_kv, 1024, (bf16_t*)(ws + OFF_BTKV), 1024, 0, scr, 64 * kb, 32 * nb, 32 * nb + l31, lane); continue; } r -= I_KV;
            if (r < I_MR) { const int kb = r / 32, nb = r % 32; transpose_item(p.w_br_ret, 1024, (bf16_t*)(ws + OFF_BTMG), 2048, 0, scr, 64 * kb, 32 * nb, 32 * nb + l31, lane); continue; } r -= I_MR;
            if (r < I_MS) { const int kb = r / 32, nb = r % 32; transpose_item(p.w_br_sg, 1024, (bf16_t*)(ws + OFF_BTMG), 2048, 1024, scr, 64 * kb, 32 * nb, 32 * nb + l31, lane); continue; } r -= I_MS;
            if (r < I_MX) { const int kb = r / 32, nb = r % 32; transpose_item(p.w_br_x, 1024, (bf16_t*)(ws + OFF_BTMG), 2048, 1536, scr, 64 * kb, 32 * nb, 32 * nb + l31, lane); continue; } r -= I_MX;
            if (r < I_O) { const int kb = r / 32, nb = r % 32; transpose_item(p.w_o, 1024, (bf16_t*)(ws + OFF_BTO), 1024, 0, scr, 64 * kb, 32 * nb, 32 * nb + l31, lane); continue; } r -= I_O;
            if (r < I_UP) { const int kb = r / 176, nb = r % 176; transpose_item(p.w_up, FF2, (bf16_t*)(ws + OFF_BTUP), 1024, 0, scr, 64 * kb, 32 * nb, 32 * nb + l31, lane); continue; } r -= I_UP;
            { const int kb = r / 32, nb = r % 32; transpose_item(p.w_down, 1024, (bf16_t*)(ws + OFF_BTDN), FF, 0, scr, 64 * kb, 32 * nb, 32 * nb + l31, lane); continue; }
        }
        r -= N_TR;
        if (r < N_RMS) {
            if (r < NP) rms_row(p.x_prompt + (size_t)r * 1024, p.norm_mix_g, (bf16_t*)(ws + OFF_R2) + (size_t)r * 1024, lane);
            else if (r < MT) rms_row(p.x_sample + (size_t)(r - NP) * 1024, p.norm_mix_g, (bf16_t*)(ws + OFF_R2) + (size_t)r * 1024, lane);
            else rms_row(p.mem_prompt + (size_t)(r - MT) * 1024, p.mem_norm_g, (bf16_t*)(ws + OFF_HM) + (size_t)(r - MT) * 1024, lane);
            continue; }
        r -= N_RMS;
        if (r < N_ROPE) {
            const int pos = r < 2048 ? r : 16384 + (r - 2048);
            double inv = 1.0;
            if (lane & 1) inv *= 0.8659643233600653; if (lane & 2) inv *= 0.7498942093324559; if (lane & 4) inv *= 0.5623413251903491;
            if (lane & 8) inv *= 0.31622776601683794; if (lane & 16) inv *= 0.1; if (lane & 32) inv *= 0.01;
            double t = (double)pos * inv * 0.15915494309189535; t -= __builtin_rint(t);
            const float tf = (float)t;
            ((float*)(ws + OFF_ROPEC))[r * 64 + lane] = __builtin_amdgcn_cosf(tf);
            ((float*)(ws + OFF_ROPES))[r * 64 + lane] = __builtin_amdgcn_sinf(tf);
            continue; }
        r -= N_ROPE;
        { const int t = r & 127; const float* src = p.sg_ws + (size_t)r * 128 + 2 * lane;
          const float a = (2 * lane <= t) ? src[0] : 0.f, b = (2 * lane + 1 <= t) ? src[1] : 0.f;
          *(unsigned*)((bf16_t*)(ws + OFF_WTRIL) + (size_t)r * 128 + 2 * lane) = pk2(a, b); }
    }
}

DEV void ret_A_item(const Params& p, LAS unsigned char* lds, int item) {
    const int tid = otid(), lane = tid & 63, w = tid >> 6;
    const int c = item & 15, bh = item >> 4, h = bh & 3, b = bh >> 2;
    const size_t row0 = (size_t)b * 2048 + c * 128;
    const bf16_t* P = (const bf16_t*)(p.ws + OFF_P);
    const float lg = log_gamma(h);
    LAS unsigned char* Kt = lds; LAS unsigned char* Vt = lds + 34816;
    for (int i = tid; i < 2048; i += 512) { const int s = i >> 4, ch = i & 15;
        u32x4 v = *(const u32x4*)(P + (row0 + s) * INC + C_K + h * 128 + ch * 8);
        const float dec = __expf((float)(127 - s) * lg);
        v.x = pk2(bf_lo(v.x) * dec, bf_hi(v.x) * dec); v.y = pk2(bf_lo(v.y) * dec, bf_hi(v.y) * dec); v.z = pk2(bf_lo(v.z) * dec, bf_hi(v.z) * dec); v.w = pk2(bf_lo(v.w) * dec, bf_hi(v.w) * dec);
        *(LAS u32x4*)(Kt + s * 272 + ch * 16) = v; }
    for (int i = tid; i < 4096; i += 512) { const int s = i >> 5, ch = i & 31;
        *(LAS u32x4*)(Vt + s * 528 + ch * 16) = *(const u32x4*)(P + (row0 + s) * INC + C_V + h * 256 + ch * 8); }
    __syncthreads();
    f32x4 acc[16];
#pragma unroll
    for (int i = 0; i < 16; ++i) acc[i] = (f32x4){0.f, 0.f, 0.f, 0.f};
    LAS const unsigned char* kb = tr_lane_base(Kt, 272, lane) + 32 * w; LAS const unsigned char* vb = tr_lane_base(Vt, 528, lane);
    bf16x8 af[4]; tr_read4<272, 0, 0>(kb, af);
    static_for<0, 16>([&](auto et_) { constexpr int et = decltype(et_)::value; bf16x8 bf[4]; tr_read4<528, 0, 16 * et>(vb, bf);
#pragma unroll
        for (int ks = 0; ks < 4; ++ks) acc[et] = mfma16(af[ks], bf[ks], acc[et]); });
    float* U = p.out + (size_t)item * 32768;
    const int g = lane >> 4, col = lane & 15;
#pragma unroll
    for (int et = 0; et < 16; ++et)
#pragma unroll
        for (int j = 0; j < 4; ++j) U[(16 * w + 4 * g + j) * 256 + 16 * et + col] = acc[et][j];
    __syncthreads();
}
DEV void scan_phase(const Params& p) {
    const float* U = p.out; bf16_t* Sb = (bf16_t*)(p.ws + OFF_R2);
    for (int idx = obid() * 512 + otid(); idx < 131072; idx += gridDim.x * 512) {
        const int e8 = idx & 31, d = (idx >> 5) & 127, bh = idx >> 12, h = bh & 3;
        const float g128 = __expf(128.f * log_gamma(h));
        f32x4 s0 = (f32x4){0.f, 0.f, 0.f, 0.f}, s1 = s0;
#pragma unroll
        for (int c = 0; c < 16; ++c) {
            const size_t off = (((size_t)bh * 16 + c) * 128 + d) * 256 + e8 * 8;
            u32x4 pk; pk.x = pk2(s0.x, s0.y); pk.y = pk2(s0.z, s0.w); pk.z = pk2(s1.x, s1.y); pk.w = pk2(s1.z, s1.w);
            *(u32x4*)(Sb + off) = pk;
            const f32x4 u0 = *(const f32x4*)(U + off), u1 = *(const f32x4*)(U + off + 4);
            s0 = s0 * g128 + u0; s1 = s1 * g128 + u1; }
        float* o = p.out + O_RETP + ((size_t)bh * 128 + d) * 256 + e8 * 8;
        *(f32x4*)o = s0; *(f32x4*)(o + 4) = s1;
    }
}
DEV void ret_C_item(const Params& p, LAS unsigned char* lds, int item) {
    const int tid = otid(), lane = tid & 63, w = tid >> 6, g = lane >> 4, col = lane & 15;
    const int c = item & 15, bh = item >> 4, h = bh & 3, b = bh >> 2;
    const size_t row0 = (size_t)b * 2048 + c * 128;
    bf16_t* P = (bf16_t*)(p.ws + OFF_P);
    const bf16_t* Sb = (const bf16_t*)(p.ws + OFF_R2) + (size_t)item * 32768;
    const float lg = log_gamma(h);
    LAS unsigned char* Kt = lds; LAS unsigned char* Vh = lds + 34816; LAS unsigned char* Sh = lds + 69632; LAS unsigned char* Sc = lds + 104448 + w * 4352;
    for (int i = tid; i < 2048; i += 512) { const int s = i >> 4, ch = i & 15;
        *(LAS u32x4*)(Kt + s * 272 + ch * 16) = *(const u32x4*)(P + (row0 + s) * INC + C_K + h * 128 + ch * 8); }
    bf16x8 qf[4];
    { const bf16_t* qp = P + (row0 + 16 * w + col) * INC + C_Q + h * 128 + 8 * g;
#pragma unroll
      for (int ks = 0; ks < 4; ++ks) qf[ks] = *(const bf16x8*)(qp + 32 * ks); }
    f32x4 o[16];
    LAS const unsigned char* shb = tr_lane_base(Sh, 272, lane); LAS const unsigned char* vhb = tr_lane_base(Vh, 272, lane);
    bf16x8 scf[4];
    static_for<0, 2>([&](auto hh_) { constexpr int hh = decltype(hh_)::value;
        if (hh == 1) __syncthreads();
        for (int i = tid; i < 2048; i += 512) { const int s = i >> 4, ch = i & 15;
            *(LAS u32x4*)(Vh + s * 272 + ch * 16) = *(const u32x4*)(P + (row0 + s) * INC + C_V + h * 256 + hh * 128 + ch * 8);
            *(LAS u32x4*)(Sh + s * 272 + ch * 16) = *(const u32x4*)(Sb + s * 256 + hh * 128 + ch * 8); }
        __syncthreads();
        if (hh == 0) {
            static_for<0, 8>([&](auto st_) { constexpr int st = decltype(st_)::value; f32x4 a = (f32x4){0.f, 0.f, 0.f, 0.f};
#pragma unroll
                for (int ks = 0; ks < 4; ++ks) a = mfma16(qf[ks], lds_frag(Kt, 272, 16 * st, 32 * ks, lane), a);
#pragma unroll
                for (int j = 0; j < 4; ++j) { const int diff = (16 * w + 4 * g + j) - (16 * st + col);
                    const float v = diff >= 0 ? a[j] * __expf((float)diff * lg) : 0.f;
                    *(LAS bf16_t*)(Sc + (4 * g + j) * 272 + (16 * st + col) * 2) = f2bf(v); }
                SCHEDB; });
#pragma unroll
            for (int ks = 0; ks < 4; ++ks) scf[ks] = lds_frag(Sc, 272, 0, 32 * ks, lane);
        }
        static_for<0, 8>([&](auto et_) { constexpr int et = decltype(et_)::value; f32x4 a = (f32x4){0.f, 0.f, 0.f, 0.f};
            bf16x8 f[4]; tr_read4<272, 0, 16 * et>(shb, f);
#pragma unroll
            for (int ks = 0; ks < 4; ++ks) a = mfma16(qf[ks], f[ks], a);
#pragma unroll
            for (int j = 0; j < 4; ++j) a[j] *= __expf((float)(16 * w + 4 * g + j + 1) * lg);
            tr_read4<272, 0, 16 * et>(vhb, f);
#pragma unroll
            for (int ks = 0; ks < 4; ++ks) a = mfma16(scf[ks], f[ks], a);
            o[hh * 8 + et] = a; SCHEDB; });
    });
    const float* gn = p.ret_gn_g + h * 256;
#pragma unroll
    for (int j = 0; j < 4; ++j) {
        float s = 0.f;
#pragma unroll
        for (int t = 0; t < 16; ++t) s += o[t][j];
        const float mean = g16_sum(s) * (1.f / 256.f);
        float s2 = 0.f;
#pragma unroll
        for (int t = 0; t < 16; ++t) { const float dd = o[t][j] - mean; s2 += dd * dd; }
        const float rstd = rsqrtf(g16_sum(s2) * (1.f / 256.f) + EPS);
        bf16_t* gp = P + (row0 + 16 * w + 4 * g + j) * INC + C_G + h * 256;
#pragma unroll
        for (int t = 0; t < 16; ++t) { const int e = (t >> 3) * 128 + (t & 7) * 16 + col;
            gp[e] = f2bf((o[t][j] - mean) * rstd * gn[e] * bf2f(gp[e])); }
        SCHEDB;
    }
    __syncthreads();
}
DEV void sgu_item(const Params& p, LAS unsigned char* lds, int item) {
    const int tid = otid(), lane = tid & 63, w = tid >> 6, g = lane >> 4, col = lane & 15;
    const int gq = item & 3, bn = item >> 2; const size_t row0 = (size_t)bn * 128;
    bf16_t* P = (bf16_t*)(p.ws + OFF_P);
    LAS unsigned char* VN = lds;
    for (int rr = 0; rr < 16; ++rr) { const int s = 16 * w + rr;
        const u32x4 v = *(const u32x4*)(P + (row0 + s) * INC + C_SV + lane * 8);
        float x[8] = {bf_lo(v.x), bf_hi(v.x), bf_lo(v.y), bf_hi(v.y), bf_lo(v.z), bf_hi(v.z), bf_lo(v.w), bf_hi(v.w)};
        float sm = 0.f;
#pragma unroll
        for (int i = 0; i < 8; ++i) sm += x[i];
        const float mean = wave_sum(sm) * (1.f / 512.f); float s2 = 0.f;
#pragma unroll
        for (int i = 0; i < 8; ++i) { x[i] -= mean; s2 += x[i] * x[i]; }
        const float rstd = rsqrtf(wave_sum(s2) * (1.f / 512.f) + EPS);
        if (g == gq) { const float* lg = p.sg_ln_g + lane * 8; u32x4 o;
            o.x = pk2(x[0] * rstd * lg[0], x[1] * rstd * lg[1]); o.y = pk2(x[2] * rstd * lg[2], x[3] * rstd * lg[3]);
            o.z = pk2(x[4] * rstd * lg[4], x[5] * rstd * lg[5]); o.w = pk2(x[6] * rstd * lg[6], x[7] * rstd * lg[7]);
            *(LAS u32x4*)(VN + s * 272 + col * 16) = o; } }
    bf16x8 af[4];
    { const bf16_t* wp = (const bf16_t*)(p.ws + OFF_WTRIL) + (size_t)(gq * 128 + 16 * w + col) * 128 + 8 * g;
#pragma unroll
      for (int ks = 0; ks < 4; ++ks) af[ks] = *(const bf16x8*)(wp + 32 * ks); }
    __syncthreads();
    LAS const unsigned char* vnb = tr_lane_base(VN, 272, lane);
    static_for<0, 8>([&](auto ct_) { constexpr int ct = decltype(ct_)::value; f32x4 a = (f32x4){0.f, 0.f, 0.f, 0.f};
        bf16x8 f[4]; tr_read4<272, 0, 16 * ct>(vnb, f);
#pragma unroll
        for (int ks = 0; ks < 4; ++ks) a = mfma16(af[ks], f[ks], a);
#pragma unroll
        for (int j = 0; j < 4; ++j) { const int t = 16 * w + 4 * g + j; bf16_t* up = P + (row0 + t) * INC + C_SU + gq * 128 + 16 * ct + col;
            *up = f2bf(bf2f(*up) * (a[j] + p.sg_bs[gq * 128 + t])); } });
    __syncthreads();
}
DEV void xattn_item(const Params& p, LAS unsigned char* lds, int item) {
    const int tid = otid(), lane = tid & 63, w = tid >> 6, g = lane >> 4, col = lane & 15;
    const int qt = item & 15, bh = item >> 4, h = bh & 3, b = bh >> 2; const size_t row0 = (size_t)b * 2048 + qt * 128;
    bf16_t* P = (bf16_t*)(p.ws + OFF_P); const bf16_t* mkb = (const bf16_t*)(p.ws + OFF_MKB);
    LAS unsigned char* KV = lds; LAS unsigned char* Pw = lds + 69632 + w * 8448;
    for (int i = tid; i < 4096; i += 512) { const int m = i >> 4, ch = i & 15;
        *(LAS u32x4*)(KV + m * 272 + ch * 16) = *(const u32x4*)(mkb + (size_t)(b * 256 + m) * 1024 + h * 128 + ch * 8); }
    bf16x8 qf[4];
    { const bf16_t* qp = P + (row0 + 16 * w + col) * INC + C_XQ + h * 128 + 8 * g;
#pragma unroll
      for (int ks = 0; ks < 4; ++ks) qf[ks] = *(const bf16x8*)(qp + 32 * ks); }
    __syncthreads();
    f32x4 sc[16];
    static_for<0, 16>([&](auto mt_) { constexpr int mt = decltype(mt_)::value; f32x4 a = (f32x4){0.f, 0.f, 0.f, 0.f};
#pragma unroll
        for (int ks = 0; ks < 4; ++ks) a = mfma16(qf[ks], lds_frag(KV, 272, 16 * mt, 32 * ks, lane), a);
        sc[mt] = a * 0.08838834764831845f; SCHEDB; });
#pragma unroll
    for (int j = 0; j < 4; ++j) { float mx = -3.0e38f;
#pragma unroll
        for (int mt = 0; mt < 16; ++mt) mx = fmaxf(mx, sc[mt][j]);
        mx = g16_max(mx); float sm = 0.f;
#pragma unroll
        for (int mt = 0; mt < 16; ++mt) { const float e = __expf(sc[mt][j] - mx); sc[mt][j] = e; sm += e; }
        const float inv = 1.f / g16_sum(sm);
#pragma unroll
        for (int mt = 0; mt < 16; ++mt) *(LAS bf16_t*)(Pw + (4 * g + j) * 528 + (16 * mt + col) * 2) = f2bf(sc[mt][j] * inv); }
    __syncthreads();
    for (int i = tid; i < 4096; i += 512) { const int m = i >> 4, ch = i & 15;
        *(LAS u32x4*)(KV + m * 272 + ch * 16) = *(const u32x4*)(mkb + (size_t)(b * 256 + m) * 1024 + 512 + h * 128 + ch * 8); }
    __syncthreads();
    LAS const unsigned char* kvb = tr_lane_base(KV, 272, lane);
    bf16x8 pf[8];
#pragma unroll
    for (int ks = 0; ks < 8; ++ks) pf[ks] = lds_frag(Pw, 528, 0, 32 * ks, lane);
    static_for<0, 8>([&](auto dt_) { constexpr int dt = decltype(dt_)::value; f32x4 a = (f32x4){0.f, 0.f, 0.f, 0.f};
        bf16x8 f[4]; tr_read4<272, 0, 16 * dt>(kvb, f);
#pragma unroll
        for (int ks = 0; ks < 4; ++ks) a = mfma16(pf[ks], f[ks], a);
        tr_read4<272, 128, 16 * dt>(kvb, f);
#pragma unroll
        for (int ks = 0; ks < 4; ++ks) a = mfma16(pf[4 + ks], f[ks], a);
#pragma unroll
        for (int j = 0; j < 4; ++j) P[(row0 + 16 * w + 4 * g + j) * INC + C_XQ + h * 128 + 16 * dt + col] = f2bf(a[j]); });
    __syncthreads();
}
DEV void xattn_s_item(const Params& p, LAS unsigned char* lds, int item) {
    const int tid = otid(), lane = tid & 63, w = tid >> 6, l32 = lane & 31, slot = w * 2 + (lane >> 5);
    const int h = item & 3, b = item >> 2; const size_t rowb = (size_t)NP + b * 4;
    bf16_t* P = (bf16_t*)(p.ws + OFF_P);
    LAS float* sc = (LAS float*)lds; LAS float* red = (LAS float*)(lds + 4096);
    float q[4][4];
#pragma unroll
    for (int l = 0; l < 4; ++l) { const u32x2 v = *(const u32x2*)(P + (rowb + l) * INC + C_XQ + h * 128 + 4 * l32); q[l][0] = bf_lo(v.x); q[l][1] = bf_hi(v.x); q[l][2] = bf_lo(v.y); q[l][3] = bf_hi(v.y); }
#pragma unroll
    for (int it = 0; it < 16; ++it) { const int m = it * 16 + slot;
        const f32x4 kv = *(const f32x4*)(p.cache_k + (((size_t)b * 256 + m) * 4 + h) * 128 + 4 * l32);
#pragma unroll
        for (int l = 0; l < 4; ++l) { float d = q[l][0] * kv.x + q[l][1] * kv.y + q[l][2] * kv.z + q[l][3] * kv.w;
#pragma unroll
            for (int o = 1; o < 32; o <<= 1) d += __shfl_xor(d, o);
            if (l32 == 0) sc[l * 256 + m] = d * 0.08838834764831845f; } }
    __syncthreads();
    if (w < 4) { float v[4]; float mx = -3.0e38f;
#pragma unroll
        for (int i = 0; i < 4; ++i) { v[i] = sc[w * 256 + lane + 64 * i]; mx = fmaxf(mx, v[i]); }
        mx = wave_max(mx); float sm = 0.f;
#pragma unroll
        for (int i = 0; i < 4; ++i) { v[i] = __expf(v[i] - mx); sm += v[i]; }
        const float inv = 1.f / wave_sum(sm);
#pragma unroll
        for (int i = 0; i < 4; ++i) sc[w * 256 + lane + 64 * i] = v[i] * inv; }
    __syncthreads();
    f32x4 o[4];
#pragma unroll
    for (int l = 0; l < 4; ++l) o[l] = (f32x4){0.f, 0.f, 0.f, 0.f};
#pragma unroll
    for (int it = 0; it < 16; ++it) { const int m = it * 16 + slot;
        const f32x4 vv = *(const f32x4*)(p.cache_v + (((size_t)b * 256 + m) * 4 + h) * 128 + 4 * l32);
#pragma unroll
        for (int l = 0; l < 4; ++l) o[l] += vv * sc[l * 256 + m]; }
#pragma unroll
    for (int l = 0; l < 4; ++l) *(LAS f32x4*)(red + (slot * 4 + l) * 128 + 4 * l32) = o[l];
    __syncthreads();
    { const int l = tid >> 7, d = tid & 127; float s = 0.f;
#pragma unroll
      for (int k = 0; k < 16; ++k) s += red[(k * 4 + l) * 128 + d];
      P[(rowb + l) * INC + C_XQ + h * 128 + d] = f2bf(s); }
    __syncthreads();
}
DEV void ret_s_item(const Params& p, LAS unsigned char* lds, int item) {
    const int tid = otid(), lane = tid & 63, w = tid >> 6;
    const int h = item & 3, b = item >> 2; const size_t rowb = (size_t)NP + b * 4;
    bf16_t* P = (bf16_t*)(p.ws + OFF_P);
    const float lg = log_gamma(h);
    LAS float* qs = (LAS float*)lds;
    LAS float* kr = qs + 512;
    LAS float* vs = kr + 512;
    LAS float* ob = vs + 1024;
    LAS float* scm = ob + 1024;
    LAS float* red = scm + 16;
    { const int t = tid >> 7, d = tid & 127;
      qs[t * 128 + d] = bf2f(P[(rowb + t) * INC + C_Q + h * 128 + d]); kr[t * 128 + d] = bf2f(P[(rowb + t) * INC + C_K + h * 128 + d]);
      vs[t * 256 + d] = bf2f(P[(rowb + t) * INC + C_V + h * 256 + d]); vs[t * 256 + 128 + d] = bf2f(P[(rowb + t) * INC + C_V + h * 256 + 128 + d]); }
    __syncthreads();
    if (tid < 16) { const int t = tid >> 2, s = tid & 3; float d = 0.f;
        for (int k = 0; k < 128; ++k) d += qs[t * 128 + k] * kr[s * 128 + k];
        scm[tid] = (t >= s) ? d * __expf((float)(t - s) * lg) : 0.f; }
    f32x4 v[4], cr[4];
#pragma unroll
    for (int s = 0; s < 4; ++s) { v[s] = *(LAS f32x4*)(vs + s * 256 + 4 * lane); cr[s] = (f32x4){0.f, 0.f, 0.f, 0.f}; }
    const float g4 = __expf(4.f * lg), kd0 = __expf(3.f * lg), kd1 = __expf(2.f * lg), kd2 = __expf(lg);
    const float* S0 = p.state_ret + ((size_t)item * 128) * 256; float* Sn = p.out + O_RETS + ((size_t)item * 128) * 256;
#pragma unroll 8
    for (int dd = 0; dd < 16; ++dd) { const int d = 16 * w + dd;
        const f32x4 s0 = *(const f32x4*)(S0 + d * 256 + 4 * lane);
#pragma unroll
        for (int t = 0; t < 4; ++t) cr[t] += s0 * qs[t * 128 + d];
        f32x4 sn = s0 * g4 + v[0] * (kr[d] * kd0) + v[1] * (kr[128 + d] * kd1) + v[2] * (kr[256 + d] * kd2) + v[3] * kr[384 + d];
        *(f32x4*)(Sn + d * 256 + 4 * lane) = sn; }
#pragma unroll
    for (int t = 0; t < 4; ++t) *(LAS f32x4*)(red + (w * 4 + t) * 256 + 4 * lane) = cr[t];
    __syncthreads();
    { const int t = tid >> 7, e2 = (tid & 127) * 2; const float qd = __expf((float)(t + 1) * lg);
#pragma unroll
      for (int i = 0; i < 2; ++i) { const int e = e2 + i; float c = 0.f;
#pragma unroll
          for (int k = 0; k < 8; ++k) c += red[(k * 4 + t) * 256 + e];
          float in = 0.f;
#pragma unroll
          for (int s = 0; s < 4; ++s) in += scm[t * 4 + s] * vs[s * 256 + e];
          ob[t * 256 + e] = in + c * qd; } }
    __syncthreads();
    if (w < 4) { float x[4]; float sm = 0.f;
#pragma unroll
        for (int i = 0; i < 4; ++i) { x[i] = ob[w * 256 + lane + 64 * i]; sm += x[i]; }
        const float mean = wave_sum(sm) * (1.f / 256.f); float s2 = 0.f;
#pragma unroll
        for (int i = 0; i < 4; ++i) { x[i] -= mean; s2 += x[i] * x[i]; }
        const float rstd = rsqrtf(wave_sum(s2) * (1.f / 256.f) + EPS);
        bf16_t* gp = P + (rowb + w) * INC + C_G + h * 256;
#pragma unroll
        for (int i = 0; i < 4; ++i) { const int e = lane + 64 * i; gp[e] = f2bf(x[i] * rstd * p.ret_gn_g[h * 256 + e] * bf2f(gp[e])); } }
    __syncthreads();
}
DEV void sgu_s_item(const Params& p, LAS unsigned char* lds, int b) {
    const int tid = otid(), lane = tid & 63, w = tid >> 6;
    const size_t rowb = (size_t)NP + b * 4;
    bf16_t* P = (bf16_t*)(p.ws + OFF_P);
    LAS float* part = (LAS float*)lds;
    float x[4];
#pragma unroll
    for (int r = 0; r < 4; ++r) { x[r] = bf2f(P[(rowb + r) * INC + C_SV + tid]); const float s = wave_sum(x[r]); if (lane == 0) part[w * 4 + r] = s; }
    __syncthreads();
    float mean[4];
#pragma unroll
    for (int r = 0; r < 4; ++r) { float s = 0.f;
#pragma unroll
        for (int k = 0; k < 8; ++k) s += part[k * 4 + r];
        mean[r] = s * (1.f / 512.f); }
    __syncthreads();
#pragma unroll
    for (int r = 0; r < 4; ++r) { x[r] -= mean[r]; const float s = wave_sum(x[r] * x[r]); if (lane == 0) part[w * 4 + r] = s; }
    __syncthreads();
    const float lng = p.sg_ln_g[tid]; const int gq = tid >> 7;
    float vn[4];
#pragma unroll
    for (int r = 0; r < 4; ++r) { float s = 0.f;
#pragma unroll
        for (int k = 0; k < 8; ++k) s += part[k * 4 + r];
        vn[r] = x[r] * rsqrtf(s * (1.f / 512.f) + EPS) * lng;
        p.out[O_SGV + ((size_t)b * 4 + r) * 512 + tid] = vn[r]; }
#pragma unroll
    for (int t = 0; t < 4; ++t) { float mx = p.sg_bs[gq * 128 + t];
#pragma unroll
        for (int s = 0; s < 4; ++s) if (s <= t) mx += p.sg_ws[(size_t)(gq * 128 + t) * 128 + s] * vn[s];
        bf16_t* up = P + (rowb + t) * INC + C_SU + tid; *up = f2bf(bf2f(*up) * mx); }
    __syncthreads();
}

DEV void rms_phase(const Params& p, bool final_) {
    const int lane = otid() & 63, gw = obid() * 8 + (otid() >> 6), NGW = gridDim.x * 8;
    const float* g = final_ ? p.norm_final_g : p.norm_ffn_g;
    const float* part = (const float*)(p.ws + (final_ ? OFF_PART10 : OFF_PART6)); const int npart = final_ ? 22 : 8;
    for (int r = gw; r < MT; r += NGW) {
        float* xr = p.out + (size_t)r * 1024;
        f32x4 v[4]; float s = 0.f;
        if (r < NP) {
#pragma unroll
            for (int j = 0; j < 4; ++j) v[j] = *(const f32x4*)(xr + 4 * lane + 256 * j);
        } else {
            const float* base = final_ ? xr : p.x_sample + (size_t)(r - NP) * 1024;
#pragma unroll
            for (int j = 0; j < 4; ++j) v[j] = *(const f32x4*)(base + 4 * lane + 256 * j);
            for (int k = 0; k < npart; ++k) { const float* pr = part + (size_t)k * SROWS + (size_t)(r - NP) * 1024;
#pragma unroll
                for (int j = 0; j < 4; ++j) v[j] += *(const f32x4*)(pr + 4 * lane + 256 * j); }
            if (!final_) {
#pragma unroll
                for (int j = 0; j < 4; ++j) *(f32x4*)(xr + 4 * lane + 256 * j) = v[j]; }
        }
#pragma unroll
        for (int j = 0; j < 4; ++j) s += v[j].x * v[j].x + v[j].y * v[j].y + v[j].z * v[j].z + v[j].w * v[j].w;
        s = wave_sum(s); const float rr = rsqrtf(s * (1.f / 1024.f) + EPS);
        if (final_) {
#pragma unroll
            for (int j = 0; j < 4; ++j) { const f32x4 gv = *(const f32x4*)(g + 4 * lane + 256 * j); *(f32x4*)(xr + 4 * lane + 256 * j) = v[j] * rr * gv; }
        } else { bf16_t* orow = (bf16_t*)(p.ws + OFF_R2) + (size_t)r * 1024;
#pragma unroll
            for (int j = 0; j < 4; ++j) { const f32x4 gv = *(const f32x4*)(g + 4 * lane + 256 * j);
                u32x2 o; o.x = pk2(v[j].x * rr * gv.x, v[j].y * rr * gv.y); o.y = pk2(v[j].z * rr * gv.z, v[j].w * rr * gv.w);
                *(u32x2*)(orow + 4 * lane + 256 * j) = o; } }
    }
}
DEV void conv_phase(const Params& p) {
    const bf16_t* z = (const bf16_t*)(p.ws + OFF_Z); bf16_t* act = (bf16_t*)(p.ws + OFF_ACT);
    const long total = (long)MT * 352;
    for (long idx = (long)obid() * 512 + otid(); idx < total; idx += (long)gridDim.x * 512) {
        const int r = (int)(idx / 352), ch = (int)(idx % 352), c = ch * 8;
        const int tpos = r < NP ? (r & 2047) : ((r - NP) & 3);
        float za[8], zb[8];
#pragma unroll
        for (int i = 0; i < 8; ++i) { za[i] = p.conv_b[c + i]; zb[i] = p.conv_b[FF + c + i]; }
#pragma unroll
        for (int j = 0; j < 3; ++j) {
            const int tp = tpos - 2 + j;
            float xa[8], xb[8];
            if (tp >= 0) { const u32x4 a = *(const u32x4*)(z + (size_t)(r - 2 + j) * FF2 + c), bq = *(const u32x4*)(z + (size_t)(r - 2 + j) * FF2 + FF + c);
                xa[0] = bf_lo(a.x); xa[1] = bf_hi(a.x); xa[2] = bf_lo(a.y); xa[3] = bf_hi(a.y); xa[4] = bf_lo(a.z); xa[5] = bf_hi(a.z); xa[6] = bf_lo(a.w); xa[7] = bf_hi(a.w);
                xb[0] = bf_lo(bq.x); xb[1] = bf_hi(bq.x); xb[2] = bf_lo(bq.y); xb[3] = bf_hi(bq.y); xb[4] = bf_lo(bq.z); xb[5] = bf_hi(bq.z); xb[6] = bf_lo(bq.w); xb[7] = bf_hi(bq.w); }
            else if (r >= NP) { const float* sp = p.state_conv + ((size_t)((r - NP) >> 2) * 2 + (tp + 2)) * FF2;
#pragma unroll
                for (int i = 0; i < 8; ++i) { xa[i] = sp[c + i]; xb[i] = sp[FF + c + i]; } }
            else {
#pragma unroll
                for (int i = 0; i < 8; ++i) { xa[i] = 0.f; xb[i] = 0.f; } }
#pragma unroll
            for (int i = 0; i < 8; ++i) { za[i] += p.conv_w[j * FF2 + c + i] * xa[i]; zb[i] += p.conv_w[j * FF2 + FF + c + i] * xb[i]; }
        }
        u32x4 o; o.x = pk2(gelu_t(za[0]) * zb[0], gelu_t(za[1]) * zb[1]); o.y = pk2(gelu_t(za[2]) * zb[2], gelu_t(za[3]) * zb[3]);
        o.z = pk2(gelu_t(za[4]) * zb[4], gelu_t(za[5]) * zb[5]); o.w = pk2(gelu_t(za[6]) * zb[6], gelu_t(za[7]) * zb[7]);
        *(u32x4*)(act + (size_t)r * FF + c) = o;
    }
}

__global__ __launch_bounds__(512, 2) void mega(Params p, int ph0, int ph1) {
    extern __shared__ __attribute__((aligned(16))) unsigned char shm[];
    LAS unsigned char* lds = (LAS unsigned char*)shm;
    cg::grid_group grid = cg::this_grid();
    const int G = gridDim.x, c = obid();
    unsigned char* ws = p.ws;
#define PH_BEGIN(k) if (ph0 <= (k) && (k) < ph1) { if (PHON(k)) {
#define PH_END(k) } if ((k) + 1 < ph1) grid.sync(); }
    PH_BEGIN(0) phase_prep(p, lds); PH_END(0)
    PH_BEGIN(1)
            Sched1 S{G, c, (const char*)(ws + OFF_R2), (const char*)(ws + OFF_HM), (const char*)(ws + OFF_BTIN), (const char*)(ws + OFF_BTKV)};
            Epi1 E{(bf16_t*)(ws + OFF_P), (bf16_t*)(ws + OFF_MKB), p.out, (const float*)(ws + OFF_ROPEC), (const float*)(ws + OFF_ROPES), p.b_gate};
            pg8::gemm_phase(lds, 1024, 1024, S, E);
    PH_END(1)
    PH_BEGIN(2)
            for (int it = c; it < 2688; it += G) {
                if (it < 512) ret_A_item(p, lds, it);
                else if (it < 1024) { if (DBG_XA & 1) xattn_item(p, lds, it - 512); }
                else if (it < 1536) sgu_item(p, lds, it - 1024);
                else if (it < 2048) ret_s_item(p, lds, it - 1536);
                else if (it < 2560) { if (DBG_XA & 2) xattn_s_item(p, lds, it - 2048); }
                else sgu_s_item(p, lds, it - 2560);
            }
    PH_END(2)
    PH_BEGIN(3)
            scan_phase(p);
            SchedMgS S{c, (const char*)(ws + OFF_P), (const char*)(ws + OFF_BTMG)};
            EpiMgS E{(const bf16_t*)(ws + OFF_P), (float*)(ws + OFF_MG32)};
            pg8::gemm_phase(lds, INC, 2048, S, E);
    PH_END(3)
    PH_BEGIN(4) for (int it = c; it < 512; it += G) ret_C_item(p, lds, it); PH_END(4)
    PH_BEGIN(5)
            {
                const int i = obid() * 512 + otid();
                if (i < 131072) { f32x4 m = ((const f32x4*)(ws + OFF_MG32))[i];
#pragma unroll
                    for (int k = 1; k < 8; ++k) m += ((const f32x4*)(ws + OFF_MG32))[(size_t)k * 131072 + i];
                    u32x2 o; o.x = pk2(m.x, m.y); o.y = pk2(m.z, m.w);
                    ((u32x2*)((bf16_t*)(ws + OFF_R2) + (size_t)NP * 1024))[i] = o; } }
            SchedMg S{G, c, (const char*)(ws + OFF_P), (const char*)(ws + OFF_BTMG)};
            EpiMg E{(const bf16_t*)(ws + OFF_P), p.out, (bf16_t*)(ws + OFF_R2)};
            pg8::gemm_phase(lds, INC, 2048, S, E);
    PH_END(5)
    PH_BEGIN(6)
            SchedPS<16, 64, 8, 524288, 524288> S{G, c, (const char*)(ws + OFF_R2), (const char*)(ws + OFF_BTO)};
            EpiWo E{p.x_prompt, p.x_sample, p.out, (float*)(ws + OFF_PART6)};
            pg8::gemm_phase(lds, 1024, 1024, S, E);
    PH_END(6)
    PH_BEGIN(7) rms_phase(p, false); PH_END(7)
    PH_BEGIN(8)
            SchedPlain S{G, c, 66, 22, 16, (const char*)(ws + OFF_R2), (const char*)(ws + OFF_BTUP), (size_t)524288, (size_t)524288};
            EpiUp E{(bf16_t*)(ws + OFF_Z), p.out};
            pg8::gemm_phase(lds, 1024, 1024, S, E);
    PH_END(8)
    PH_BEGIN(9) conv_phase(p); PH_END(9)
    PH_BEGIN(10)
            SchedPS<44, 176, 22, 256 * FF * 2, 256 * FF * 2> S{G, c, (const char*)(ws + OFF_ACT), (const char*)(ws + OFF_BTDN)};
            EpiDn E{p.out, (float*)(ws + OFF_PART10)};
            pg8::gemm_phase(lds, FF, FF, S, E);
    PH_END(10)
    PH_BEGIN(11) rms_phase(p, true); PH_END(11)
}

extern "C" void kernel_launch(void* const* d_in, const int* in_sizes, int n_in, void* d_out, int out_size, void* d_ws, size_t ws_size, hipStream_t stream) {
    static int grid = 0;
    if (grid == 0) {
        if (n_in != 26 || out_size != 39018496 || ws_size < WS_END) { fprintf(stderr, "kernel_launch: unexpected shapes n_in %d out %d ws %zu (need %zu)\n", n_in, out_size, ws_size, (size_t)WS_END); grid = -1; return; }
        int dev = 0, cus = 0, per_cu = 0;
        hipGetDevice(&dev); hipDeviceGetAttribute(&cus, hipDeviceAttributeMultiprocessorCount, dev);
        if (hipFuncSetAttribute((const void*)mega, hipFuncAttributeMaxDynamicSharedMemorySize, LDS_BYTES) != hipSuccess) { fprintf(stderr, "kernel_launch: hipFuncSetAttribute failed\n"); grid = -1; return; }
        if (hipOccupancyMaxActiveBlocksPerMultiprocessor(&per_cu, (const void*)mega, 512, LDS_BYTES) != hipSuccess || per_cu < 1) { fprintf(stderr, "kernel_launch: occupancy query gave %d\n", per_cu); grid = -1; return; }
        if (cus != 256) { fprintf(stderr, "kernel_launch: built for 256 CUs, got %d\n", cus); grid = -1; return; }
        grid = cus;
    }
    if (grid < 0) return;
    Params p{};
    const float** f = (const float**)&p;
    for (int i = 0; i < 26; ++i) f[i] = (const float*)d_in[i];
    p.out = (float*)d_out; p.ws = (unsigned char*)d_ws;
#ifndef DBG_NPH
#define DBG_NPH 12
#endif
#ifndef MK_MULTI
#define MK_MULTI 0
#endif
#if MK_MULTI
#ifndef PH_SEQ
#define PH_SEQ 0,1,2,3,4,5,6,7,8,9,10,11
#endif
    { const int seq[] = {PH_SEQ}; for (int ph : seq) hipLaunchKernelGGL(mega, dim3(grid), dim3(512), LDS_BYTES, stream, p, ph, ph + 1); }
    hipError_t e = hipSuccess;
#else
    int ph0 = 0, ph1 = NPHASE;
    void* args[] = {&p, &ph0, &ph1};
    hipError_t e = hipLaunchCooperativeKernel((const void*)mega, dim3(grid), dim3(512), args, LDS_BYTES, stream);
#endif
    if (e != hipSuccess) fprintf(stderr, "cooperative launch failed: %s (grid %d)\n", hipGetErrorString(e), grid);
}
```

```cpp
#include <hip/hip_runtime.h>
#include <hip/hip_cooperative_groups.h>
#include <cstdio>
#include <cstdint>
namespace cg = cooperative_groups;

#define LAS __attribute__((address_space(3)))
#define DEV __device__ __forceinline__
typedef unsigned short bf16_t;
typedef short bf16x8 __attribute__((ext_vector_type(8)));
typedef short s16x4 __attribute__((ext_vector_type(4)));
typedef float f32x4 __attribute__((ext_vector_type(4)));
typedef unsigned u32x4 __attribute__((ext_vector_type(4)));
typedef unsigned u32x2 __attribute__((ext_vector_type(2)));

constexpr int NP = 16384, NS = 512, MT = 16896, INC = 7680, FF = 2816, FF2 = 5632;
constexpr int C_Q = 0, C_K = 512, C_V = 1024, C_G = 2048, C_SU = 3072, C_XQ = 3584, C_SV = 4096, C_GT = 4608;
constexpr float EPS = 1e-6f;
constexpr size_t OFF_BTIN = 0;
constexpr size_t OFF_BTKV = OFF_BTIN + 15728640;
constexpr size_t OFF_BTMG = OFF_BTKV + 2097152;
constexpr size_t OFF_BTO = OFF_BTMG + 4194304;
constexpr size_t OFF_BTUP = OFF_BTO + 2097152;
constexpr size_t OFF_BTDN = OFF_BTUP + 11534336;
constexpr size_t OFF_ROPEC = OFF_BTDN + 5767168;
constexpr size_t OFF_ROPES = OFF_ROPEC + 525312;
constexpr size_t OFF_WTRIL = OFF_ROPES + 525312;
constexpr size_t OFF_HM = OFF_WTRIL + 131072;
constexpr size_t OFF_MKB = OFF_HM + 4194304;
constexpr size_t OFF_P = OFF_MKB + 4194304;
constexpr size_t OFF_R2 = OFF_P + 259522560;
constexpr size_t OFF_MG32 = OFF_R2 + 34603008;
constexpr size_t WS_END = OFF_MG32 + 8 * 2097152;
constexpr size_t OFF_BAR = WS_END;
constexpr size_t WS_END2 = OFF_BAR + 16384;
constexpr size_t OFF_PART6 = OFF_P, OFF_PART10 = OFF_P;
constexpr int SROWS = 512 * 1024;
constexpr size_t OFF_Z = OFF_P;
constexpr size_t OFF_ACT = OFF_P + 190316544;
constexpr size_t O_Y = 0, O_RETP = 17301504, O_CONVP = 18350080, O_MK = 18440192, O_MV = 19488768, O_RETS = 20537344, O_CONVS = 37314560, O_SGV = 38756352;
constexpr int LDS_BYTES = 147456;
constexpr int NPHASE = 12;
#ifndef DBG_XA
#define DBG_XA 3
#endif
#ifndef ONLY_PH
#define ONLY_PH -1
#endif
#ifndef SKIP_PH
#define SKIP_PH -2
#endif
#define PHON(n) ((ONLY_PH < 0 || ONLY_PH == (n)) && SKIP_PH != (n))

struct Params {
    const float *x_prompt, *x_sample, *mem_prompt, *state_ret, *state_conv, *cache_k, *cache_v, *norm_mix_g, *w_in, *b_gate, *ret_gn_g, *sg_ln_g, *sg_ws, *sg_bs,
        *mem_norm_g, *w_mem_kv, *w_br_ret, *w_br_sg, *w_br_x, *w_o, *norm_ffn_g, *w_up, *conv_w, *conv_b, *w_down, *norm_final_g;
    float* out; unsigned char* ws;
};

typedef __bf16 bf16v2_t __attribute__((ext_vector_type(2)));
typedef float f32x2_t __attribute__((ext_vector_type(2)));
DEV unsigned pk2(float lo, float hi) { const f32x2_t f = {lo, hi}; const bf16v2_t v = __builtin_convertvector(f, bf16v2_t); return __builtin_bit_cast(unsigned, v); }
DEV bf16_t f2bf(float v) { return (bf16_t)(pk2(v, 0.f) & 0xffffu); }
DEV float bf_lo(unsigned u) { return __uint_as_float(u << 16); }
DEV float bf_hi(unsigned u) { return __uint_as_float(u & 0xffff0000u); }
DEV float bf2f(bf16_t b) { return __uint_as_float(((unsigned)b) << 16); }
DEV float wave_sum(float v) {
#pragma unroll
    for (int o = 1; o < 64; o <<= 1) v += __shfl_xor(v, o);
    return v; }
DEV float wave_max(float v) {
#pragma unroll
    for (int o = 1; o < 64; o <<= 1) v = fmaxf(v, __shfl_xor(v, o));
    return v; }
DEV float g16_sum(float v) {
#pragma unroll
    for (int o = 1; o < 16; o <<= 1) v += __shfl_xor(v, o);
    return v; }
DEV float g16_max(float v) {
#pragma unroll
    for (int o = 1; o < 16; o <<= 1) v = fmaxf(v, __shfl_xor(v, o));
    return v; }
DEV float gelu_t(float x) { const float u = 1.5957691216057308f * (x + 0.044715f * x * x * x); return x / (1.f + __expf(-u)); }
DEV float silu_f(float x) { return x / (1.f + __expf(-x)); }
DEV float sigm_f(float x) { return 1.f / (1.f + __expf(-x)); }
DEV float log_gamma(int h) { return log1pf(-exp2f(-5.f - (float)h)); }
DEV int otid() { int t = threadIdx.x; asm volatile("" : "+v"(t)); return t; }
DEV int obid() { int t = blockIdx.x; asm volatile("" : "+s"(t)); return t; }
DEV unsigned ldsaddr(LAS const void* p) { return (unsigned)(uintptr_t)p; }
DEV f32x4 mfma16(bf16x8 a, bf16x8 b, f32x4 c) { return __builtin_amdgcn_mfma_f32_16x16x32_bf16(a, b, c, 0, 0, 0); }
DEV bf16x8 lds_frag(LAS const unsigned char* base, int pitch, int row0, int k0, int lane) {
    return *(LAS const bf16x8*)(base + (row0 + (lane & 15)) * pitch + (k0 + 8 * (lane >> 4)) * 2); }
DEV LAS const unsigned char* tr_lane_base(LAS const unsigned char* base, int pitch, int lane) { const int g = lane >> 4, q = (lane & 15) >> 2, pp = lane & 3; return base + ((8 * g + q) * pitch + 8 * pp); }
template <int PITCH, int KB, int X0> DEV void tr_read4(LAS const unsigned char* a, bf16x8 (&f)[4]) {
    constexpr int o0 = KB * PITCH + X0 * 2;
    static_assert(o0 + 100 * PITCH < 65536, "ds offset field");
#pragma unroll
    for (int ks = 0; ks < 4; ++ks) {
        const s16x4 lo = __builtin_amdgcn_ds_read_tr16_b64_v4i16((LAS s16x4*)(a + o0 + ks * 32 * PITCH));
        const s16x4 hi = __builtin_amdgcn_ds_read_tr16_b64_v4i16((LAS s16x4*)(a + o0 + ks * 32 * PITCH + 4 * PITCH));
        f[ks] = (bf16x8){lo[0], lo[1], lo[2], lo[3], hi[0], hi[1], hi[2], hi[3]}; } }
template <int V> struct IC { static constexpr int value = V; };
template <int I, int N, class F> DEV void static_for(F&& f) { if constexpr (I < N) { f(IC<I>{}); static_for<I + 1, N>(f); } }
#define SCHEDB __builtin_amdgcn_sched_barrier(0)

namespace pg8 {
constexpr int BM = 256, BK = 64, HALF = 128, HTB = HALF * BK * 2, NXCD = 8, WGM = 8;
DEV int lds_byte(int r, int c) { const int st = (r >> 4) * 2 + (c >> 5), rr = r & 15, cc = c & 31, ob = rr * 64 + cc * 2; return st * 1024 + (ob ^ (((ob >> 9) & 1) << 5)); }
DEV void stage_rc(int b, int& R, int& C) { const int st = b / 1024, sb = b % 1024, swz = sb ^ (((sb >> 9) & 1) << 5); R = (st >> 1) * 16 + swz / 64; C = (st & 1) * 32 + (swz % 64) / 2; }
DEV int perm32(int rho) { const int n = rho >> 4, i = rho & 15; return 8 * (i >> 2) + 4 * n + (i & 3); }
struct Unit { int pm, pn, kind, nt; const char* A; const char* B; };
DEV void tile_map(int L, int nM, int nN, int& pm, int& pn) {
    const int nwg = nM * nN; int wgid = L; { const int q = nwg / NXCD, r = nwg % NXCD, xcd = wgid % NXCD, off = wgid / NXCD; wgid = (xcd < r ? xcd * (q + 1) : r * (q + 1) + (xcd - r) * q) + off; }
    const int nig = WGM * nN, gid = wgid / nig, fm = gid * WGM, gsz = (nM - fm) < WGM ? (nM - fm) : WGM;
    pm = fm + ((wgid % nig) % gsz); pn = (wgid % nig) / gsz; }

template <class Epi, class Sched>
DEV void gemm_phase(LAS unsigned char* lds, int lda, int ldb, const Sched& S, const Epi& E) {
    const int tid = otid(), wid = __builtin_amdgcn_readfirstlane(tid >> 6), lane = tid & 63, wr = wid >> 2, wc = wid & 3, fr = lane & 15, fq = lane >> 4;
    unsigned voffA[2], voffB[2];
#pragma unroll
    for (int i = 0; i < 2; ++i) { int R, C; stage_rc(tid * 16 + i * 8192, R, C); const int Rb = (R & ~31) + perm32(R & 31);
        voffA[i] = (unsigned)(R * lda + C) * 2u; voffB[i] = (unsigned)(Rb * ldb + C) * 2u; }
    const size_t kstep = (size_t)(BK * 2);
    const size_t hstepA = (size_t)HALF * lda * 2, hstepB = (size_t)HALF * ldb * 2;
    const unsigned ldsw = (unsigned)wid * 1024u;
    const int aoff = lds_byte(wr * 64 + fr, fq * 8), boff = lds_byte(wc * 32 + fr, fq * 8);
#define PG8_SA(b, h) (((b) * 2 + (h)) * HTB)
#define PG8_SB(b, h) ((4 + (b) * 2 + (h)) * HTB)
#define PG8_STAGE(bufoff, gbase, voff) do { _Pragma("unroll") for (int _i = 0; _i < 2; ++_i) \
        __builtin_amdgcn_global_load_lds((const unsigned*)((const char*)(gbase) + (voff)[_i]), (LAS unsigned*)(lds + (bufoff) + ldsw + _i * 8192), 16, 0, 0); } while (0)
#define PG8_LDA(dst, b, h) do { _Pragma("unroll") for (int m = 0; m < 4; ++m) _Pragma("unroll") for (int k = 0; k < 2; ++k) dst[m][k] = *(const LAS bf16x8*)(lds + PG8_SA(b, h) + aoff + m * 2048 + k * 1024); } while (0)
#define PG8_LDB(dst, b, h) do { _Pragma("unroll") for (int n = 0; n < 2; ++n) _Pragma("unroll") for (int k = 0; k < 2; ++k) dst[n][k] = *(const LAS bf16x8*)(lds + PG8_SB(b, h) + boff + n * 2048 + k * 1024); } while (0)
#define PG8_MMA(ai, bj, At, Bt) do { __builtin_amdgcn_s_setprio(1); _Pragma("unroll") for (int m = 0; m < 4; ++m) _Pragma("unroll") for (int n = 0; n < 2; ++n) _Pragma("unroll") for (int k = 0; k < 2; ++k) \
        acc[ai][bj][m][n] = __builtin_amdgcn_mfma_f32_16x16x32_bf16(Bt[n][k], At[m][k], acc[ai][bj][m][n], 0, 0, 0); __builtin_amdgcn_s_setprio(0); } while (0)
#define PG8_WAIT_V(n) asm volatile("s_waitcnt vmcnt(" #n ")" ::: "memory")
#define PG8_WAIT_L(n) asm volatile("s_waitcnt lgkmcnt(" #n ")" ::: "memory")
#define PG8_BAR __builtin_amdgcn_s_barrier()
#define PG8_SCHED __builtin_amdgcn_sched_barrier(0)
    Unit cur, nxt; int ui = 0;
    if (!S.next(0, cur)) return;
    f32x4 acc[2][2][4][2];
#pragma unroll
    for (int a = 0; a < 2; ++a)
#pragma unroll
        for (int b = 0; b < 2; ++b)
#pragma unroll
            for (int m = 0; m < 4; ++m)
#pragma unroll
                for (int n = 0; n < 2; ++n) acc[a][b][m][n] = (f32x4){0.f, 0.f, 0.f, 0.f};
    bf16x8 At[4][2], B0[2][2], B1[2][2];
    const char* cA = cur.A; const char* cB = cur.B;
    PG8_STAGE(PG8_SB(0, 0), cB, voffB); PG8_STAGE(PG8_SA(0, 0), cA, voffA); PG8_STAGE(PG8_SB(0, 1), cB + hstepB, voffB); PG8_STAGE(PG8_SA(0, 1), cA + hstepA, voffA);
    if (wr == 1) PG8_BAR;
    PG8_WAIT_V(4); PG8_BAR;
    PG8_STAGE(PG8_SB(1, 0), cB + kstep, voffB); PG8_STAGE(PG8_SA(1, 0), cA + kstep, voffA); PG8_STAGE(PG8_SB(1, 1), cB + hstepB + kstep, voffB);
    PG8_WAIT_V(6); PG8_BAR;
    for (;;) {
        const bool has_next = S.next(ui + 1, nxt);
        const char* nA = has_next ? nxt.A : cA; const char* nB = has_next ? nxt.B : cB;
        const int nt = cur.nt;
        for (int t = 0; t < nt; t += 2) {
            const bool last = (t == nt - 2);
            const char* a1 = cA + (size_t)(t + 1) * kstep;
            const char* a2 = last ? nA : cA + (size_t)(t + 2) * kstep; const char* b2 = last ? nB : cB + (size_t)(t + 2) * kstep;
            const char* a3 = a2 + kstep; const char* b3 = b2 + kstep;
            PG8_LDB(B0, 0, 0); PG8_SCHED; PG8_LDA(At, 0, 0); PG8_STAGE(PG8_SA(1, 1), a1 + hstepA, voffA);
            PG8_WAIT_L(8); PG8_BAR; PG8_WAIT_L(0); PG8_MMA(0, 0, At, B0); PG8_BAR; PG8_SCHED;
            PG8_LDB(B1, 0, 1); PG8_STAGE(PG8_SB(0, 0), b2, voffB);
            PG8_BAR; PG8_WAIT_L(0); PG8_MMA(0, 1, At, B1); PG8_BAR;
            PG8_LDA(At, 0, 1); PG8_STAGE(PG8_SA(0, 0), a2, voffA);
            PG8_BAR; PG8_WAIT_L(0); PG8_MMA(1, 0, At, B0); PG8_BAR; PG8_SCHED;
            PG8_STAGE(PG8_SB(0, 1), b2 + hstepB, voffB);
            PG8_WAIT_V(6); PG8_BAR; PG8_MMA(1, 1, At, B1); PG8_BAR;
            PG8_LDB(B0, 1, 0); PG8_SCHED; PG8_LDA(At, 1, 0); PG8_STAGE(PG8_SA(0, 1), a2 + hstepA, voffA);
            PG8_WAIT_L(8); PG8_BAR; PG8_WAIT_L(0); PG8_MMA(0, 0, At, B0); PG8_BAR; PG8_SCHED;
            PG8_LDB(B1, 1, 1); PG8_STAGE(PG8_SB(1, 0), b3, voffB);
            PG8_BAR; PG8_WAIT_L(0); PG8_MMA(0, 1, At, B1); PG8_BAR;
            PG8_LDA(At, 1, 1); PG8_STAGE(PG8_SA(1, 0), a3, voffA);
            PG8_BAR; PG8_WAIT_L(0); PG8_MMA(1, 0, At, B0); PG8_BAR; PG8_SCHED;
            PG8_STAGE(PG8_SB(1, 1), b3 + hstepB, voffB);
            PG8_WAIT_V(6); PG8_BAR; PG8_MMA(1, 1, At, B1); PG8_BAR;
        }
        E(acc, cur, wr, wc, fr, fq);
        if (!has_next) break;
#pragma unroll
        for (int a = 0; a < 2; ++a)
#pragma unroll
            for (int b = 0; b < 2; ++b)
#pragma unroll
                for (int m = 0; m < 4; ++m)
#pragma unroll
                    for (int n = 0; n < 2; ++n) acc[a][b][m][n] = (f32x4){0.f, 0.f, 0.f, 0.f};
        cur = nxt; cA = nA; cB = nB; ++ui;
    }
    PG8_WAIT_V(0);
    if (wr == 0) PG8_BAR;
    PG8_BAR;
#undef PG8_SA
#undef PG8_SB
#undef PG8_STAGE
#undef PG8_LDA
#undef PG8_LDB
#undef PG8_MMA
#undef PG8_WAIT_V
#undef PG8_WAIT_L
#undef PG8_BAR
#undef PG8_SCHED
}
#define EPI_LOOP_BEGIN \
    _Pragma("unroll") for (int ai = 0; ai < 2; ++ai) _Pragma("unroll") for (int m = 0; m < 4; ++m) { const int row = u.pm * 256 + ai * 128 + wr * 64 + m * 16 + fr; \
    _Pragma("unroll") for (int bj = 0; bj < 2; ++bj) { const int col0 = u.pn * 256 + bj * 128 + wc * 32 + fq * 8; const f32x4 v0 = acc[ai][bj][m][0], v1 = acc[ai][bj][m][1];
#define EPI_LOOP_END } }
}
using pg8::Unit;
typedef f32x4 AccT[2][2][4][2];

struct Sched1 { int G, c; const char *h, *hm, *btin, *btkv;
    DEV bool next(int i, Unit& u) const {
        long L = (long)i * G + c;
        if (L < 1980) { pg8::tile_map((int)L, 66, 30, u.pm, u.pn); u.kind = 0; u.nt = 16; u.A = h + (size_t)u.pm * 524288; u.B = btin + (size_t)u.pn * 524288; return true; }
        L -= 1980; if (L < 32) { u.pm = (int)(L & 7); u.pn = (int)(L >> 3); u.kind = 1; u.nt = 16; u.A = hm + (size_t)u.pm * 524288; u.B = btkv + (size_t)u.pn * 524288; return true; }
        return false; } };
struct Epi1 { bf16_t* P; bf16_t* mkb; float* out; const float *ropeC, *ropeS, *b_gate;
    DEV void operator()(const AccT& acc, const Unit& u, int wr, int wc, int fr, int fq) const {
        if (u.kind == 1) {
            EPI_LOOP_BEGIN
                float* o = (col0 < 512) ? out + O_MK + (size_t)row * 512 + col0 : out + O_MV + (size_t)row * 512 + (col0 - 512);
                *(f32x4*)o = v0; *(f32x4*)(o + 4) = v1;
                u32x4 pk; pk.x = pk2(v0.x, v0.y); pk.y = pk2(v0.z, v0.w); pk.z = pk2(v1.x, v1.y); pk.w = pk2(v1.z, v1.w);
                *(u32x4*)(mkb + (size_t)row * 1024 + col0) = pk;
            EPI_LOOP_END
            return; }
        const int pn = u.pn;
        if (pn < 4) {
            const float sc = (pn >= 2) ? 0.08838834764831845f : 1.f;
            EPI_LOOP_BEGIN
                const int pidx = row < NP ? (row & 2047) : 2048 + ((row - NP) & 3);
                const int uu = (col0 & 127) >> 3, hb = col0 & ~127;
                const f32x4 cs = *(const f32x4*)(ropeC + pidx * 64 + 4 * uu), sn = *(const f32x4*)(ropeS + pidx * 64 + 4 * uu);
                const f32x4 o1 = (v0 * cs - v1 * sn) * sc, o2 = (v0 * sn + v1 * cs) * sc;
                u32x2 a; a.x = pk2(o1.x, o1.y); a.y = pk2(o1.z, o1.w); u32x2 b; b.x = pk2(o2.x, o2.y); b.y = pk2(o2.z, o2.w);
                *(u32x2*)(P + (size_t)row * INC + hb + 4 * uu) = a; *(u32x2*)(P + (size_t)row * INC + hb + 64 + 4 * uu) = b;
            EPI_LOOP_END
            return; }
        const int mode = pn < 8 ? 0 : pn < 12 ? 1 : pn < 14 ? 2 : pn < 16 ? 0 : pn < 18 ? 2 : 3;
        EPI_LOOP_BEGIN
            f32x4 a = v0, b = v1;
            if (mode == 1) { for (int i = 0; i < 4; ++i) { a[i] = silu_f(a[i]); b[i] = silu_f(b[i]); } }
            else if (mode == 2) { for (int i = 0; i < 4; ++i) { a[i] = gelu_t(a[i]); b[i] = gelu_t(b[i]); } }
            else if (mode == 3) { const f32x4 b0 = *(const f32x4*)(b_gate + col0 - C_GT), b1 = *(const f32x4*)(b_gate + col0 - C_GT + 4);
                for (int i = 0; i < 4; ++i) { a[i] = sigm_f(a[i] + b0[i]); b[i] = sigm_f(b[i] + b1[i]); } }
            u32x4 pk; pk.x = pk2(a.x, a.y); pk.y = pk2(a.z, a.w); pk.z = pk2(b.x, b.y); pk.w = pk2(b.z, b.w);
            *(u32x4*)(P + (size_t)row * INC + col0) = pk;
        EPI_LOOP_END
    } };

struct SchedMg { int G, c; const char *P, *bt;
    DEV bool next(int i, Unit& u) const {
        const int T = i / 3, br = i - 3 * T; const long L = (long)T * G + c; if (L >= 256) return false;
        pg8::tile_map((int)L, 64, 4, u.pm, u.pn); u.kind = br; u.nt = br == 0 ? 16 : 8;
        const int koff = br == 0 ? 0 : br == 1 ? 1024 : 1536;
        u.A = P + (size_t)u.pm * 256 * INC * 2 + (size_t)(C_G + koff) * 2; u.B = bt + (size_t)u.pn * 256 * 2048 * 2 + (size_t)koff * 2; return true; } };
struct SchedMgS { int c; const char *P, *bt;
    DEV bool next(int i, Unit& u) const {
        if (i > 0 || c >= 64) return false;
        const int tile = c >> 3, ch = c & 7; u.pm = 64 + (tile >> 2); u.pn = tile & 3; u.kind = ch; u.nt = 4;
        const int koff = ch * 256;
        u.A = P + (size_t)u.pm * 256 * INC * 2 + (size_t)(C_G + koff) * 2; u.B = bt + (size_t)u.pn * 256 * 2048 * 2 + (size_t)koff * 2; return true; } };
struct EpiMg { const bf16_t* P; float* tmp; bf16_t* mg;
    DEV void operator()(const AccT& acc, const Unit& u, int wr, int wc, int fr, int fq) const {
        const int br = u.kind;
        EPI_LOOP_BEGIN
            const u32x4 g = *(const u32x4*)(P + (size_t)row * INC + C_GT + br * 1024 + col0);
            f32x4 a, b; a.x = bf_lo(g.x) * v0.x; a.y = bf_hi(g.x) * v0.y; a.z = bf_lo(g.y) * v0.z; a.w = bf_hi(g.y) * v0.w;
            b.x = bf_lo(g.z) * v1.x; b.y = bf_hi(g.z) * v1.y; b.z = bf_lo(g.w) * v1.z; b.w = bf_hi(g.w) * v1.w;
            float* t = tmp + (size_t)row * 1024 + col0;
            if (br > 0) { a += *(const f32x4*)t; b += *(const f32x4*)(t + 4); }
            if (br < 2) { *(f32x4*)t = a; *(f32x4*)(t + 4) = b; }
            else { u32x4 pk; pk.x = pk2(a.x, a.y); pk.y = pk2(a.z, a.w); pk.z = pk2(b.x, b.y); pk.w = pk2(b.z, b.w); *(u32x4*)(mg + (size_t)row * 1024 + col0) = pk; }
        EPI_LOOP_END
    } };
struct EpiMgS { const bf16_t* P; float* part;
    DEV void operator()(const AccT& acc, const Unit& u, int wr, int wc, int fr, int fq) const {
        const int ch = u.kind, br = ch < 4 ? 0 : ch < 6 ? 1 : 2;
        const bf16_t* gp = P + C_GT + br * 1024; float* tp = part + (size_t)ch * SROWS - (size_t)NP * 1024;
        EPI_LOOP_BEGIN
            const u32x4 g = *(const u32x4*)(gp + (size_t)row * INC + col0);
            float* t = tp + (size_t)row * 1024 + col0;
            f32x4 a, b; a.x = bf_lo(g.x) * v0.x; a.y = bf_hi(g.x) * v0.y; a.z = bf_lo(g.y) * v0.z; a.w = bf_hi(g.y) * v0.w;
            b.x = bf_lo(g.z) * v1.x; b.y = bf_hi(g.z) * v1.y; b.z = bf_lo(g.w) * v1.z; b.w = bf_hi(g.w) * v1.w;
            *(f32x4*)t = a; *(f32x4*)(t + 4) = b; SCHEDB;
        EPI_LOOP_END
    } };
template <int nt, int nsub, int nchunk, int astep, int bstep> struct SchedPS { int G, c; const char *A, *B;
    DEV bool next(int i, Unit& u) const {
        const long L = (long)i * G + c;
        if (L < 256) { pg8::tile_map((int)L, 64, 4, u.pm, u.pn); u.kind = 0; u.nt = nt; u.A = A + (size_t)u.pm * astep; u.B = B + (size_t)u.pn * bstep; return true; }
        const int s = (int)(L - 256); if (s >= nsub) return false;
        const int tile = s / nchunk, ch = s - tile * nchunk; u.pm = 64 + (tile >> 2); u.pn = tile & 3; u.kind = 1 + ch; u.nt = 2;
        u.A = A + (size_t)u.pm * astep + (size_t)ch * 256; u.B = B + (size_t)u.pn * bstep + (size_t)ch * 256; return true; } };
struct SchedPlain { int G, c, nM, nN, nt; const char *A, *B; size_t astep, bstep;
    DEV bool next(int i, Unit& u) const {
        const long L = (long)i * G + c; if (L >= (long)nM * nN) return false;
        pg8::tile_map((int)L, nM, nN, u.pm, u.pn); u.kind = 0; u.nt = nt; u.A = A + (size_t)u.pm * astep; u.B = B + (size_t)u.pn * bstep; return true; } };
struct EpiWo { const float *xp, *xs; float* out; float* part;
    DEV void operator()(const AccT& acc, const Unit& u, int wr, int wc, int fr, int fq) const {
        if (u.kind >= 1) {
            EPI_LOOP_BEGIN
                float* t = part + (size_t)(u.kind - 1) * SROWS + (size_t)(row - NP) * 1024 + col0; *(f32x4*)t = v0; *(f32x4*)(t + 4) = v1;
            EPI_LOOP_END
            return; }
        EPI_LOOP_BEGIN
            const float* x = (row < NP ? xp + (size_t)row * 1024 : xs + (size_t)(row - NP) * 1024) + col0;
            float* o = out + (size_t)row * 1024 + col0;
            *(f32x4*)o = *(const f32x4*)x + v0; *(f32x4*)(o + 4) = *(const f32x4*)(x + 4) + v1;
        EPI_LOOP_END
    } };
struct EpiUp { bf16_t* z; float* out;
    DEV void operator()(const AccT& acc, const Unit& u, int wr, int wc, int fr, int fq) const {
        EPI_LOOP_BEGIN
            u32x4 pk; pk.x = pk2(v0.x, v0.y); pk.y = pk2(v0.z, v0.w); pk.z = pk2(v1.x, v1.y); pk.w = pk2(v1.z, v1.w);
            *(u32x4*)(z + (size_t)row * FF2 + col0) = pk;
            float* o = nullptr;
            if (row < NP) { const int t = row & 2047; if (t >= 2046) o = out + O_CONVP + ((size_t)(row >> 11) * 2 + (t - 2046)) * FF2 + col0; }
            else { const int rs = row - NP, t = rs & 3; if (t >= 2) o = out + O_CONVS + ((size_t)(rs >> 2) * 2 + (t - 2)) * FF2 + col0; }
            if (o) { *(f32x4*)o = v0; *(f32x4*)(o + 4) = v1; }
        EPI_LOOP_END
    } };
struct EpiDn { float* out; float* part;
    DEV void operator()(const AccT& acc, const Unit& u, int wr, int wc, int fr, int fq) const {
        if (u.kind >= 1) {
            EPI_LOOP_BEGIN
                float* t = part + (size_t)(u.kind - 1) * SROWS + (size_t)(row - NP) * 1024 + col0; *(f32x4*)t = v0; *(f32x4*)(t + 4) = v1;
            EPI_LOOP_END
            return; }
        EPI_LOOP_BEGIN
            float* o = out + (size_t)row * 1024 + col0;
            *(f32x4*)o = *(const f32x4*)o + v0; *(f32x4*)(o + 4) = *(const f32x4*)(o + 4) + v1;
        EPI_LOOP_END
    } };

DEV int srccol_in(int p) {
    if (p < 1024) { const int hb = p & ~127, pp = p & 127, uu = pp >> 3, v = pp & 7; return hb + ((v < 4) ? 4 * uu + v : 64 + 4 * uu + (v - 4)); }
    if (p >= C_XQ && p < C_SV) return p + 512;
    if (p >= C_SV && p < C_GT) return p - 512;
    return p; }
DEV void transpose_item(const float* W, int N, bf16_t* WT, int ldk, int koff, LAS float* scr, int k0, int n0, int srccol, int lane) {
#pragma unroll 8
    for (int i = 0; i < 32; ++i) { const int kk = 2 * i + (lane >> 5); scr[kk * 33 + (lane & 31)] = W[(size_t)(k0 + kk) * N + srccol]; }
    const int c = lane & 7;
#pragma unroll
    for (int j = 0; j < 4; ++j) { const int n = (lane >> 3) + 8 * j; const LAS float* s = scr + (8 * c) * 33 + n;
        u32x4 o; o.x = pk2(s[0 * 33], s[1 * 33]); o.y = pk2(s[2 * 33], s[3 * 33]); o.z = pk2(s[4 * 33], s[5 * 33]); o.w = pk2(s[6 * 33], s[7 * 33]);
        *(u32x4*)(WT + (size_t)(n0 + n) * ldk + koff + k0 + 8 * c) = o; }
}
DEV void rms_row(const float* xrow, const float* g, bf16_t* orow, int lane) {
    f32x4 v[4]; float s = 0.f;
#pragma unroll
    for (int j = 0; j < 4; ++j) { v[j] = *(const f32x4*)(xrow + 4 * lane + 256 * j); s += v[j].x * v[j].x + v[j].y * v[j].y + v[j].z * v[j].z + v[j].w * v[j].w; }
    s = wave_sum(s); const float r = rsqrtf(s * (1.f / 1024.f) + EPS);
#pragma unroll
    for (int j = 0; j < 4; ++j) { const f32x4 gv = *(const f32x4*)(g + 4 * lane + 256 * j);
        u32x2 o; o.x = pk2(v[j].x * r * gv.x, v[j].y * r * gv.y); o.y = pk2(v[j].z * r * gv.z, v[j].w * r * gv.w);
        *(u32x2*)(orow + 4 * lane + 256 * j) = o; }
}
DEV void phase_prep(const Params& p, LAS unsigned char* lds) {
    const int tid = otid(), lane = tid & 63, wave = tid >> 6;
    const int gw = obid() * 8 + wave, NGW = gridDim.x * 8;
    LAS float* scr = (LAS float*)(lds + wave * 8448);
    unsigned char* ws = p.ws;
    constexpr int I_IN = 16 * 240, I_KV = 16 * 32, I_MR = 16 * 32, I_MS = 8 * 32, I_MX = 8 * 32, I_O = 16 * 32, I_UP = 16 * 176, I_DN = 44 * 32;
    constexpr int N_TR = I_IN + I_KV + I_MR + I_MS + I_MX + I_O + I_UP + I_DN;
    constexpr int N_RMS = MT + 2048, N_ROPE = 2052, N_TRIL = 512;
    constexpr int N_ALL = N_TR + N_RMS + N_ROPE + N_TRIL;
    for (int it = gw; it < N_ALL; it += NGW) {
        int r = it;
        if (r < N_TR) {
            const int l31 = lane & 31;
            if (r < I_IN) { const int kb = r / 240, nb = r % 240; transpose_item(p.w_in, INC, (bf16_t*)(ws + OFF_BTIN), 1024, 0, scr, 64 * kb, 32 * nb, srccol_in(32 * nb + l31), lane); continue; } r -= I_IN;
            if (r < I_KV) { const int kb = r / 32, nb = r % 32; transpose_item(p.w_mem_kv, 1024, (bf16_t*)(ws + OFF_BTKV), 1024, 0, scr, 64 * kb, 32 * nb, 32 * nb + l31, lane); continue; } r -= I_KV;
            if (r < I_MR) { const int kb = r / 32, nb = r % 32; transpose_item(p.w_br_ret, 1024, (bf16_t*)(ws + OFF_BTMG), 2048, 0, scr, 64 * kb, 32 * nb, 32 * nb + l31, lane); continue; } r -= I_MR;
            if (r < I_MS) { const int kb = r / 32, nb = r % 32; transpose_item(p.w_br_sg, 1024, (bf16_t*)(ws + OFF_BTMG), 2048, 1024, scr, 64 * kb, 32 * nb, 32 * nb + l31, lane); continue; } r -= I_MS;
            if (r < I_MX) { const int kb = r / 32, nb = r % 32; transpose_item(p.w_br_x, 1024, (bf16_t*)(ws + OFF_BTMG), 2048, 1536, scr, 64 * kb, 32 * nb, 32 * nb + l31, lane); continue; } r -= I_MX;
            if (r < I_O) { const int kb = r / 32, nb = r % 32; transpose_item(p.w_o, 1024, (bf16_t*)(ws + OFF_BTO), 1024, 0, scr, 64 * kb, 32 * nb, 32 * nb + l31, lane); continue; } r -= I_O;
            if (r < I_UP) { const int kb = r / 176, nb = r % 176; transpose_item(p.w_up, FF2, (bf16_t*)(ws + OFF_BTUP), 1024, 0, scr, 64 * kb, 32 * nb, 32 * nb + l31, lane); continue; } r -= I_UP;
            { const int kb = r / 32, nb = r % 32; transpose_item(p.w_down, 1024, (bf16_t*)(ws + OFF_BTDN), FF, 0, scr, 64 * kb, 32 * nb, 32 * nb + l31, lane); continue; }
        }
        r -= N_TR;
        if (r < N_RMS) {
            if (r < NP) rms_row(p.x_prompt + (size_t)r * 1024, p.norm_mix_g, (bf16_t*)(ws + OFF_R2) + (size_t)r * 1024, lane);
            else if (r < MT) rms_row(p.x_sample + (size_t)(r - NP) * 1024, p.norm_mix_g, (bf16_t*)(ws + OFF_R2) + (size_t)r * 1024, lane);
            else rms_row(p.mem_prompt + (size_t)(r - MT) * 1024, p.mem_norm_g, (bf16_t*)(ws + OFF_HM) + (size_t)(r - MT) * 1024, lane);
            continue; }
        r -= N_RMS;
        if (r < N_ROPE) {
            const int pos = r < 2048 ? r : 16384 + (r - 2048);
            double inv = 1.0;
            if (lane & 1) inv *= 0.8659643233600653; if (lane & 2) inv *= 0.7498942093324559; if (lane & 4) inv *= 0.5623413251903491;
            if (lane & 8) inv *= 0.31622776601683794; if (lane & 16) inv *= 0.1; if (lane & 32) inv *= 0.01;
            double t = (double)pos * inv * 0.15915494309189535; t -= __builtin_rint(t);
            const float tf = (float)t;
            ((float*)(ws + OFF_ROPEC))[r * 64 + lane] = __builtin_amdgcn_cosf(tf);
            ((float*)(ws + OFF_ROPES))[r * 64 + lane] = __builtin_amdgcn_sinf(tf);
            continue; }
        r -= N_ROPE;
        { const int t = r & 127; const float* src = p.sg_ws + (size_t)r * 128 + 2 * lane;
          const float a = (2 * lane <= t) ? src[0] : 0.f, b = (2 * lane + 1 <= t) ? src[1] : 0.f;
          *(unsigned*)((bf16_t*)(ws + OFF_WTRIL) + (size_t)r * 128 + 2 * lane) = pk2(a, b); }
    }
}

DEV void ret_A_item(const Params& p, LAS unsigned char* lds, int item) {
    const int tid = otid(), lane = tid & 63, w = tid >> 6;
    const int c = item & 15, bh = item >> 4, h = bh & 3, b = bh >> 2;
    const size_t row0 = (size_t)b * 2048 + c * 128;
    const bf16_t* P = (const bf16_t*)(p.ws + OFF_P);
    const float lg = log_gamma(h);
    LAS unsigned char* Kt = lds; LAS unsigned char* Vt = lds + 34816;
    for (int i = tid; i < 2048; i += 512) { const int s = i >> 4, ch = i & 15;
        u32x4 v = *(const u32x4*)(P + (row0 + s) * INC + C_K + h * 128 + ch * 8);
        const float dec = __expf((float)(127 - s) * lg);
        v.x = pk2(bf_lo(v.x) * dec, bf_hi(v.x) * dec); v.y = pk2(bf_lo(v.y) * dec, bf_hi(v.y) * dec); v.z = pk2(bf_lo(v.z) * dec, bf_hi(v.z) * dec); v.w = pk2(bf_lo(v.w) * dec, bf_hi(v.w) * dec);
        *(LAS u32x4*)(Kt + s * 272 + ch * 16) = v; }
    for (int i = tid; i < 4096; i += 512) { const int s = i >> 5, ch = i & 31;
        *(LAS u32x4*)(Vt + s * 528 + ch * 16) = *(const u32x4*)(P + (row0 + s) * INC + C_V + h * 256 + ch * 8); }
    __syncthreads();
    f32x4 acc[16];
#pragma unroll
    for (int i = 0; i < 16; ++i) acc[i] = (f32x4){0.f, 0.f, 0.f, 0.f};
    LAS const unsigned char* kb = tr_lane_base(Kt, 272, lane) + 32 * w; LAS const unsigned char* vb = tr_lane_base(Vt, 528, lane);
    bf16x8 af[4]; tr_read4<272, 0, 0>(kb, af);
    static_for<0, 16>([&](auto et_) { constexpr int et = decltype(et_)::value; bf16x8 bf[4]; tr_read4<528, 0, 16 * et>(vb, bf);
#pragma unroll
        for (int ks = 0; ks < 4; ++ks) acc[et] = mfma16(af[ks], bf[ks], acc[et]); });
    float* U = p.out + (size_t)item * 32768;
    const int g = lane >> 4, col = lane & 15;
#pragma unroll
    for (int et = 0; et < 16; ++et)
#pragma unroll
        for (int j = 0; j < 4; ++j) U[(16 * w + 4 * g + j) * 256 + 16 * et + col] = acc[et][j];
    __syncthreads();
}
DEV void scan_phase(const Params& p) {
    const float* U = p.out; bf16_t* Sb = (bf16_t*)(p.ws + OFF_R2);
    for (int idx = obid() * 512 + otid(); idx < 131072; idx += gridDim.x * 512) {
        const int e8 = idx & 31, d = (idx >> 5) & 127, bh = idx >> 12, h = bh & 3;
        const float g128 = __expf(128.f * log_gamma(h));
        f32x4 s0 = (f32x4){0.f, 0.f, 0.f, 0.f}, s1 = s0;
#pragma unroll
        for (int c = 0; c < 16; ++c) {
            const size_t off = (((size_t)bh * 16 + c) * 128 + d) * 256 + e8 * 8;
            u32x4 pk; pk.x = pk2(s0.x, s0.y); pk.y = pk2(s0.z, s0.w); pk.z = pk2(s1.x, s1.y); pk.w = pk2(s1.z, s1.w);
            *(u32x4*)(Sb + off) = pk;
            const f32x4 u0 = *(const f32x4*)(U + off), u1 = *(const f32x4*)(U + off + 4);
            s0 = s0 * g128 + u0; s1 = s1 * g128 + u1; }
        float* o = p.out + O_RETP + ((size_t)bh * 128 + d) * 256 + e8 * 8;
        *(f32x4*)o = s0; *(f32x4*)(o + 4) = s1;
    }
}
DEV void ret_C_item(const Params& p, LAS unsigned char* lds, int item) {
    const int tid = otid(), lane = tid & 63, w = tid >> 6, g = lane >> 4, col = lane & 15;
    const int c = item & 15, bh = item >> 4, h = bh & 3, b = bh >> 2;
    const size_t row0 = (size_t)b * 2048 + c * 128;
    bf16_t* P = (bf16_t*)(p.ws + OFF_P);
    const bf16_t* Sb = (const bf16_t*)(p.ws + OFF_R2) + (size_t)item * 32768;
    const float lg = log_gamma(h);
    LAS unsigned char* Kt = lds; LAS unsigned char* Vh = lds + 34816; LAS unsigned char* Sh = lds + 69632; LAS unsigned char* Sc = lds + 104448 + w * 4352;
    for (int i = tid; i < 2048; i += 512) { const int s = i >> 4, ch = i & 15;
        *(LAS u32x4*)(Kt + s * 272 + ch * 16) = *(const u32x4*)(P + (row0 + s) * INC + C_K + h * 128 + ch * 8); }
    bf16x8 qf[4];
    { const bf16_t* qp = P + (row0 + 16 * w + col) * INC + C_Q + h * 128 + 8 * g;
#pragma unroll
      for (int ks = 0; ks < 4; ++ks) qf[ks] = *(const bf16x8*)(qp + 32 * ks); }
    f32x4 o[16];
    LAS const unsigned char* shb = tr_lane_base(Sh, 272, lane); LAS const unsigned char* vhb = tr_lane_base(Vh, 272, lane);
    bf16x8 scf[4];
    static_for<0, 2>([&](auto hh_) { constexpr int hh = decltype(hh_)::value;
        if (hh == 1) __syncthreads();
        for (int i = tid; i < 2048; i += 512) { const int s = i >> 4, ch = i & 15;
            *(LAS u32x4*)(Vh + s * 272 + ch * 16) = *(const u32x4*)(P + (row0 + s) * INC + C_V + h * 256 + hh * 128 + ch * 8);
            *(LAS u32x4*)(Sh + s * 272 + ch * 16) = *(const u32x4*)(Sb + s * 256 + hh * 128 + ch * 8); }
        __syncthreads();
        if (hh == 0) {
            static_for<0, 8>([&](auto st_) { constexpr int st = decltype(st_)::value; f32x4 a = (f32x4){0.f, 0.f, 0.f, 0.f};
#pragma unroll
                for (int ks = 0; ks < 4; ++ks) a = mfma16(qf[ks], lds_frag(Kt, 272, 16 * st, 32 * ks, lane), a);
#pragma unroll
                for (int j = 0; j < 4; ++j) { const int diff = (16 * w + 4 * g + j) - (16 * st + col);
                    const float v = diff >= 0 ? a[j] * __expf((float)diff * lg) : 0.f;
                    *(LAS bf16_t*)(Sc + (4 * g + j) * 272 + (16 * st + col) * 2) = f2bf(v); }
                SCHEDB; });
#pragma unroll
            for (int ks = 0; ks < 4; ++ks) scf[ks] = lds_frag(Sc, 272, 0, 32 * ks, lane);
        }
        static_for<0, 8>([&](auto et_) { constexpr int et = decltype(et_)::value; f32x4 a = (f32x4){0.f, 0.f, 0.f, 0.f};
            bf16x8 f[4]; tr_read4<272, 0, 16 * et>(shb, f);
#pragma unroll
            for (int ks = 0; ks < 4; ++ks) a = mfma16(qf[ks], f[ks], a);
#pragma unroll
            for (int j = 0; j < 4; ++j) a[j] *= __expf((float)(16 * w + 4 * g + j + 1) * lg);
            tr_read4<272, 0, 16 * et>(vhb, f);
#pragma unroll
            for (int ks = 0; ks < 4; ++ks) a = mfma16(scf[ks], f[ks], a);
            o[hh * 8 + et] = a; SCHEDB; });
    });
    const float* gn = p.ret_gn_g + h * 256;
#pragma unroll
    for (int j = 0; j < 4; ++j) {
        float s = 0.f;
#pragma unroll
        for (int t = 0; t < 16; ++t) s += o[t][j];
        const float mean = g16_sum(s) * (1.f / 256.f);
        float s2 = 0.f;
#pragma unroll
        for (int t = 0; t < 16; ++t) { const float dd = o[t][j] - mean; s2 += dd * dd; }
        const float rstd = rsqrtf(g16_sum(s2) * (1.f / 256.f) + EPS);
        bf16_t* gp = P + (row0 + 16 * w + 4 * g + j) * INC + C_G + h * 256;
#pragma unroll
        for (int t = 0; t < 16; ++t) { const int e = (t >> 3) * 128 + (t & 7) * 16 + col;
            gp[e] = f2bf((o[t][j] - mean) * rstd * gn[e] * bf2f(gp[e])); }
        SCHEDB;
    }
    __syncthreads();
}
DEV void sgu_item(const Params& p, LAS unsigned char* lds, int item) {
    const int tid = otid(), lane = tid & 63, w = tid >> 6, g = lane >> 4, col = lane & 15;
    const int gq = item & 3, bn = item >> 2; const size_t row0 = (size_t)bn * 128;
    bf16_t* P = (bf16_t*)(p.ws + OFF_P);
    LAS unsigned char* VN = lds;
    for (int rr = 0; rr < 16; ++rr) { const int s = 16 * w + rr;
        const u32x4 v = *(const u32x4*)(P + (row0 + s) * INC + C_SV + lane * 8);
        float x[8] = {bf_lo(v.x), bf_hi(v.x), bf_lo(v.y), bf_hi(v.y), bf_lo(v.z), bf_hi(v.z), bf_lo(v.w), bf_hi(v.w)};
        float sm = 0.f;
#pragma unroll
        for (int i = 0; i < 8; ++i) sm += x[i];
        const float mean = wave_sum(sm) * (1.f / 512.f); float s2 = 0.f;
#pragma unroll
        for (int i = 0; i < 8; ++i) { x[i] -= mean; s2 += x[i] * x[i]; }
        const float rstd = rsqrtf(wave_sum(s2) * (1.f / 512.f) + EPS);
        if (g == gq) { const float* lg = p.sg_ln_g + lane * 8; u32x4 o;
            o.x = pk2(x[0] * rstd * lg[0], x[1] * rstd * lg[1]); o.y = pk2(x[2] * rstd * lg[2], x[3] * rstd * lg[3]);
            o.z = pk2(x[4] * rstd * lg[4], x[5] * rstd * lg[5]); o.w = pk2(x[6] * rstd * lg[6], x[7] * rstd * lg[7]);
            *(LAS u32x4*)(VN + s * 272 + col * 16) = o; } }
    bf16x8 af[4];
    { const bf16_t* wp = (const bf16_t*)(p.ws + OFF_WTRIL) + (size_t)(gq * 128 + 16 * w + col) * 128 + 8 * g;
#pragma unroll
      for (int ks = 0; ks < 4; ++ks) af[ks] = *(const bf16x8*)(wp + 32 * ks); }
    __syncthreads();
    LAS const unsigned char* vnb = tr_lane_base(VN, 272, lane);
    static_for<0, 8>([&](auto ct_) { constexpr int ct = decltype(ct_)::value; f32x4 a = (f32x4){0.f, 0.f, 0.f, 0.f};
        bf16x8 f[4]; tr_read4<272, 0, 16 * ct>(vnb, f);
#pragma unroll
        for (int ks = 0; ks < 4; ++ks) a = mfma16(af[ks], f[ks], a);
#pragma unroll
        for (int j = 0; j < 4; ++j) { const int t = 16 * w + 4 * g + j; bf16_t* up = P + (row0 + t) * INC + C_SU + gq * 128 + 16 * ct + col;
            *up = f2bf(bf2f(*up) * (a[j] + p.sg_bs[gq * 128 + t])); } });
    __syncthreads();
}
DEV void xattn_item(const Params& p, LAS unsigned char* lds, int item) {
    const int tid = otid(), lane = tid & 63, w = tid >> 6, g = lane >> 4, col = lane & 15;
    const int qt = item & 15, bh = item >> 4, h = bh & 3, b = bh >> 2; const size_t row0 = (size_t)b * 2048 + qt * 128;
    bf16_t* P = (bf16_t*)(p.ws + OFF_P); const bf16_t* mkb = (const bf16_t*)(p.ws + OFF_MKB);
    LAS unsigned char* KV = lds; LAS unsigned char* Pw = lds + 69632 + w * 8448;
    for (int i = tid; i < 4096; i += 512) { const int m = i >> 4, ch = i & 15;
        *(LAS u32x4*)(KV + m * 272 + ch * 16) = *(const u32x4*)(mkb + (size_t)(b * 256 + m) * 1024 + h * 128 + ch * 8); }
    bf16x8 qf[4];
    { const bf16_t* qp = P + (row0 + 16 * w + col) * INC + C_XQ + h * 128 + 8 * g;
#pragma unroll
      for (int ks = 0; ks < 4; ++ks) qf[ks] = *(const bf16x8*)(qp + 32 * ks); }
    __syncthreads();
    f32x4 sc[16];
    static_for<0, 16>([&](auto mt_) { constexpr int mt = decltype(mt_)::value; f32x4 a = (f32x4){0.f, 0.f, 0.f, 0.f};
#pragma unroll
        for (int ks = 0; ks < 4; ++ks) a = mfma16(qf[ks], lds_frag(KV, 272, 16 * mt, 32 * ks, lane), a);
        sc[mt] = a * 0.08838834764831845f; SCHEDB; });
#pragma unroll
    for (int j = 0; j < 4; ++j) { float mx = -3.0e38f;
#pragma unroll
        for (int mt = 0; mt < 16; ++mt) mx = fmaxf(mx, sc[mt][j]);
        mx = g16_max(mx); float sm = 0.f;
#pragma unroll
        for (int mt = 0; mt < 16; ++mt) { const float e = __expf(sc[mt][j] - mx); sc[mt][j] = e; sm += e; }
        const float inv = 1.f / g16_sum(sm);
#pragma unroll
        for (int mt = 0; mt < 16; ++mt) *(LAS bf16_t*)(Pw + (4 * g + j) * 528 + (16 * mt + col) * 2) = f2bf(sc[mt][j] * inv); }
    __syncthreads();
    for (int i = tid; i < 4096; i += 512) { const int m = i >> 4, ch = i & 15;
        *(LAS u32x4*)(KV + m * 272 + ch * 16) = *(const u32x4*)(mkb + (size_t)(b * 256 + m) * 1024 + 512 + h * 128 + ch * 8); }
    __syncthreads();
    LAS const unsigned char* kvb = tr_lane_base(KV, 272, lane);
    bf16x8 pf[8];
#pragma unroll
    for (int ks = 0; ks < 8; ++ks) pf[ks] = lds_frag(Pw, 528, 0, 32 * ks, lane);
    static_for<0, 8>([&](auto dt_) { constexpr int dt = decltype(dt_)::value; f32x4 a = (f32x4){0.f, 0.f, 0.f, 0.f};
        bf16x8 f[4]; tr_read4<272, 0, 16 * dt>(kvb, f);
#pragma unroll
        for (int ks = 0; ks < 4; ++ks) a = mfma16(pf[ks], f[ks], a);
        tr_read4<272, 128, 16 * dt>(kvb, f);
#pragma unroll
        for (int ks = 0; ks < 4; ++ks) a = mfma16(pf[4 + ks], f[ks], a);
#pragma unroll
        for (int j = 0; j < 4; ++j) P[(row0 + 16 * w + 4 * g + j) * INC + C_XQ + h * 128 + 16 * dt + col] = f2bf(a[j]); });
    __syncthreads();
}
DEV void xattn_s_item(const Params& p, LAS unsigned char* lds, int item) {
    const int tid = otid(), lane = tid & 63, w = tid >> 6, l32 = lane & 31, slot = w * 2 + (lane >> 5);
    const int h = item & 3, b = item >> 2; const size_t rowb = (size_t)NP + b * 4;
    bf16_t* P = (bf16_t*)(p.ws + OFF_P);
    LAS float* sc = (LAS float*)lds; LAS float* red = (LAS float*)(lds + 4096);
    float q[4][4];
#pragma unroll
    for (int l = 0; l < 4; ++l) { const u32x2 v = *(const u32x2*)(P + (rowb + l) * INC + C_XQ + h * 128 + 4 * l32); q[l][0] = bf_lo(v.x); q[l][1] = bf_hi(v.x); q[l][2] = bf_lo(v.y); q[l][3] = bf_hi(v.y); }
#pragma unroll
    for (int it = 0; it < 16; ++it) { const int m = it * 16 + slot;
        const f32x4 kv = *(const f32x4*)(p.cache_k + (((size_t)b * 256 + m) * 4 + h) * 128 + 4 * l32);
#pragma unroll
        for (int l = 0; l < 4; ++l) { float d = q[l][0] * kv.x + q[l][1] * kv.y + q[l][2] * kv.z + q[l][3] * kv.w;
#pragma unroll
            for (int o = 1; o < 32; o <<= 1) d += __shfl_xor(d, o);
            if (l32 == 0) sc[l * 256 + m] = d * 0.08838834764831845f; } }
    __syncthreads();
    if (w < 4) { float v[4]; float mx = -3.0e38f;
#pragma unroll
        for (int i = 0; i < 4; ++i) { v[i] = sc[w * 256 + lane + 64 * i]; mx = fmaxf(mx, v[i]); }
        mx = wave_max(mx); float sm = 0.f;
#pragma unroll
        for (int i = 0; i < 4; ++i) { v[i] = __expf(v[i] - mx); sm += v[i]; }
        const float inv = 1.f / wave_sum(sm);
#pragma unroll
        for (int i = 0; i < 4; ++i) sc[w * 256 + lane + 64 * i] = v[i] * inv; }
    __syncthreads();
    f32x4 o[4];
#pragma unroll
    for (int l = 0; l < 4; ++l) o[l] = (f32x4){0.f, 0.f, 0.f, 0.f};
#pragma unroll
    for (int it = 0; it < 16; ++it) { const int m = it * 16 + slot;
        const f32x4 vv = *(const f32x4*)(p.cache_v + (((size_t)b * 256 + m) * 4 + h) * 128 + 4 * l32);
#pragma unroll
        for (int l = 0; l < 4; ++l) o[l] += vv * sc[l * 256 + m]; }
#pragma unroll
    for (int l = 0; l < 4; ++l) *(LAS f32x4*)(red + (slot * 4 + l) * 128 + 4 * l32) = o[l];
    __syncthreads();
    { const int l = tid >> 7, d = tid & 127; float s = 0.f;
#pragma unroll
      for (int k = 0; k < 16; ++k) s += red[(k * 4 + l) * 128 + d];
      P[(rowb + l) * INC + C_XQ + h * 128 + d] = f2bf(s); }
    __syncthreads();
}
DEV void ret_s_item(const Params& p, LAS unsigned char* lds, int item) {
    const int tid = otid(), lane = tid & 63, w = tid >> 6;
    const int h = item & 3, b = item >> 2; const size_t rowb = (size_t)NP + b * 4;
    bf16_t* P = (bf16_t*)(p.ws + OFF_P);
    const float lg = log_gamma(h);
    LAS float* qs = (LAS float*)lds;
    LAS float* kr = qs + 512;
    LAS float* vs = kr + 512;
    LAS float* ob = vs + 1024;
    LAS float* scm = ob + 1024;
    LAS float* red = scm + 16;
    { const int t = tid >> 7, d = tid & 127;
      qs[t * 128 + d] = bf2f(P[(rowb + t) * INC + C_Q + h * 128 + d]); kr[t * 128 + d] = bf2f(P[(rowb + t) * INC + C_K + h * 128 + d]);
      vs[t * 256 + d] = bf2f(P[(rowb + t) * INC + C_V + h * 256 + d]); vs[t * 256 + 128 + d] = bf2f(P[(rowb + t) * INC + C_V + h * 256 + 128 + d]); }
    __syncthreads();
    if (tid < 16) { const int t = tid >> 2, s = tid & 3; float d = 0.f;
        for (int k = 0; k < 128; ++k) d += qs[t * 128 + k] * kr[s * 128 + k];
        scm[tid] = (t >= s) ? d * __expf((float)(t - s) * lg) : 0.f; }
    f32x4 v[4], cr[4];
#pragma unroll
    for (int s = 0; s < 4; ++s) { v[s] = *(LAS f32x4*)(vs + s * 256 + 4 * lane); cr[s] = (f32x4){0.f, 0.f, 0.f, 0.f}; }
    const float g4 = __expf(4.f * lg), kd0 = __expf(3.f * lg), kd1 = __expf(2.f * lg), kd2 = __expf(lg);
    const float* S0 = p.state_ret + ((size_t)item * 128) * 256; float* Sn = p.out + O_RETS + ((size_t)item * 128) * 256;
#pragma unroll 8
    for (int dd = 0; dd < 16; ++dd) { const int d = 16 * w + dd;
        const f32x4 s0 = *(const f32x4*)(S0 + d * 256 + 4 * lane);
#pragma unroll
        for (int t = 0; t < 4; ++t) cr[t] += s0 * qs[t * 128 + d];
        f32x4 sn = s0 * g4 + v[0] * (kr[d] * kd0) + v[1] * (kr[128 + d] * kd1) + v[2] * (kr[256 + d] * kd2) + v[3] * kr[384 + d];
        *(f32x4*)(Sn + d * 256 + 4 * lane) = sn; }
#pragma unroll
    for (int t = 0; t < 4; ++t) *(LAS f32x4*)(red + (w * 4 + t) * 256 + 4 * lane) = cr[t];
    __syncthreads();
    { const int t = tid >> 7, e2 = (tid & 127) * 2; const float qd = __expf((float)(t + 1) * lg);
#pragma unroll
      for (int i = 0; i < 2; ++i) { const int e = e2 + i; float c = 0.f;
#pragma unroll
          for (int k = 0; k < 8; ++k) c += red[(k * 4 + t) * 256 + e];
          float in = 0.f;
#pragma unroll
          for (int s = 0; s < 4; ++s) in += scm[t * 4 + s] * vs[s * 256 + e];
          ob[t * 256 + e] = in + c * qd; } }
    __syncthreads();
    if (w < 4) { float x[4]; float sm = 0.f;
#pragma unroll
        for (int i = 0; i < 4; ++i) { x[i] = ob[w * 256 + lane + 64 * i]; sm += x[i]; }
        const float mean = wave_sum(sm) * (1.f / 256.f); float s2 = 0.f;
#pragma unroll
        for (int i = 0; i < 4; ++i) { x[i] -= mean; s2 += x[i] * x[i]; }
        const float rstd = rsqrtf(wave_sum(s2) * (1.f / 256.f) + EPS);
        bf16_t* gp = P + (rowb + w) * INC + C_G + h * 256;
#pragma unroll
        for (int i = 0; i < 4; ++i) { const int e = lane + 64 * i; gp[e] = f2bf(x[i] * rstd * p.ret_gn_g[h * 256 + e] * bf2f(gp[e])); } }
    __syncthreads();
}
DEV void sgu_s_item(const Params& p, LAS unsigned char* lds, int b) {
    const int tid = otid(), lane = tid & 63, w = tid >> 6;
    const size_t rowb = (size_t)NP + b * 4;
    bf16_t* P = (bf16_t*)(p.ws + OFF_P);
    LAS float* part = (LAS float*)lds;
    float x[4];
#pragma unroll
    for (int r = 0; r < 4; ++r) { x[r] = bf2f(P[(rowb + r) * INC + C_SV + tid]); const float s = wave_sum(x[r]); if (lane == 0) part[w * 4 + r] = s; }
    __syncthreads();
    float mean[4];
#pragma unroll
    for (int r = 0; r < 4; ++r) { float s = 0.f;
#pragma unroll
        for (int k = 0; k < 8; ++k) s += part[k * 4 + r];
        mean[r] = s * (1.f / 512.f); }
    __syncthreads();
#pragma unroll
    for (int r = 0; r < 4; ++r) { x[r] -= mean[r]; const float s = wave_sum(x[r] * x[r]); if (lane == 0) part[w * 4 + r] = s; }
    __syncthreads();
    const float lng = p.sg_ln_g[tid]; const int gq = tid >> 7;
    float vn[4];
#pragma unroll
    for (int r = 0; r < 4; ++r) { float s = 0.f;
#pragma unroll
        for (int k = 0; k < 8; ++k) s += part[k * 4 + r];
        vn[r] = x[r] * rsqrtf(s * (1.f / 512.f) + EPS) * lng;
        p.out[O_SGV + ((size_t)b * 4 + r) * 512 + tid] = vn[r]; }
#pragma unroll
    for (int t = 0; t < 4; ++t) { float mx = p.sg_bs[gq * 128 + t];
#pragma unroll
        for (int s = 0; s < 4; ++s) if (s <= t) mx += p.sg_ws[(size_t)(gq * 128 + t) * 128 + s] * vn[s];
        bf16_t* up = P + (rowb + t) * INC + C_SU + tid; *up = f2bf(bf2f(*up) * mx); }
    __syncthreads();
}

DEV void rms_phase(const Params& p, bool final_) {
    const int lane = otid() & 63, gw = obid() * 8 + (otid() >> 6), NGW = gridDim.x * 8;
    const float* g = final_ ? p.norm_final_g : p.norm_ffn_g;
    const float* part = (const float*)(p.ws + (final_ ? OFF_PART10 : OFF_PART6)); const int npart = final_ ? 22 : 8;
    for (int r = gw; r < MT; r += NGW) {
        float* xr = p.out + (size_t)r * 1024;
        f32x4 v[4]; float s = 0.f;
        if (r < NP) {
#pragma unroll
            for (int j = 0; j < 4; ++j) v[j] = *(const f32x4*)(xr + 4 * lane + 256 * j);
        } else {
            const float* base = final_ ? xr : p.x_sample + (size_t)(r - NP) * 1024;
#pragma unroll
            for (int j = 0; j < 4; ++j) v[j] = *(const f32x4*)(base + 4 * lane + 256 * j);
            for (int k = 0; k < npart; ++k) { const float* pr = part + (size_t)k * SROWS + (size_t)(r - NP) * 1024;
#pragma unroll
                for (int j = 0; j < 4; ++j) v[j] += *(const f32x4*)(pr + 4 * lane + 256 * j); }
            if (!final_) {
#pragma unroll
                for (int j = 0; j < 4; ++j) *(f32x4*)(xr + 4 * lane + 256 * j) = v[j]; }
        }
#pragma unroll
        for (int j = 0; j < 4; ++j) s += v[j].x * v[j].x + v[j].y * v[j].y + v[j].z * v[j].z + v[j].w * v[j].w;
        s = wave_sum(s); const float rr = rsqrtf(s * (1.f / 1024.f) + EPS);
        if (final_) {
#pragma unroll
            for (int j = 0; j < 4; ++j) { const f32x4 gv = *(const f32x4*)(g + 4 * lane + 256 * j); *(f32x4*)(xr + 4 * lane + 256 * j) = v[j] * rr * gv; }
        } else { bf16_t* orow = (bf16_t*)(p.ws + OFF_R2) + (size_t)r * 1024;
#pragma unroll
            for (int j = 0; j < 4; ++j) { const f32x4 gv = *(const f32x4*)(g + 4 * lane + 256 * j);
                u32x2 o; o.x = pk2(v[j].x * rr * gv.x, v[j].y * rr * gv.y); o.y = pk2(v[j].z * rr * gv.z, v[j].w * rr * gv.w);
                *(u32x2*)(orow + 4 * lane + 256 * j) = o; } }
    }
}
DEV void conv_phase(const Params& p) {
    const bf16_t* z = (const bf16_t*)(p.ws + OFF_Z); bf16_t* act = (bf16_t*)(p.ws + OFF_ACT);
    const long total = (long)MT * 352;
    for (long idx = (long)obid() * 512 + otid(); idx < total; idx += (long)gridDim.x * 512) {
        const int r = (int)(idx / 352), ch = (int)(idx % 352), c = ch * 8;
        const int tpos = r < NP ? (r & 2047) : ((r - NP) & 3);
        float za[8], zb[8];
#pragma unroll
        for (int i = 0; i < 8; ++i) { za[i] = p.conv_b[c + i]; zb[i] = p.conv_b[FF + c + i]; }
#pragma unroll
        for (int j = 0; j < 3; ++j) {
            const int tp = tpos - 2 + j;
            float xa[8], xb[8];
            if (tp >= 0) { const u32x4 a = *(const u32x4*)(z + (size_t)(r - 2 + j) * FF2 + c), bq = *(const u32x4*)(z + (size_t)(r - 2 + j) * FF2 + FF + c);
                xa[0] = bf_lo(a.x); xa[1] = bf_hi(a.x); xa[2] = bf_lo(a.y); xa[3] = bf_hi(a.y); xa[4] = bf_lo(a.z); xa[5] = bf_hi(a.z); xa[6] = bf_lo(a.w); xa[7] = bf_hi(a.w);
                xb[0] = bf_lo(bq.x); xb[1] = bf_hi(bq.x); xb[2] = bf_lo(bq.y); xb[3] = bf_hi(bq.y); xb[4] = bf_lo(bq.z); xb[5] = bf_hi(bq.z); xb[6] = bf_lo(bq.w); xb[7] = bf_hi(bq.w); }
            else if (r >= NP) { const float* sp = p.state_conv + ((size_t)((r - NP) >> 2) * 2 + (tp + 2)) * FF2;
#pragma unroll
                for (int i = 0; i < 8; ++i) { xa[i] = sp[c + i]; xb[i] = sp[FF + c + i]; } }
            else {
#pragma unroll
                for (int i = 0; i < 8; ++i) { xa[i] = 0.f; xb[i] = 0.f; } }
#pragma unroll
            for (int i = 0; i < 8; ++i) { za[i] += p.conv_w[j * FF2 + c + i] * xa[i]; zb[i] += p.conv_w[j * FF2 + FF + c + i] * xb[i]; }
        }
        u32x4 o; o.x = pk2(gelu_t(za[0]) * zb[0], gelu_t(za[1]) * zb[1]); o.y = pk2(gelu_t(za[2]) * zb[2], gelu_t(za[3]) * zb[3]);
        o.z = pk2(gelu_t(za[4]) * zb[4], gelu_t(za[5]) * zb[5]); o.w = pk2(gelu_t(za[6]) * zb[6], gelu_t(za[7]) * zb[7]);
        *(u32x4*)(act + (size_t)r * FF + c) = o;
    }
}


#define XB_TMO      128
#define XB_XCNT(j)  (256  + 64 * (j))
#define XB_XSUB(j)  (1280 + 64 * (j))
#define XB_XGEN(j)  (2304 + 64 * (j))
#define XB_TOP      3328
#define XB_TOPGEN   3392
#define XCD_BAR_WORDS 3456
#define XB_SPIN_CAP (1u << 18)
DEV unsigned xb_ld(unsigned* p)              { return __hip_atomic_load(p, __ATOMIC_RELAXED, __HIP_MEMORY_SCOPE_AGENT); }
DEV unsigned xb_add(unsigned* p, unsigned v) { return __hip_atomic_fetch_add(p, v, __ATOMIC_RELAXED, __HIP_MEMORY_SCOPE_AGENT); }
DEV unsigned xb_xcc_id() { return (unsigned)__builtin_amdgcn_s_getreg((3 << 11) | 20) & 0xFu; }
#define XB_SPIN(cond, bar) do { unsigned _sp = 0; while (cond) { __builtin_amdgcn_s_sleep(1); \
    if ((++_sp & 255u) == 0u) { if (xb_ld(&(bar)[XB_TMO])) break; if (_sp > XB_SPIN_CAP) { atomicAdd(&(bar)[XB_TMO], 1u); break; } } } } while (0)
struct XcdBarrier { unsigned* bar; unsigned x; volatile LAS unsigned* st; };
DEV XcdBarrier xcd_barrier_post(unsigned* bar, volatile LAS unsigned* st) {
    XcdBarrier b; b.bar = bar; b.x = xb_xcc_id(); b.st = st;
    if (threadIdx.x == 0) (void)xb_add(&bar[XB_XCNT(b.x)], 1u);
    return b; }
DEV void xcd_barrier_complete(unsigned* bar, unsigned x, unsigned& nloc, unsigned& nx) {
    const unsigned G = gridDim.x * gridDim.y * gridDim.z;
    unsigned sum, cnt, mine, sp = 0u;
    for (;;) {
        sum = 0u; cnt = 0u; mine = 0u;
#pragma unroll
        for (unsigned j = 0; j < 16; ++j) { const unsigned c = xb_ld(&bar[XB_XCNT(j)]); sum += c; cnt += (c > 0u) ? 1u : 0u; mine = (j == x) ? c : mine; }
        if (sum == G) break;
        __builtin_amdgcn_s_sleep(1);
        if ((++sp & 255u) == 0u) { if (xb_ld(&bar[XB_TMO])) break; if (sp > XB_SPIN_CAP) { atomicAdd(&bar[XB_TMO], 1u); break; } }
    }
    nloc = mine > 0u ? mine : 1u; nx = cnt > 0u ? cnt : 1u; }
DEV void xcd_barrier(unsigned* bar_, volatile LAS unsigned* st_) {
    XcdBarrier b; b.bar = bar_; b.x = xb_xcc_id(); b.st = st_;
    asm volatile("s_waitcnt vmcnt(0)" ::: "memory");
    __syncthreads();
    if (threadIdx.x == 0) {
        unsigned* bar = b.bar;
        __builtin_amdgcn_s_waitcnt(0);
        unsigned nloc = b.st[0], nx = b.st[1];
        if (nloc == 0u) { xcd_barrier_complete(bar, b.x, nloc, nx); b.st[0] = nloc; b.st[1] = nx; }
        const unsigned old = xb_add(&bar[XB_XSUB(b.x)], 1u);
        const unsigned gen = old / nloc;
        if (old + 1u == (gen + 1u) * nloc) {
            __builtin_amdgcn_fence(__ATOMIC_RELEASE, "agent");
            asm volatile("s_waitcnt vmcnt(0)" ::: "memory");
            const unsigned og = xb_add(&bar[XB_TOP], 1u);
            const unsigned tg = og / nx;
            if (og + 1u == (tg + 1u) * nx) xb_add(&bar[XB_TOPGEN], 1u);
            else XB_SPIN(xb_ld(&bar[XB_TOPGEN]) == tg, bar);
            __builtin_amdgcn_fence(__ATOMIC_ACQUIRE, "agent");
            xb_add(&bar[XB_XGEN(b.x)], 1u);
            asm volatile("s_waitcnt vmcnt(0)" ::: "memory");
        } else {
            XB_SPIN(xb_ld(&bar[XB_XGEN(b.x)]) == gen, bar);
            __builtin_amdgcn_fence(__ATOMIC_ACQUIRE, "agent");
            asm volatile("s_waitcnt vmcnt(0)" ::: "memory");
        }
    }
    __syncthreads();
}

DEV Params kp_load() { Params r{};
#if defined(__HIP_DEVICE_COMPILE__)
    typedef const unsigned long long __attribute__((address_space(4))) KA;
    KA* q = (KA*)__builtin_amdgcn_kernarg_segment_ptr(); asm volatile("" : "+s"(q));
    unsigned long long t[28];
#pragma unroll
    for (int i = 0; i < 28; ++i) t[i] = q[i];
    __builtin_memcpy(&r, t, sizeof(Params));
#endif
    return r; }
__global__ __launch_bounds__(512, 2) void mega(Params p_arg, int ph0, int ph1) {
    extern __shared__ __attribute__((aligned(16))) unsigned char shm[];
    LAS unsigned char* lds = (LAS unsigned char*)shm;
    cg::grid_group grid = cg::this_grid();
    const int G = gridDim.x, c = obid();
    volatile LAS unsigned* xst = (volatile LAS unsigned*)(lds + LDS_BYTES - 16);
    if (threadIdx.x == 0) { xst[0] = 0u; xst[1] = 0u; }
    __syncthreads();
    (void)xcd_barrier_post((unsigned*)(kp_load().ws + OFF_BAR), xst);
#define PH_BEGIN(k) if (ph0 <= (k) && (k) < ph1) { if (PHON(k)) { const Params p = kp_load(); unsigned char* ws = p.ws;
#define PH_END(k) } if ((k) + 1 < ph1) { if ((k) == 0) grid.sync(); else xcd_barrier((unsigned*)(kp_load().ws + OFF_BAR), (volatile LAS unsigned*)(lds + LDS_BYTES - 16)); } }
    PH_BEGIN(0) phase_prep(p, lds); PH_END(0)
    PH_BEGIN(1)
            Sched1 S{G, c, (const char*)(ws + OFF_R2), (const char*)(ws + OFF_HM), (const char*)(ws + OFF_BTIN), (const char*)(ws + OFF_BTKV)};
            Epi1 E{(bf16_t*)(ws + OFF_P), (bf16_t*)(ws + OFF_MKB), p.out, (const float*)(ws + OFF_ROPEC), (const float*)(ws + OFF_ROPES), p.b_gate};
            pg8::gemm_phase(lds, 1024, 1024, S, E);
    PH_END(1)
    PH_BEGIN(2)
            for (int it = c; it < 2688; it += G) {
                if (it < 512) ret_A_item(p, lds, it);
                else if (it < 1024) { if (DBG_XA & 1) xattn_item(p, lds, it - 512); }
                else if (it < 1536) sgu_item(p, lds, it - 1024);
                else if (it < 2048) ret_s_item(p, lds, it - 1536);
                else if (it < 2560) { if (DBG_XA & 2) xattn_s_item(p, lds, it - 2048); }
                else sgu_s_item(p, lds, it - 2560);
            }
    PH_END(2)
    PH_BEGIN(3)
            scan_phase(p);
            SchedMgS S{c, (const char*)(ws + OFF_P), (const char*)(ws + OFF_BTMG)};
            EpiMgS E{(const bf16_t*)(ws + OFF_P), (float*)(ws + OFF_MG32)};
            pg8::gemm_phase(lds, INC, 2048, S, E);
    PH_END(3)
    PH_BEGIN(4) for (int it = c; it < 512; it += G) ret_C_item(p, lds, it); PH_END(4)
    PH_BEGIN(5)
            {
                const int i = obid() * 512 + otid();
                if (i < 131072) { f32x4 m = ((const f32x4*)(ws + OFF_MG32))[i];
#pragma unroll
                    for (int k = 1; k < 8; ++k) m += ((const f32x4*)(ws + OFF_MG32))[(size_t)k * 131072 + i];
                    u32x2 o; o.x = pk2(m.x, m.y); o.y = pk2(m.z, m.w);
                    ((u32x2*)((bf16_t*)(ws + OFF_R2) + (size_t)NP * 1024))[i] = o; } }
            SchedMg S{G, c, (const char*)(ws + OFF_P), (const char*)(ws + OFF_BTMG)};
            EpiMg E{(const bf16_t*)(ws + OFF_P), p.out, (bf16_t*)(ws + OFF_R2)};
            pg8::gemm_phase(lds, INC, 2048, S, E);
    PH_END(5)
    PH_BEGIN(6)
            SchedPS<16, 64, 8, 524288, 524288> S{G, c, (const char*)(ws + OFF_R2), (const char*)(ws + OFF_BTO)};
            EpiWo E{p.x_prompt, p.x_sample, p.out, (float*)(ws + OFF_PART6)};
            pg8::gemm_phase(lds, 1024, 1024, S, E);
    PH_END(6)
    PH_BEGIN(7) rms_phase(p, false); PH_END(7)
    PH_BEGIN(8)
            SchedPlain S{G, c, 66, 22, 16, (const char*)(ws + OFF_R2), (const char*)(ws + OFF_BTUP), (size_t)524288, (size_t)524288};
            EpiUp E{(bf16_t*)(ws + OFF_Z), p.out};
            pg8::gemm_phase(lds, 1024, 1024, S, E);
    PH_END(8)
    PH_BEGIN(9) conv_phase(p); PH_END(9)
    PH_BEGIN(10)
            SchedPS<44, 176, 22, 256 * FF * 2, 256 * FF * 2> S{G, c, (const char*)(ws + OFF_ACT), (const char*)(ws + OFF_BTDN)};
            EpiDn E{p.out, (float*)(ws + OFF_PART10)};
            pg8::gemm_phase(lds, FF, FF, S, E);
    PH_END(10)
    PH_BEGIN(11) rms_phase(p, true); PH_END(11)
}

extern "C" void kernel_launch(void* const* d_in, const int* in_sizes, int n_in, void* d_out, int out_size, void* d_ws, size_t ws_size, hipStream_t stream) {
    static int grid = 0;
    if (grid == 0) {
        if (n_in != 26 || out_size != 39018496 || ws_size < WS_END2) { fprintf(stderr, "kernel_launch: unexpected shapes n_in %d out %d ws %zu (need %zu)\n", n_in, out_size, ws_size, (size_t)WS_END2); grid = -1; return; }
        int dev = 0, cus = 0, per_cu = 0;
        hipGetDevice(&dev); hipDeviceGetAttribute(&cus, hipDeviceAttributeMultiprocessorCount, dev);
        if (hipFuncSetAttribute((const void*)mega, hipFuncAttributeMaxDynamicSharedMemorySize, LDS_BYTES) != hipSuccess) { fprintf(stderr, "kernel_launch: hipFuncSetAttribute failed\n"); grid = -1; return; }
        if (hipOccupancyMaxActiveBlocksPerMultiprocessor(&per_cu, (const void*)mega, 512, LDS_BYTES) != hipSuccess || per_cu < 1) { fprintf(stderr, "kernel_launch: occupancy query gave %d\n", per_cu); grid = -1; return; }
        if (cus != 256) { fprintf(stderr, "kernel_launch: built for 256 CUs, got %d\n", cus); grid = -1; return; }
        grid = cus;
    }
    if (grid < 0) return;
    Params p{};
    const float** f = (const float**)&p;
    for (int i = 0; i < 26; ++i) f[i] = (const float*)d_in[i];
    p.out = (float*)d_out; p.ws = (unsigned char*)d_ws;
#ifndef DBG_NPH
#define DBG_NPH 12
#endif
#ifndef MK_MULTI
#define MK_MULTI 0
#endif
#if MK_MULTI
#ifndef PH_SEQ
#define PH_SEQ 0,1,2,3,4,5,6,7,8,9,10,11
#endif
    { const int seq[] = {PH_SEQ}; for (int ph : seq) hipLaunchKernelGGL(mega, dim3(grid), dim3(512), LDS_BYTES, stream, p, ph, ph + 1); }
    hipError_t e = hipSuccess;
#else
    (void)hipMemsetAsync((unsigned char*)d_ws + OFF_BAR, 0, 16384, stream);
    int ph0 = 0, ph1 = NPHASE;
    void* args[] = {&p, &ph0, &ph1};
    hipError_t e = hipLaunchCooperativeKernel((const void*)mega, dim3(grid), dim3(512), args, LDS_BYTES, stream);
#endif
    if (e != hipSuccess) fprintf(stderr, "cooperative launch failed: %s (grid %d)\n", hipGetErrorString(e), grid);
}
```

```cpp
#include <hip/hip_runtime.h>
#include <hip/hip_cooperative_groups.h>
#include <cstdio>
#include <cstdint>
namespace cg = cooperative_groups;

#define LAS __attribute__((address_space(3)))
#define DEV __device__ __forceinline__
typedef unsigned short bf16_t;
typedef short bf16x8 __attribute__((ext_vector_type(8)));
typedef short s16x4 __attribute__((ext_vector_type(4)));
typedef float f32x4 __attribute__((ext_vector_type(4)));
typedef unsigned u32x4 __attribute__((ext_vector_type(4)));
typedef unsigned u32x2 __attribute__((ext_vector_type(2)));

constexpr int NP = 16384, NS = 512, MT = 16896, INC = 7680, FF = 2816, FF2 = 5632;
constexpr int C_Q = 0, C_K = 512, C_V = 1024, C_G = 2048, C_SU = 3072, C_XQ = 3584, C_SV = 4096, C_GT = 4608;
constexpr float EPS = 1e-6f;
constexpr size_t OFF_BTIN = 0;
constexpr size_t OFF_BTKV = OFF_BTIN + 15728640;
constexpr size_t OFF_BTMG = OFF_BTKV + 2097152;
constexpr size_t OFF_BTO = OFF_BTMG + 4194304;
constexpr size_t OFF_BTUP = OFF_BTO + 2097152;
constexpr size_t OFF_BTDN = OFF_BTUP + 11534336;
constexpr size_t OFF_ROPEC = OFF_BTDN + 5767168;
constexpr size_t OFF_ROPES = OFF_ROPEC + 525312;
constexpr size_t OFF_WTRIL = OFF_ROPES + 525312;
constexpr size_t OFF_HM = OFF_WTRIL + 131072;
constexpr size_t OFF_MKB = OFF_HM + 4194304;
constexpr size_t OFF_P = OFF_MKB + 4194304;
constexpr size_t OFF_R2 = OFF_P + 259522560;
constexpr size_t OFF_MG32 = OFF_R2 + 34603008;
constexpr size_t WS_END = OFF_MG32 + 8 * 2097152;
constexpr size_t OFF_BAR = WS_END;
constexpr size_t WS_END2 = OFF_BAR + 16384;
constexpr size_t OFF_PART6 = OFF_P, OFF_PART10 = OFF_P;
constexpr int SROWS = 512 * 1024;
constexpr size_t OFF_Z = OFF_P;
constexpr size_t OFF_ACT = OFF_P + 190316544;
constexpr size_t O_Y = 0, O_RETP = 17301504, O_CONVP = 18350080, O_MK = 18440192, O_MV = 19488768, O_RETS = 20537344, O_CONVS = 37314560, O_SGV = 38756352;
constexpr int LDS_BYTES = 147456;
constexpr int NPHASE = 12;
#ifndef DBG_XA
#define DBG_XA 3
#endif
#ifndef ONLY_PH
#define ONLY_PH -1
#endif
#ifndef SKIP_PH
#define SKIP_PH -2
#endif
#define PHON(n) ((ONLY_PH < 0 || ONLY_PH == (n)) && SKIP_PH != (n))

struct Params {
    const float *x_prompt, *x_sample, *mem_prompt, *state_ret, *state_conv, *cache_k, *cache_v, *norm_mix_g, *w_in, *b_gate, *ret_gn_g, *sg_ln_g, *sg_ws, *sg_bs,
        *mem_norm_g, *w_mem_kv, *w_br_ret, *w_br_sg, *w_br_x, *w_o, *norm_ffn_g, *w_up, *conv_w, *conv_b, *w_down, *norm_final_g;
    float* out; unsigned char* ws;
};

typedef __bf16 bf16v2_t __attribute__((ext_vector_type(2)));
typedef float f32x2_t __attribute__((ext_vector_type(2)));
DEV unsigned pk2(float lo, float hi) { const f32x2_t f = {lo, hi}; const bf16v2_t v = __builtin_convertvector(f, bf16v2_t); return __builtin_bit_cast(unsigned, v); }
DEV bf16_t f2bf(float v) { return (bf16_t)(pk2(v, 0.f) & 0xffffu); }
DEV float bf_lo(unsigned u) { return __uint_as_float(u << 16); }
DEV float bf_hi(unsigned u) { return __uint_as_float(u & 0xffff0000u); }
DEV float bf2f(bf16_t b) { return __uint_as_float(((unsigned)b) << 16); }
DEV float wave_sum(float v) {
#pragma unroll
    for (int o = 1; o < 64; o <<= 1) v += __shfl_xor(v, o);
    return v; }
DEV float wave_max(float v) {
#pragma unroll
    for (int o = 1; o < 64; o <<= 1) v = fmaxf(v, __shfl_xor(v, o));
    return v; }
DEV float g16_sum(float v) {
#pragma unroll
    for (int o = 1; o < 16; o <<= 1) v += __shfl_xor(v, o);
    return v; }
DEV float g16_max(float v) {
#pragma unroll
    for (int o = 1; o < 16; o <<= 1) v = fmaxf(v, __shfl_xor(v, o));
    return v; }
DEV float gelu_t(float x) { const float u = 1.5957691216057308f * (x + 0.044715f * x * x * x); return x / (1.f + __expf(-u)); }
DEV float silu_f(float x) { return x / (1.f + __expf(-x)); }
DEV float sigm_f(float x) { return 1.f / (1.f + __expf(-x)); }
DEV float log_gamma(int h) { return log1pf(-exp2f(-5.f - (float)h)); }
DEV int otid() { int t = threadIdx.x; asm volatile("" : "+v"(t)); return t; }
DEV int obid() { int t = blockIdx.x; asm volatile("" : "+s"(t)); return t; }
DEV unsigned ldsaddr(LAS const void* p) { return (unsigned)(uintptr_t)p; }
DEV f32x4 mfma16(bf16x8 a, bf16x8 b, f32x4 c) { return __builtin_amdgcn_mfma_f32_16x16x32_bf16(a, b, c, 0, 0, 0); }
DEV bf16x8 lds_frag(LAS const unsigned char* base, int pitch, int row0, int k0, int lane) {
    return *(LAS const bf16x8*)(base + (row0 + (lane & 15)) * pitch + (k0 + 8 * (lane >> 4)) * 2); }
DEV LAS const unsigned char* tr_lane_base(LAS const unsigned char* base, int pitch, int lane) { const int g = lane >> 4, q = (lane & 15) >> 2, pp = lane & 3; return base + ((8 * g + q) * pitch + 8 * pp); }
template <int PITCH, int KB, int X0> DEV void tr_read4(LAS const unsigned char* a, bf16x8 (&f)[4]) {
    constexpr int o0 = KB * PITCH + X0 * 2;
    static_assert(o0 + 100 * PITCH < 65536, "ds offset field");
#pragma unroll
    for (int ks = 0; ks < 4; ++ks) {
        const s16x4 lo = __builtin_amdgcn_ds_read_tr16_b64_v4i16((LAS s16x4*)(a + o0 + ks * 32 * PITCH));
        const s16x4 hi = __builtin_amdgcn_ds_read_tr16_b64_v4i16((LAS s16x4*)(a + o0 + ks * 32 * PITCH + 4 * PITCH));
        f[ks] = (bf16x8){lo[0], lo[1], lo[2], lo[3], hi[0], hi[1], hi[2], hi[3]}; } }
template <int V> struct IC { static constexpr int value = V; };
template <int I, int N, class F> DEV void static_for(F&& f) { if constexpr (I < N) { f(IC<I>{}); static_for<I + 1, N>(f); } }
#define SCHEDB __builtin_amdgcn_sched_barrier(0)

namespace pg8 {
constexpr int BM = 256, BK = 64, HALF = 128, HTB = HALF * BK * 2, NXCD = 8, WGM = 8;
DEV int lds_byte(int r, int c) { const int st = (r >> 4) * 2 + (c >> 5), rr = r & 15, cc = c & 31, ob = rr * 64 + cc * 2; return st * 1024 + (ob ^ (((ob >> 9) & 1) << 5)); }
DEV void stage_rc(int b, int& R, int& C) { const int st = b / 1024, sb = b % 1024, swz = sb ^ (((sb >> 9) & 1) << 5); R = (st >> 1) * 16 + swz / 64; C = (st & 1) * 32 + (swz % 64) / 2; }
DEV int perm32(int rho) { const int n = rho >> 4, i = rho & 15; return 8 * (i >> 2) + 4 * n + (i & 3); }
struct Unit { int pm, pn, kind, nt; const char* A; const char* B; };
DEV void tile_map(int L, int nM, int nN, int& pm, int& pn) {
    const int nwg = nM * nN; int wgid = L; { const int q = nwg / NXCD, r = nwg % NXCD, xcd = wgid % NXCD, off = wgid / NXCD; wgid = (xcd < r ? xcd * (q + 1) : r * (q + 1) + (xcd - r) * q) + off; }
    const int nig = WGM * nN, gid = wgid / nig, fm = gid * WGM, gsz = (nM - fm) < WGM ? (nM - fm) : WGM;
    pm = fm + ((wgid % nig) % gsz); pn = (wgid % nig) / gsz; }

template <class Epi, class Sched>
DEV void gemm_phase(LAS unsigned char* lds, int lda, int ldb, const Sched& S, const Epi& E) {
    const int tid = otid(), wid = __builtin_amdgcn_readfirstlane(tid >> 6), lane = tid & 63, wr = wid >> 2, wc = wid & 3, fr = lane & 15, fq = lane >> 4;
    unsigned voffA[2], voffB[2];
#pragma unroll
    for (int i = 0; i < 2; ++i) { int R, C; stage_rc(tid * 16 + i * 8192, R, C); const int Rb = (R & ~31) + perm32(R & 31);
        voffA[i] = (unsigned)(R * lda + C) * 2u; voffB[i] = (unsigned)(Rb * ldb + C) * 2u; }
    const size_t kstep = (size_t)(BK * 2);
    const size_t hstepA = (size_t)HALF * lda * 2, hstepB = (size_t)HALF * ldb * 2;
    const unsigned ldsw = (unsigned)wid * 1024u;
    const int aoff = lds_byte(wr * 64 + fr, fq * 8), boff = lds_byte(wc * 32 + fr, fq * 8);
#define PG8_SA(b, h) (((b) * 2 + (h)) * HTB)
#define PG8_SB(b, h) ((4 + (b) * 2 + (h)) * HTB)
#define PG8_STAGE(bufoff, gbase, voff) do { _Pragma("unroll") for (int _i = 0; _i < 2; ++_i) \
        __builtin_amdgcn_global_load_lds((const unsigned*)((const char*)(gbase) + (voff)[_i]), (LAS unsigned*)(lds + (bufoff) + ldsw + _i * 8192), 16, 0, 0); } while (0)
#define PG8_LDA(dst, b, h) do { _Pragma("unroll") for (int m = 0; m < 4; ++m) _Pragma("unroll") for (int k = 0; k < 2; ++k) dst[m][k] = *(const LAS bf16x8*)(lds + PG8_SA(b, h) + aoff + m * 2048 + k * 1024); } while (0)
#define PG8_LDB(dst, b, h) do { _Pragma("unroll") for (int n = 0; n < 2; ++n) _Pragma("unroll") for (int k = 0; k < 2; ++k) dst[n][k] = *(const LAS bf16x8*)(lds + PG8_SB(b, h) + boff + n * 2048 + k * 1024); } while (0)
#define PG8_MMA(ai, bj, At, Bt) do { __builtin_amdgcn_s_setprio(1); _Pragma("unroll") for (int m = 0; m < 4; ++m) _Pragma("unroll") for (int n = 0; n < 2; ++n) _Pragma("unroll") for (int k = 0; k < 2; ++k) \
        acc[ai][bj][m][n] = __builtin_amdgcn_mfma_f32_16x16x32_bf16(Bt[n][k], At[m][k], acc[ai][bj][m][n], 0, 0, 0); __builtin_amdgcn_s_setprio(0); } while (0)
#define PG8_WAIT_V(n) asm volatile("s_waitcnt vmcnt(" #n ")" ::: "memory")
#define PG8_WAIT_L(n) asm volatile("s_waitcnt lgkmcnt(" #n ")" ::: "memory")
#define PG8_BAR __builtin_amdgcn_s_barrier()
#define PG8_SCHED __builtin_amdgcn_sched_barrier(0)
    Unit cur, nxt; int ui = 0;
    if (!S.next(0, cur)) return;
    f32x4 acc[2][2][4][2];
#pragma unroll
    for (int a = 0; a < 2; ++a)
#pragma unroll
        for (int b = 0; b < 2; ++b)
#pragma unroll
            for (int m = 0; m < 4; ++m)
#pragma unroll
                for (int n = 0; n < 2; ++n) acc[a][b][m][n] = (f32x4){0.f, 0.f, 0.f, 0.f};
    bf16x8 At[4][2], B0[2][2], B1[2][2];
    const char* cA = cur.A; const char* cB = cur.B;
    PG8_STAGE(PG8_SB(0, 0), cB, voffB); PG8_STAGE(PG8_SA(0, 0), cA, voffA); PG8_STAGE(PG8_SB(0, 1), cB + hstepB, voffB); PG8_STAGE(PG8_SA(0, 1), cA + hstepA, voffA);
    if (wr == 1) PG8_BAR;
    PG8_WAIT_V(4); PG8_BAR;
    PG8_STAGE(PG8_SB(1, 0), cB + kstep, voffB); PG8_STAGE(PG8_SA(1, 0), cA + kstep, voffA); PG8_STAGE(PG8_SB(1, 1), cB + hstepB + kstep, voffB);
    PG8_WAIT_V(6); PG8_BAR;
    for (;;) {
        const bool has_next = S.next(ui + 1, nxt);
        const char* nA = has_next ? nxt.A : cA; const char* nB = has_next ? nxt.B : cB;
        const int nt = cur.nt;
        for (int t = 0; t < nt; t += 2) {
            const bool last = (t == nt - 2);
            const char* a1 = cA + (size_t)(t + 1) * kstep;
            const char* a2 = last ? nA : cA + (size_t)(t + 2) * kstep; const char* b2 = last ? nB : cB + (size_t)(t + 2) * kstep;
            const char* a3 = a2 + kstep; const char* b3 = b2 + kstep;
            PG8_LDB(B0, 0, 0); PG8_SCHED; PG8_LDA(At, 0, 0); PG8_STAGE(PG8_SA(1, 1), a1 + hstepA, voffA);
            PG8_WAIT_L(8); PG8_BAR; PG8_WAIT_L(0); PG8_MMA(0, 0, At, B0); PG8_BAR; PG8_SCHED;
            PG8_LDB(B1, 0, 1); PG8_STAGE(PG8_SB(0, 0), b2, voffB);
            PG8_BAR; PG8_WAIT_L(0); PG8_MMA(0, 1, At, B1); PG8_BAR;
            PG8_LDA(At, 0, 1); PG8_STAGE(PG8_SA(0, 0), a2, voffA);
            PG8_BAR; PG8_WAIT_L(0); PG8_MMA(1, 0, At, B0); PG8_BAR; PG8_SCHED;
            PG8_STAGE(PG8_SB(0, 1), b2 + hstepB, voffB);
            PG8_WAIT_V(6); PG8_BAR; PG8_MMA(1, 1, At, B1); PG8_BAR;
            PG8_LDB(B0, 1, 0); PG8_SCHED; PG8_LDA(At, 1, 0); PG8_STAGE(PG8_SA(0, 1), a2 + hstepA, voffA);
            PG8_WAIT_L(8); PG8_BAR; PG8_WAIT_L(0); PG8_MMA(0, 0, At, B0); PG8_BAR; PG8_SCHED;
            PG8_LDB(B1, 1, 1); PG8_STAGE(PG8_SB(1, 0), b3, voffB);
            PG8_BAR; PG8_WAIT_L(0); PG8_MMA(0, 1, At, B1); PG8_BAR;
            PG8_LDA(At, 1, 1); PG8_STAGE(PG8_SA(1, 0), a3, voffA);
            PG8_BAR; PG8_WAIT_L(0); PG8_MMA(1, 0, At, B0); PG8_BAR; PG8_SCHED;
            PG8_STAGE(PG8_SB(1, 1), b3 + hstepB, voffB);
            PG8_WAIT_V(6); PG8_BAR; PG8_MMA(1, 1, At, B1); PG8_BAR;
        }
        E(acc, cur, wr, wc, fr, fq);
        if (!has_next) break;
#pragma unroll
        for (int a = 0; a < 2; ++a)
#pragma unroll
            for (int b = 0; b < 2; ++b)
#pragma unroll
                for (int m = 0; m < 4; ++m)
#pragma unroll
                    for (int n = 0; n < 2; ++n) acc[a][b][m][n] = (f32x4){0.f, 0.f, 0.f, 0.f};
        cur = nxt; cA = nA; cB = nB; ++ui;
    }
    PG8_WAIT_V(0);
    if (wr == 0) PG8_BAR;
    PG8_BAR;
#undef PG8_SA
#undef PG8_SB
#undef PG8_STAGE
#undef PG8_LDA
#undef PG8_LDB
#undef PG8_MMA
#undef PG8_WAIT_V
#undef PG8_WAIT_L
#undef PG8_BAR
#undef PG8_SCHED
}
#define EPI_LOOP_BEGIN \
    _Pragma("unroll") for (int ai = 0; ai < 2; ++ai) _Pragma("unroll") for (int m = 0; m < 4; ++m) { const int row = u.pm * 256 + ai * 128 + wr * 64 + m * 16 + fr; \
    _Pragma("unroll") for (int bj = 0; bj < 2; ++bj) { const int col0 = u.pn * 256 + bj * 128 + wc * 32 + fq * 8; const f32x4 v0 = acc[ai][bj][m][0], v1 = acc[ai][bj][m][1];
#define EPI_LOOP_END } }
}
using pg8::Unit;
typedef f32x4 AccT[2][2][4][2];

struct Sched1 { int G, c; const char *h, *hm, *btin, *btkv;
    DEV bool next(int i, Unit& u) const {
        long L = (long)i * G + c;
        if (L < 1980) { pg8::tile_map((int)L, 66, 30, u.pm, u.pn); u.kind = 0; u.nt = 16; u.A = h + (size_t)u.pm * 524288; u.B = btin + (size_t)u.pn * 524288; return true; }
        L -= 1980; if (L < 32) { u.pm = (int)(L & 7); u.pn = (int)(L >> 3); u.kind = 1; u.nt = 16; u.A = hm + (size_t)u.pm * 524288; u.B = btkv + (size_t)u.pn * 524288; return true; }
        return false; } };
struct Epi1 { bf16_t* P; bf16_t* mkb; float* out; const float *ropeC, *ropeS, *b_gate;
    DEV void operator()(const AccT& acc, const Unit& u, int wr, int wc, int fr, int fq) const {
        if (u.kind == 1) {
            EPI_LOOP_BEGIN
                float* o = (col0 < 512) ? out + O_MK + (size_t)row * 512 + col0 : out + O_MV + (size_t)row * 512 + (col0 - 512);
                *(f32x4*)o = v0; *(f32x4*)(o + 4) = v1;
                u32x4 pk; pk.x = pk2(v0.x, v0.y); pk.y = pk2(v0.z, v0.w); pk.z = pk2(v1.x, v1.y); pk.w = pk2(v1.z, v1.w);
                *(u32x4*)(mkb + (size_t)row * 1024 + col0) = pk;
            EPI_LOOP_END
            return; }
        const int pn = u.pn;
        if (pn < 4) {
            const float sc = (pn >= 2) ? 0.08838834764831845f : 1.f;
            EPI_LOOP_BEGIN
                const int pidx = row < NP ? (row & 2047) : 2048 + ((row - NP) & 3);
                const int uu = (col0 & 127) >> 3, hb = col0 & ~127;
                const f32x4 cs = *(const f32x4*)(ropeC + pidx * 64 + 4 * uu), sn = *(const f32x4*)(ropeS + pidx * 64 + 4 * uu);
                const f32x4 o1 = (v0 * cs - v1 * sn) * sc, o2 = (v0 * sn + v1 * cs) * sc;
                u32x2 a; a.x = pk2(o1.x, o1.y); a.y = pk2(o1.z, o1.w); u32x2 b; b.x = pk2(o2.x, o2.y); b.y = pk2(o2.z, o2.w);
                *(u32x2*)(P + (size_t)row * INC + hb + 4 * uu) = a; *(u32x2*)(P + (size_t)row * INC + hb + 64 + 4 * uu) = b;
            EPI_LOOP_END
            return; }
        const int mode = pn < 8 ? 0 : pn < 12 ? 1 : pn < 14 ? 2 : pn < 16 ? 0 : pn < 18 ? 2 : 3;
        EPI_LOOP_BEGIN
            f32x4 a = v0, b = v1;
            if (mode == 1) { for (int i = 0; i < 4; ++i) { a[i] = silu_f(a[i]); b[i] = silu_f(b[i]); } }
            else if (mode == 2) { for (int i = 0; i < 4; ++i) { a[i] = gelu_t(a[i]); b[i] = gelu_t(b[i]); } }
            else if (mode == 3) { const f32x4 b0 = *(const f32x4*)(b_gate + col0 - C_GT), b1 = *(const f32x4*)(b_gate + col0 - C_GT + 4);
                for (int i = 0; i < 4; ++i) { a[i] = sigm_f(a[i] + b0[i]); b[i] = sigm_f(b[i] + b1[i]); } }
            u32x4 pk; pk.x = pk2(a.x, a.y); pk.y = pk2(a.z, a.w); pk.z = pk2(b.x, b.y); pk.w = pk2(b.z, b.w);
            *(u32x4*)(P + (size_t)row * INC + col0) = pk;
        EPI_LOOP_END
    } };

struct SchedMg { int G, c; const char *P, *bt;
    DEV bool next(int i, Unit& u) const {
        const int T = i / 3, br = i - 3 * T; const long L = (long)T * G + c; if (L >= 256) return false;
        pg8::tile_map((int)L, 64, 4, u.pm, u.pn); u.kind = br; u.nt = br == 0 ? 16 : 8;
        const int koff = br == 0 ? 0 : br == 1 ? 1024 : 1536;
        u.A = P + (size_t)u.pm * 256 * INC * 2 + (size_t)(C_G + koff) * 2; u.B = bt + (size_t)u.pn * 256 * 2048 * 2 + (size_t)koff * 2; return true; } };
struct SchedMgS { int c; const char *P, *bt;
    DEV bool next(int i, Unit& u) const {
        if (i > 0 || c >= 64) return false;
        const int tile = c >> 3, ch = c & 7; u.pm = 64 + (tile >> 2); u.pn = tile & 3; u.kind = ch; u.nt = 4;
        const int koff = ch * 256;
        u.A = P + (size_t)u.pm * 256 * INC * 2 + (size_t)(C_G + koff) * 2; u.B = bt + (size_t)u.pn * 256 * 2048 * 2 + (size_t)koff * 2; return true; } };
struct EpiMg { const bf16_t* P; float* tmp; bf16_t* mg;
    DEV void operator()(const AccT& acc, const Unit& u, int wr, int wc, int fr, int fq) const {
        const int br = u.kind;
        EPI_LOOP_BEGIN
            const u32x4 g = *(const u32x4*)(P + (size_t)row * INC + C_GT + br * 1024 + col0);
            f32x4 a, b; a.x = bf_lo(g.x) * v0.x; a.y = bf_hi(g.x) * v0.y; a.z = bf_lo(g.y) * v0.z; a.w = bf_hi(g.y) * v0.w;
            b.x = bf_lo(g.z) * v1.x; b.y = bf_hi(g.z) * v1.y; b.z = bf_lo(g.w) * v1.z; b.w = bf_hi(g.w) * v1.w;
            float* t = tmp + (size_t)row * 1024 + col0;
            if (br > 0) { a += *(const f32x4*)t; b += *(const f32x4*)(t + 4); }
            if (br < 2) { *(f32x4*)t = a; *(f32x4*)(t + 4) = b; }
            else { u32x4 pk; pk.x = pk2(a.x, a.y); pk.y = pk2(a.z, a.w); pk.z = pk2(b.x, b.y); pk.w = pk2(b.z, b.w); *(u32x4*)(mg + (size_t)row * 1024 + col0) = pk; }
        EPI_LOOP_END
    } };
struct EpiMgS { const bf16_t* P; float* part;
    DEV void operator()(const AccT& acc, const Unit& u, int wr, int wc, int fr, int fq) const {
        const int ch = u.kind, br = ch < 4 ? 0 : ch < 6 ? 1 : 2;
        const bf16_t* gp = P + C_GT + br * 1024; float* tp = part + (size_t)ch * SROWS - (size_t)NP * 1024;
        EPI_LOOP_BEGIN
            const u32x4 g = *(const u32x4*)(gp + (size_t)row * INC + col0);
            float* t = tp + (size_t)row * 1024 + col0;
            f32x4 a, b; a.x = bf_lo(g.x) * v0.x; a.y = bf_hi(g.x) * v0.y; a.z = bf_lo(g.y) * v0.z; a.w = bf_hi(g.y) * v0.w;
            b.x = bf_lo(g.z) * v1.x; b.y = bf_hi(g.z) * v1.y; b.z = bf_lo(g.w) * v1.z; b.w = bf_hi(g.w) * v1.w;
            *(f32x4*)t = a; *(f32x4*)(t + 4) = b; SCHEDB;
        EPI_LOOP_END
    } };
template <int nt, int nsub, int nchunk, int astep, int bstep> struct SchedPS { int G, c; const char *A, *B;
    DEV bool next(int i, Unit& u) const {
        const long L = (long)i * G + c;
        if (L < 256) { pg8::tile_map((int)L, 64, 4, u.pm, u.pn); u.kind = 0; u.nt = nt; u.A = A + (size_t)u.pm * astep; u.B = B + (size_t)u.pn * bstep; return true; }
        const int s = (int)(L - 256); if (s >= nsub) return false;
        const int tile = s / nchunk, ch = s - tile * nchunk; u.pm = 64 + (tile >> 2); u.pn = tile & 3; u.kind = 1 + ch; u.nt = 2;
        u.A = A + (size_t)u.pm * astep + (size_t)ch * 256; u.B = B + (size_t)u.pn * bstep + (size_t)ch * 256; return true; } };
struct SchedPlain { int G, c, nM, nN, nt; const char *A, *B; size_t astep, bstep;
    DEV bool next(int i, Unit& u) const {
        const long L = (long)i * G + c; if (L >= (long)nM * nN) return false;
        pg8::tile_map((int)L, nM, nN, u.pm, u.pn); u.kind = 0; u.nt = nt; u.A = A + (size_t)u.pm * astep; u.B = B + (size_t)u.pn * bstep; return true; } };
struct EpiWo { const float *xp, *xs; float* out; float* part;
    DEV void operator()(const AccT& acc, const Unit& u, int wr, int wc, int fr, int fq) const {
        if (u.kind >= 1) {
            EPI_LOOP_BEGIN
                float* t = part + (size_t)(u.kind - 1) * SROWS + (size_t)(row - NP) * 1024 + col0; *(f32x4*)t = v0; *(f32x4*)(t + 4) = v1;
            EPI_LOOP_END
            return; }
        EPI_LOOP_BEGIN
            const float* x = (row < NP ? xp + (size_t)row * 1024 : xs + (size_t)(row - NP) * 1024) + col0;
            float* o = out + (size_t)row * 1024 + col0;
            *(f32x4*)o = *(const f32x4*)x + v0; *(f32x4*)(o + 4) = *(const f32x4*)(x + 4) + v1;
        EPI_LOOP_END
    } };
struct EpiUp { bf16_t* z; float* out;
    DEV void operator()(const AccT& acc, const Unit& u, int wr, int wc, int fr, int fq) const {
        EPI_LOOP_BEGIN
            u32x4 pk; pk.x = pk2(v0.x, v0.y); pk.y = pk2(v0.z, v0.w); pk.z = pk2(v1.x, v1.y); pk.w = pk2(v1.z, v1.w);
            *(u32x4*)(z + (size_t)row * FF2 + col0) = pk;
            float* o = nullptr;
            if (row < NP) { const int t = row & 2047; if (t >= 2046) o = out + O_CONVP + ((size_t)(row >> 11) * 2 + (t - 2046)) * FF2 + col0; }
            else { const int rs = row - NP, t = rs & 3; if (t >= 2) o = out + O_CONVS + ((size_t)(rs >> 2) * 2 + (t - 2)) * FF2 + col0; }
            if (o) { *(f32x4*)o = v0; *(f32x4*)(o + 4) = v1; }
        EPI_LOOP_END
    } };
struct EpiDn { float* out; float* part;
    DEV void operator()(const AccT& acc, const Unit& u, int wr, int wc, int fr, int fq) const {
        if (u.kind >= 1) {
            EPI_LOOP_BEGIN
                float* t = part + (size_t)(u.kind - 1) * SROWS + (size_t)(row - NP) * 1024 + col0; *(f32x4*)t = v0; *(f32x4*)(t + 4) = v1;
            EPI_LOOP_END
            return; }
        EPI_LOOP_BEGIN
            float* o = out + (size_t)row * 1024 + col0;
            *(f32x4*)o = *(const f32x4*)o + v0; *(f32x4*)(o + 4) = *(const f32x4*)(o + 4) + v1;
            if (bj == 1 && (m & 1)) SCHEDB;
        EPI_LOOP_END
    } };

DEV int srccol_in(int p) {
    if (p < 1024) { const int hb = p & ~127, pp = p & 127, uu = pp >> 3, v = pp & 7; return hb + ((v < 4) ? 4 * uu + v : 64 + 4 * uu + (v - 4)); }
    if (p >= C_XQ && p < C_SV) return p + 512;
    if (p >= C_SV && p < C_GT) return p - 512;
    return p; }
DEV void transpose_item(const float* W, int N, bf16_t* WT, int ldk, int koff, LAS float* scr, int k0, int n0, int srccol, int lane) {
    float tv[32];
#pragma unroll
    for (int i = 0; i < 32; ++i) tv[i] = W[(size_t)(k0 + 2 * i + (lane >> 5)) * N + srccol];
#pragma unroll
    for (int i = 0; i < 32; ++i) scr[(2 * i + (lane >> 5)) * 33 + (lane & 31)] = tv[i];
    const int c = lane & 7;
#pragma unroll
    for (int j = 0; j < 4; ++j) { const int n = (lane >> 3) + 8 * j; const LAS float* s = scr + (8 * c) * 33 + n;
        u32x4 o; o.x = pk2(s[0 * 33], s[1 * 33]); o.y = pk2(s[2 * 33], s[3 * 33]); o.z = pk2(s[4 * 33], s[5 * 33]); o.w = pk2(s[6 * 33], s[7 * 33]);
        *(u32x4*)(WT + (size_t)(n0 + n) * ldk + koff + k0 + 8 * c) = o; }
}
DEV void rms_row(const float* xrow, const float* g, bf16_t* orow, int lane) {
    f32x4 v[4]; float s = 0.f;
#pragma unroll
    for (int j = 0; j < 4; ++j) { v[j] = *(const f32x4*)(xrow + 4 * lane + 256 * j); s += v[j].x * v[j].x + v[j].y * v[j].y + v[j].z * v[j].z + v[j].w * v[j].w; }
    s = wave_sum(s); const float r = rsqrtf(s * (1.f / 1024.f) + EPS);
#pragma unroll
    for (int j = 0; j < 4; ++j) { const f32x4 gv = *(const f32x4*)(g + 4 * lane + 256 * j);
        u32x2 o; o.x = pk2(v[j].x * r * gv.x, v[j].y * r * gv.y); o.y = pk2(v[j].z * r * gv.z, v[j].w * r * gv.w);
        *(u32x2*)(orow + 4 * lane + 256 * j) = o; }
}
DEV void phase_prep(const Params& p, LAS unsigned char* lds) {
    const int tid = otid(), lane = tid & 63, wave = tid >> 6;
    const int gw = obid() * 8 + wave, NGW = gridDim.x * 8;
    LAS float* scr = (LAS float*)(lds + wave * 8448);
    unsigned char* ws = p.ws;
    constexpr int I_IN = 16 * 240, I_KV = 16 * 32, I_MR = 16 * 32, I_MS = 8 * 32, I_MX = 8 * 32, I_O = 16 * 32, I_UP = 16 * 176, I_DN = 44 * 32;
    constexpr int N_TR = I_IN + I_KV + I_MR + I_MS + I_MX + I_O + I_UP + I_DN;
    constexpr int N_RMS = MT + 2048, N_ROPE = 2052, N_TRIL = 512;
    constexpr int N_ALL = N_TR + N_RMS + N_ROPE + N_TRIL;
    for (int it = gw; it < N_ALL; it += NGW) {
        int r = it;
        if (r < N_TR) {
            const int l31 = lane & 31;
            if (r < I_IN) { const int kb = r / 240, nb = r % 240; transpose_item(p.w_in, INC, (bf16_t*)(ws + OFF_BTIN), 1024, 0, scr, 64 * kb, 32 * nb, srccol_in(32 * nb + l31), lane); continue; } r -= I_IN;
            if (r < I_KV) { const int kb = r / 32, nb = r % 32; transpose_item(p.w_mem_kv, 1024, (bf16_t*)(ws + OFF_BTKV), 1024, 0, scr, 64 * kb, 32 * nb, 32 * nb + l31, lane); continue; } r -= I_KV;
            if (r < I_MR) { const int kb = r / 32, nb = r % 32; transpose_item(p.w_br_ret, 1024, (bf16_t*)(ws + OFF_BTMG), 2048, 0, scr, 64 * kb, 32 * nb, 32 * nb + l31, lane); continue; } r -= I_MR;
            if (r < I_MS) { const int kb = r / 32, nb = r % 32; transpose_item(p.w_br_sg, 1024, (bf16_t*)(ws + OFF_BTMG), 2048, 1024, scr, 64 * kb, 32 * nb, 32 * nb + l31, lane); continue; } r -= I_MS;
            if (r < I_MX) { const int kb = r / 32, nb = r % 32; transpose_item(p.w_br_x, 1024, (bf16_t*)(ws + OFF_BTMG), 2048, 1536, scr, 64 * kb, 32 * nb, 32 * nb + l31, lane); continue; } r -= I_MX;
            if (r < I_O) { const int kb = r / 32, nb = r % 32; transpose_item(p.w_o, 1024, (bf16_t*)(ws + OFF_BTO), 1024, 0, scr, 64 * kb, 32 * nb, 32 * nb + l31, lane); continue; } r -= I_O;
            if (r < I_UP) { const int kb = r / 176, nb = r % 176; transpose_item(p.w_up, FF2, (bf16_t*)(ws + OFF_BTUP), 1024, 0, scr, 64 * kb, 32 * nb, 32 * nb + l31, lane); continue; } r -= I_UP;
            { const int kb = r / 32, nb = r % 32; transpose_item(p.w_down, 1024, (bf16_t*)(ws + OFF_BTDN), FF, 0, scr, 64 * kb, 32 * nb, 32 * nb + l31, lane); continue; }
        }
        r -= N_TR;
        if (r < N_RMS) {
            if (r < NP) rms_row(p.x_prompt + (size_t)r * 1024, p.norm_mix_g, (bf16_t*)(ws + OFF_R2) + (size_t)r * 1024, lane);
            else if (r < MT) rms_row(p.x_sample + (size_t)(r - NP) * 1024, p.norm_mix_g, (bf16_t*)(ws + OFF_R2) + (size_t)r * 1024, lane);
            else rms_row(p.mem_prompt + (size_t)(r - MT) * 1024, p.mem_norm_g, (bf16_t*)(ws + OFF_HM) + (size_t)(r - MT) * 1024, lane);
            continue; }
        r -= N_RMS;
        if (r < N_ROPE) {
            const int pos = r < 2048 ? r : 16384 + (r - 2048);
            double inv = 1.0;
            if (lane & 1) inv *= 0.8659643233600653; if (lane & 2) inv *= 0.7498942093324559; if (lane & 4) inv *= 0.5623413251903491;
            if (lane & 8) inv *= 0.31622776601683794; if (lane & 16) inv *= 0.1; if (lane & 32) inv *= 0.01;
            double t = (double)pos * inv * 0.15915494309189535; t -= __builtin_rint(t);
            const float tf = (float)t;
            ((float*)(ws + OFF_ROPEC))[r * 64 + lane] = __builtin_amdgcn_cosf(tf);
            ((float*)(ws + OFF_ROPES))[r * 64 + lane] = __builtin_amdgcn_sinf(tf);
            continue; }
        r -= N_ROPE;
        { const int t = r & 127; const float* src = p.sg_ws + (size_t)r * 128 + 2 * lane;
          const float a = (2 * lane <= t) ? src[0] : 0.f, b = (2 * lane + 1 <= t) ? src[1] : 0.f;
          *(unsigned*)((bf16_t*)(ws + OFF_WTRIL) + (size_t)r * 128 + 2 * lane) = pk2(a, b); }
    }
}

DEV void ret_A_item(const Params& p, LAS unsigned char* lds, int item) {
    const int tid = otid(), lane = tid & 63, w = tid >> 6;
    const int c = item & 15, bh = item >> 4, h = bh & 3, b = bh >> 2;
    const size_t row0 = (size_t)b * 2048 + c * 128;
    const bf16_t* P = (const bf16_t*)(p.ws + OFF_P);
    const float lg = log_gamma(h);
    LAS unsigned char* Kt = lds; LAS unsigned char* Vt = lds + 34816;
    for (int i = tid; i < 2048; i += 512) { const int s = i >> 4, ch = i & 15;
        u32x4 v = *(const u32x4*)(P + (row0 + s) * INC + C_K + h * 128 + ch * 8);
        const float dec = __expf((float)(127 - s) * lg);
        v.x = pk2(bf_lo(v.x) * dec, bf_hi(v.x) * dec); v.y = pk2(bf_lo(v.y) * dec, bf_hi(v.y) * dec); v.z = pk2(bf_lo(v.z) * dec, bf_hi(v.z) * dec); v.w = pk2(bf_lo(v.w) * dec, bf_hi(v.w) * dec);
        *(LAS u32x4*)(Kt + s * 272 + ch * 16) = v; }
    for (int i = tid; i < 4096; i += 512) { const int s = i >> 5, ch = i & 31;
        *(LAS u32x4*)(Vt + s * 528 + ch * 16) = *(const u32x4*)(P + (row0 + s) * INC + C_V + h * 256 + ch * 8); }
    __syncthreads();
    f32x4 acc[16];
#pragma unroll
    for (int i = 0; i < 16; ++i) acc[i] = (f32x4){0.f, 0.f, 0.f, 0.f};
    LAS const unsigned char* kb = tr_lane_base(Kt, 272, lane) + 32 * w; LAS const unsigned char* vb = tr_lane_base(Vt, 528, lane);
    bf16x8 af[4]; tr_read4<272, 0, 0>(kb, af);
    static_for<0, 16>([&](auto et_) { constexpr int et = decltype(et_)::value; bf16x8 bf[4]; tr_read4<528, 0, 16 * et>(vb, bf);
#pragma unroll
        for (int ks = 0; ks < 4; ++ks) acc[et] = mfma16(af[ks], bf[ks], acc[et]); });
    float* U = p.out + (size_t)item * 32768;
    const int g = lane >> 4, col = lane & 15;
#pragma unroll
    for (int et = 0; et < 16; ++et)
#pragma unroll
        for (int j = 0; j < 4; ++j) U[(16 * w + 4 * g + j) * 256 + 16 * et + col] = acc[et][j];
    __syncthreads();
}
DEV void scan_phase(const Params& p) {
    const float* U = p.out; bf16_t* Sb = (bf16_t*)(p.ws + OFF_R2);
    for (int idx = obid() * 512 + otid(); idx < 131072; idx += gridDim.x * 512) {
        const int e8 = idx & 31, d = (idx >> 5) & 127, bh = idx >> 12, h = bh & 3;
        const float g128 = __expf(128.f * log_gamma(h));
        f32x4 s0 = (f32x4){0.f, 0.f, 0.f, 0.f}, s1 = s0;
#pragma unroll
        for (int c = 0; c < 16; ++c) {
            const size_t off = (((size_t)bh * 16 + c) * 128 + d) * 256 + e8 * 8;
            u32x4 pk; pk.x = pk2(s0.x, s0.y); pk.y = pk2(s0.z, s0.w); pk.z = pk2(s1.x, s1.y); pk.w = pk2(s1.z, s1.w);
            *(u32x4*)(Sb + off) = pk;
            const f32x4 u0 = *(const f32x4*)(U + off), u1 = *(const f32x4*)(U + off + 4);
            s0 = s0 * g128 + u0; s1 = s1 * g128 + u1; }
        float* o = p.out + O_RETP + ((size_t)bh * 128 + d) * 256 + e8 * 8;
        *(f32x4*)o = s0; *(f32x4*)(o + 4) = s1;
    }
}
DEV void ret_C_item(const Params& p, LAS unsigned char* lds, int item) {
    const int tid = otid(), lane = tid & 63, w = tid >> 6, g = lane >> 4, col = lane & 15;
    const int c = item & 15, bh = item >> 4, h = bh & 3, b = bh >> 2;
    const size_t row0 = (size_t)b * 2048 + c * 128;
    bf16_t* P = (bf16_t*)(p.ws + OFF_P);
    const bf16_t* Sb = (const bf16_t*)(p.ws + OFF_R2) + (size_t)item * 32768;
    const float lg = log_gamma(h);
    LAS unsigned char* Kt = lds; LAS unsigned char* Vh = lds + 34816; LAS unsigned char* Sh = lds + 69632; LAS unsigned char* Sc = lds + 104448 + w * 4352;
    for (int i = tid; i < 2048; i += 512) { const int s = i >> 4, ch = i & 15;
        *(LAS u32x4*)(Kt + s * 272 + ch * 16) = *(const u32x4*)(P + (row0 + s) * INC + C_K + h * 128 + ch * 8); }
    bf16x8 qf[4];
    { const bf16_t* qp = P + (row0 + 16 * w + col) * INC + C_Q + h * 128 + 8 * g;
#pragma unroll
      for (int ks = 0; ks < 4; ++ks) qf[ks] = *(const bf16x8*)(qp + 32 * ks); }
    f32x4 o[16];
    LAS const unsigned char* shb = tr_lane_base(Sh, 272, lane); LAS const unsigned char* vhb = tr_lane_base(Vh, 272, lane);
    bf16x8 scf[4];
    static_for<0, 2>([&](auto hh_) { constexpr int hh = decltype(hh_)::value;
        if (hh == 1) __syncthreads();
        for (int i = tid; i < 2048; i += 512) { const int s = i >> 4, ch = i & 15;
            *(LAS u32x4*)(Vh + s * 272 + ch * 16) = *(const u32x4*)(P + (row0 + s) * INC + C_V + h * 256 + hh * 128 + ch * 8);
            *(LAS u32x4*)(Sh + s * 272 + ch * 16) = *(const u32x4*)(Sb + s * 256 + hh * 128 + ch * 8); }
        __syncthreads();
        if (hh == 0) {
            static_for<0, 8>([&](auto st_) { constexpr int st = decltype(st_)::value; f32x4 a = (f32x4){0.f, 0.f, 0.f, 0.f};
#pragma unroll
                for (int ks = 0; ks < 4; ++ks) a = mfma16(qf[ks], lds_frag(Kt, 272, 16 * st, 32 * ks, lane), a);
#pragma unroll
                for (int j = 0; j < 4; ++j) { const int diff = (16 * w + 4 * g + j) - (16 * st + col);
                    const float v = diff >= 0 ? a[j] * __expf((float)diff * lg) : 0.f;
                    *(LAS bf16_t*)(Sc + (4 * g + j) * 272 + (16 * st + col) * 2) = f2bf(v); }
                SCHEDB; });
#pragma unroll
            for (int ks = 0; ks < 4; ++ks) scf[ks] = lds_frag(Sc, 272, 0, 32 * ks, lane);
        }
        static_for<0, 8>([&](auto et_) { constexpr int et = decltype(et_)::value; f32x4 a = (f32x4){0.f, 0.f, 0.f, 0.f};
            bf16x8 f[4]; tr_read4<272, 0, 16 * et>(shb, f);
#pragma unroll
            for (int ks = 0; ks < 4; ++ks) a = mfma16(qf[ks], f[ks], a);
#pragma unroll
            for (int j = 0; j < 4; ++j) a[j] *= __expf((float)(16 * w + 4 * g + j + 1) * lg);
            tr_read4<272, 0, 16 * et>(vhb, f);
#pragma unroll
            for (int ks = 0; ks < 4; ++ks) a = mfma16(scf[ks], f[ks], a);
            o[hh * 8 + et] = a; SCHEDB; });
    });
    const float* gn = p.ret_gn_g + h * 256;
#pragma unroll
    for (int j = 0; j < 4; ++j) {
        float s = 0.f;
#pragma unroll
        for (int t = 0; t < 16; ++t) s += o[t][j];
        const float mean = g16_sum(s) * (1.f / 256.f);
        float s2 = 0.f;
#pragma unroll
        for (int t = 0; t < 16; ++t) { const float dd = o[t][j] - mean; s2 += dd * dd; }
        const float rstd = rsqrtf(g16_sum(s2) * (1.f / 256.f) + EPS);
        bf16_t* gp = P + (row0 + 16 * w + 4 * g + j) * INC + C_G + h * 256;
#pragma unroll
        for (int t = 0; t < 16; ++t) { const int e = (t >> 3) * 128 + (t & 7) * 16 + col;
            gp[e] = f2bf((o[t][j] - mean) * rstd * gn[e] * bf2f(gp[e])); }
        SCHEDB;
    }
    __syncthreads();
}
DEV void sgu_item(const Params& p, LAS unsigned char* lds, int item) {
    const int tid = otid(), lane = tid & 63, w = tid >> 6, g = lane >> 4, col = lane & 15;
    const int gq = item & 3, bn = item >> 2; const size_t row0 = (size_t)bn * 128;
    bf16_t* P = (bf16_t*)(p.ws + OFF_P);
    LAS unsigned char* VN = lds;
    for (int rr = 0; rr < 16; ++rr) { const int s = 16 * w + rr;
        const u32x4 v = *(const u32x4*)(P + (row0 + s) * INC + C_SV + lane * 8);
        float x[8] = {bf_lo(v.x), bf_hi(v.x), bf_lo(v.y), bf_hi(v.y), bf_lo(v.z), bf_hi(v.z), bf_lo(v.w), bf_hi(v.w)};
        float sm = 0.f;
#pragma unroll
        for (int i = 0; i < 8; ++i) sm += x[i];
        const float mean = wave_sum(sm) * (1.f / 512.f); float s2 = 0.f;
#pragma unroll
        for (int i = 0; i < 8; ++i) { x[i] -= mean; s2 += x[i] * x[i]; }
        const float rstd = rsqrtf(wave_sum(s2) * (1.f / 512.f) + EPS);
        if (g == gq) { const float* lg = p.sg_ln_g + lane * 8; u32x4 o;
            o.x = pk2(x[0] * rstd * lg[0], x[1] * rstd * lg[1]); o.y = pk2(x[2] * rstd * lg[2], x[3] * rstd * lg[3]);
            o.z = pk2(x[4] * rstd * lg[4], x[5] * rstd * lg[5]); o.w = pk2(x[6] * rstd * lg[6], x[7] * rstd * lg[7]);
            *(LAS u32x4*)(VN + s * 272 + col * 16) = o; } }
    bf16x8 af[4];
    { const bf16_t* wp = (const bf16_t*)(p.ws + OFF_WTRIL) + (size_t)(gq * 128 + 16 * w + col) * 128 + 8 * g;
#pragma unroll
      for (int ks = 0; ks < 4; ++ks) af[ks] = *(const bf16x8*)(wp + 32 * ks); }
    __syncthreads();
    LAS const unsigned char* vnb = tr_lane_base(VN, 272, lane);
    static_for<0, 8>([&](auto ct_) { constexpr int ct = decltype(ct_)::value; f32x4 a = (f32x4){0.f, 0.f, 0.f, 0.f};
        bf16x8 f[4]; tr_read4<272, 0, 16 * ct>(vnb, f);
#pragma unroll
        for (int ks = 0; ks < 4; ++ks) a = mfma16(af[ks], f[ks], a);
#pragma unroll
        for (int j = 0; j < 4; ++j) { const int t = 16 * w + 4 * g + j; bf16_t* up = P + (row0 + t) * INC + C_SU + gq * 128 + 16 * ct + col;
            *up = f2bf(bf2f(*up) * (a[j] + p.sg_bs[gq * 128 + t])); } });
    __syncthreads();
}
DEV void xattn_item(const Params& p, LAS unsigned char* lds, int item) {
    const int tid = otid(), lane = tid & 63, w = tid >> 6, g = lane >> 4, col = lane & 15;
    const int qt = item & 15, bh = item >> 4, h = bh & 3, b = bh >> 2; const size_t row0 = (size_t)b * 2048 + qt * 128;
    bf16_t* P = (bf16_t*)(p.ws + OFF_P); const bf16_t* mkb = (const bf16_t*)(p.ws + OFF_MKB);
    LAS unsigned char* KV = lds; LAS unsigned char* Pw = lds + 69632 + w * 8448;
    for (int i = tid; i < 4096; i += 512) { const int m = i >> 4, ch = i & 15;
        *(LAS u32x4*)(KV + m * 272 + ch * 16) = *(const u32x4*)(mkb + (size_t)(b * 256 + m) * 1024 + h * 128 + ch * 8); }
    bf16x8 qf[4];
    { const bf16_t* qp = P + (row0 + 16 * w + col) * INC + C_XQ + h * 128 + 8 * g;
#pragma unroll
      for (int ks = 0; ks < 4; ++ks) qf[ks] = *(const bf16x8*)(qp + 32 * ks); }
    __syncthreads();
    f32x4 sc[16];
    static_for<0, 16>([&](auto mt_) { constexpr int mt = decltype(mt_)::value; f32x4 a = (f32x4){0.f, 0.f, 0.f, 0.f};
#pragma unroll
        for (int ks = 0; ks < 4; ++ks) a = mfma16(qf[ks], lds_frag(KV, 272, 16 * mt, 32 * ks, lane), a);
        sc[mt] = a * 0.08838834764831845f; SCHEDB; });
#pragma unroll
    for (int j = 0; j < 4; ++j) { float mx = -3.0e38f;
#pragma unroll
        for (int mt = 0; mt < 16; ++mt) mx = fmaxf(mx, sc[mt][j]);
        mx = g16_max(mx); float sm = 0.f;
#pragma unroll
        for (int mt = 0; mt < 16; ++mt) { const float e = __expf(sc[mt][j] - mx); sc[mt][j] = e; sm += e; }
        const float inv = 1.f / g16_sum(sm);
#pragma unroll
        for (int mt = 0; mt < 16; ++mt) *(LAS bf16_t*)(Pw + (4 * g + j) * 528 + (16 * mt + col) * 2) = f2bf(sc[mt][j] * inv); }
    __syncthreads();
    for (int i = tid; i < 4096; i += 512) { const int m = i >> 4, ch = i & 15;
        *(LAS u32x4*)(KV + m * 272 + ch * 16) = *(const u32x4*)(mkb + (size_t)(b * 256 + m) * 1024 + 512 + h * 128 + ch * 8); }
    __syncthreads();
    LAS const unsigned char* kvb = tr_lane_base(KV, 272, lane);
    bf16x8 pf[8];
#pragma unroll
    for (int ks = 0; ks < 8; ++ks) pf[ks] = lds_frag(Pw, 528, 0, 32 * ks, lane);
    static_for<0, 8>([&](auto dt_) { constexpr int dt = decltype(dt_)::value; f32x4 a = (f32x4){0.f, 0.f, 0.f, 0.f};
        bf16x8 f[4]; tr_read4<272, 0, 16 * dt>(kvb, f);
#pragma unroll
        for (int ks = 0; ks < 4; ++ks) a = mfma16(pf[ks], f[ks], a);
        tr_read4<272, 128, 16 * dt>(kvb, f);
#pragma unroll
        for (int ks = 0; ks < 4; ++ks) a = mfma16(pf[4 + ks], f[ks], a);
#pragma unroll
        for (int j = 0; j < 4; ++j) P[(row0 + 16 * w + 4 * g + j) * INC + C_XQ + h * 128 + 16 * dt + col] = f2bf(a[j]); });
    __syncthreads();
}
DEV void xattn_s_item(const Params& p, LAS unsigned char* lds, int item) {
    const int tid = otid(), lane = tid & 63, w = tid >> 6, l32 = lane & 31, slot = w * 2 + (lane >> 5);
    const int h = item & 3, b = item >> 2; const size_t rowb = (size_t)NP + b * 4;
    bf16_t* P = (bf16_t*)(p.ws + OFF_P);
    LAS float* sc = (LAS float*)lds; LAS float* red = (LAS float*)(lds + 4096);
    float q[4][4];
#pragma unroll
    for (int l = 0; l < 4; ++l) { const u32x2 v = *(const u32x2*)(P + (rowb + l) * INC + C_XQ + h * 128 + 4 * l32); q[l][0] = bf_lo(v.x); q[l][1] = bf_hi(v.x); q[l][2] = bf_lo(v.y); q[l][3] = bf_hi(v.y); }
#pragma unroll
    for (int it = 0; it < 16; ++it) { const int m = it * 16 + slot;
        const f32x4 kv = *(const f32x4*)(p.cache_k + (((size_t)b * 256 + m) * 4 + h) * 128 + 4 * l32);
#pragma unroll
        for (int l = 0; l < 4; ++l) { float d = q[l][0] * kv.x + q[l][1] * kv.y + q[l][2] * kv.z + q[l][3] * kv.w;
#pragma unroll
            for (int o = 1; o < 32; o <<= 1) d += __shfl_xor(d, o);
            if (l32 == 0) sc[l * 256 + m] = d * 0.08838834764831845f; } }
    __syncthreads();
    if (w < 4) { float v[4]; float mx = -3.0e38f;
#pragma unroll
        for (int i = 0; i < 4; ++i) { v[i] = sc[w * 256 + lane + 64 * i]; mx = fmaxf(mx, v[i]); }
        mx = wave_max(mx); float sm = 0.f;
#pragma unroll
        for (int i = 0; i < 4; ++i) { v[i] = __expf(v[i] - mx); sm += v[i]; }
        const float inv = 1.f / wave_sum(sm);
#pragma unroll
        for (int i = 0; i < 4; ++i) sc[w * 256 + lane + 64 * i] = v[i] * inv; }
    __syncthreads();
    f32x4 o[4];
#pragma unroll
    for (int l = 0; l < 4; ++l) o[l] = (f32x4){0.f, 0.f, 0.f, 0.f};
#pragma unroll
    for (int it = 0; it < 16; ++it) { const int m = it * 16 + slot;
        const f32x4 vv = *(const f32x4*)(p.cache_v + (((size_t)b * 256 + m) * 4 + h) * 128 + 4 * l32);
#pragma unroll
        for (int l = 0; l < 4; ++l) o[l] += vv * sc[l * 256 + m]; }
#pragma unroll
    for (int l = 0; l < 4; ++l) *(LAS f32x4*)(red + (slot * 4 + l) * 128 + 4 * l32) = o[l];
    __syncthreads();
    { const int l = tid >> 7, d = tid & 127; float s = 0.f;
#pragma unroll
      for (int k = 0; k < 16; ++k) s += red[(k * 4 + l) * 128 + d];
      P[(rowb + l) * INC + C_XQ + h * 128 + d] = f2bf(s); }
    __syncthreads();
}
DEV void ret_s_item(const Params& p, LAS unsigned char* lds, int item) {
    const int tid = otid(), lane = tid & 63, w = tid >> 6;
    const int h = item & 3, b = item >> 2; const size_t rowb = (size_t)NP + b * 4;
    bf16_t* P = (bf16_t*)(p.ws + OFF_P);
    const float lg = log_gamma(h);
    LAS float* qs = (LAS float*)lds;
    LAS float* kr = qs + 512;
    LAS float* vs = kr + 512;
    LAS float* ob = vs + 1024;
    LAS float* scm = ob + 1024;
    LAS float* red = scm + 16;
    { const int t = tid >> 7, d = tid & 127;
      qs[t * 128 + d] = bf2f(P[(rowb + t) * INC + C_Q + h * 128 + d]); kr[t * 128 + d] = bf2f(P[(rowb + t) * INC + C_K + h * 128 + d]);
      vs[t * 256 + d] = bf2f(P[(rowb + t) * INC + C_V + h * 256 + d]); vs[t * 256 + 128 + d] = bf2f(P[(rowb + t) * INC + C_V + h * 256 + 128 + d]); }
    __syncthreads();
    if (tid < 16) { const int t = tid >> 2, s = tid & 3; float d = 0.f;
        for (int k = 0; k < 128; ++k) d += qs[t * 128 + k] * kr[s * 128 + k];
        scm[tid] = (t >= s) ? d * __expf((float)(t - s) * lg) : 0.f; }
    f32x4 v[4], cr[4];
#pragma unroll
    for (int s = 0; s < 4; ++s) { v[s] = *(LAS f32x4*)(vs + s * 256 + 4 * lane); cr[s] = (f32x4){0.f, 0.f, 0.f, 0.f}; }
    const float g4 = __expf(4.f * lg), kd0 = __expf(3.f * lg), kd1 = __expf(2.f * lg), kd2 = __expf(lg);
    const float* S0 = p.state_ret + ((size_t)item * 128) * 256; float* Sn = p.out + O_RETS + ((size_t)item * 128) * 256;
#pragma unroll 8
    for (int dd = 0; dd < 16; ++dd) { const int d = 16 * w + dd;
        const f32x4 s0 = *(const f32x4*)(S0 + d * 256 + 4 * lane);
#pragma unroll
        for (int t = 0; t < 4; ++t) cr[t] += s0 * qs[t * 128 + d];
        f32x4 sn = s0 * g4 + v[0] * (kr[d] * kd0) + v[1] * (kr[128 + d] * kd1) + v[2] * (kr[256 + d] * kd2) + v[3] * kr[384 + d];
        *(f32x4*)(Sn + d * 256 + 4 * lane) = sn; }
#pragma unroll
    for (int t = 0; t < 4; ++t) *(LAS f32x4*)(red + (w * 4 + t) * 256 + 4 * lane) = cr[t];
    __syncthreads();
    { const int t = tid >> 7, e2 = (tid & 127) * 2; const float qd = __expf((float)(t + 1) * lg);
#pragma unroll
      for (int i = 0; i < 2; ++i) { const int e = e2 + i; float c = 0.f;
#pragma unroll
          for (int k = 0; k < 8; ++k) c += red[(k * 4 + t) * 256 + e];
          float in = 0.f;
#pragma unroll
          for (int s = 0; s < 4; ++s) in += scm[t * 4 + s] * vs[s * 256 + e];
          ob[t * 256 + e] = in + c * qd; } }
    __syncthreads();
    if (w < 4) { float x[4]; float sm = 0.f;
#pragma unroll
        for (int i = 0; i < 4; ++i) { x[i] = ob[w * 256 + lane + 64 * i]; sm += x[i]; }
        const float mean = wave_sum(sm) * (1.f / 256.f); float s2 = 0.f;
#pragma unroll
        for (int i = 0; i < 4; ++i) { x[i] -= mean; s2 += x[i] * x[i]; }
        const float rstd = rsqrtf(wave_sum(s2) * (1.f / 256.f) + EPS);
        bf16_t* gp = P + (rowb + w) * INC + C_G + h * 256;
#pragma unroll
        for (int i = 0; i < 4; ++i) { const int e = lane + 64 * i; gp[e] = f2bf(x[i] * rstd * p.ret_gn_g[h * 256 + e] * bf2f(gp[e])); } }
    __syncthreads();
}
DEV void sgu_s_item(const Params& p, LAS unsigned char* lds, int b) {
    const int tid = otid(), lane = tid & 63, w = tid >> 6;
    const size_t rowb = (size_t)NP + b * 4;
    bf16_t* P = (bf16_t*)(p.ws + OFF_P);
    LAS float* part = (LAS float*)lds;
    float x[4];
#pragma unroll
    for (int r = 0; r < 4; ++r) { x[r] = bf2f(P[(rowb + r) * INC + C_SV + tid]); const float s = wave_sum(x[r]); if (lane == 0) part[w * 4 + r] = s; }
    __syncthreads();
    float mean[4];
#pragma unroll
    for (int r = 0; r < 4; ++r) { float s = 0.f;
#pragma unroll
        for (int k = 0; k < 8; ++k) s += part[k * 4 + r];
        mean[r] = s * (1.f / 512.f); }
    __syncthreads();
#pragma unroll
    for (int r = 0; r < 4; ++r) { x[r] -= mean[r]; const float s = wave_sum(x[r] * x[r]); if (lane == 0) part[w * 4 + r] = s; }
    __syncthreads();
    const float lng = p.sg_ln_g[tid]; const int gq = tid >> 7;
    float vn[4];
#pragma unroll
    for (int r = 0; r < 4; ++r) { float s = 0.f;
#pragma unroll
        for (int k = 0; k < 8; ++k) s += part[k * 4 + r];
        vn[r] = x[r] * rsqrtf(s * (1.f / 512.f) + EPS) * lng;
        p.out[O_SGV + ((size_t)b * 4 + r) * 512 + tid] = vn[r]; }
#pragma unroll
    for (int t = 0; t < 4; ++t) { float mx = p.sg_bs[gq * 128 + t];
#pragma unroll
        for (int s = 0; s < 4; ++s) if (s <= t) mx += p.sg_ws[(size_t)(gq * 128 + t) * 128 + s] * vn[s];
        bf16_t* up = P + (rowb + t) * INC + C_SU + tid; *up = f2bf(bf2f(*up) * mx); }
    __syncthreads();
}

DEV void rms_phase(const Params& p, bool final_) {
    const int lane = otid() & 63, gw = obid() * 8 + (otid() >> 6), NGW = gridDim.x * 8;
    const float* g = final_ ? p.norm_final_g : p.norm_ffn_g;
    const float* part = (const float*)(p.ws + (final_ ? OFF_PART10 : OFF_PART6)); const int npart = final_ ? 22 : 8;
    for (int r = gw; r < MT; r += NGW) {
        float* xr = p.out + (size_t)r * 1024;
        f32x4 v[4]; float s = 0.f;
        if (r < NP) {
#pragma unroll
            for (int j = 0; j < 4; ++j) v[j] = *(const f32x4*)(xr + 4 * lane + 256 * j);
        } else {
            const float* base = final_ ? xr : p.x_sample + (size_t)(r - NP) * 1024;
#pragma unroll
            for (int j = 0; j < 4; ++j) v[j] = *(const f32x4*)(base + 4 * lane + 256 * j);
            for (int k = 0; k < npart; ++k) { const float* pr = part + (size_t)k * SROWS + (size_t)(r - NP) * 1024;
#pragma unroll
                for (int j = 0; j < 4; ++j) v[j] += *(const f32x4*)(pr + 4 * lane + 256 * j); }
            if (!final_) {
#pragma unroll
                for (int j = 0; j < 4; ++j) *(f32x4*)(xr + 4 * lane + 256 * j) = v[j]; }
        }
#pragma unroll
        for (int j = 0; j < 4; ++j) s += v[j].x * v[j].x + v[j].y * v[j].y + v[j].z * v[j].z + v[j].w * v[j].w;
        s = wave_sum(s); const float rr = rsqrtf(s * (1.f / 1024.f) + EPS);
        if (final_) {
#pragma unroll
            for (int j = 0; j < 4; ++j) { const f32x4 gv = *(const f32x4*)(g + 4 * lane + 256 * j); *(f32x4*)(xr + 4 * lane + 256 * j) = v[j] * rr * gv; }
        } else { bf16_t* orow = (bf16_t*)(p.ws + OFF_R2) + (size_t)r * 1024;
#pragma unroll
            for (int j = 0; j < 4; ++j) { const f32x4 gv = *(const f32x4*)(g + 4 * lane + 256 * j);
                u32x2 o; o.x = pk2(v[j].x * rr * gv.x, v[j].y * rr * gv.y); o.y = pk2(v[j].z * rr * gv.z, v[j].w * rr * gv.w);
                *(u32x2*)(orow + 4 * lane + 256 * j) = o; } }
    }
}
DEV void unpack8(const u32x4 a, float (&x)[8]) { x[0] = bf_lo(a.x); x[1] = bf_hi(a.x); x[2] = bf_lo(a.y); x[3] = bf_hi(a.y); x[4] = bf_lo(a.z); x[5] = bf_hi(a.z); x[6] = bf_lo(a.w); x[7] = bf_hi(a.w); }
DEV void conv_phase(const Params& p) {
    const bf16_t* z = (const bf16_t*)(p.ws + OFF_Z); bf16_t* act = (bf16_t*)(p.ws + OFF_ACT);
    const int gtid = obid() * 512 + otid(), NT = gridDim.x * 512;
    for (int idx = gtid; idx < (NP / 8) * 352; idx += NT) {
        const int rb = idx / 352, ch = idx - rb * 352, c = ch * 8, r0 = rb * 8;
        float wa[3][8], wb[3][8], ba[8], bb[8];
#pragma unroll
        for (int j = 0; j < 3; ++j) { const f32x4 a0 = *(const f32x4*)(p.conv_w + j * FF2 + c), a1 = *(const f32x4*)(p.conv_w + j * FF2 + c + 4), b0 = *(const f32x4*)(p.conv_w + j * FF2 + FF + c), b1 = *(const f32x4*)(p.conv_w + j * FF2 + FF + c + 4);
#pragma unroll
            for (int i = 0; i < 4; ++i) { wa[j][i] = a0[i]; wa[j][4 + i] = a1[i]; wb[j][i] = b0[i]; wb[j][4 + i] = b1[i]; } }
        { const f32x4 a0 = *(const f32x4*)(p.conv_b + c), a1 = *(const f32x4*)(p.conv_b + c + 4), b0 = *(const f32x4*)(p.conv_b + FF + c), b1 = *(const f32x4*)(p.conv_b + FF + c + 4);
#pragma unroll
          for (int i = 0; i < 4; ++i) { ba[i] = a0[i]; ba[4 + i] = a1[i]; bb[i] = b0[i]; bb[4 + i] = b1[i]; } }
        u32x4 ra[10], rbq[10];
        const bool first = (r0 & 2047) == 0;
#pragma unroll
        for (int k = 0; k < 10; ++k) { const int rr = r0 - 2 + k;
            if (k < 2 && first) { ra[k] = (u32x4){0u, 0u, 0u, 0u}; rbq[k] = ra[k]; }
            else { ra[k] = *(const u32x4*)(z + (size_t)rr * FF2 + c); rbq[k] = *(const u32x4*)(z + (size_t)rr * FF2 + FF + c); } }
        float xa[3][8], xb[3][8];
        unpack8(ra[0], xa[0]); unpack8(rbq[0], xb[0]); unpack8(ra[1], xa[1]); unpack8(rbq[1], xb[1]);
#pragma unroll
        for (int k = 0; k < 8; ++k) {
            unpack8(ra[k + 2], xa[(k + 2) % 3]); unpack8(rbq[k + 2], xb[(k + 2) % 3]);
            float o[8];
#pragma unroll
            for (int i = 0; i < 8; ++i) {
                const float za = ba[i] + wa[0][i] * xa[k % 3][i] + wa[1][i] * xa[(k + 1) % 3][i] + wa[2][i] * xa[(k + 2) % 3][i];
                const float zb = bb[i] + wb[0][i] * xb[k % 3][i] + wb[1][i] * xb[(k + 1) % 3][i] + wb[2][i] * xb[(k + 2) % 3][i];
                o[i] = gelu_t(za) * zb; }
            u32x4 ov; ov.x = pk2(o[0], o[1]); ov.y = pk2(o[2], o[3]); ov.z = pk2(o[4], o[5]); ov.w = pk2(o[6], o[7]);
            *(u32x4*)(act + (size_t)(r0 + k) * FF + c) = ov; }
    }
    for (int idx = gtid; idx < NS * 352; idx += NT) {
        const int rs = idx / 352, ch = idx - rs * 352, c = ch * 8, r = NP + rs, tpos = rs & 3;
        float za[8], zb[8];
#pragma unroll
        for (int i = 0; i < 8; ++i) { za[i] = p.conv_b[c + i]; zb[i] = p.conv_b[FF + c + i]; }
#pragma unroll
        for (int j = 0; j < 3; ++j) {
            const int tp = tpos - 2 + j;
            float xa[8], xb[8];
            if (tp >= 0) { unpack8(*(const u32x4*)(z + (size_t)(r - 2 + j) * FF2 + c), xa); unpack8(*(const u32x4*)(z + (size_t)(r - 2 + j) * FF2 + FF + c), xb); }
            else { const float* sp = p.state_conv + ((size_t)(rs >> 2) * 2 + (tp + 2)) * FF2;
#pragma unroll
                for (int i = 0; i < 8; ++i) { xa[i] = sp[c + i]; xb[i] = sp[FF + c + i]; } }
#pragma unroll
            for (int i = 0; i < 8; ++i) { za[i] += p.conv_w[j * FF2 + c + i] * xa[i]; zb[i] += p.conv_w[j * FF2 + FF + c + i] * xb[i]; }
        }
        u32x4 o; o.x = pk2(gelu_t(za[0]) * zb[0], gelu_t(za[1]) * zb[1]); o.y = pk2(gelu_t(za[2]) * zb[2], gelu_t(za[3]) * zb[3]);
        o.z = pk2(gelu_t(za[4]) * zb[4], gelu_t(za[5]) * zb[5]); o.w = pk2(gelu_t(za[6]) * zb[6], gelu_t(za[7]) * zb[7]);
        *(u32x4*)(act + (size_t)r * FF + c) = o;
    }
}

#define XB_TMO      128
#define XB_XCNT(j)  (256  + 64 * (j))
#define XB_XSUB(j)  (1280 + 64 * (j))
#define XB_XGEN(j)  (2304 + 64 * (j))
#define XB_TOP      3328
#define XB_TOPGEN   3392
#define XCD_BAR_WORDS 3456
#define XB_SPIN_CAP (1u << 18)
DEV unsigned xb_ld(unsigned* p)              { return __hip_atomic_load(p, __ATOMIC_RELAXED, __HIP_MEMORY_SCOPE_AGENT); }
DEV unsigned xb_add(unsigned* p, unsigned v) { return __hip_atomic_fetch_add(p, v, __ATOMIC_RELAXED, __HIP_MEMORY_SCOPE_AGENT); }
DEV unsigned xb_xcc_id() { return (unsigned)__builtin_amdgcn_s_getreg((3 << 11) | 20) & 0xFu; }
#define XB_SPIN(cond, bar) do { unsigned _sp = 0; while (cond) { __builtin_amdgcn_s_sleep(1); \
    if ((++_sp & 255u) == 0u) { if (xb_ld(&(bar)[XB_TMO])) break; if (_sp > XB_SPIN_CAP) { atomicAdd(&(bar)[XB_TMO], 1u); break; } } } } while (0)
struct XcdBarrier { unsigned* bar; unsigned x; volatile LAS unsigned* st; };
DEV XcdBarrier xcd_barrier_post(unsigned* bar, volatile LAS unsigned* st) {
    XcdBarrier b; b.bar = bar; b.x = xb_xcc_id(); b.st = st;
    if (threadIdx.x == 0) (void)xb_add(&bar[XB_XCNT(b.x)], 1u);
    return b; }
DEV void xcd_barrier_complete(unsigned* bar, unsigned x, unsigned& nloc, unsigned& nx) {
    const unsigned G = gridDim.x * gridDim.y * gridDim.z;
    unsigned sum, cnt, mine, sp = 0u;
    for (;;) {
        sum = 0u; cnt = 0u; mine = 0u;
#pragma unroll
        for (unsigned j = 0; j < 16; ++j) { const unsigned c = xb_ld(&bar[XB_XCNT(j)]); sum += c; cnt += (c > 0u) ? 1u : 0u; mine = (j == x) ? c : mine; }
        if (sum == G) break;
        __builtin_amdgcn_s_sleep(1);
        if ((++sp & 255u) == 0u) { if (xb_ld(&bar[XB_TMO])) break; if (sp > XB_SPIN_CAP) { atomicAdd(&bar[XB_TMO], 1u); break; } }
    }
    nloc = mine > 0u ? mine : 1u; nx = cnt > 0u ? cnt : 1u; }
DEV void xcd_barrier(unsigned* bar_, volatile LAS unsigned* st_) {
    XcdBarrier b; b.bar = bar_; b.x = xb_xcc_id(); b.st = st_;
    asm volatile("s_waitcnt vmcnt(0)" ::: "memory");
    __syncthreads();
    if (threadIdx.x == 0) {
        unsigned* bar = b.bar;
        __builtin_amdgcn_s_waitcnt(0);
        unsigned nloc = b.st[0], nx = b.st[1];
        if (nloc == 0u) { xcd_barrier_complete(bar, b.x, nloc, nx); b.st[0] = nloc; b.st[1] = nx; }
        const unsigned old = xb_add(&bar[XB_XSUB(b.x)], 1u);
        const unsigned gen = old / nloc;
        if (old + 1u == (gen + 1u) * nloc) {
            __builtin_amdgcn_fence(__ATOMIC_RELEASE, "agent");
            asm volatile("s_waitcnt vmcnt(0)" ::: "memory");
            const unsigned og = xb_add(&bar[XB_TOP], 1u);
            const unsigned tg = og / nx;
            if (og + 1u == (tg + 1u) * nx) xb_add(&bar[XB_TOPGEN], 1u);
            else XB_SPIN(xb_ld(&bar[XB_TOPGEN]) == tg, bar);
            __builtin_amdgcn_fence(__ATOMIC_ACQUIRE, "agent");
            xb_add(&bar[XB_XGEN(b.x)], 1u);
            asm volatile("s_waitcnt vmcnt(0)" ::: "memory");
        } else {
            XB_SPIN(xb_ld(&bar[XB_XGEN(b.x)]) == gen, bar);
            __builtin_amdgcn_fence(__ATOMIC_ACQUIRE, "agent");
            asm volatile("s_waitcnt vmcnt(0)" ::: "memory");
        }
    }
    __syncthreads();
}

DEV Params kp_load() { Params r{};
#if defined(__HIP_DEVICE_COMPILE__)
    typedef const unsigned long long __attribute__((address_space(4))) KA;
    KA* q = (KA*)__builtin_amdgcn_kernarg_segment_ptr(); asm volatile("" : "+s"(q));
    unsigned long long t[28];
#pragma unroll
    for (int i = 0; i < 28; ++i) t[i] = q[i];
    __builtin_memcpy(&r, t, sizeof(Params));
#endif
    return r; }
__global__ __launch_bounds__(512, 2) void mega(Params p_arg, int ph0, int ph1) {
    extern __shared__ __attribute__((aligned(16))) unsigned char shm[];
    LAS unsigned char* lds = (LAS unsigned char*)shm;
    cg::grid_group grid = cg::this_grid();
    const int G = gridDim.x, c = obid();
    volatile LAS unsigned* xst = (volatile LAS unsigned*)(lds + LDS_BYTES - 16);
    if (threadIdx.x == 0) { xst[0] = 0u; xst[1] = 0u; }
    __syncthreads();
    (void)xcd_barrier_post((unsigned*)(kp_load().ws + OFF_BAR), xst);
#define PH_BEGIN(k) if (ph0 <= (k) && (k) < ph1) { if (PHON(k)) { const Params p = kp_load(); unsigned char* ws = p.ws;
#define PH_END(k) } if ((k) + 1 < ph1) { if ((k) == 0) grid.sync(); else xcd_barrier((unsigned*)(kp_load().ws + OFF_BAR), (volatile LAS unsigned*)(lds + LDS_BYTES - 16)); } }
    PH_BEGIN(0) phase_prep(p, lds); PH_END(0)
    PH_BEGIN(1)
            Sched1 S{G, c, (const char*)(ws + OFF_R2), (const char*)(ws + OFF_HM), (const char*)(ws + OFF_BTIN), (const char*)(ws + OFF_BTKV)};
            Epi1 E{(bf16_t*)(ws + OFF_P), (bf16_t*)(ws + OFF_MKB), p.out, (const float*)(ws + OFF_ROPEC), (const float*)(ws + OFF_ROPES), p.b_gate};
            pg8::gemm_phase(lds, 1024, 1024, S, E);
    PH_END(1)
    PH_BEGIN(2)
            for (int it = c; it < 2688; it += G) {
                if (it < 512) ret_A_item(p, lds, it);
                else if (it < 1024) { if (DBG_XA & 1) xattn_item(p, lds, it - 512); }
                else if (it < 1536) sgu_item(p, lds, it - 1024);
                else if (it < 2048) ret_s_item(p, lds, it - 1536);
                else if (it < 2560) { if (DBG_XA & 2) xattn_s_item(p, lds, it - 2048); }
                else sgu_s_item(p, lds, it - 2560);
            }
    PH_END(2)
    PH_BEGIN(3)
            scan_phase(p);
            SchedMgS S{c, (const char*)(ws + OFF_P), (const char*)(ws + OFF_BTMG)};
            EpiMgS E{(const bf16_t*)(ws + OFF_P), (float*)(ws + OFF_MG32)};
            pg8::gemm_phase(lds, INC, 2048, S, E);
    PH_END(3)
    PH_BEGIN(4) for (int it = c; it < 512; it += G) ret_C_item(p, lds, it); PH_END(4)
    PH_BEGIN(5)
            {
                const int i = obid() * 512 + otid();
                if (i < 131072) { f32x4 m = ((const f32x4*)(ws + OFF_MG32))[i];
#pragma unroll
                    for (int k = 1; k < 8; ++k) m += ((const f32x4*)(ws + OFF_MG32))[(size_t)k * 131072 + i];
                    u32x2 o; o.x = pk2(m.x, m.y); o.y = pk2(m.z, m.w);
                    ((u32x2*)((bf16_t*)(ws + OFF_R2) + (size_t)NP * 1024))[i] = o; } }
            SchedMg S{G, c, (const char*)(ws + OFF_P), (const char*)(ws + OFF_BTMG)};
            EpiMg E{(const bf16_t*)(ws + OFF_P), p.out, (bf16_t*)(ws + OFF_R2)};
            pg8::gemm_phase(lds, INC, 2048, S, E);
    PH_END(5)
    PH_BEGIN(6)
            SchedPS<16, 64, 8, 524288, 524288> S{G, c, (const char*)(ws + OFF_R2), (const char*)(ws + OFF_BTO)};
            EpiWo E{p.x_prompt, p.x_sample, p.out, (float*)(ws + OFF_PART6)};
            pg8::gemm_phase(lds, 1024, 1024, S, E);
    PH_END(6)
    PH_BEGIN(7) rms_phase(p, false); PH_END(7)
    PH_BEGIN(8)
            SchedPlain S{G, c, 66, 22, 16, (const char*)(ws + OFF_R2), (const char*)(ws + OFF_BTUP), (size_t)524288, (size_t)524288};
            EpiUp E{(bf16_t*)(ws + OFF_Z), p.out};
            pg8::gemm_phase(lds, 1024, 1024, S, E);
    PH_END(8)
    PH_BEGIN(9) conv_phase(p); PH_END(9)
    PH_BEGIN(10)
            SchedPS<44, 176, 22, 256 * FF * 2, 256 * FF * 2> S{G, c, (const char*)(ws + OFF_ACT), (const char*)(ws + OFF_BTDN)};
            EpiDn E{p.out, (float*)(ws + OFF_PART10)};
            pg8::gemm_phase(lds, FF, FF, S, E);
    PH_END(10)
    PH_BEGIN(11) rms_phase(p, true); PH_END(11)
}

extern "C" void kernel_launch(void* const* d_in, const int* in_sizes, int n_in, void* d_out, int out_size, void* d_ws, size_t ws_size, hipStream_t stream) {
    static int grid = 0;
    if (grid == 0) {
        if (n_in != 26 || out_size != 39018496 || ws_size < WS_END2) { fprintf(stderr, "kernel_launch: unexpected shapes n_in %d out %d ws %zu (need %zu)\n", n_in, out_size, ws_size, (size_t)WS_END2); grid = -1; return; }
        int dev = 0, cus = 0, per_cu = 0;
        hipGetDevice(&dev); hipDeviceGetAttribute(&cus, hipDeviceAttributeMultiprocessorCount, dev);
        if (hipFuncSetAttribute((const void*)mega, hipFuncAttributeMaxDynamicSharedMemorySize, LDS_BYTES) != hipSuccess) { fprintf(stderr, "kernel_launch: hipFuncSetAttribute failed\n"); grid = -1; return; }
        if (hipOccupancyMaxActiveBlocksPerMultiprocessor(&per_cu, (const void*)mega, 512, LDS_BYTES) != hipSuccess || per_cu < 1) { fprintf(stderr, "kernel_launch: occupancy query gave %d\n", per_cu); grid = -1; return; }
        if (cus != 256) { fprintf(stderr, "kernel_launch: built for 256 CUs, got %d\n", cus); grid = -1; return; }
        grid = cus;
    }
    if (grid < 0) return;
    Params p{};
    const float** f = (const float**)&p;
    for (int i = 0; i < 26; ++i) f[i] = (const float*)d_in[i];
    p.out = (float*)d_out; p.ws = (unsigned char*)d_ws;
#ifndef DBG_NPH
#define DBG_NPH 12
#endif
#ifndef MK_MULTI
#define MK_MULTI 0
#endif
#if MK_MULTI
#ifndef PH_SEQ
#define PH_SEQ 0,1,2,3,4,5,6,7,8,9,10,11
#endif
    { const int seq[] = {PH_SEQ}; for (int ph : seq) hipLaunchKernelGGL(mega, dim3(grid), dim3(512), LDS_BYTES, stream, p, ph, ph + 1); }
    hipError_t e = hipSuccess;
#else
    (void)hipMemsetAsync((unsigned char*)d_ws + OFF_BAR, 0, 16384, stream);
    int ph0 = 0, ph1 = NPHASE;
    void* args[] = {&p, &ph0, &ph1};
    hipError_t e = hipLaunchCooperativeKernel((const void*)mega, dim3(grid), dim3(512), args, LDS_BYTES, stream);
#endif
    if (e != hipSuccess) fprintf(stderr, "cooperative launch failed: %s (grid %d)\n", hipGetErrorString(e), grid);
}
```

```cpp
#include <hip/hip_runtime.h>
#include <hip/hip_cooperative_groups.h>
#include <cstdio>
#include <cstdint>
namespace cg = cooperative_groups;

#define LAS __attribute__((address_space(3)))
#define DEV __device__ __forceinline__
typedef unsigned short bf16_t;
typedef short bf16x8 __attribute__((ext_vector_type(8)));
typedef short s16x4 __attribute__((ext_vector_type(4)));
typedef float f32x4 __attribute__((ext_vector_type(4)));
typedef unsigned u32x4 __attribute__((ext_vector_type(4)));
typedef unsigned u32x2 __attribute__((ext_vector_type(2)));

constexpr int NP = 16384, NS = 512, MT = 16896, INC = 7680, FF = 2816, FF2 = 5632;
constexpr int C_Q = 0, C_K = 512, C_V = 1024, C_G = 2048, C_SU = 3072, C_XQ = 3584, C_SV = 4096, C_GT = 4608;
constexpr float EPS = 1e-6f;
constexpr size_t OFF_BTIN = 0;
constexpr size_t OFF_BTKV = OFF_BTIN + 15728640;
constexpr size_t OFF_BTMG = OFF_BTKV + 2097152;
constexpr size_t OFF_BTO = OFF_BTMG + 4194304;
constexpr size_t OFF_BTUP = OFF_BTO + 2097152;
constexpr size_t OFF_BTDN = OFF_BTUP + 11534336;
constexpr size_t OFF_ROPEC = OFF_BTDN + 5767168;
constexpr size_t OFF_ROPES = OFF_ROPEC + 525312;
constexpr size_t OFF_WTRIL = OFF_ROPES + 525312;
constexpr size_t OFF_HM = OFF_WTRIL + 131072;
constexpr size_t OFF_MKB = OFF_HM + 4194304;
constexpr size_t OFF_P = OFF_MKB + 4194304;
constexpr size_t OFF_R2 = OFF_P + 259522560;
constexpr size_t OFF_MG32 = OFF_R2 + 34603008;
constexpr size_t WS_END = OFF_MG32 + 8 * 2097152;
constexpr size_t OFF_BAR = WS_END;
constexpr size_t WS_END2 = OFF_BAR + 16384;
constexpr size_t OFF_PART6 = OFF_P, OFF_PART10 = OFF_P;
constexpr int SROWS = 512 * 1024;
constexpr size_t OFF_Z = OFF_P;
constexpr size_t OFF_ACT = OFF_P + 190316544;
constexpr size_t O_Y = 0, O_RETP = 17301504, O_CONVP = 18350080, O_MK = 18440192, O_MV = 19488768, O_RETS = 20537344, O_CONVS = 37314560, O_SGV = 38756352;
constexpr int LDS_BYTES = 147456;
constexpr int NPHASE = 12;
#ifndef DBG_XA
#define DBG_XA 3
#endif
#ifndef ONLY_PH
#define ONLY_PH -1
#endif
#ifndef SKIP_PH
#define SKIP_PH -2
#endif
#define PHON(n) ((ONLY_PH < 0 || ONLY_PH == (n)) && SKIP_PH != (n))

struct Params {
    const float *x_prompt, *x_sample, *mem_prompt, *state_ret, *state_conv, *cache_k, *cache_v, *norm_mix_g, *w_in, *b_gate, *ret_gn_g, *sg_ln_g, *sg_ws, *sg_bs,
        *mem_norm_g, *w_mem_kv, *w_br_ret, *w_br_sg, *w_br_x, *w_o, *norm_ffn_g, *w_up, *conv_w, *conv_b, *w_down, *norm_final_g;
    float* out; unsigned char* ws;
};

typedef __bf16 bf16v2_t __attribute__((ext_vector_type(2)));
typedef float f32x2_t __attribute__((ext_vector_type(2)));
DEV unsigned pk2(float lo, float hi) { const f32x2_t f = {lo, hi}; const bf16v2_t v = __builtin_convertvector(f, bf16v2_t); return __builtin_bit_cast(unsigned, v); }
DEV bf16_t f2bf(float v) { return (bf16_t)(pk2(v, 0.f) & 0xffffu); }
DEV float bf_lo(unsigned u) { return __uint_as_float(u << 16); }
DEV float bf_hi(unsigned u) { return __uint_as_float(u & 0xffff0000u); }
DEV float bf2f(bf16_t b) { return __uint_as_float(((unsigned)b) << 16); }
DEV void unpack8(const u32x4 a, float (&x)[8]) { x[0] = bf_lo(a.x); x[1] = bf_hi(a.x); x[2] = bf_lo(a.y); x[3] = bf_hi(a.y); x[4] = bf_lo(a.z); x[5] = bf_hi(a.z); x[6] = bf_lo(a.w); x[7] = bf_hi(a.w); }
template <int CTRL> DEV float dpp_f(float v) { return __int_as_float(__builtin_amdgcn_update_dpp(0, __float_as_int(v), CTRL, 0xF, 0xF, true)); }
DEV float rdl(float v, int l) { return __int_as_float(__builtin_amdgcn_readlane(__float_as_int(v), l)); }
DEV float g16_sum(float v) { v += dpp_f<0xB1>(v); v += dpp_f<0x4E>(v); v += dpp_f<0x141>(v); v += dpp_f<0x140>(v); return v; }
DEV float g16_max(float v) { v = fmaxf(v, dpp_f<0xB1>(v)); v = fmaxf(v, dpp_f<0x4E>(v)); v = fmaxf(v, dpp_f<0x141>(v)); v = fmaxf(v, dpp_f<0x140>(v)); return v; }
DEV float wave_sum(float v) { v = g16_sum(v); return (rdl(v, 0) + rdl(v, 16)) + (rdl(v, 32) + rdl(v, 48)); }
DEV float wave_max(float v) { v = g16_max(v); return fmaxf(fmaxf(rdl(v, 0), rdl(v, 16)), fmaxf(rdl(v, 32), rdl(v, 48))); }
DEV float sigm_f(float x) { return __builtin_amdgcn_rcpf(1.f + __builtin_amdgcn_exp2f(-1.4426950408889634f * x)); }
DEV float silu_f(float x) { return x * sigm_f(x); }
DEV float gelu_t(float x) { const float u = x * (2.3022081646f + 0.1029432406f * x * x); return x * __builtin_amdgcn_rcpf(1.f + __builtin_amdgcn_exp2f(-u)); }
DEV float log_gamma(int h) { return log1pf(-exp2f(-5.f - (float)h)); }
DEV int otid() { int t = threadIdx.x; asm volatile("" : "+v"(t)); return t; }
DEV int obid() { int t = blockIdx.x; asm volatile("" : "+s"(t)); return t; }
DEV unsigned ldsaddr(LAS const void* p) { return (unsigned)(uintptr_t)p; }
DEV f32x4 mfma16(bf16x8 a, bf16x8 b, f32x4 c) { return __builtin_amdgcn_mfma_f32_16x16x32_bf16(a, b, c, 0, 0, 0); }
DEV bf16x8 lds_frag(LAS const unsigned char* base, int pitch, int row0, int k0, int lane) {
    return *(LAS const bf16x8*)(base + (row0 + (lane & 15)) * pitch + (k0 + 8 * (lane >> 4)) * 2); }
DEV LAS const unsigned char* tr_lane_base(LAS const unsigned char* base, int pitch, int lane) { const int g = lane >> 4, q = (lane & 15) >> 2, pp = lane & 3; return base + ((8 * g + q) * pitch + 8 * pp); }
template <int PITCH, int KB, int X0> DEV void tr_read4(LAS const unsigned char* a, bf16x8 (&f)[4]) {
    constexpr int o0 = KB * PITCH + X0 * 2;
    static_assert(o0 + 100 * PITCH < 65536, "ds offset field");
#pragma unroll
    for (int ks = 0; ks < 4; ++ks) {
        const s16x4 lo = __builtin_amdgcn_ds_read_tr16_b64_v4i16((LAS s16x4*)(a + o0 + ks * 32 * PITCH));
        const s16x4 hi = __builtin_amdgcn_ds_read_tr16_b64_v4i16((LAS s16x4*)(a + o0 + ks * 32 * PITCH + 4 * PITCH));
        f[ks] = (bf16x8){lo[0], lo[1], lo[2], lo[3], hi[0], hi[1], hi[2], hi[3]}; } }
template <int V> struct IC { static constexpr int value = V; };
template <int I, int N, class F> DEV void static_for(F&& f) { if constexpr (I < N) { f(IC<I>{}); static_for<I + 1, N>(f); } }
#define SCHEDB __builtin_amdgcn_sched_barrier(0)

namespace pg8 {
constexpr int BM = 256, BK = 64, HALF = 128, HTB = HALF * BK * 2, NXCD = 8, WGM = 8;
DEV int lds_byte(int r, int c) { const int st = (r >> 4) * 2 + (c >> 5), rr = r & 15, cc = c & 31, ob = rr * 64 + cc * 2; return st * 1024 + (ob ^ (((ob >> 9) & 1) << 5)); }
DEV void stage_rc(int b, int& R, int& C) { const int st = b / 1024, sb = b % 1024, swz = sb ^ (((sb >> 9) & 1) << 5); R = (st >> 1) * 16 + swz / 64; C = (st & 1) * 32 + (swz % 64) / 2; }
DEV int perm32(int rho) { const int n = rho >> 4, i = rho & 15; return 8 * (i >> 2) + 4 * n + (i & 3); }
struct Unit { int pm, pn, kind, nt; const char* A; const char* B; };
DEV void tile_map(int L, int nM, int nN, int& pm, int& pn) {
    const int nwg = nM * nN; int wgid = L; { const int q = nwg / NXCD, r = nwg % NXCD, xcd = wgid % NXCD, off = wgid / NXCD; wgid = (xcd < r ? xcd * (q + 1) : r * (q + 1) + (xcd - r) * q) + off; }
    const int nig = WGM * nN, gid = wgid / nig, fm = gid * WGM, gsz = (nM - fm) < WGM ? (nM - fm) : WGM;
    pm = fm + ((wgid % nig) % gsz); pn = (wgid % nig) / gsz; }

template <class Epi, class Sched>
DEV void gemm_phase(LAS unsigned char* lds, int lda, int ldb, const Sched& S, const Epi& E) {
    const int tid = otid(), wid = __builtin_amdgcn_readfirstlane(tid >> 6), lane = tid & 63, wr = wid >> 2, wc = wid & 3, fr = lane & 15, fq = lane >> 4;
    unsigned voffA[2], voffB[2];
#pragma unroll
    for (int i = 0; i < 2; ++i) { int R, C; stage_rc(tid * 16 + i * 8192, R, C); const int Rb = (R & ~31) + perm32(R & 31);
        voffA[i] = (unsigned)(R * lda + C) * 2u; voffB[i] = (unsigned)(Rb * ldb + C) * 2u; }
    const size_t kstep = (size_t)(BK * 2);
    const size_t hstepA = (size_t)HALF * lda * 2, hstepB = (size_t)HALF * ldb * 2;
    const unsigned ldsw = (unsigned)wid * 1024u;
    const int aoff = lds_byte(wr * 64 + fr, fq * 8), boff = lds_byte(wc * 32 + fr, fq * 8);
#define PG8_SA(b, h) (((b) * 2 + (h)) * HTB)
#define PG8_SB(b, h) ((4 + (b) * 2 + (h)) * HTB)
#define PG8_STAGE(bufoff, gbase, voff) do { _Pragma("unroll") for (int _i = 0; _i < 2; ++_i) \
        __builtin_amdgcn_global_load_lds((const unsigned*)((const char*)(gbase) + (voff)[_i]), (LAS unsigned*)(lds + (bufoff) + ldsw + _i * 8192), 16, 0, 0); } while (0)
#define PG8_LDA(dst, b, h) do { _Pragma("unroll") for (int m = 0; m < 4; ++m) _Pragma("unroll") for (int k = 0; k < 2; ++k) dst[m][k] = *(const LAS bf16x8*)(lds + PG8_SA(b, h) + aoff + m * 2048 + k * 1024); } while (0)
#define PG8_LDB(dst, b, h) do { _Pragma("unroll") for (int n = 0; n < 2; ++n) _Pragma("unroll") for (int k = 0; k < 2; ++k) dst[n][k] = *(const LAS bf16x8*)(lds + PG8_SB(b, h) + boff + n * 2048 + k * 1024); } while (0)
#define PG8_MMA(ai, bj, At, Bt) do { __builtin_amdgcn_s_setprio(1); _Pragma("unroll") for (int m = 0; m < 4; ++m) _Pragma("unroll") for (int n = 0; n < 2; ++n) _Pragma("unroll") for (int k = 0; k < 2; ++k) \
        acc[ai][bj][m][n] = __builtin_amdgcn_mfma_f32_16x16x32_bf16(Bt[n][k], At[m][k], acc[ai][bj][m][n], 0, 0, 0); __builtin_amdgcn_s_setprio(0); } while (0)
#define PG8_WAIT_V(n) asm volatile("s_waitcnt vmcnt(" #n ")" ::: "memory")
#define PG8_WAIT_L(n) asm volatile("s_waitcnt lgkmcnt(" #n ")" ::: "memory")
#define PG8_BAR __builtin_amdgcn_s_barrier()
#define PG8_SCHED __builtin_amdgcn_sched_barrier(0)
    Unit cur, nxt; int ui = 0;
    if (!S.next(0, cur)) return;
    f32x4 acc[2][2][4][2];
#pragma unroll
    for (int a = 0; a < 2; ++a)
#pragma unroll
        for (int b = 0; b < 2; ++b)
#pragma unroll
            for (int m = 0; m < 4; ++m)
#pragma unroll
                for (int n = 0; n < 2; ++n) acc[a][b][m][n] = (f32x4){0.f, 0.f, 0.f, 0.f};
    bf16x8 At[4][2], B0[2][2], B1[2][2];
    const char* cA = cur.A; const char* cB = cur.B;
    PG8_STAGE(PG8_SB(0, 0), cB, voffB); PG8_STAGE(PG8_SA(0, 0), cA, voffA); PG8_STAGE(PG8_SB(0, 1), cB + hstepB, voffB); PG8_STAGE(PG8_SA(0, 1), cA + hstepA, voffA);
    if (wr == 1) PG8_BAR;
    PG8_WAIT_V(4); PG8_BAR;
    PG8_STAGE(PG8_SB(1, 0), cB + kstep, voffB); PG8_STAGE(PG8_SA(1, 0), cA + kstep, voffA); PG8_STAGE(PG8_SB(1, 1), cB + hstepB + kstep, voffB);
    PG8_WAIT_V(6); PG8_BAR;
    for (;;) {
        const bool has_next = S.next(ui + 1, nxt);
        const char* nA = has_next ? nxt.A : cA; const char* nB = has_next ? nxt.B : cB;
        const int nt = cur.nt;
        for (int t = 0; t < nt; t += 2) {
            const bool last = (t == nt - 2);
            const char* a1 = cA + (size_t)(t + 1) * kstep;
            const char* a2 = last ? nA : cA + (size_t)(t + 2) * kstep; const char* b2 = last ? nB : cB + (size_t)(t + 2) * kstep;
            const char* a3 = a2 + kstep; const char* b3 = b2 + kstep;
            PG8_LDB(B0, 0, 0); PG8_SCHED; PG8_LDA(At, 0, 0); PG8_STAGE(PG8_SA(1, 1), a1 + hstepA, voffA);
            PG8_WAIT_L(8); PG8_BAR; PG8_WAIT_L(0); PG8_MMA(0, 0, At, B0); PG8_BAR; PG8_SCHED;
            PG8_LDB(B1, 0, 1); PG8_STAGE(PG8_SB(0, 0), b2, voffB);
            PG8_BAR; PG8_WAIT_L(0); PG8_MMA(0, 1, At, B1); PG8_BAR;
            PG8_LDA(At, 0, 1); PG8_STAGE(PG8_SA(0, 0), a2, voffA);
            PG8_BAR; PG8_WAIT_L(0); PG8_MMA(1, 0, At, B0); PG8_BAR; PG8_SCHED;
            PG8_STAGE(PG8_SB(0, 1), b2 + hstepB, voffB);
            PG8_WAIT_V(6); PG8_BAR; PG8_MMA(1, 1, At, B1); PG8_BAR;
            PG8_LDB(B0, 1, 0); PG8_SCHED; PG8_LDA(At, 1, 0); PG8_STAGE(PG8_SA(0, 1), a2 + hstepA, voffA);
            PG8_WAIT_L(8); PG8_BAR; PG8_WAIT_L(0); PG8_MMA(0, 0, At, B0); PG8_BAR; PG8_SCHED;
            PG8_LDB(B1, 1, 1); PG8_STAGE(PG8_SB(1, 0), b3, voffB);
            PG8_BAR; PG8_WAIT_L(0); PG8_MMA(0, 1, At, B1); PG8_BAR;
            PG8_LDA(At, 1, 1); PG8_STAGE(PG8_SA(1, 0), a3, voffA);
            PG8_BAR; PG8_WAIT_L(0); PG8_MMA(1, 0, At, B0); PG8_BAR; PG8_SCHED;
            PG8_STAGE(PG8_SB(1, 1), b3 + hstepB, voffB);
            PG8_WAIT_V(6); PG8_BAR; PG8_MMA(1, 1, At, B1); PG8_BAR;
        }
        const bool keep = E(acc, cur, wr, wc, fr, fq);
        if (!has_next) break;
        if (!keep)
#pragma unroll
        for (int a = 0; a < 2; ++a)
#pragma unroll
            for (int b = 0; b < 2; ++b)
#pragma unroll
                for (int m = 0; m < 4; ++m)
#pragma unroll
                    for (int n = 0; n < 2; ++n) acc[a][b][m][n] = (f32x4){0.f, 0.f, 0.f, 0.f};
        cur = nxt; cA = nA; cB = nB; ++ui;
    }
    PG8_WAIT_V(0);
    if (wr == 0) PG8_BAR;
    PG8_BAR;
#undef PG8_SA
#undef PG8_SB
#undef PG8_STAGE
#undef PG8_LDA
#undef PG8_LDB
#undef PG8_MMA
#undef PG8_WAIT_V
#undef PG8_WAIT_L
#undef PG8_BAR
#undef PG8_SCHED
}
#define EPI_LOOP_BEGIN \
    _Pragma("unroll") for (int ai = 0; ai < 2; ++ai) _Pragma("unroll") for (int m = 0; m < 4; ++m) { const int row = u.pm * 256 + ai * 128 + wr * 64 + m * 16 + fr; \
    _Pragma("unroll") for (int bj = 0; bj < 2; ++bj) { const int col0 = u.pn * 256 + bj * 128 + wc * 32 + fq * 8; const f32x4 v0 = acc[ai][bj][m][0], v1 = acc[ai][bj][m][1];
#define EPI_LOOP_END } }
#define EPI_AI_BEGIN _Pragma("unroll") for (int ai = 0; ai < 2; ++ai) {
#define EPI_AI_END }
#define EPI_G_BEGIN _Pragma("unroll") for (int m = 0; m < 4; ++m) { const int row = u.pm * 256 + ai * 128 + wr * 64 + m * 16 + fr; \
    _Pragma("unroll") for (int bj = 0; bj < 2; ++bj) { const int col0 = u.pn * 256 + bj * 128 + wc * 32 + fq * 8; const int gi = m * 2 + bj; (void)gi; (void)row; (void)col0;
#define EPI_G_END } }
}
using pg8::Unit;
typedef f32x4 AccT[2][2][4][2];

struct Sched1 { int G, c; const char *h, *hm, *btin, *btkv;
    DEV bool next(int i, Unit& u) const {
        long L = (long)i * G + c;
        if (L < 1980) { pg8::tile_map((int)L, 66, 30, u.pm, u.pn); u.kind = 0; u.nt = 16; u.A = h + (size_t)u.pm * 524288; u.B = btin + (size_t)u.pn * 524288; return true; }
        L -= 1980; if (L < 32) { u.pm = (int)(L & 7); u.pn = (int)(L >> 3); u.kind = 1; u.nt = 16; u.A = hm + (size_t)u.pm * 524288; u.B = btkv + (size_t)u.pn * 524288; return true; }
        return false; } };
struct Epi1 { bf16_t* P; bf16_t* mkb; float* out; const float *ropeC, *ropeS, *b_gate;
    DEV bool operator()(AccT& acc, const Unit& u, int wr, int wc, int fr, int fq) const {
        if (u.kind == 1) {
            EPI_LOOP_BEGIN
                float* o = (col0 < 512) ? out + O_MK + (size_t)row * 512 + col0 : out + O_MV + (size_t)row * 512 + (col0 - 512);
                *(f32x4*)o = v0; *(f32x4*)(o + 4) = v1;
                u32x4 pk; pk.x = pk2(v0.x, v0.y); pk.y = pk2(v0.z, v0.w); pk.z = pk2(v1.x, v1.y); pk.w = pk2(v1.z, v1.w);
                *(u32x4*)(mkb + (size_t)row * 1024 + col0) = pk;
            EPI_LOOP_END
            return false; }
        const int pn = u.pn;
        if (pn < 4) {
            const float sc = (pn >= 2) ? 0.08838834764831845f : 1.f;
            EPI_AI_BEGIN
                f32x4 cs[8], sn[8];
                EPI_G_BEGIN
                    const int pidx = row < NP ? (row & 2047) : 2048 + ((row - NP) & 3); const int uu = (col0 & 127) >> 3;
                    cs[gi] = *(const f32x4*)(ropeC + pidx * 64 + 4 * uu); sn[gi] = *(const f32x4*)(ropeS + pidx * 64 + 4 * uu);
                EPI_G_END
                EPI_G_BEGIN
                    const f32x4 v0 = acc[ai][bj][m][0], v1 = acc[ai][bj][m][1];
                    const int uu = (col0 & 127) >> 3, hb = col0 & ~127;
                    const f32x4 o1 = (v0 * cs[gi] - v1 * sn[gi]) * sc, o2 = (v0 * sn[gi] + v1 * cs[gi]) * sc;
                    u32x2 a; a.x = pk2(o1.x, o1.y); a.y = pk2(o1.z, o1.w); u32x2 b; b.x = pk2(o2.x, o2.y); b.y = pk2(o2.z, o2.w);
                    *(u32x2*)(P + (size_t)row * INC + hb + 4 * uu) = a; *(u32x2*)(P + (size_t)row * INC + hb + 64 + 4 * uu) = b;
                EPI_G_END
            EPI_AI_END
            return false; }
        const int mode = pn < 8 ? 0 : pn < 12 ? 1 : pn < 14 ? 2 : pn < 16 ? 0 : pn < 18 ? 2 : 3;
        f32x4 bg[2][2];
#pragma unroll
        for (int bj = 0; bj < 2; ++bj) { const int cg = (mode == 3) ? u.pn * 256 + bj * 128 + wc * 32 + fq * 8 - C_GT : 0; bg[bj][0] = *(const f32x4*)(b_gate + cg); bg[bj][1] = *(const f32x4*)(b_gate + cg + 4); }
        EPI_LOOP_BEGIN
            f32x4 a = v0, b = v1;
            if (mode == 1) { for (int i = 0; i < 4; ++i) { a[i] = silu_f(a[i]); b[i] = silu_f(b[i]); } }
            else if (mode == 2) { for (int i = 0; i < 4; ++i) { a[i] = gelu_t(a[i]); b[i] = gelu_t(b[i]); } }
            else if (mode == 3) { for (int i = 0; i < 4; ++i) { a[i] = sigm_f(a[i] + bg[bj][0][i]); b[i] = sigm_f(b[i] + bg[bj][1][i]); } }
            u32x4 pk; pk.x = pk2(a.x, a.y); pk.y = pk2(a.z, a.w); pk.z = pk2(b.x, b.y); pk.w = pk2(b.z, b.w);
            *(u32x4*)(P + (size_t)row * INC + col0) = pk;
        EPI_LOOP_END
        return false;
    } };

struct SchedMg { int G, c; const char *P, *bt;
    DEV bool next(int i, Unit& u) const {
        const int T = i / 3, br = i - 3 * T; const long L = (long)T * G + c; if (L >= 256) return false;
        pg8::tile_map((int)L, 64, 4, u.pm, u.pn); u.kind = br; u.nt = br == 0 ? 16 : 8;
        const int koff = br == 0 ? 0 : br == 1 ? 1024 : 1536;
        u.A = P + (size_t)u.pm * 256 * INC * 2 + (size_t)(C_G + koff) * 2; u.B = bt + (size_t)u.pn * 256 * 2048 * 2 + (size_t)koff * 2; return true; } };
struct SchedMgS { int c; const char *P, *bt;
    DEV bool next(int i, Unit& u) const {
        if (i > 0 || c >= 64) return false;
        const int tile = c >> 3, ch = c & 7; u.pm = 64 + (tile >> 2); u.pn = tile & 3; u.kind = ch; u.nt = 4;
        const int koff = ch * 256;
        u.A = P + (size_t)u.pm * 256 * INC * 2 + (size_t)(C_G + koff) * 2; u.B = bt + (size_t)u.pn * 256 * 2048 * 2 + (size_t)koff * 2; return true; } };
struct EpiMg { const bf16_t* P; bf16_t* mg;
    DEV bool operator()(AccT& acc, const Unit& u, int wr, int wc, int fr, int fq) const {
        const int br = u.kind;
        EPI_AI_BEGIN
            u32x4 gg[8], hh[8];
            EPI_G_BEGIN
                const bf16_t* gp = P + (size_t)row * INC + C_GT + br * 1024 + col0;
                gg[gi] = *(const u32x4*)gp; hh[gi] = (br < 2) ? *(const u32x4*)(gp + 1024) : gg[gi];
            EPI_G_END
            EPI_G_BEGIN
                float s8[8], d8[8]; unpack8(gg[gi], s8);
                if (br < 2) { unpack8(hh[gi], d8);
#pragma unroll
                    for (int i = 0; i < 8; ++i) s8[i] *= __builtin_amdgcn_rcpf(d8[i]); }
                f32x4& v0 = acc[ai][bj][m][0]; f32x4& v1 = acc[ai][bj][m][1];
                v0.x *= s8[0]; v0.y *= s8[1]; v0.z *= s8[2]; v0.w *= s8[3]; v1.x *= s8[4]; v1.y *= s8[5]; v1.z *= s8[6]; v1.w *= s8[7];
                if (br == 2) { u32x4 pk; pk.x = pk2(v0.x, v0.y); pk.y = pk2(v0.z, v0.w); pk.z = pk2(v1.x, v1.y); pk.w = pk2(v1.z, v1.w); *(u32x4*)(mg + (size_t)row * 1024 + col0) = pk; }
            EPI_G_END
        EPI_AI_END
        return br < 2;
    } };
struct EpiMgS { const bf16_t* P; float* part;
    DEV bool operator()(AccT& acc, const Unit& u, int wr, int wc, int fr, int fq) const {
        const int ch = u.kind, br = ch < 4 ? 0 : ch < 6 ? 1 : 2;
        const bf16_t* gp = P + C_GT + br * 1024; float* tp = part + (size_t)ch * SROWS - (size_t)NP * 1024;
        EPI_AI_BEGIN
            u32x4 gg[8];
            EPI_G_BEGIN
                gg[gi] = *(const u32x4*)(gp + (size_t)row * INC + col0);
            EPI_G_END
            EPI_G_BEGIN
                float s8[8]; unpack8(gg[gi], s8); const f32x4 v0 = acc[ai][bj][m][0], v1 = acc[ai][bj][m][1];
                float* t = tp + (size_t)row * 1024 + col0;
                *(f32x4*)t = (f32x4){s8[0] * v0.x, s8[1] * v0.y, s8[2] * v0.z, s8[3] * v0.w}; *(f32x4*)(t + 4) = (f32x4){s8[4] * v1.x, s8[5] * v1.y, s8[6] * v1.z, s8[7] * v1.w};
            EPI_G_END
        EPI_AI_END
        return false;
    } };
template <int nt, int nsub, int nchunk, int astep, int bstep> struct SchedPS { int G, c; const char *A, *B;
    DEV bool next(int i, Unit& u) const {
        const long L = (long)i * G + c;
        if (L < 256) { pg8::tile_map((int)L, 64, 4, u.pm, u.pn); u.kind = 0; u.nt = nt; u.A = A + (size_t)u.pm * astep; u.B = B + (size_t)u.pn * bstep; return true; }
        const int s = (int)(L - 256); if (s >= nsub) return false;
        const int tile = s / nchunk, ch = s - tile * nchunk; u.pm = 64 + (tile >> 2); u.pn = tile & 3; u.kind = 1 + ch; u.nt = 2;
        u.A = A + (size_t)u.pm * astep + (size_t)ch * 256; u.B = B + (size_t)u.pn * bstep + (size_t)ch * 256; return true; } };
struct SchedPlain { int G, c, nM, nN, nt; const char *A, *B; size_t astep, bstep;
    DEV bool next(int i, Unit& u) const {
        const long L = (long)i * G + c; if (L >= (long)nM * nN) return false;
        pg8::tile_map((int)L, nM, nN, u.pm, u.pn); u.kind = 0; u.nt = nt; u.A = A + (size_t)u.pm * astep; u.B = B + (size_t)u.pn * bstep; return true; } };
struct EpiWo { const float *xp, *xs; float* out; float* part;
    DEV bool operator()(AccT& acc, const Unit& u, int wr, int wc, int fr, int fq) const {
        if (u.kind >= 1) {
            EPI_LOOP_BEGIN
                float* t = part + (size_t)(u.kind - 1) * SROWS + (size_t)(row - NP) * 1024 + col0; *(f32x4*)t = v0; *(f32x4*)(t + 4) = v1;
            EPI_LOOP_END
            return false; }
        EPI_LOOP_BEGIN
            u32x4 pk; pk.x = pk2(v0.x, v0.y); pk.y = pk2(v0.z, v0.w); pk.z = pk2(v1.x, v1.y); pk.w = pk2(v1.z, v1.w);
            *(u32x4*)((bf16_t*)out + (size_t)row * 2048 + 1024 + col0) = pk;
        EPI_LOOP_END
        return false;
    } };
struct EpiUp { bf16_t* z; float* out;
    DEV bool operator()(AccT& acc, const Unit& u, int wr, int wc, int fr, int fq) const {
        EPI_LOOP_BEGIN
            u32x4 pk; pk.x = pk2(v0.x, v0.y); pk.y = pk2(v0.z, v0.w); pk.z = pk2(v1.x, v1.y); pk.w = pk2(v1.z, v1.w);
            *(u32x4*)(z + (size_t)row * FF2 + col0) = pk;
            float* o = nullptr;
            if (row < NP) { const int t = row & 2047; if (t >= 2046) o = out + O_CONVP + ((size_t)(row >> 11) * 2 + (t - 2046)) * FF2 + col0; }
            else { const int rs = row - NP, t = rs & 3; if (t >= 2) o = out + O_CONVS + ((size_t)(rs >> 2) * 2 + (t - 2)) * FF2 + col0; }
            if (o) { *(f32x4*)o = v0; *(f32x4*)(o + 4) = v1; }
        EPI_LOOP_END
        return false;
    } };
struct EpiDn { float* out; float* part;
    DEV bool operator()(AccT& acc, const Unit& u, int wr, int wc, int fr, int fq) const {
        if (u.kind >= 1) {
            EPI_LOOP_BEGIN
                float* t = part + (size_t)(u.kind - 1) * SROWS + (size_t)(row - NP) * 1024 + col0; *(f32x4*)t = v0; *(f32x4*)(t + 4) = v1;
            EPI_LOOP_END
            return false; }
        EPI_LOOP_BEGIN
            u32x4 pk; pk.x = pk2(v0.x, v0.y); pk.y = pk2(v0.z, v0.w); pk.z = pk2(v1.x, v1.y); pk.w = pk2(v1.z, v1.w);
            *(u32x4*)((bf16_t*)out + (size_t)row * 2048 + col0) = pk;
        EPI_LOOP_END
        return false;
    } };

DEV int srccol_in(int p) {
    if (p < 1024) { const int hb = p & ~127, pp = p & 127, uu = pp >> 3, v = pp & 7; return hb + ((v < 4) ? 4 * uu + v : 64 + 4 * uu + (v - 4)); }
    if (p >= C_XQ && p < C_SV) return p + 512;
    if (p >= C_SV && p < C_GT) return p - 512;
    return p; }
DEV void transpose_item(const float* W, int N, bf16_t* WT, int ldk, int koff, LAS float* scr, int k0, int n0, int srccol, int lane) {
    float tv[32];
#pragma unroll
    for (int i = 0; i < 32; ++i) tv[i] = W[(size_t)(k0 + 2 * i + (lane >> 5)) * N + srccol];
#pragma unroll
    for (int i = 0; i < 32; ++i) scr[(2 * i + (lane >> 5)) * 33 + (lane & 31)] = tv[i];
    const int c = lane & 7;
#pragma unroll
    for (int j = 0; j < 4; ++j) { const int n = (lane >> 3) + 8 * j; const LAS float* s = scr + (8 * c) * 33 + n;
        u32x4 o; o.x = pk2(s[0 * 33], s[1 * 33]); o.y = pk2(s[2 * 33], s[3 * 33]); o.z = pk2(s[4 * 33], s[5 * 33]); o.w = pk2(s[6 * 33], s[7 * 33]);
        *(u32x4*)(WT + (size_t)(n0 + n) * ldk + koff + k0 + 8 * c) = o; }
}
DEV void rms_row(const float* xrow, const float* g, bf16_t* orow, int lane) {
    f32x4 v[4]; float s = 0.f;
#pragma unroll
    for (int j = 0; j < 4; ++j) { v[j] = *(const f32x4*)(xrow + 4 * lane + 256 * j); s += v[j].x * v[j].x + v[j].y * v[j].y + v[j].z * v[j].z + v[j].w * v[j].w; }
    s = wave_sum(s); const float r = rsqrtf(s * (1.f / 1024.f) + EPS);
#pragma unroll
    for (int j = 0; j < 4; ++j) { const f32x4 gv = *(const f32x4*)(g + 4 * lane + 256 * j);
        u32x2 o; o.x = pk2(v[j].x * r * gv.x, v[j].y * r * gv.y); o.y = pk2(v[j].z * r * gv.z, v[j].w * r * gv.w);
        *(u32x2*)(orow + 4 * lane + 256 * j) = o; }
}
DEV void phase_prep(const Params& p, LAS unsigned char* lds) {
    const int tid = otid(), lane = tid & 63, wave = tid >> 6;
    const int gw = obid() * 8 + wave, NGW = gridDim.x * 8;
    LAS float* scr = (LAS float*)(lds + wave * 8448);
    unsigned char* ws = p.ws;
    constexpr int I_IN = 16 * 240, I_KV = 16 * 32, I_MR = 16 * 32, I_MS = 8 * 32, I_MX = 8 * 32, I_O = 16 * 32, I_UP = 16 * 176, I_DN = 44 * 32;
    constexpr int N_TR = I_IN + I_KV + I_MR + I_MS + I_MX + I_O + I_UP + I_DN;
    constexpr int N_RMS = MT + 2048, N_ROPE = 2052, N_TRIL = 512;
    constexpr int N_ALL = N_TR + N_RMS + N_ROPE + N_TRIL;
    for (int it = gw; it < N_ALL; it += NGW) {
        int r = it;
        if (r < N_TR) {
            const int l31 = lane & 31;
            if (r < I_IN) { const int kb = r / 240, nb = r % 240; transpose_item(p.w_in, INC, (bf16_t*)(ws + OFF_BTIN), 1024, 0, scr, 64 * kb, 32 * nb, srccol_in(32 * nb + l31), lane); continue; } r -= I_IN;
            if (r < I_KV) { const int kb = r / 32, nb = r % 32; transpose_item(p.w_mem_kv, 1024, (bf16_t*)(ws + OFF_BTKV), 1024, 0, scr, 64 * kb, 32 * nb, 32 * nb + l31, lane); continue; } r -= I_KV;
            if (r < I_MR) { const int kb = r / 32, nb = r % 32; transpose_item(p.w_br_ret, 1024, (bf16_t*)(ws + OFF_BTMG), 2048, 0, scr, 64 * kb, 32 * nb, 32 * nb + l31, lane); continue; } r -= I_MR;
            if (r < I_MS) { const int kb = r / 32, nb = r % 32; transpose_item(p.w_br_sg, 1024, (bf16_t*)(ws + OFF_BTMG), 2048, 1024, scr, 64 * kb, 32 * nb, 32 * nb + l31, lane); continue; } r -= I_MS;
            if (r < I_MX) { const int kb = r / 32, nb = r % 32; transpose_item(p.w_br_x, 1024, (bf16_t*)(ws + OFF_BTMG), 2048, 1536, scr, 64 * kb, 32 * nb, 32 * nb + l31, lane); continue; } r -= I_MX;
            if (r < I_O) { const int kb = r / 32, nb = r % 32; transpose_item(p.w_o, 1024, (bf16_t*)(ws + OFF_BTO), 1024, 0, scr, 64 * kb, 32 * nb, 32 * nb + l31, lane); continue; } r -= I_O;
            if (r < I_UP) { const int kb = r / 176, nb = r % 176; transpose_item(p.w_up, FF2, (bf16_t*)(ws + OFF_BTUP), 1024, 0, scr, 64 * kb, 32 * nb, 32 * nb + l31, lane); continue; } r -= I_UP;
            { const int kb = r / 32, nb = r % 32; transpose_item(p.w_down, 1024, (bf16_t*)(ws + OFF_BTDN), FF, 0, scr, 64 * kb, 32 * nb, 32 * nb + l31, lane); continue; }
        }
        r -= N_TR;
        if (r < N_RMS) {
            if (r < NP) rms_row(p.x_prompt + (size_t)r * 1024, p.norm_mix_g, (bf16_t*)(ws + OFF_R2) + (size_t)r * 1024, lane);
            else if (r < MT) rms_row(p.x_sample + (size_t)(r - NP) * 1024, p.norm_mix_g, (bf16_t*)(ws + OFF_R2) + (size_t)r * 1024, lane);
            else rms_row(p.mem_prompt + (size_t)(r - MT) * 1024, p.mem_norm_g, (bf16_t*)(ws + OFF_HM) + (size_t)(r - MT) * 1024, lane);
            continue; }
        r -= N_RMS;
        if (r < N_ROPE) {
            const int pos = r < 2048 ? r : 16384 + (r - 2048);
            double inv = 1.0;
            if (lane & 1) inv *= 0.8659643233600653; if (lane & 2) inv *= 0.7498942093324559; if (lane & 4) inv *= 0.5623413251903491;
            if (lane & 8) inv *= 0.31622776601683794; if (lane & 16) inv *= 0.1; if (lane & 32) inv *= 0.01;
            double t = (double)pos * inv * 0.15915494309189535; t -= __builtin_rint(t);
            const float tf = (float)t;
            ((float*)(ws + OFF_ROPEC))[r * 64 + lane] = __builtin_amdgcn_cosf(tf);
            ((float*)(ws + OFF_ROPES))[r * 64 + lane] = __builtin_amdgcn_sinf(tf);
            continue; }
        r -= N_ROPE;
        { const int t = r & 127; const float* src = p.sg_ws + (size_t)r * 128 + 2 * lane;
          const float a = (2 * lane <= t) ? src[0] : 0.f, b = (2 * lane + 1 <= t) ? src[1] : 0.f;
          *(unsigned*)((bf16_t*)(ws + OFF_WTRIL) + (size_t)r * 128 + 2 * lane) = pk2(a, b); }
    }
}

DEV void ret_A_item(const Params& p, LAS unsigned char* lds, int item) {
    const int tid = otid(), lane = tid & 63, w = tid >> 6;
    const int c = item & 15, bh = item >> 4, h = bh & 3, b = bh >> 2;
    const size_t row0 = (size_t)b * 2048 + c * 128;
    const bf16_t* P = (const bf16_t*)(p.ws + OFF_P);
    const float lg = log_gamma(h);
    LAS unsigned char* Kt = lds; LAS unsigned char* Vt = lds + 34816;
#pragma unroll
    for (int k_ = 0; k_ < 4; ++k_) { const int i = tid + 512 * k_; const int s = i >> 4, ch = i & 15;
        u32x4 v = *(const u32x4*)(P + (row0 + s) * INC + C_K + h * 128 + ch * 8);
        const float dec = __expf((float)(127 - s) * lg);
        v.x = pk2(bf_lo(v.x) * dec, bf_hi(v.x) * dec); v.y = pk2(bf_lo(v.y) * dec, bf_hi(v.y) * dec); v.z = pk2(bf_lo(v.z) * dec, bf_hi(v.z) * dec); v.w = pk2(bf_lo(v.w) * dec, bf_hi(v.w) * dec);
        *(LAS u32x4*)(Kt + s * 272 + ch * 16) = v; }
#pragma unroll
    for (int k_ = 0; k_ < 8; ++k_) { const int i = tid + 512 * k_; const int s = i >> 5, ch = i & 31;
        *(LAS u32x4*)(Vt + s * 528 + ch * 16) = *(const u32x4*)(P + (row0 + s) * INC + C_V + h * 256 + ch * 8); }
    __syncthreads();
    f32x4 acc[16];
#pragma unroll
    for (int i = 0; i < 16; ++i) acc[i] = (f32x4){0.f, 0.f, 0.f, 0.f};
    LAS const unsigned char* kb = tr_lane_base(Kt, 272, lane) + 32 * w; LAS const unsigned char* vb = tr_lane_base(Vt, 528, lane);
    bf16x8 af[4]; tr_read4<272, 0, 0>(kb, af);
    static_for<0, 16>([&](auto et_) { constexpr int et = decltype(et_)::value; bf16x8 bf[4]; tr_read4<528, 0, 16 * et>(vb, bf);
#pragma unroll
        for (int ks = 0; ks < 4; ++ks) acc[et] = mfma16(af[ks], bf[ks], acc[et]); });
    float* U = p.out + (size_t)item * 32768;
    const int g = lane >> 4, col = lane & 15;
#pragma unroll
    for (int et = 0; et < 16; ++et)
#pragma unroll
        for (int j = 0; j < 4; ++j) U[(16 * w + 4 * g + j) * 256 + 16 * et + col] = acc[et][j];
    __syncthreads();
}
DEV void scan_phase(const Params& p) {
    const float* U = p.out; bf16_t* Sb = (bf16_t*)(p.ws + OFF_R2);
    for (int idx = obid() * 512 + otid(); idx < 131072; idx += gridDim.x * 512) {
        const int e8 = idx & 31, d = (idx >> 5) & 127, bh = idx >> 12, h = bh & 3;
        const float g128 = __expf(128.f * log_gamma(h));
        f32x4 s0 = (f32x4){0.f, 0.f, 0.f, 0.f}, s1 = s0;
#pragma unroll
        for (int c = 0; c < 16; ++c) {
            const size_t off = (((size_t)bh * 16 + c) * 128 + d) * 256 + e8 * 8;
            u32x4 pk; pk.x = pk2(s0.x, s0.y); pk.y = pk2(s0.z, s0.w); pk.z = pk2(s1.x, s1.y); pk.w = pk2(s1.z, s1.w);
            *(u32x4*)(Sb + off) = pk;
            const f32x4 u0 = *(const f32x4*)(U + off), u1 = *(const f32x4*)(U + off + 4);
            s0 = s0 * g128 + u0; s1 = s1 * g128 + u1; }
        float* o = p.out + O_RETP + ((size_t)bh * 128 + d) * 256 + e8 * 8;
        *(f32x4*)o = s0; *(f32x4*)(o + 4) = s1;
    }
}
DEV void ret_C_item(const Params& p, LAS unsigned char* lds, int item) {
    const int tid = otid(), lane = tid & 63, w = tid >> 6, g = lane >> 4, col = lane & 15;
    const int c = item & 15, bh = item >> 4, h = bh & 3, b = bh >> 2;
    const size_t row0 = (size_t)b * 2048 + c * 128;
    bf16_t* P = (bf16_t*)(p.ws + OFF_P);
    const bf16_t* Sb = (const bf16_t*)(p.ws + OFF_R2) + (size_t)item * 32768;
    const float lg = log_gamma(h);
    LAS unsigned char* Kt = lds; LAS unsigned char* Vh = lds + 34816; LAS unsigned char* Sh = lds + 69632; LAS unsigned char* Sc = lds + 104448 + w * 4352;
#pragma unroll
    for (int k_ = 0; k_ < 4; ++k_) { const int i = tid + 512 * k_; const int s = i >> 4, ch = i & 15;
        *(LAS u32x4*)(Kt + s * 272 + ch * 16) = *(const u32x4*)(P + (row0 + s) * INC + C_K + h * 128 + ch * 8); }
    bf16x8 qf[4];
    { const bf16_t* qp = P + (row0 + 16 * w + col) * INC + C_Q + h * 128 + 8 * g;
#pragma unroll
      for (int ks = 0; ks < 4; ++ks) qf[ks] = *(const bf16x8*)(qp + 32 * ks); }
    f32x4 o[16];
    float sg[16][4];
#pragma unroll
    for (int j = 0; j < 4; ++j)
#pragma unroll
        for (int t = 0; t < 16; ++t) sg[t][j] = bf2f(P[(row0 + 16 * w + 4 * g + j) * INC + C_G + h * 256 + (t >> 3) * 128 + (t & 7) * 16 + col]);
    LAS const unsigned char* shb = tr_lane_base(Sh, 272, lane); LAS const unsigned char* vhb = tr_lane_base(Vh, 272, lane);
    bf16x8 scf[4];
    static_for<0, 2>([&](auto hh_) { constexpr int hh = decltype(hh_)::value;
        if (hh == 1) __syncthreads();
#pragma unroll
        for (int k_ = 0; k_ < 4; ++k_) { const int i = tid + 512 * k_; const int s = i >> 4, ch = i & 15;
            *(LAS u32x4*)(Vh + s * 272 + ch * 16) = *(const u32x4*)(P + (row0 + s) * INC + C_V + h * 256 + hh * 128 + ch * 8);
            *(LAS u32x4*)(Sh + s * 272 + ch * 16) = *(const u32x4*)(Sb + s * 256 + hh * 128 + ch * 8); }
        __syncthreads();
        if (hh == 0) {
            static_for<0, 8>([&](auto st_) { constexpr int st = decltype(st_)::value; f32x4 a = (f32x4){0.f, 0.f, 0.f, 0.f};
#pragma unroll
                for (int ks = 0; ks < 4; ++ks) a = mfma16(qf[ks], lds_frag(Kt, 272, 16 * st, 32 * ks, lane), a);
#pragma unroll
                for (int j = 0; j < 4; ++j) { const int diff = (16 * w + 4 * g + j) - (16 * st + col);
                    const float v = diff >= 0 ? a[j] * __expf((float)diff * lg) : 0.f;
                    *(LAS bf16_t*)(Sc + (4 * g + j) * 272 + (16 * st + col) * 2) = f2bf(v); }
                SCHEDB; });
#pragma unroll
            for (int ks = 0; ks < 4; ++ks) scf[ks] = lds_frag(Sc, 272, 0, 32 * ks, lane);
        }
        static_for<0, 8>([&](auto et_) { constexpr int et = decltype(et_)::value; f32x4 a = (f32x4){0.f, 0.f, 0.f, 0.f};
            bf16x8 f[4]; tr_read4<272, 0, 16 * et>(shb, f);
#pragma unroll
            for (int ks = 0; ks < 4; ++ks) a = mfma16(qf[ks], f[ks], a);
#pragma unroll
            for (int j = 0; j < 4; ++j) a[j] *= __expf((float)(16 * w + 4 * g + j + 1) * lg);
            tr_read4<272, 0, 16 * et>(vhb, f);
#pragma unroll
            for (int ks = 0; ks < 4; ++ks) a = mfma16(scf[ks], f[ks], a);
            o[hh * 8 + et] = a; SCHEDB; });
    });
    float gnv[16];
#pragma unroll
    for (int t = 0; t < 16; ++t) gnv[t] = p.ret_gn_g[h * 256 + (t >> 3) * 128 + (t & 7) * 16 + col];
#pragma unroll
    for (int j = 0; j < 4; ++j) {
        float s = 0.f;
#pragma unroll
        for (int t = 0; t < 16; ++t) s += o[t][j];
        const float mean = g16_sum(s) * (1.f / 256.f);
        float s2 = 0.f;
#pragma unroll
        for (int t = 0; t < 16; ++t) { const float dd = o[t][j] - mean; s2 += dd * dd; }
        const float rstd = rsqrtf(g16_sum(s2) * (1.f / 256.f) + EPS);
        bf16_t* gp = P + (row0 + 16 * w + 4 * g + j) * INC + C_G + h * 256;
#pragma unroll
        for (int t = 0; t < 16; ++t) { const int e = (t >> 3) * 128 + (t & 7) * 16 + col;
            gp[e] = f2bf((o[t][j] - mean) * rstd * gnv[t] * sg[t][j]); }
    }
    __syncthreads();
}
DEV void sgu_item(const Params& p, LAS unsigned char* lds, int item) {
    const int tid = otid(), lane = tid & 63, w = tid >> 6, g = lane >> 4, col = lane & 15;
    const int gq = item & 3, bn = item >> 2; const size_t row0 = (size_t)bn * 128;
    bf16_t* P = (bf16_t*)(p.ws + OFF_P);
    LAS unsigned char* VN = lds;
#pragma unroll
    for (int rr = 0; rr < 16; ++rr) { const int s = 16 * w + rr;
        const u32x4 v = *(const u32x4*)(P + (row0 + s) * INC + C_SV + lane * 8);
        float x[8] = {bf_lo(v.x), bf_hi(v.x), bf_lo(v.y), bf_hi(v.y), bf_lo(v.z), bf_hi(v.z), bf_lo(v.w), bf_hi(v.w)};
        float sm = 0.f;
#pragma unroll
        for (int i = 0; i < 8; ++i) sm += x[i];
        const float mean = wave_sum(sm) * (1.f / 512.f); float s2 = 0.f;
#pragma unroll
        for (int i = 0; i < 8; ++i) { x[i] -= mean; s2 += x[i] * x[i]; }
        const float rstd = rsqrtf(wave_sum(s2) * (1.f / 512.f) + EPS);
        if (g == gq) { const float* lg = p.sg_ln_g + lane * 8; u32x4 o;
            o.x = pk2(x[0] * rstd * lg[0], x[1] * rstd * lg[1]); o.y = pk2(x[2] * rstd * lg[2], x[3] * rstd * lg[3]);
            o.z = pk2(x[4] * rstd * lg[4], x[5] * rstd * lg[5]); o.w = pk2(x[6] * rstd * lg[6], x[7] * rstd * lg[7]);
            *(LAS u32x4*)(VN + s * 272 + col * 16) = o; } }
    bf16x8 af[4];
    { const bf16_t* wp = (const bf16_t*)(p.ws + OFF_WTRIL) + (size_t)(gq * 128 + 16 * w + col) * 128 + 8 * g;
#pragma unroll
      for (int ks = 0; ks < 4; ++ks) af[ks] = *(const bf16x8*)(wp + 32 * ks); }
    __syncthreads();
    LAS const unsigned char* vnb = tr_lane_base(VN, 272, lane);
    float uv[8][4], bsv[4];
#pragma unroll
    for (int j = 0; j < 4; ++j) { bsv[j] = p.sg_bs[gq * 128 + 16 * w + 4 * g + j];
#pragma unroll
        for (int ct = 0; ct < 8; ++ct) uv[ct][j] = bf2f(P[(row0 + 16 * w + 4 * g + j) * INC + C_SU + gq * 128 + 16 * ct + col]); }
    static_for<0, 8>([&](auto ct_) { constexpr int ct = decltype(ct_)::value; f32x4 a = (f32x4){0.f, 0.f, 0.f, 0.f};
        bf16x8 f[4]; tr_read4<272, 0, 16 * ct>(vnb, f);
#pragma unroll
        for (int ks = 0; ks < 4; ++ks) a = mfma16(af[ks], f[ks], a);
#pragma unroll
        for (int j = 0; j < 4; ++j) P[(row0 + 16 * w + 4 * g + j) * INC + C_SU + gq * 128 + 16 * ct + col] = f2bf(uv[ct][j] * (a[j] + bsv[j])); });
    __syncthreads();
}
DEV void xattn_item(const Params& p, LAS unsigned char* lds, int item) {
    const int tid = otid(), lane = tid & 63, w = tid >> 6, g = lane >> 4, col = lane & 15;
    const int qt = item & 15, bh = item >> 4, h = bh & 3, b = bh >> 2; const size_t row0 = (size_t)b * 2048 + qt * 128;
    bf16_t* P = (bf16_t*)(p.ws + OFF_P); const bf16_t* mkb = (const bf16_t*)(p.ws + OFF_MKB);
    LAS unsigned char* KV = lds; LAS unsigned char* Pw = lds + 69632 + w * 8448;
#pragma unroll
    for (int k_ = 0; k_ < 8; ++k_) { const int i = tid + 512 * k_; const int m = i >> 4, ch = i & 15;
        *(LAS u32x4*)(KV + m * 272 + ch * 16) = *(const u32x4*)(mkb + (size_t)(b * 256 + m) * 1024 + h * 128 + ch * 8); }
    bf16x8 qf[4];
    { const bf16_t* qp = P + (row0 + 16 * w + col) * INC + C_XQ + h * 128 + 8 * g;
#pragma unroll
      for (int ks = 0; ks < 4; ++ks) qf[ks] = *(const bf16x8*)(qp + 32 * ks); }
    __syncthreads();
    f32x4 sc[16];
    static_for<0, 16>([&](auto mt_) { constexpr int mt = decltype(mt_)::value; f32x4 a = (f32x4){0.f, 0.f, 0.f, 0.f};
#pragma unroll
        for (int ks = 0; ks < 4; ++ks) a = mfma16(qf[ks], lds_frag(KV, 272, 16 * mt, 32 * ks, lane), a);
        sc[mt] = a * 0.08838834764831845f; SCHEDB; });
#pragma unroll
    for (int j = 0; j < 4; ++j) { float mx = -3.0e38f;
#pragma unroll
        for (int mt = 0; mt < 16; ++mt) mx = fmaxf(mx, sc[mt][j]);
        mx = g16_max(mx); float sm = 0.f;
#pragma unroll
        for (int mt = 0; mt < 16; ++mt) { const float e = __expf(sc[mt][j] - mx); sc[mt][j] = e; sm += e; }
        const float inv = 1.f / g16_sum(sm);
#pragma unroll
        for (int mt = 0; mt < 16; ++mt) *(LAS bf16_t*)(Pw + (4 * g + j) * 528 + (16 * mt + col) * 2) = f2bf(sc[mt][j] * inv); }
    __syncthreads();
#pragma unroll
    for (int k_ = 0; k_ < 8; ++k_) { const int i = tid + 512 * k_; const int m = i >> 4, ch = i & 15;
        *(LAS u32x4*)(KV + m * 272 + ch * 16) = *(const u32x4*)(mkb + (size_t)(b * 256 + m) * 1024 + 512 + h * 128 + ch * 8); }
    __syncthreads();
    LAS const unsigned char* kvb = tr_lane_base(KV, 272, lane);
    bf16x8 pf[8];
#pragma unroll
    for (int ks = 0; ks < 8; ++ks) pf[ks] = lds_frag(Pw, 528, 0, 32 * ks, lane);
    static_for<0, 8>([&](auto dt_) { constexpr int dt = decltype(dt_)::value; f32x4 a = (f32x4){0.f, 0.f, 0.f, 0.f};
        bf16x8 f[4]; tr_read4<272, 0, 16 * dt>(kvb, f);
#pragma unroll
        for (int ks = 0; ks < 4; ++ks) a = mfma16(pf[ks], f[ks], a);
        tr_read4<272, 128, 16 * dt>(kvb, f);
#pragma unroll
        for (int ks = 0; ks < 4; ++ks) a = mfma16(pf[4 + ks], f[ks], a);
#pragma unroll
        for (int j = 0; j < 4; ++j) P[(row0 + 16 * w + 4 * g + j) * INC + C_XQ + h * 128 + 16 * dt + col] = f2bf(a[j]); });
    __syncthreads();
}
DEV void xattn_s_item(const Params& p, LAS unsigned char* lds, int item) {
    const int tid = otid(), lane = tid & 63, w = tid >> 6, l32 = lane & 31, slot = w * 2 + (lane >> 5);
    const int h = item & 3, b = item >> 2; const size_t rowb = (size_t)NP + b * 4;
    bf16_t* P = (bf16_t*)(p.ws + OFF_P);
    LAS float* sc = (LAS float*)lds; LAS float* red = (LAS float*)(lds + 4096);
    float q[4][4];
#pragma unroll
    for (int l = 0; l < 4; ++l) { const u32x2 v = *(const u32x2*)(P + (rowb + l) * INC + C_XQ + h * 128 + 4 * l32); q[l][0] = bf_lo(v.x); q[l][1] = bf_hi(v.x); q[l][2] = bf_lo(v.y); q[l][3] = bf_hi(v.y); }
#pragma unroll
    for (int it = 0; it < 16; ++it) { const int m = it * 16 + slot;
        const f32x4 kv = *(const f32x4*)(p.cache_k + (((size_t)b * 256 + m) * 4 + h) * 128 + 4 * l32);
        float d[4];
#pragma unroll
        for (int l = 0; l < 4; ++l) d[l] = q[l][0] * kv.x + q[l][1] * kv.y + q[l][2] * kv.z + q[l][3] * kv.w;
        const bool b0 = l32 & 1, b1 = l32 & 2;
        float a0 = b0 ? d[2] : d[0], a1 = b0 ? d[3] : d[1];
        a0 += __shfl_xor(b0 ? d[0] : d[2], 1); a1 += __shfl_xor(b0 ? d[1] : d[3], 1);
        float r = b1 ? a1 : a0; r += __shfl_xor(b1 ? a0 : a1, 2);
        r += __shfl_xor(r, 4); r += __shfl_xor(r, 8); r += __shfl_xor(r, 16);
        if (l32 < 4) sc[((l32 & 1) * 2 + (l32 >> 1)) * 256 + m] = r * 0.08838834764831845f; }
    __syncthreads();
    if (w < 4) { float v[4]; float mx = -3.0e38f;
#pragma unroll
        for (int i = 0; i < 4; ++i) { v[i] = sc[w * 256 + lane + 64 * i]; mx = fmaxf(mx, v[i]); }
        mx = wave_max(mx); float sm = 0.f;
#pragma unroll
        for (int i = 0; i < 4; ++i) { v[i] = __expf(v[i] - mx); sm += v[i]; }
        const float inv = 1.f / wave_sum(sm);
#pragma unroll
        for (int i = 0; i < 4; ++i) sc[w * 256 + lane + 64 * i] = v[i] * inv; }
    __syncthreads();
    f32x4 o[4];
#pragma unroll
    for (int l = 0; l < 4; ++l) o[l] = (f32x4){0.f, 0.f, 0.f, 0.f};
#pragma unroll
    for (int it = 0; it < 16; ++it) { const int m = it * 16 + slot;
        const f32x4 vv = *(const f32x4*)(p.cache_v + (((size_t)b * 256 + m) * 4 + h) * 128 + 4 * l32);
#pragma unroll
        for (int l = 0; l < 4; ++l) o[l] += vv * sc[l * 256 + m]; }
#pragma unroll
    for (int l = 0; l < 4; ++l) *(LAS f32x4*)(red + (slot * 4 + l) * 128 + 4 * l32) = o[l];
    __syncthreads();
    { const int l = tid >> 7, d = tid & 127; float s = 0.f;
#pragma unroll
      for (int k = 0; k < 16; ++k) s += red[(k * 4 + l) * 128 + d];
      P[(rowb + l) * INC + C_XQ + h * 128 + d] = f2bf(s); }
    __syncthreads();
}
DEV void ret_s_item(const Params& p, LAS unsigned char* lds, int item) {
    const int tid = otid(), lane = tid & 63, w = tid >> 6;
    const int h = item & 3, b = item >> 2; const size_t rowb = (size_t)NP + b * 4;
    bf16_t* P = (bf16_t*)(p.ws + OFF_P);
    const float lg = log_gamma(h);
    LAS float* qs = (LAS float*)lds;
    LAS float* kr = qs + 512;
    LAS float* vs = kr + 512;
    LAS float* ob = vs + 1024;
    LAS float* scm = ob + 1024;
    LAS float* red = scm + 16;
    { const int t = tid >> 7, d = tid & 127;
      qs[t * 128 + d] = bf2f(P[(rowb + t) * INC + C_Q + h * 128 + d]); kr[t * 128 + d] = bf2f(P[(rowb + t) * INC + C_K + h * 128 + d]);
      vs[t * 256 + d] = bf2f(P[(rowb + t) * INC + C_V + h * 256 + d]); vs[t * 256 + 128 + d] = bf2f(P[(rowb + t) * INC + C_V + h * 256 + 128 + d]); }
    __syncthreads();
    { const int pr = tid >> 5, t = pr >> 2, s2 = pr & 3, l32 = tid & 31;
      const f32x4 qa = *(LAS f32x4*)(qs + t * 128 + 4 * l32), kb = *(LAS f32x4*)(kr + s2 * 128 + 4 * l32);
      float d = qa.x * kb.x + qa.y * kb.y + qa.z * kb.z + qa.w * kb.w;
#pragma unroll
      for (int o = 1; o < 32; o <<= 1) d += __shfl_xor(d, o);
      if (l32 == 0) scm[pr] = (t >= s2) ? d * __expf((float)(t - s2) * lg) : 0.f; }
    f32x4 v[4], cr[4];
#pragma unroll
    for (int s = 0; s < 4; ++s) { v[s] = *(LAS f32x4*)(vs + s * 256 + 4 * lane); cr[s] = (f32x4){0.f, 0.f, 0.f, 0.f}; }
    const float g4 = __expf(4.f * lg), kd0 = __expf(3.f * lg), kd1 = __expf(2.f * lg), kd2 = __expf(lg);
    const float* S0 = p.state_ret + ((size_t)item * 128) * 256; float* Sn = p.out + O_RETS + ((size_t)item * 128) * 256;
#pragma unroll
    for (int dd = 0; dd < 16; ++dd) { const int d = 16 * w + dd;
        const f32x4 s0 = *(const f32x4*)(S0 + d * 256 + 4 * lane);
#pragma unroll
        for (int t = 0; t < 4; ++t) cr[t] += s0 * qs[t * 128 + d];
        f32x4 sn = s0 * g4 + v[0] * (kr[d] * kd0) + v[1] * (kr[128 + d] * kd1) + v[2] * (kr[256 + d] * kd2) + v[3] * kr[384 + d];
        *(f32x4*)(Sn + d * 256 + 4 * lane) = sn; }
#pragma unroll
    for (int t = 0; t < 4; ++t) *(LAS f32x4*)(red + (w * 4 + t) * 256 + 4 * lane) = cr[t];
    __syncthreads();
    { const int t = tid >> 7, e2 = (tid & 127) * 2; const float qd = __expf((float)(t + 1) * lg);
#pragma unroll
      for (int i = 0; i < 2; ++i) { const int e = e2 + i; float c = 0.f;
#pragma unroll
          for (int k = 0; k < 8; ++k) c += red[(k * 4 + t) * 256 + e];
          float in = 0.f;
#pragma unroll
          for (int s = 0; s < 4; ++s) in += scm[t * 4 + s] * vs[s * 256 + e];
          ob[t * 256 + e] = in + c * qd; } }
    __syncthreads();
    if (w < 4) { float x[4]; float sm = 0.f;
#pragma unroll
        for (int i = 0; i < 4; ++i) { x[i] = ob[w * 256 + lane + 64 * i]; sm += x[i]; }
        const float mean = wave_sum(sm) * (1.f / 256.f); float s2 = 0.f;
#pragma unroll
        for (int i = 0; i < 4; ++i) { x[i] -= mean; s2 += x[i] * x[i]; }
        const float rstd = rsqrtf(wave_sum(s2) * (1.f / 256.f) + EPS);
        bf16_t* gp = P + (rowb + w) * INC + C_G + h * 256;
#pragma unroll
        for (int i = 0; i < 4; ++i) { const int e = lane + 64 * i; gp[e] = f2bf(x[i] * rstd * p.ret_gn_g[h * 256 + e] * bf2f(gp[e])); } }
    __syncthreads();
}
DEV void sgu_s_item(const Params& p, LAS unsigned char* lds, int b) {
    const int tid = otid(), lane = tid & 63, w = tid >> 6;
    const size_t rowb = (size_t)NP + b * 4;
    bf16_t* P = (bf16_t*)(p.ws + OFF_P);
    LAS float* part = (LAS float*)lds;
    float x[4];
#pragma unroll
    for (int r = 0; r < 4; ++r) { x[r] = bf2f(P[(rowb + r) * INC + C_SV + tid]); const float s = wave_sum(x[r]); if (lane == 0) part[w * 4 + r] = s; }
    __syncthreads();
    float mean[4];
#pragma unroll
    for (int r = 0; r < 4; ++r) { float s = 0.f;
#pragma unroll
        for (int k = 0; k < 8; ++k) s += part[k * 4 + r];
        mean[r] = s * (1.f / 512.f); }
    __syncthreads();
#pragma unroll
    for (int r = 0; r < 4; ++r) { x[r] -= mean[r]; const float s = wave_sum(x[r] * x[r]); if (lane == 0) part[w * 4 + r] = s; }
    __syncthreads();
    const float lng = p.sg_ln_g[tid]; const int gq = tid >> 7;
    float vn[4];
#pragma unroll
    for (int r = 0; r < 4; ++r) { float s = 0.f;
#pragma unroll
        for (int k = 0; k < 8; ++k) s += part[k * 4 + r];
        vn[r] = x[r] * rsqrtf(s * (1.f / 512.f) + EPS) * lng;
        p.out[O_SGV + ((size_t)b * 4 + r) * 512 + tid] = vn[r]; }
#pragma unroll
    for (int t = 0; t < 4; ++t) { float mx = p.sg_bs[gq * 128 + t];
#pragma unroll
        for (int s = 0; s < 4; ++s) if (s <= t) mx += p.sg_ws[(size_t)(gq * 128 + t) * 128 + s] * vn[s];
        bf16_t* up = P + (rowb + t) * INC + C_SU + tid; *up = f2bf(bf2f(*up) * mx); }
    __syncthreads();
}


DEV float rl_bf(unsigned packed, int d) { return (d & 1) ? bf_hi(packed) : bf_lo(packed); }
DEV void ret_s_wave(const Params& p, int item, int lane) {
    const int h = item & 3, b = item >> 2; const size_t rowb = (size_t)NP + b * 4;
    bf16_t* P = (bf16_t*)(p.ws + OFF_P);
    const float lg = log_gamma(h);
    unsigned qp[4], kp[4]; f32x4 v[4];
#pragma unroll
    for (int t = 0; t < 4; ++t) { qp[t] = *(const unsigned*)(P + (rowb + t) * INC + C_Q + h * 128 + 2 * lane); kp[t] = *(const unsigned*)(P + (rowb + t) * INC + C_K + h * 128 + 2 * lane);
        const u32x2 x = *(const u32x2*)(P + (rowb + t) * INC + C_V + h * 256 + 4 * lane); v[t] = (f32x4){bf_lo(x.x), bf_hi(x.x), bf_lo(x.y), bf_hi(x.y)}; }
    float sc[4][4];
#pragma unroll
    for (int t = 0; t < 4; ++t)
#pragma unroll
        for (int s2 = 0; s2 < 4; ++s2) { if (s2 <= t) sc[t][s2] = wave_sum(bf_lo(qp[t]) * bf_lo(kp[s2]) + bf_hi(qp[t]) * bf_hi(kp[s2])) * __expf((float)(t - s2) * lg); else sc[t][s2] = 0.f; }
    const float g4 = __expf(4.f * lg), kdec[4] = {__expf(3.f * lg), __expf(2.f * lg), __expf(lg), 1.f};
    f32x4 cr[4];
#pragma unroll
    for (int t = 0; t < 4; ++t) cr[t] = (f32x4){0.f, 0.f, 0.f, 0.f};
    const float* S0 = p.state_ret + (size_t)item * 32768 + 4 * lane; float* Sn = p.out + O_RETS + (size_t)item * 32768 + 4 * lane;
    f32x4 sA[8], sB[8];
#pragma unroll
    for (int i = 0; i < 8; ++i) sA[i] = *(const f32x4*)(S0 + i * 256);
#define RETS_PROC(buf, d0) _Pragma("unroll") for (int i = 0; i < 8; ++i) { const int src = ((d0) + i) >> 1; f32x4 sn = buf[i] * g4; \
        _Pragma("unroll") for (int t = 0; t < 4; ++t) { const float qd = rl_bf((unsigned)__builtin_amdgcn_readlane((int)qp[t], src), i), kd = rl_bf((unsigned)__builtin_amdgcn_readlane((int)kp[t], src), i) * kdec[t]; \
            cr[t] += buf[i] * qd; sn += v[t] * kd; } \
        *(f32x4*)(Sn + ((d0) + i) * 256) = sn; }
    for (int d0 = 0; d0 < 128; d0 += 16) {
#pragma unroll
        for (int i = 0; i < 8; ++i) sB[i] = *(const f32x4*)(S0 + (d0 + 8 + i) * 256);
        RETS_PROC(sA, d0)
        if (d0 + 16 < 128) {
#pragma unroll
            for (int i = 0; i < 8; ++i) sA[i] = *(const f32x4*)(S0 + (d0 + 16 + i) * 256); }
        RETS_PROC(sB, d0 + 8)
    }
#undef RETS_PROC
    const f32x4 gn4 = *(const f32x4*)(p.ret_gn_g + h * 256 + 4 * lane);
#pragma unroll
    for (int t = 0; t < 4; ++t) {
        f32x4 o = cr[t] * __expf((float)(t + 1) * lg);
#pragma unroll
        for (int s2 = 0; s2 < 4; ++s2) o += v[s2] * sc[t][s2];
        const float mean = wave_sum(o.x + o.y + o.z + o.w) * (1.f / 256.f);
        o = o - mean;
        const float rstd = rsqrtf(wave_sum(o.x * o.x + o.y * o.y + o.z * o.z + o.w * o.w) * (1.f / 256.f) + EPS);
        bf16_t* gp = P + (rowb + t) * INC + C_G + h * 256 + 4 * lane;
        const u32x2 gg = *(const u32x2*)gp;
        u32x2 ov; ov.x = pk2(o.x * rstd * gn4.x * bf_lo(gg.x), o.y * rstd * gn4.y * bf_hi(gg.x)); ov.y = pk2(o.z * rstd * gn4.z * bf_lo(gg.y), o.w * rstd * gn4.w * bf_hi(gg.y));
        *(u32x2*)gp = ov; }
}
DEV void xattn_s_wave(const Params& p, LAS float* sc  , int item, int lane) {
    const int l32 = lane & 31, hf = lane >> 5;
    const int h = item & 3, b = item >> 2; const size_t rowb = (size_t)NP + b * 4;
    bf16_t* P = (bf16_t*)(p.ws + OFF_P);
    float q[4][4];
#pragma unroll
    for (int l = 0; l < 4; ++l) { const u32x2 x = *(const u32x2*)(P + (rowb + l) * INC + C_XQ + h * 128 + 4 * l32); q[l][0] = bf_lo(x.x); q[l][1] = bf_hi(x.x); q[l][2] = bf_lo(x.y); q[l][3] = bf_hi(x.y); }
    const float* Kb = p.cache_k + (((size_t)b * 256 + hf) * 4 + h) * 128 + 4 * l32;
    const float* Vb = p.cache_v + (((size_t)b * 256 + hf) * 4 + h) * 128 + 4 * l32;
    const bool b0 = l32 & 1, b1 = l32 & 2; const int lmap = (l32 & 1) * 2 + ((l32 >> 1) & 1);
    for (int it0 = 0; it0 < 128; it0 += 16) {
        f32x4 kv[16];
#pragma unroll
        for (int i = 0; i < 16; ++i) kv[i] = *(const f32x4*)(Kb + (size_t)(it0 + i) * 1024);
#pragma unroll
        for (int i = 0; i < 16; ++i) { float d[4];
#pragma unroll
            for (int l = 0; l < 4; ++l) d[l] = q[l][0] * kv[i].x + q[l][1] * kv[i].y + q[l][2] * kv[i].z + q[l][3] * kv[i].w;
            float a0 = b0 ? d[2] : d[0], a1 = b0 ? d[3] : d[1];
            a0 += dpp_f<0xB1>(b0 ? d[0] : d[2]); a1 += dpp_f<0xB1>(b0 ? d[1] : d[3]);
            float r = b1 ? a1 : a0; r += dpp_f<0x4E>(b1 ? a0 : a1);
            r += dpp_f<0x124>(r); r += dpp_f<0x128>(r);
            r += __shfl_xor(r, 16);
            if (l32 < 4) sc[lmap * 256 + 2 * (it0 + i) + hf] = r * 0.08838834764831845f; }
    }
#pragma unroll
    for (int l = 0; l < 4; ++l) { float vv[4]; float mx = -3.0e38f;
#pragma unroll
        for (int i = 0; i < 4; ++i) { vv[i] = sc[l * 256 + lane + 64 * i]; mx = fmaxf(mx, vv[i]); }
        mx = wave_max(mx); float sm = 0.f;
#pragma unroll
        for (int i = 0; i < 4; ++i) { vv[i] = __expf(vv[i] - mx); sm += vv[i]; }
        const float inv = 1.f / wave_sum(sm);
#pragma unroll
        for (int i = 0; i < 4; ++i) sc[l * 256 + lane + 64 * i] = vv[i] * inv; }
    f32x4 o[4];
#pragma unroll
    for (int l = 0; l < 4; ++l) o[l] = (f32x4){0.f, 0.f, 0.f, 0.f};
    for (int it0 = 0; it0 < 128; it0 += 16) {
        f32x4 vv[16];
#pragma unroll
        for (int i = 0; i < 16; ++i) vv[i] = *(const f32x4*)(Vb + (size_t)(it0 + i) * 1024);
#pragma unroll
        for (int i = 0; i < 16; ++i) { const int m = 2 * (it0 + i) + hf;
#pragma unroll
            for (int l = 0; l < 4; ++l) o[l] += vv[i] * sc[l * 256 + m]; }
    }
#pragma unroll
    for (int l = 0; l < 4; ++l) { f32x4 t = o[l];
        t.x += __shfl_xor(t.x, 32); t.y += __shfl_xor(t.y, 32); t.z += __shfl_xor(t.z, 32); t.w += __shfl_xor(t.w, 32);
        if (hf == 0) { u32x2 ov; ov.x = pk2(t.x, t.y); ov.y = pk2(t.z, t.w); *(u32x2*)(P + (rowb + l) * INC + C_XQ + h * 128 + 4 * l32) = ov; } }
}
DEV void sgu_s_wave(const Params& p, int b, int lane) {
    const size_t rowb = (size_t)NP + b * 4;
    bf16_t* P = (bf16_t*)(p.ws + OFF_P);
    const int gq = lane >> 4;
    float vn[4][8];
    const f32x4 l0 = *(const f32x4*)(p.sg_ln_g + 8 * lane), l1 = *(const f32x4*)(p.sg_ln_g + 8 * lane + 4);
    const float lng[8] = {l0.x, l0.y, l0.z, l0.w, l1.x, l1.y, l1.z, l1.w};
#pragma unroll
    for (int r = 0; r < 4; ++r) { float x[8]; unpack8(*(const u32x4*)(P + (rowb + r) * INC + C_SV + 8 * lane), x);
        float sm = 0.f;
#pragma unroll
        for (int i = 0; i < 8; ++i) sm += x[i];
        const float mean = wave_sum(sm) * (1.f / 512.f); float s2 = 0.f;
#pragma unroll
        for (int i = 0; i < 8; ++i) { x[i] -= mean; s2 += x[i] * x[i]; }
        const float rstd = rsqrtf(wave_sum(s2) * (1.f / 512.f) + EPS);
#pragma unroll
        for (int i = 0; i < 8; ++i) vn[r][i] = x[i] * rstd * lng[i];
        float* o = p.out + O_SGV + ((size_t)b * 4 + r) * 512 + 8 * lane;
        *(f32x4*)o = (f32x4){vn[r][0], vn[r][1], vn[r][2], vn[r][3]}; *(f32x4*)(o + 4) = (f32x4){vn[r][4], vn[r][5], vn[r][6], vn[r][7]}; }
#pragma unroll
    for (int t = 0; t < 4; ++t) { float mx[8];
#pragma unroll
        for (int i = 0; i < 8; ++i) mx[i] = p.sg_bs[gq * 128 + t];
#pragma unroll
        for (int s2 = 0; s2 < 4; ++s2) if (s2 <= t) { const float wv = p.sg_ws[(size_t)(gq * 128 + t) * 128 + s2];
#pragma unroll
            for (int i = 0; i < 8; ++i) mx[i] += wv * vn[s2][i]; }
        bf16_t* up = P + (rowb + t) * INC + C_SU + 8 * lane; float u[8]; unpack8(*(const u32x4*)up, u);
        u32x4 ov; ov.x = pk2(u[0] * mx[0], u[1] * mx[1]); ov.y = pk2(u[2] * mx[2], u[3] * mx[3]); ov.z = pk2(u[4] * mx[4], u[5] * mx[5]); ov.w = pk2(u[6] * mx[6], u[7] * mx[7]);
        *(u32x4*)up = ov; }
}

DEV void rms_phase(const Params& p, bool final_) {
    const int lane = otid() & 63, gw = obid() * 8 + (otid() >> 6), NGW = gridDim.x * 8;
    const float* g = final_ ? p.norm_final_g : p.norm_ffn_g;
    const float* part = (const float*)(p.ws + (final_ ? OFF_PART10 : OFF_PART6)); const int npart = final_ ? 22 : 8;
    for (int r = gw; r < MT; r += NGW) {
        float* xr = p.out + (size_t)r * 1024;
        f32x4 v[4]; float s = 0.f;
        if (r < NP) {
            const float* xin = p.x_prompt + (size_t)r * 1024; const bf16_t* sc = (const bf16_t*)xr;
            u32x2 mx[4], fx[4];
#pragma unroll
            for (int j = 0; j < 4; ++j) { v[j] = *(const f32x4*)(xin + 4 * lane + 256 * j); mx[j] = *(const u32x2*)(sc + 1024 + 4 * lane + 256 * j); fx[j] = final_ ? *(const u32x2*)(sc + 4 * lane + 256 * j) : (u32x2){0u, 0u}; }
#pragma unroll
            for (int j = 0; j < 4; ++j) { v[j].x += bf_lo(mx[j].x) + bf_lo(fx[j].x); v[j].y += bf_hi(mx[j].x) + bf_hi(fx[j].x); v[j].z += bf_lo(mx[j].y) + bf_lo(fx[j].y); v[j].w += bf_hi(mx[j].y) + bf_hi(fx[j].y); }
        } else {
            const float* base = final_ ? xr : p.x_sample + (size_t)(r - NP) * 1024;
#pragma unroll
            for (int j = 0; j < 4; ++j) v[j] = *(const f32x4*)(base + 4 * lane + 256 * j);
            for (int k = 0; k < npart; ++k) { const float* pr = part + (size_t)k * SROWS + (size_t)(r - NP) * 1024;
#pragma unroll
                for (int j = 0; j < 4; ++j) v[j] += *(const f32x4*)(pr + 4 * lane + 256 * j); }
            if (!final_) {
#pragma unroll
                for (int j = 0; j < 4; ++j) *(f32x4*)(xr + 4 * lane + 256 * j) = v[j]; }
        }
#pragma unroll
        for (int j = 0; j < 4; ++j) s += v[j].x * v[j].x + v[j].y * v[j].y + v[j].z * v[j].z + v[j].w * v[j].w;
        s = wave_sum(s); const float rr = rsqrtf(s * (1.f / 1024.f) + EPS);
        if (final_) {
#pragma unroll
            for (int j = 0; j < 4; ++j) { const f32x4 gv = *(const f32x4*)(g + 4 * lane + 256 * j); *(f32x4*)(xr + 4 * lane + 256 * j) = v[j] * rr * gv; }
        } else { bf16_t* orow = (bf16_t*)(p.ws + OFF_R2) + (size_t)r * 1024;
#pragma unroll
            for (int j = 0; j < 4; ++j) { const f32x4 gv = *(const f32x4*)(g + 4 * lane + 256 * j);
                u32x2 o; o.x = pk2(v[j].x * rr * gv.x, v[j].y * rr * gv.y); o.y = pk2(v[j].z * rr * gv.z, v[j].w * rr * gv.w);
                *(u32x2*)(orow + 4 * lane + 256 * j) = o; } }
    }
}
DEV void conv_phase(const Params& p) {
    const bf16_t* z = (const bf16_t*)(p.ws + OFF_Z); bf16_t* act = (bf16_t*)(p.ws + OFF_ACT);
    const int gtid = obid() * 512 + otid(), NT = gridDim.x * 512;
    for (int idx = gtid; idx < (NP / 8) * 352; idx += NT) {
        const int rb = idx / 352, ch = idx - rb * 352, c = ch * 8, r0 = rb * 8;
        float wa[3][8], wb[3][8], ba[8], bb[8];
#pragma unroll
        for (int j = 0; j < 3; ++j) { const f32x4 a0 = *(const f32x4*)(p.conv_w + j * FF2 + c), a1 = *(const f32x4*)(p.conv_w + j * FF2 + c + 4), b0 = *(const f32x4*)(p.conv_w + j * FF2 + FF + c), b1 = *(const f32x4*)(p.conv_w + j * FF2 + FF + c + 4);
#pragma unroll
            for (int i = 0; i < 4; ++i) { wa[j][i] = a0[i]; wa[j][4 + i] = a1[i]; wb[j][i] = b0[i]; wb[j][4 + i] = b1[i]; } }
        { const f32x4 a0 = *(const f32x4*)(p.conv_b + c), a1 = *(const f32x4*)(p.conv_b + c + 4), b0 = *(const f32x4*)(p.conv_b + FF + c), b1 = *(const f32x4*)(p.conv_b + FF + c + 4);
#pragma unroll
          for (int i = 0; i < 4; ++i) { ba[i] = a0[i]; ba[4 + i] = a1[i]; bb[i] = b0[i]; bb[4 + i] = b1[i]; } }
        u32x4 ra[10], rbq[10];
        const bool first = (r0 & 2047) == 0;
#pragma unroll
        for (int k = 0; k < 10; ++k) { const int rr = r0 - 2 + k;
            if (k < 2 && first) { ra[k] = (u32x4){0u, 0u, 0u, 0u}; rbq[k] = ra[k]; }
            else { ra[k] = *(const u32x4*)(z + (size_t)rr * FF2 + c); rbq[k] = *(const u32x4*)(z + (size_t)rr * FF2 + FF + c); } }
        float xa[3][8], xb[3][8];
        unpack8(ra[0], xa[0]); unpack8(rbq[0], xb[0]); unpack8(ra[1], xa[1]); unpack8(rbq[1], xb[1]);
#pragma unroll
        for (int k = 0; k < 8; ++k) {
            unpack8(ra[k + 2], xa[(k + 2) % 3]); unpack8(rbq[k + 2], xb[(k + 2) % 3]);
            float o[8];
#pragma unroll
            for (int i = 0; i < 8; ++i) {
                const float za = ba[i] + wa[0][i] * xa[k % 3][i] + wa[1][i] * xa[(k + 1) % 3][i] + wa[2][i] * xa[(k + 2) % 3][i];
                const float zb = bb[i] + wb[0][i] * xb[k % 3][i] + wb[1][i] * xb[(k + 1) % 3][i] + wb[2][i] * xb[(k + 2) % 3][i];
                o[i] = gelu_t(za) * zb; }
            u32x4 ov; ov.x = pk2(o[0], o[1]); ov.y = pk2(o[2], o[3]); ov.z = pk2(o[4], o[5]); ov.w = pk2(o[6], o[7]);
            *(u32x4*)(act + (size_t)(r0 + k) * FF + c) = ov; }
    }
    for (int idx = gtid; idx < NS * 352; idx += NT) {
        const int rs = idx / 352, ch = idx - rs * 352, c = ch * 8, r = NP + rs, tpos = rs & 3;
        float za[8], zb[8];
#pragma unroll
        for (int i = 0; i < 8; ++i) { za[i] = p.conv_b[c + i]; zb[i] = p.conv_b[FF + c + i]; }
#pragma unroll
        for (int j = 0; j < 3; ++j) {
            const int tp = tpos - 2 + j;
            float xa[8], xb[8];
            if (tp >= 0) { unpack8(*(const u32x4*)(z + (size_t)(r - 2 + j) * FF2 + c), xa); unpack8(*(const u32x4*)(z + (size_t)(r - 2 + j) * FF2 + FF + c), xb); }
            else { const float* sp = p.state_conv + ((size_t)(rs >> 2) * 2 + (tp + 2)) * FF2;
#pragma unroll
                for (int i = 0; i < 8; ++i) { xa[i] = sp[c + i]; xb[i] = sp[FF + c + i]; } }
#pragma unroll
            for (int i = 0; i < 8; ++i) { za[i] += p.conv_w[j * FF2 + c + i] * xa[i]; zb[i] += p.conv_w[j * FF2 + FF + c + i] * xb[i]; }
        }
        u32x4 o; o.x = pk2(gelu_t(za[0]) * zb[0], gelu_t(za[1]) * zb[1]); o.y = pk2(gelu_t(za[2]) * zb[2], gelu_t(za[3]) * zb[3]);
        o.z = pk2(gelu_t(za[4]) * zb[4], gelu_t(za[5]) * zb[5]); o.w = pk2(gelu_t(za[6]) * zb[6], gelu_t(za[7]) * zb[7]);
        *(u32x4*)(act + (size_t)r * FF + c) = o;
    }
}

#define XB_TMO      128
#define XB_XCNT(j)  (256  + 64 * (j))
#define XB_XSUB(j)  (1280 + 64 * (j))
#define XB_XGEN(j)  (2304 + 64 * (j))
#define XB_TOP      3328
#define XB_TOPGEN   3392
#define XCD_BAR_WORDS 3456
#define XB_SPIN_CAP (1u << 18)
DEV unsigned xb_ld(unsigned* p)              { return __hip_atomic_load(p, __ATOMIC_RELAXED, __HIP_MEMORY_SCOPE_AGENT); }
DEV unsigned xb_add(unsigned* p, unsigned v) { return __hip_atomic_fetch_add(p, v, __ATOMIC_RELAXED, __HIP_MEMORY_SCOPE_AGENT); }
DEV unsigned xb_xcc_id() { return (unsigned)__builtin_amdgcn_s_getreg((3 << 11) | 20) & 0xFu; }
#define XB_SPIN(cond, bar) do { unsigned _sp = 0; while (cond) { __builtin_amdgcn_s_sleep(1); \
    if ((++_sp & 255u) == 0u) { if (xb_ld(&(bar)[XB_TMO])) break; if (_sp > XB_SPIN_CAP) { atomicAdd(&(bar)[XB_TMO], 1u); break; } } } } while (0)
struct XcdBarrier { unsigned* bar; unsigned x; volatile LAS unsigned* st; };
DEV XcdBarrier xcd_barrier_post(unsigned* bar, volatile LAS unsigned* st) {
    XcdBarrier b; b.bar = bar; b.x = xb_xcc_id(); b.st = st;
    if (threadIdx.x == 0) (void)xb_add(&bar[XB_XCNT(b.x)], 1u);
    return b; }
DEV void xcd_barrier_complete(unsigned* bar, unsigned x, unsigned& nloc, unsigned& nx) {
    const unsigned G = gridDim.x * gridDim.y * gridDim.z;
    unsigned sum, cnt, mine, sp = 0u;
    for (;;) {
        sum = 0u; cnt = 0u; mine = 0u;
#pragma unroll
        for (unsigned j = 0; j < 16; ++j) { const unsigned c = xb_ld(&bar[XB_XCNT(j)]); sum += c; cnt += (c > 0u) ? 1u : 0u; mine = (j == x) ? c : mine; }
        if (sum == G) break;
        __builtin_amdgcn_s_sleep(1);
        if ((++sp & 255u) == 0u) { if (xb_ld(&bar[XB_TMO])) break; if (sp > XB_SPIN_CAP) { atomicAdd(&bar[XB_TMO], 1u); break; } }
    }
    nloc = mine > 0u ? mine : 1u; nx = cnt > 0u ? cnt : 1u; }
DEV void xcd_barrier(unsigned* bar_, volatile LAS unsigned* st_) {
    XcdBarrier b; b.bar = bar_; b.x = xb_xcc_id(); b.st = st_;
    asm volatile("s_waitcnt vmcnt(0)" ::: "memory");
    __syncthreads();
    if (threadIdx.x == 0) {
        unsigned* bar = b.bar;
        __builtin_amdgcn_s_waitcnt(0);
        unsigned nloc = b.st[0], nx = b.st[1];
        if (nloc == 0u) { xcd_barrier_complete(bar, b.x, nloc, nx); b.st[0] = nloc; b.st[1] = nx; }
        const unsigned old = xb_add(&bar[XB_XSUB(b.x)], 1u);
        const unsigned gen = old / nloc;
        if (old + 1u == (gen + 1u) * nloc) {
            __builtin_amdgcn_fence(__ATOMIC_RELEASE, "agent");
            asm volatile("s_waitcnt vmcnt(0)" ::: "memory");
            const unsigned og = xb_add(&bar[XB_TOP], 1u);
            const unsigned tg = og / nx;
            if (og + 1u == (tg + 1u) * nx) xb_add(&bar[XB_TOPGEN], 1u);
            else XB_SPIN(xb_ld(&bar[XB_TOPGEN]) == tg, bar);
            __builtin_amdgcn_fence(__ATOMIC_ACQUIRE, "agent");
            xb_add(&bar[XB_XGEN(b.x)], 1u);
            asm volatile("s_waitcnt vmcnt(0)" ::: "memory");
        } else {
            XB_SPIN(xb_ld(&bar[XB_XGEN(b.x)]) == gen, bar);
            __builtin_amdgcn_fence(__ATOMIC_ACQUIRE, "agent");
            asm volatile("s_waitcnt vmcnt(0)" ::: "memory");
        }
    }
    __syncthreads();
}

DEV Params kp_load() { Params r{};
#if defined(__HIP_DEVICE_COMPILE__)
    typedef const unsigned long long __attribute__((address_space(4))) KA;
    KA* q = (KA*)__builtin_amdgcn_kernarg_segment_ptr(); asm volatile("" : "+s"(q));
    unsigned long long t[28];
#pragma unroll
    for (int i = 0; i < 28; ++i) t[i] = q[i];
    __builtin_memcpy(&r, t, sizeof(Params));
#endif
    return r; }
__global__ __launch_bounds__(512, 2) void mega(Params p_arg, int ph0, int ph1) {
    extern __shared__ __attribute__((aligned(16))) unsigned char shm[];
    LAS unsigned char* lds = (LAS unsigned char*)shm;
    cg::grid_group grid = cg::this_grid();
#ifndef TIME_SEL
#define TIME_SEL 0
#endif
    unsigned long long tacc = 0;
    const int G = gridDim.x, c = obid();
    volatile LAS unsigned* xst = (volatile LAS unsigned*)(lds + LDS_BYTES - 16);
    if (threadIdx.x == 0) { xst[0] = 0u; xst[1] = 0u; }
    __syncthreads();
    (void)xcd_barrier_post((unsigned*)(kp_load().ws + OFF_BAR), xst);
    if (ph1 - ph0 > 1) grid.sync();
#ifndef DUP_PH
#define DUP_PH -1
#endif
#ifndef PH_TIME_MASK
#define PH_TIME_MASK 0
#endif
#define PH_BEGIN(k) if (ph0 <= (k) && (k) < ph1) { const unsigned long long tph_ = ((PH_TIME_MASK) >> (k)) & 1 ? __builtin_amdgcn_s_memrealtime() : 0ull; if (PHON(k)) { for (int rep_ = 0; rep_ < ((k) == DUP_PH ? 2 : 1); ++rep_) { const Params p = kp_load(); unsigned char* ws = p.ws;
#define PH_END(k) } } if ((k) + 1 < ph1) { if (false) grid.sync(); else xcd_barrier((unsigned*)(kp_load().ws + OFF_BAR), (volatile LAS unsigned*)(lds + LDS_BYTES - 16)); } if (((PH_TIME_MASK) >> (k)) & 1) tacc += __builtin_amdgcn_s_memrealtime() - tph_; }
    PH_BEGIN(0) phase_prep(p, lds); PH_END(0)
    PH_BEGIN(1)
            Sched1 S{G, c, (const char*)(ws + OFF_R2), (const char*)(ws + OFF_HM), (const char*)(ws + OFF_BTIN), (const char*)(ws + OFF_BTKV)};
            Epi1 E{(bf16_t*)(ws + OFF_P), (bf16_t*)(ws + OFF_MKB), p.out, (const float*)(ws + OFF_ROPEC), (const float*)(ws + OFF_ROPES), p.b_gate};
            pg8::gemm_phase(lds, 1024, 1024, S, E);
    PH_END(1)
    PH_BEGIN(2)
            for (int it = c; it < 1536; it += G) {
                if (it < 512) ret_A_item(p, lds, it);
                else if (it < 1024) xattn_item(p, lds, it - 512);
                else sgu_item(p, lds, it - 1024);
            }
            {
                const int tid2 = otid(), w2 = __builtin_amdgcn_readfirstlane(tid2 >> 6), lane2 = tid2 & 63;
                if (w2 < 2) ret_s_wave(p, c + 256 * w2, lane2);
                else if (w2 < 4) xattn_s_wave(p, (LAS float*)(lds + 4096 * w2), c + 256 * (w2 - 2), lane2);
                else if (w2 == 4 && c < 128) sgu_s_wave(p, c, lane2);
            }
    PH_END(2)
    PH_BEGIN(3)
            scan_phase(p);
            SchedMgS S{c, (const char*)(ws + OFF_P), (const char*)(ws + OFF_BTMG)};
            EpiMgS E{(const bf16_t*)(ws + OFF_P), (float*)(ws + OFF_MG32)};
            pg8::gemm_phase(lds, INC, 2048, S, E);
    PH_END(3)
    PH_BEGIN(4) for (int it = c; it < 512; it += G) ret_C_item(p, lds, it); PH_END(4)
    PH_BEGIN(5)
            {
                const int i = obid() * 512 + otid();
                if (i < 131072) { f32x4 m = ((const f32x4*)(ws + OFF_MG32))[i];
#pragma unroll
                    for (int k = 1; k < 8; ++k) m += ((const f32x4*)(ws + OFF_MG32))[(size_t)k * 131072 + i];
                    u32x2 o; o.x = pk2(m.x, m.y); o.y = pk2(m.z, m.w);
                    ((u32x2*)((bf16_t*)(ws + OFF_R2) + (size_t)NP * 1024))[i] = o; } }
            SchedMg S{G, c, (const char*)(ws + OFF_P), (const char*)(ws + OFF_BTMG)};
            EpiMg E{(const bf16_t*)(ws + OFF_P), (bf16_t*)(ws + OFF_R2)};
            pg8::gemm_phase(lds, INC, 2048, S, E);
    PH_END(5)
    PH_BEGIN(6)
            SchedPS<16, 64, 8, 524288, 524288> S{G, c, (const char*)(ws + OFF_R2), (const char*)(ws + OFF_BTO)};
            EpiWo E{p.x_prompt, p.x_sample, p.out, (float*)(ws + OFF_PART6)};
            pg8::gemm_phase(lds, 1024, 1024, S, E);
    PH_END(6)
    PH_BEGIN(7) rms_phase(p, false); PH_END(7)
    PH_BEGIN(8)
            SchedPlain S{G, c, 66, 22, 16, (const char*)(ws + OFF_R2), (const char*)(ws + OFF_BTUP), (size_t)524288, (size_t)524288};
            EpiUp E{(bf16_t*)(ws + OFF_Z), p.out};
            pg8::gemm_phase(lds, 1024, 1024, S, E);
    PH_END(8)
    PH_BEGIN(9) conv_phase(p); PH_END(9)
    PH_BEGIN(10)
            SchedPS<44, 176, 22, 256 * FF * 2, 256 * FF * 2> S{G, c, (const char*)(ws + OFF_ACT), (const char*)(ws + OFF_BTDN)};
            EpiDn E{p.out, (float*)(ws + OFF_PART10)};
            pg8::gemm_phase(lds, FF, FF, S, E);
    PH_END(10)
    PH_BEGIN(11) rms_phase(p, true); PH_END(11)
    if (((TIME_SEL) || (PH_TIME_MASK)) && blockIdx.x == 0 && ph1 > 1) { const unsigned long long t0_ = __builtin_amdgcn_s_memrealtime(); while (__builtin_amdgcn_s_memrealtime() - t0_ < tacc) __builtin_amdgcn_s_sleep(8); }
}

extern "C" void kernel_launch(void* const* d_in, const int* in_sizes, int n_in, void* d_out, int out_size, void* d_ws, size_t ws_size, hipStream_t stream) {
    static int grid = 0;
    if (grid == 0) {
        if (n_in != 26 || out_size != 39018496 || ws_size < WS_END2) { fprintf(stderr, "kernel_launch: unexpected shapes n_in %d out %d ws %zu (need %zu)\n", n_in, out_size, ws_size, (size_t)WS_END2); grid = -1; return; }
        int dev = 0, cus = 0, per_cu = 0;
        hipGetDevice(&dev); hipDeviceGetAttribute(&cus, hipDeviceAttributeMultiprocessorCount, dev);
        if (hipFuncSetAttribute((const void*)mega, hipFuncAttributeMaxDynamicSharedMemorySize, LDS_BYTES) != hipSuccess) { fprintf(stderr, "kernel_launch: hipFuncSetAttribute failed\n"); grid = -1; return; }
        if (hipOccupancyMaxActiveBlocksPerMultiprocessor(&per_cu, (const void*)mega, 512, LDS_BYTES) != hipSuccess || per_cu < 1) { fprintf(stderr, "kernel_launch: occupancy query gave %d\n", per_cu); grid = -1; return; }
        if (cus != 256) { fprintf(stderr, "kernel_launch: built for 256 CUs, got %d\n", cus); grid = -1; return; }
        grid = cus;
    }
    if (grid < 0) return;
    Params p{};
    const float** f = (const float**)&p;
    for (int i = 0; i < 26; ++i) f[i] = (const float*)d_in[i];
    p.out = (float*)d_out; p.ws = (unsigned char*)d_ws;
#ifndef DBG_NPH
#define DBG_NPH 12
#endif
#ifndef MK_MULTI
#define MK_MULTI 0
#endif
#if MK_MULTI
#ifndef PH_SEQ
#define PH_SEQ 0,1,2,3,4,5,6,7,8,9,10,11
#endif
    { const int seq[] = {PH_SEQ}; for (int ph : seq) hipLaunchKernelGGL(mega, dim3(grid), dim3(512), LDS_BYTES, stream, p, ph, ph + 1); }
    hipError_t e = hipSuccess;
#else
    (void)hipMemsetAsync((unsigned char*)d_ws + OFF_BAR, 0, 16384, stream);
    int ph0 = 0, ph1 = NPHASE;
    void* args[] = {&p, &ph0, &ph1};
    hipError_t e = hipLaunchCooperativeKernel((const void*)mega, dim3(grid), dim3(512), args, LDS_BYTES, stream);
#endif
    if (e != hipSuccess) fprintf(stderr, "cooperative launch failed: %s (grid %d)\n", hipGetErrorString(e), grid);
}
```

```cpp
#include <hip/hip_runtime.h>
#include <hip/hip_cooperative_groups.h>
#include <cstdio>
#include <cstdint>
namespace cg = cooperative_groups;

#define LAS __attribute__((address_space(3)))
#define DEV __device__ __forceinline__
typedef unsigned short bf16_t;
typedef short bf16x8 __attribute__((ext_vector_type(8)));
typedef short s16x4 __attribute__((ext_vector_type(4)));
typedef float f32x4 __attribute__((ext_vector_type(4)));
typedef unsigned u32x4 __attribute__((ext_vector_type(4)));
typedef unsigned u32x2 __attribute__((ext_vector_type(2)));

constexpr int NP = 16384, NS = 512, MT = 16896, INC = 7680, FF = 2816, FF2 = 5632;
constexpr int C_Q = 0, C_K = 512, C_V = 1024, C_G = 2048, C_SU = 3072, C_XQ = 3584, C_SV = 4096, C_GT = 4608;
constexpr float EPS = 1e-6f;
constexpr size_t OFF_BTIN = 0;
constexpr size_t OFF_BTKV = OFF_BTIN + 15728640;
constexpr size_t OFF_BTMG = OFF_BTKV + 2097152;
constexpr size_t OFF_BTO = OFF_BTMG + 4194304;
constexpr size_t OFF_BTUP = OFF_BTO + 2097152;
constexpr size_t OFF_BTDN = OFF_BTUP + 11534336;
constexpr size_t OFF_ROPEC = OFF_BTDN + 5767168;
constexpr size_t OFF_ROPES = OFF_ROPEC + 525312;
constexpr size_t OFF_WTRIL = OFF_ROPES + 525312;
constexpr size_t OFF_HM = OFF_WTRIL + 131072;
constexpr size_t OFF_MKB = OFF_HM + 4194304;
constexpr size_t OFF_P = OFF_MKB + 4194304;
constexpr size_t OFF_R2 = OFF_P + 259522560;
constexpr size_t OFF_MG32 = OFF_R2 + 34603008;
constexpr size_t WS_END = OFF_MG32 + 8 * 2097152;
constexpr size_t OFF_BAR = WS_END;
constexpr size_t WS_END2 = OFF_BAR + 16384;
constexpr size_t OFF_PART6 = OFF_P, OFF_PART10 = OFF_P;
constexpr int SROWS = 512 * 1024;
constexpr size_t OFF_Z = OFF_P;
constexpr size_t OFF_ACT = OFF_P + 190316544;
constexpr size_t O_Y = 0, O_RETP = 17301504, O_CONVP = 18350080, O_MK = 18440192, O_MV = 19488768, O_RETS = 20537344, O_CONVS = 37314560, O_SGV = 38756352;
constexpr int LDS_BYTES = 147456;
constexpr int NPHASE = 12;
#ifndef DBG_XA
#define DBG_XA 3
#endif
#ifndef ONLY_PH
#define ONLY_PH -1
#endif
#ifndef SKIP_PH
#define SKIP_PH -2
#endif
#define PHON(n) ((ONLY_PH < 0 || ONLY_PH == (n)) && SKIP_PH != (n))

struct Params {
    const float *x_prompt, *x_sample, *mem_prompt, *state_ret, *state_conv, *cache_k, *cache_v, *norm_mix_g, *w_in, *b_gate, *ret_gn_g, *sg_ln_g, *sg_ws, *sg_bs,
        *mem_norm_g, *w_mem_kv, *w_br_ret, *w_br_sg, *w_br_x, *w_o, *norm_ffn_g, *w_up, *conv_w, *conv_b, *w_down, *norm_final_g;
    float* out; unsigned char* ws;
};

typedef __bf16 bf16v2_t __attribute__((ext_vector_type(2)));
typedef float f32x2_t __attribute__((ext_vector_type(2)));
DEV unsigned pk2(float lo, float hi) { const f32x2_t f = {lo, hi}; const bf16v2_t v = __builtin_convertvector(f, bf16v2_t); return __builtin_bit_cast(unsigned, v); }
DEV bf16_t f2bf(float v) { return (bf16_t)(pk2(v, 0.f) & 0xffffu); }
DEV float bf_lo(unsigned u) { return __uint_as_float(u << 16); }
DEV float bf_hi(unsigned u) { return __uint_as_float(u & 0xffff0000u); }
DEV float bf2f(bf16_t b) { return __uint_as_float(((unsigned)b) << 16); }
DEV void unpack8(const u32x4 a, float (&x)[8]) { x[0] = bf_lo(a.x); x[1] = bf_hi(a.x); x[2] = bf_lo(a.y); x[3] = bf_hi(a.y); x[4] = bf_lo(a.z); x[5] = bf_hi(a.z); x[6] = bf_lo(a.w); x[7] = bf_hi(a.w); }
template <int CTRL> DEV float dpp_f(float v) { return __int_as_float(__builtin_amdgcn_update_dpp(0, __float_as_int(v), CTRL, 0xF, 0xF, true)); }
DEV float rdl(float v, int l) { return __int_as_float(__builtin_amdgcn_readlane(__float_as_int(v), l)); }
DEV float g16_sum(float v) { v += dpp_f<0xB1>(v); v += dpp_f<0x4E>(v); v += dpp_f<0x141>(v); v += dpp_f<0x140>(v); return v; }
DEV float g16_max(float v) { v = fmaxf(v, dpp_f<0xB1>(v)); v = fmaxf(v, dpp_f<0x4E>(v)); v = fmaxf(v, dpp_f<0x141>(v)); v = fmaxf(v, dpp_f<0x140>(v)); return v; }
DEV float wave_sum(float v) { v = g16_sum(v); return (rdl(v, 0) + rdl(v, 16)) + (rdl(v, 32) + rdl(v, 48)); }
DEV float wave_max(float v) { v = g16_max(v); return fmaxf(fmaxf(rdl(v, 0), rdl(v, 16)), fmaxf(rdl(v, 32), rdl(v, 48))); }
DEV float sigm_f(float x) { return __builtin_amdgcn_rcpf(1.f + __builtin_amdgcn_exp2f(-1.4426950408889634f * x)); }
DEV float silu_f(float x) { return x * sigm_f(x); }
DEV float gelu_t(float x) { const float u = x * (2.3022081646f + 0.1029432406f * x * x); return x * __builtin_amdgcn_rcpf(1.f + __builtin_amdgcn_exp2f(-u)); }
DEV float log_gamma(int h) { return log1pf(-exp2f(-5.f - (float)h)); }
DEV int otid() { int t = threadIdx.x; asm volatile("" : "+v"(t)); return t; }
DEV int obid() { int t = blockIdx.x; asm volatile("" : "+s"(t)); return t; }
DEV unsigned ldsaddr(LAS const void* p) { return (unsigned)(uintptr_t)p; }
DEV f32x4 mfma16(bf16x8 a, bf16x8 b, f32x4 c) { return __builtin_amdgcn_mfma_f32_16x16x32_bf16(a, b, c, 0, 0, 0); }
DEV bf16x8 lds_frag(LAS const unsigned char* base, int pitch, int row0, int k0, int lane) {
    return *(LAS const bf16x8*)(base + (row0 + (lane & 15)) * pitch + (k0 + 8 * (lane >> 4)) * 2); }
DEV LAS const unsigned char* tr_lane_base(LAS const unsigned char* base, int pitch, int lane) { const int g = lane >> 4, q = (lane & 15) >> 2, pp = lane & 3; return base + ((8 * g + q) * pitch + 8 * pp); }
template <int PITCH, int KB, int X0> DEV void tr_read4(LAS const unsigned char* a, bf16x8 (&f)[4]) {
    constexpr int o0 = KB * PITCH + X0 * 2;
    static_assert(o0 + 100 * PITCH < 65536, "ds offset field");
#pragma unroll
    for (int ks = 0; ks < 4; ++ks) {
        const s16x4 lo = __builtin_amdgcn_ds_read_tr16_b64_v4i16((LAS s16x4*)(a + o0 + ks * 32 * PITCH));
        const s16x4 hi = __builtin_amdgcn_ds_read_tr16_b64_v4i16((LAS s16x4*)(a + o0 + ks * 32 * PITCH + 4 * PITCH));
        f[ks] = (bf16x8){lo[0], lo[1], lo[2], lo[3], hi[0], hi[1], hi[2], hi[3]}; } }
template <int V> struct IC { static constexpr int value = V; };
template <int I, int N, class F> DEV void static_for(F&& f) { if constexpr (I < N) { f(IC<I>{}); static_for<I + 1, N>(f); } }
#define SCHEDB __builtin_amdgcn_sched_barrier(0)

namespace pg8 {
constexpr int BM = 256, BK = 64, HALF = 128, HTB = HALF * BK * 2, NXCD = 8, WGM = 8;
DEV int lds_byte(int r, int c) { const int st = (r >> 4) * 2 + (c >> 5), rr = r & 15, cc = c & 31, ob = rr * 64 + cc * 2; return st * 1024 + (ob ^ (((ob >> 9) & 1) << 5)); }
DEV void stage_rc(int b, int& R, int& C) { const int st = b / 1024, sb = b % 1024, swz = sb ^ (((sb >> 9) & 1) << 5); R = (st >> 1) * 16 + swz / 64; C = (st & 1) * 32 + (swz % 64) / 2; }
DEV int perm32(int rho) { const int n = rho >> 4, i = rho & 15; return 8 * (i >> 2) + 4 * n + (i & 3); }
struct Unit { int pm, pn, kind, nt; const char* A; const char* B; };
DEV void tile_map(int L, int nM, int nN, int& pm, int& pn) {
    const int nwg = nM * nN; int wgid = L; { const int q = nwg / NXCD, r = nwg % NXCD, xcd = wgid % NXCD, off = wgid / NXCD; wgid = (xcd < r ? xcd * (q + 1) : r * (q + 1) + (xcd - r) * q) + off; }
    const int nig = WGM * nN, gid = wgid / nig, fm = gid * WGM, gsz = (nM - fm) < WGM ? (nM - fm) : WGM;
    pm = fm + ((wgid % nig) % gsz); pn = (wgid % nig) / gsz; }

template <class Epi, class Sched>
DEV void gemm_phase(LAS unsigned char* lds, int lda, int ldb, const Sched& S, const Epi& E) {
    const int tid = otid(), wid = __builtin_amdgcn_readfirstlane(tid >> 6), lane = tid & 63, wr = wid >> 2, wc = wid & 3, fr = lane & 15, fq = lane >> 4;
    unsigned voffA[2], voffB[2];
#pragma unroll
    for (int i = 0; i < 2; ++i) { int R, C; stage_rc(tid * 16 + i * 8192, R, C); const int Rb = (R & ~31) + perm32(R & 31);
        voffA[i] = (unsigned)(R * lda + C) * 2u; voffB[i] = (unsigned)(Rb * ldb + C) * 2u; }
    const size_t kstep = (size_t)(BK * 2);
    const size_t hstepA = (size_t)HALF * lda * 2, hstepB = (size_t)HALF * ldb * 2;
    const unsigned ldsw = (unsigned)wid * 1024u;
    const int aoff = lds_byte(wr * 64 + fr, fq * 8), boff = lds_byte(wc * 32 + fr, fq * 8);
#define PG8_SA(b, h) (((b) * 2 + (h)) * HTB)
#define PG8_SB(b, h) ((4 + (b) * 2 + (h)) * HTB)
#define PG8_STAGE(bufoff, gbase, voff) do { _Pragma("unroll") for (int _i = 0; _i < 2; ++_i) \
        __builtin_amdgcn_global_load_lds((const unsigned*)((const char*)(gbase) + (voff)[_i]), (LAS unsigned*)(lds + (bufoff) + ldsw + _i * 8192), 16, 0, 0); } while (0)
#define PG8_LDA(dst, b, h) do { _Pragma("unroll") for (int m = 0; m < 4; ++m) _Pragma("unroll") for (int k = 0; k < 2; ++k) dst[m][k] = *(const LAS bf16x8*)(lds + PG8_SA(b, h) + aoff + m * 2048 + k * 1024); } while (0)
#define PG8_LDB(dst, b, h) do { _Pragma("unroll") for (int n = 0; n < 2; ++n) _Pragma("unroll") for (int k = 0; k < 2; ++k) dst[n][k] = *(const LAS bf16x8*)(lds + PG8_SB(b, h) + boff + n * 2048 + k * 1024); } while (0)
#define PG8_MMA(ai, bj, At, Bt) do { __builtin_amdgcn_s_setprio(1); _Pragma("unroll") for (int m = 0; m < 4; ++m) _Pragma("unroll") for (int n = 0; n < 2; ++n) _Pragma("unroll") for (int k = 0; k < 2; ++k) \
        acc[ai][bj][m][n] = __builtin_amdgcn_mfma_f32_16x16x32_bf16(Bt[n][k], At[m][k], acc[ai][bj][m][n], 0, 0, 0); __builtin_amdgcn_s_setprio(0); } while (0)
#define PG8_WAIT_V(n) asm volatile("s_waitcnt vmcnt(" #n ")" ::: "memory")
#define PG8_WAIT_L(n) asm volatile("s_waitcnt lgkmcnt(" #n ")" ::: "memory")
#define PG8_BAR __builtin_amdgcn_s_barrier()
#define PG8_SCHED __builtin_amdgcn_sched_barrier(0)
    Unit cur, nxt; int ui = 0;
    if (!S.next(0, cur)) return;
    f32x4 acc[2][2][4][2];
#pragma unroll
    for (int a = 0; a < 2; ++a)
#pragma unroll
        for (int b = 0; b < 2; ++b)
#pragma unroll
            for (int m = 0; m < 4; ++m)
#pragma unroll
                for (int n = 0; n < 2; ++n) acc[a][b][m][n] = (f32x4){0.f, 0.f, 0.f, 0.f};
    bf16x8 At[4][2], B0[2][2], B1[2][2];
    const char* cA = cur.A; const char* cB = cur.B;
    PG8_STAGE(PG8_SB(0, 0), cB, voffB); PG8_STAGE(PG8_SA(0, 0), cA, voffA); PG8_STAGE(PG8_SB(0, 1), cB + hstepB, voffB); PG8_STAGE(PG8_SA(0, 1), cA + hstepA, voffA);
    if (wr == 1) PG8_BAR;
    PG8_WAIT_V(4); PG8_BAR;
    PG8_STAGE(PG8_SB(1, 0), cB + kstep, voffB); PG8_STAGE(PG8_SA(1, 0), cA + kstep, voffA); PG8_STAGE(PG8_SB(1, 1), cB + hstepB + kstep, voffB);
    PG8_WAIT_V(6); PG8_BAR;
    for (;;) {
        const bool has_next = S.next(ui + 1, nxt);
        const char* nA = has_next ? nxt.A : cA; const char* nB = has_next ? nxt.B : cB;
        const int nt = cur.nt;
        for (int t = 0; t < nt; t += 2) {
            const bool last = (t == nt - 2);
            const char* a1 = cA + (size_t)(t + 1) * kstep;
            const char* a2 = last ? nA : cA + (size_t)(t + 2) * kstep; const char* b2 = last ? nB : cB + (size_t)(t + 2) * kstep;
            const char* a3 = a2 + kstep; const char* b3 = b2 + kstep;
            PG8_LDB(B0, 0, 0); PG8_SCHED; PG8_LDA(At, 0, 0); PG8_STAGE(PG8_SA(1, 1), a1 + hstepA, voffA);
            PG8_WAIT_L(8); PG8_BAR; PG8_WAIT_L(0); PG8_MMA(0, 0, At, B0); PG8_BAR; PG8_SCHED;
            PG8_LDB(B1, 0, 1); PG8_STAGE(PG8_SB(0, 0), b2, voffB);
            PG8_BAR; PG8_WAIT_L(0); PG8_MMA(0, 1, At, B1); PG8_BAR;
            PG8_LDA(At, 0, 1); PG8_STAGE(PG8_SA(0, 0), a2, voffA);
            PG8_BAR; PG8_WAIT_L(0); PG8_MMA(1, 0, At, B0); PG8_BAR; PG8_SCHED;
            PG8_STAGE(PG8_SB(0, 1), b2 + hstepB, voffB);
            PG8_WAIT_V(6); PG8_BAR; PG8_MMA(1, 1, At, B1); PG8_BAR;
            PG8_LDB(B0, 1, 0); PG8_SCHED; PG8_LDA(At, 1, 0); PG8_STAGE(PG8_SA(0, 1), a2 + hstepA, voffA);
            PG8_WAIT_L(8); PG8_BAR; PG8_WAIT_L(0); PG8_MMA(0, 0, At, B0); PG8_BAR; PG8_SCHED;
            PG8_LDB(B1, 1, 1); PG8_STAGE(PG8_SB(1, 0), b3, voffB);
            PG8_BAR; PG8_WAIT_L(0); PG8_MMA(0, 1, At, B1); PG8_BAR;
            PG8_LDA(At, 1, 1); PG8_STAGE(PG8_SA(1, 0), a3, voffA);
            PG8_BAR; PG8_WAIT_L(0); PG8_MMA(1, 0, At, B0); PG8_BAR; PG8_SCHED;
            PG8_STAGE(PG8_SB(1, 1), b3 + hstepB, voffB);
            PG8_WAIT_V(6); PG8_BAR; PG8_MMA(1, 1, At, B1); PG8_BAR;
        }
        const bool keep = E(acc, cur, wr, wc, fr, fq);
        if (!has_next) break;
        if (!keep)
#pragma unroll
        for (int a = 0; a < 2; ++a)
#pragma unroll
            for (int b = 0; b < 2; ++b)
#pragma unroll
                for (int m = 0; m < 4; ++m)
#pragma unroll
                    for (int n = 0; n < 2; ++n) acc[a][b][m][n] = (f32x4){0.f, 0.f, 0.f, 0.f};
        cur = nxt; cA = nA; cB = nB; ++ui;
    }
    PG8_WAIT_V(0);
    if (wr == 0) PG8_BAR;
    PG8_BAR;
#undef PG8_SA
#undef PG8_SB
#undef PG8_STAGE
#undef PG8_LDA
#undef PG8_LDB
#undef PG8_MMA
#undef PG8_WAIT_V
#undef PG8_WAIT_L
#undef PG8_BAR
#undef PG8_SCHED
}
#define EPI_LOOP_BEGIN \
    _Pragma("unroll") for (int ai = 0; ai < 2; ++ai) _Pragma("unroll") for (int m = 0; m < 4; ++m) { const int row = u.pm * 256 + ai * 128 + wr * 64 + m * 16 + fr; \
    _Pragma("unroll") for (int bj = 0; bj < 2; ++bj) { const int col0 = u.pn * 256 + bj * 128 + wc * 32 + fq * 8; const f32x4 v0 = acc[ai][bj][m][0], v1 = acc[ai][bj][m][1];
#define EPI_LOOP_END } }
#define EPI_AI_BEGIN _Pragma("unroll") for (int ai = 0; ai < 2; ++ai) {
#define EPI_AI_END }
#define EPI_G_BEGIN _Pragma("unroll") for (int m = 0; m < 4; ++m) { const int row = u.pm * 256 + ai * 128 + wr * 64 + m * 16 + fr; \
    _Pragma("unroll") for (int bj = 0; bj < 2; ++bj) { const int col0 = u.pn * 256 + bj * 128 + wc * 32 + fq * 8; const int gi = m * 2 + bj; (void)gi; (void)row; (void)col0;
#define EPI_G_END } }
}
using pg8::Unit;
typedef f32x4 AccT[2][2][4][2];

struct Sched1 { int G, c; const char *h, *hm, *btin, *btkv;
    DEV bool next(int i, Unit& u) const {
        long L = (long)i * G + c;
        if (L < 1980) { pg8::tile_map((int)L, 66, 30, u.pm, u.pn); u.kind = 0; u.nt = 16; u.A = h + (size_t)u.pm * 524288; u.B = btin + (size_t)u.pn * 524288; return true; }
        L -= 1980; if (L < 32) { u.pm = (int)(L & 7); u.pn = (int)(L >> 3); u.kind = 1; u.nt = 16; u.A = hm + (size_t)u.pm * 524288; u.B = btkv + (size_t)u.pn * 524288; return true; }
        return false; } };
struct Epi1 { bf16_t* P; bf16_t* mkb; float* out; const float *ropeC, *ropeS, *b_gate;
    DEV bool operator()(AccT& acc, const Unit& u, int wr, int wc, int fr, int fq) const {
        if (u.kind == 1) {
            EPI_LOOP_BEGIN
                float* o = (col0 < 512) ? out + O_MK + (size_t)row * 512 + col0 : out + O_MV + (size_t)row * 512 + (col0 - 512);
                *(f32x4*)o = v0; *(f32x4*)(o + 4) = v1;
                u32x4 pk; pk.x = pk2(v0.x, v0.y); pk.y = pk2(v0.z, v0.w); pk.z = pk2(v1.x, v1.y); pk.w = pk2(v1.z, v1.w);
                *(u32x4*)(mkb + (size_t)row * 1024 + col0) = pk;
            EPI_LOOP_END
            return false; }
        const int pn = u.pn;
        if (pn < 4) {
            const float sc = (pn >= 2) ? 0.08838834764831845f : 1.f;
            EPI_AI_BEGIN
                f32x4 cs[8], sn[8];
                EPI_G_BEGIN
                    const int pidx = row < NP ? (row & 2047) : 2048 + ((row - NP) & 3); const int uu = (col0 & 127) >> 3;
                    cs[gi] = *(const f32x4*)(ropeC + pidx * 64 + 4 * uu); sn[gi] = *(const f32x4*)(ropeS + pidx * 64 + 4 * uu);
                EPI_G_END
                EPI_G_BEGIN
                    const f32x4 v0 = acc[ai][bj][m][0], v1 = acc[ai][bj][m][1];
                    const int uu = (col0 & 127) >> 3, hb = col0 & ~127;
                    const f32x4 o1 = (v0 * cs[gi] - v1 * sn[gi]) * sc, o2 = (v0 * sn[gi] + v1 * cs[gi]) * sc;
                    u32x2 a; a.x = pk2(o1.x, o1.y); a.y = pk2(o1.z, o1.w); u32x2 b; b.x = pk2(o2.x, o2.y); b.y = pk2(o2.z, o2.w);
                    *(u32x2*)(P + (size_t)row * INC + hb + 4 * uu) = a; *(u32x2*)(P + (size_t)row * INC + hb + 64 + 4 * uu) = b;
                EPI_G_END
            EPI_AI_END
            return false; }
        const int mode = pn < 8 ? 0 : pn < 12 ? 1 : pn < 14 ? 2 : pn < 16 ? 0 : pn < 18 ? 2 : 3;
        f32x4 bg[2][2];
#pragma unroll
        for (int bj = 0; bj < 2; ++bj) { const int cg = (mode == 3) ? u.pn * 256 + bj * 128 + wc * 32 + fq * 8 - C_GT : 0; bg[bj][0] = *(const f32x4*)(b_gate + cg); bg[bj][1] = *(const f32x4*)(b_gate + cg + 4); }
        EPI_LOOP_BEGIN
            f32x4 a = v0, b = v1;
            if (mode == 1) { for (int i = 0; i < 4; ++i) { a[i] = silu_f(a[i]); b[i] = silu_f(b[i]); } }
            else if (mode == 2) { for (int i = 0; i < 4; ++i) { a[i] = gelu_t(a[i]); b[i] = gelu_t(b[i]); } }
            else if (mode == 3) { for (int i = 0; i < 4; ++i) { a[i] = sigm_f(a[i] + bg[bj][0][i]); b[i] = sigm_f(b[i] + bg[bj][1][i]); } }
            u32x4 pk; pk.x = pk2(a.x, a.y); pk.y = pk2(a.z, a.w); pk.z = pk2(b.x, b.y); pk.w = pk2(b.z, b.w);
            *(u32x4*)(P + (size_t)row * INC + col0) = pk;
        EPI_LOOP_END
        return false;
    } };

struct SchedMg { int G, c; const char *P, *bt;
    DEV bool next(int i, Unit& u) const {
        const int T = i / 3, br = i - 3 * T; const long L = (long)T * G + c; if (L >= 256) return false;
        pg8::tile_map((int)L, 64, 4, u.pm, u.pn); u.kind = br; u.nt = br == 0 ? 16 : 8;
        const int koff = br == 0 ? 0 : br == 1 ? 1024 : 1536;
        u.A = P + (size_t)u.pm * 256 * INC * 2 + (size_t)(C_G + koff) * 2; u.B = bt + (size_t)u.pn * 256 * 2048 * 2 + (size_t)koff * 2; return true; } };
struct SchedMgS { int c; const char *P, *bt;
    DEV bool next(int i, Unit& u) const {
        if (i > 0 || c >= 64) return false;
        const int tile = c >> 3, ch = c & 7; u.pm = 64 + (tile >> 2); u.pn = tile & 3; u.kind = ch; u.nt = 4;
        const int koff = ch * 256;
        u.A = P + (size_t)u.pm * 256 * INC * 2 + (size_t)(C_G + koff) * 2; u.B = bt + (size_t)u.pn * 256 * 2048 * 2 + (size_t)koff * 2; return true; } };
struct EpiMg { const bf16_t* P; bf16_t* mg;
    DEV bool operator()(AccT& acc, const Unit& u, int wr, int wc, int fr, int fq) const {
        const int br = u.kind;
        EPI_AI_BEGIN
            u32x4 gg[8], hh[8];
            EPI_G_BEGIN
                const bf16_t* gp = P + (size_t)row * INC + C_GT + br * 1024 + col0;
                gg[gi] = *(const u32x4*)gp; hh[gi] = (br < 2) ? *(const u32x4*)(gp + 1024) : gg[gi];
            EPI_G_END
            EPI_G_BEGIN
                float s8[8], d8[8]; unpack8(gg[gi], s8);
                if (br < 2) { unpack8(hh[gi], d8);
#pragma unroll
                    for (int i = 0; i < 8; ++i) s8[i] *= __builtin_amdgcn_rcpf(d8[i]); }
                f32x4& v0 = acc[ai][bj][m][0]; f32x4& v1 = acc[ai][bj][m][1];
                v0.x *= s8[0]; v0.y *= s8[1]; v0.z *= s8[2]; v0.w *= s8[3]; v1.x *= s8[4]; v1.y *= s8[5]; v1.z *= s8[6]; v1.w *= s8[7];
                if (br == 2) { u32x4 pk; pk.x = pk2(v0.x, v0.y); pk.y = pk2(v0.z, v0.w); pk.z = pk2(v1.x, v1.y); pk.w = pk2(v1.z, v1.w); *(u32x4*)(mg + (size_t)row * 1024 + col0) = pk; }
            EPI_G_END
        EPI_AI_END
        return br < 2;
    } };
struct EpiMgS { const bf16_t* P; float* part;
    DEV bool operator()(AccT& acc, const Unit& u, int wr, int wc, int fr, int fq) const {
        const int ch = u.kind, br = ch < 4 ? 0 : ch < 6 ? 1 : 2;
        const bf16_t* gp = P + C_GT + br * 1024; float* tp = part + (size_t)ch * SROWS - (size_t)NP * 1024;
        EPI_AI_BEGIN
            u32x4 gg[8];
            EPI_G_BEGIN
                gg[gi] = *(const u32x4*)(gp + (size_t)row * INC + col0);
            EPI_G_END
            EPI_G_BEGIN
                float s8[8]; unpack8(gg[gi], s8); const f32x4 v0 = acc[ai][bj][m][0], v1 = acc[ai][bj][m][1];
                float* t = tp + (size_t)row * 1024 + col0;
                *(f32x4*)t = (f32x4){s8[0] * v0.x, s8[1] * v0.y, s8[2] * v0.z, s8[3] * v0.w}; *(f32x4*)(t + 4) = (f32x4){s8[4] * v1.x, s8[5] * v1.y, s8[6] * v1.z, s8[7] * v1.w};
            EPI_G_END
        EPI_AI_END
        return false;
    } };
template <int nt, int nsub, int nchunk, int astep, int bstep> struct SchedPS { int G, c; const char *A, *B;
    DEV bool next(int i, Unit& u) const {
        const long L = (long)i * G + c;
        if (L < 256) { pg8::tile_map((int)L, 64, 4, u.pm, u.pn); u.kind = 0; u.nt = nt; u.A = A + (size_t)u.pm * astep; u.B = B + (size_t)u.pn * bstep; return true; }
        const int s = (int)(L - 256); if (s >= nsub) return false;
        const int tile = s / nchunk, ch = s - tile * nchunk; u.pm = 64 + (tile >> 2); u.pn = tile & 3; u.kind = 1 + ch; u.nt = 2;
        u.A = A + (size_t)u.pm * astep + (size_t)ch * 256; u.B = B + (size_t)u.pn * bstep + (size_t)ch * 256; return true; } };
struct SchedPlain { int G, c, nM, nN, nt; const char *A, *B; size_t astep, bstep;
    DEV bool next(int i, Unit& u) const {
        const long L = (long)i * G + c; if (L >= (long)nM * nN) return false;
        pg8::tile_map((int)L, nM, nN, u.pm, u.pn); u.kind = 0; u.nt = nt; u.A = A + (size_t)u.pm * astep; u.B = B + (size_t)u.pn * bstep; return true; } };
struct EpiWo { const float *xp, *xs; float* out; float* part;
    DEV bool operator()(AccT& acc, const Unit& u, int wr, int wc, int fr, int fq) const {
        if (u.kind >= 1) {
            EPI_LOOP_BEGIN
                float* t = part + (size_t)(u.kind - 1) * SROWS + (size_t)(row - NP) * 1024 + col0; *(f32x4*)t = v0; *(f32x4*)(t + 4) = v1;
            EPI_LOOP_END
            return false; }
        EPI_LOOP_BEGIN
            u32x4 pk; pk.x = pk2(v0.x, v0.y); pk.y = pk2(v0.z, v0.w); pk.z = pk2(v1.x, v1.y); pk.w = pk2(v1.z, v1.w);
            *(u32x4*)((bf16_t*)out + (size_t)row * 2048 + 1024 + col0) = pk;
        EPI_LOOP_END
        return false;
    } };
struct EpiUp { bf16_t* z; float* out;
    DEV bool operator()(AccT& acc, const Unit& u, int wr, int wc, int fr, int fq) const {
        EPI_LOOP_BEGIN
            u32x4 pk; pk.x = pk2(v0.x, v0.y); pk.y = pk2(v0.z, v0.w); pk.z = pk2(v1.x, v1.y); pk.w = pk2(v1.z, v1.w);
            *(u32x4*)(z + (size_t)row * FF2 + col0) = pk;
            float* o = nullptr;
            if (row < NP) { const int t = row & 2047; if (t >= 2046) o = out + O_CONVP + ((size_t)(row >> 11) * 2 + (t - 2046)) * FF2 + col0; }
            else { const int rs = row - NP, t = rs & 3; if (t >= 2) o = out + O_CONVS + ((size_t)(rs >> 2) * 2 + (t - 2)) * FF2 + col0; }
            if (o) { *(f32x4*)o = v0; *(f32x4*)(o + 4) = v1; }
        EPI_LOOP_END
        return false;
    } };
struct EpiDn { float* out; float* part;
    DEV bool operator()(AccT& acc, const Unit& u, int wr, int wc, int fr, int fq) const {
        if (u.kind >= 1) {
            EPI_LOOP_BEGIN
                float* t = part + (size_t)(u.kind - 1) * SROWS + (size_t)(row - NP) * 1024 + col0; *(f32x4*)t = v0; *(f32x4*)(t + 4) = v1;
            EPI_LOOP_END
            return false; }
        EPI_LOOP_BEGIN
            u32x4 pk; pk.x = pk2(v0.x, v0.y); pk.y = pk2(v0.z, v0.w); pk.z = pk2(v1.x, v1.y); pk.w = pk2(v1.z, v1.w);
            *(u32x4*)((bf16_t*)out + (size_t)row * 2048 + col0) = pk;
        EPI_LOOP_END
        return false;
    } };

DEV int srccol_in(int p) {
    if (p < 1024) { const int hb = p & ~127, pp = p & 127, uu = pp >> 3, v = pp & 7; return hb + ((v < 4) ? 4 * uu + v : 64 + 4 * uu + (v - 4)); }
    if (p >= C_XQ && p < C_SV) return p + 512;
    if (p >= C_SV && p < C_GT) return p - 512;
    return p; }
DEV void transpose_item(const float* W, int N, bf16_t* WT, int ldk, int koff, LAS float* scr, int k0, int n0, int srccol, int lane) {
    float tv[32];
#pragma unroll
    for (int i = 0; i < 32; ++i) tv[i] = __builtin_nontemporal_load(W + (size_t)(k0 + 2 * i + (lane >> 5)) * N + srccol);
#pragma unroll
    for (int i = 0; i < 32; ++i) scr[(2 * i + (lane >> 5)) * 33 + (lane & 31)] = tv[i];
    const int c = lane & 7;
#pragma unroll
    for (int j = 0; j < 4; ++j) { const int n = (lane >> 3) + 8 * j; const LAS float* s = scr + (8 * c) * 33 + n;
        u32x4 o; o.x = pk2(s[0 * 33], s[1 * 33]); o.y = pk2(s[2 * 33], s[3 * 33]); o.z = pk2(s[4 * 33], s[5 * 33]); o.w = pk2(s[6 * 33], s[7 * 33]);
        *(u32x4*)(WT + (size_t)(n0 + n) * ldk + koff + k0 + 8 * c) = o; }
}
DEV void rms_row(const float* xrow, const float* g, bf16_t* orow, int lane) {
    f32x4 v[4]; float s = 0.f;
#pragma unroll
    for (int j = 0; j < 4; ++j) { v[j] = __builtin_nontemporal_load((const f32x4*)(xrow + 4 * lane + 256 * j)); s += v[j].x * v[j].x + v[j].y * v[j].y + v[j].z * v[j].z + v[j].w * v[j].w; }
    s = wave_sum(s); const float r = rsqrtf(s * (1.f / 1024.f) + EPS);
#pragma unroll
    for (int j = 0; j < 4; ++j) { const f32x4 gv = *(const f32x4*)(g + 4 * lane + 256 * j);
        u32x2 o; o.x = pk2(v[j].x * r * gv.x, v[j].y * r * gv.y); o.y = pk2(v[j].z * r * gv.z, v[j].w * r * gv.w);
        *(u32x2*)(orow + 4 * lane + 256 * j) = o; }
}
DEV void phase_prep(const Params& p, LAS unsigned char* lds) {
    const int tid = otid(), lane = tid & 63, wave = tid >> 6;
    const int gw = obid() * 8 + wave, NGW = gridDim.x * 8;
    LAS float* scr = (LAS float*)(lds + wave * 8448);
    unsigned char* ws = p.ws;
    constexpr int I_IN = 16 * 240, I_KV = 16 * 32, I_MR = 16 * 32, I_MS = 8 * 32, I_MX = 8 * 32, I_O = 16 * 32, I_UP = 16 * 176, I_DN = 44 * 32;
    constexpr int N_TR = I_IN + I_KV + I_MR + I_MS + I_MX + I_O + I_UP + I_DN;
    constexpr int N_RMS = MT + 2048, N_ROPE = 2052, N_TRIL = 512;
    constexpr int N_ALL = N_TR + N_RMS + N_ROPE + N_TRIL;
    for (int it = gw; it < N_ALL; it += NGW) {
        int r = it;
        if (r < N_TR) {
            const int l31 = lane & 31;
            if (r < I_IN) { const int kb = r / 240, nb = r % 240; transpose_item(p.w_in, INC, (bf16_t*)(ws + OFF_BTIN), 1024, 0, scr, 64 * kb, 32 * nb, srccol_in(32 * nb + l31), lane); continue; } r -= I_IN;
            if (r < I_KV) { const int kb = r / 32, nb = r % 32; transpose_item(p.w_mem_kv, 1024, (bf16_t*)(ws + OFF_BTKV), 1024, 0, scr, 64 * kb, 32 * nb, 32 * nb + l31, lane); continue; } r -= I_KV;
            if (r < I_MR) { const int kb = r / 32, nb = r % 32; transpose_item(p.w_br_ret, 1024, (bf16_t*)(ws + OFF_BTMG), 2048, 0, scr, 64 * kb, 32 * nb, 32 * nb + l31, lane); continue; } r -= I_MR;
            if (r < I_MS) { const int kb = r / 32, nb = r % 32; transpose_item(p.w_br_sg, 1024, (bf16_t*)(ws + OFF_BTMG), 2048, 1024, scr, 64 * kb, 32 * nb, 32 * nb + l31, lane); continue; } r -= I_MS;
            if (r < I_MX) { const int kb = r / 32, nb = r % 32; transpose_item(p.w_br_x, 1024, (bf16_t*)(ws + OFF_BTMG), 2048, 1536, scr, 64 * kb, 32 * nb, 32 * nb + l31, lane); continue; } r -= I_MX;
            if (r < I_O) { const int kb = r / 32, nb = r % 32; transpose_item(p.w_o, 1024, (bf16_t*)(ws + OFF_BTO), 1024, 0, scr, 64 * kb, 32 * nb, 32 * nb + l31, lane); continue; } r -= I_O;
            if (r < I_UP) { const int kb = r / 176, nb = r % 176; transpose_item(p.w_up, FF2, (bf16_t*)(ws + OFF_BTUP), 1024, 0, scr, 64 * kb, 32 * nb, 32 * nb + l31, lane); continue; } r -= I_UP;
            { const int kb = r / 32, nb = r % 32; transpose_item(p.w_down, 1024, (bf16_t*)(ws + OFF_BTDN), FF, 0, scr, 64 * kb, 32 * nb, 32 * nb + l31, lane); continue; }
        }
        r -= N_TR;
        if (r < N_RMS) {
            if (r < NP) rms_row(p.x_prompt + (size_t)r * 1024, p.norm_mix_g, (bf16_t*)(ws + OFF_R2) + (size_t)r * 1024, lane);
            else if (r < MT) rms_row(p.x_sample + (size_t)(r - NP) * 1024, p.norm_mix_g, (bf16_t*)(ws + OFF_R2) + (size_t)r * 1024, lane);
            else rms_row(p.mem_prompt + (size_t)(r - MT) * 1024, p.mem_norm_g, (bf16_t*)(ws + OFF_HM) + (size_t)(r - MT) * 1024, lane);
            continue; }
        r -= N_RMS;
        if (r < N_ROPE) {
            const int pos = r < 2048 ? r : 16384 + (r - 2048);
            double inv = 1.0;
            if (lane & 1) inv *= 0.8659643233600653; if (lane & 2) inv *= 0.7498942093324559; if (lane & 4) inv *= 0.5623413251903491;
            if (lane & 8) inv *= 0.31622776601683794; if (lane & 16) inv *= 0.1; if (lane & 32) inv *= 0.01;
            double t = (double)pos * inv * 0.15915494309189535; t -= __builtin_rint(t);
            const float tf = (float)t;
            ((float*)(ws + OFF_ROPEC))[r * 64 + lane] = __builtin_amdgcn_cosf(tf);
            ((float*)(ws + OFF_ROPES))[r * 64 + lane] = __builtin_amdgcn_sinf(tf);
            continue; }
        r -= N_ROPE;
        { const int t = r & 127; const float* src = p.sg_ws + (size_t)r * 128 + 2 * lane;
          const float a = (2 * lane <= t) ? src[0] : 0.f, b = (2 * lane + 1 <= t) ? src[1] : 0.f;
          *(unsigned*)((bf16_t*)(ws + OFF_WTRIL) + (size_t)r * 128 + 2 * lane) = pk2(a, b); }
    }
}

DEV void ret_A_item(const Params& p, LAS unsigned char* lds, int item) {
    const int tid = otid(), lane = tid & 63, w = tid >> 6;
    const int c = item & 15, bh = item >> 4, h = bh & 3, b = bh >> 2;
    const size_t row0 = (size_t)b * 2048 + c * 128;
    const bf16_t* P = (const bf16_t*)(p.ws + OFF_P);
    const float lg = log_gamma(h);
    LAS unsigned char* Kt = lds; LAS unsigned char* Vt = lds + 34816;
#pragma unroll
    for (int k_ = 0; k_ < 4; ++k_) { const int i = tid + 512 * k_; const int s = i >> 4, ch = i & 15;
        u32x4 v = *(const u32x4*)(P + (row0 + s) * INC + C_K + h * 128 + ch * 8);
        const float dec = __expf((float)(127 - s) * lg);
        v.x = pk2(bf_lo(v.x) * dec, bf_hi(v.x) * dec); v.y = pk2(bf_lo(v.y) * dec, bf_hi(v.y) * dec); v.z = pk2(bf_lo(v.z) * dec, bf_hi(v.z) * dec); v.w = pk2(bf_lo(v.w) * dec, bf_hi(v.w) * dec);
        *(LAS u32x4*)(Kt + s * 272 + ch * 16) = v; }
#pragma unroll
    for (int k_ = 0; k_ < 8; ++k_) { const int i = tid + 512 * k_; const int s = i >> 5, ch = i & 31;
        *(LAS u32x4*)(Vt + s * 528 + ch * 16) = *(const u32x4*)(P + (row0 + s) * INC + C_V + h * 256 + ch * 8); }
    __syncthreads();
    f32x4 acc[16];
#pragma unroll
    for (int i = 0; i < 16; ++i) acc[i] = (f32x4){0.f, 0.f, 0.f, 0.f};
    LAS const unsigned char* kb = tr_lane_base(Kt, 272, lane) + 32 * w; LAS const unsigned char* vb = tr_lane_base(Vt, 528, lane);
    bf16x8 af[4]; tr_read4<272, 0, 0>(kb, af);
    static_for<0, 16>([&](auto et_) { constexpr int et = decltype(et_)::value; bf16x8 bf[4]; tr_read4<528, 0, 16 * et>(vb, bf);
#pragma unroll
        for (int ks = 0; ks < 4; ++ks) acc[et] = mfma16(af[ks], bf[ks], acc[et]); });
    float* U = p.out + (size_t)item * 32768;
    const int g = lane >> 4, col = lane & 15;
#pragma unroll
    for (int et = 0; et < 16; ++et)
#pragma unroll
        for (int j = 0; j < 4; ++j) U[(16 * w + 4 * g + j) * 256 + 16 * et + col] = acc[et][j];
    __syncthreads();
}
DEV void scan_phase(const Params& p) {
    const float* U = p.out; bf16_t* Sb = (bf16_t*)(p.ws + OFF_R2);
    for (int idx = obid() * 512 + otid(); idx < 131072; idx += gridDim.x * 512) {
        const int e8 = idx & 31, d = (idx >> 5) & 127, bh = idx >> 12, h = bh & 3;
        const float g128 = __expf(128.f * log_gamma(h));
        f32x4 s0 = (f32x4){0.f, 0.f, 0.f, 0.f}, s1 = s0;
#pragma unroll
        for (int c = 0; c < 16; ++c) {
            const size_t off = (((size_t)bh * 16 + c) * 128 + d) * 256 + e8 * 8;
            u32x4 pk; pk.x = pk2(s0.x, s0.y); pk.y = pk2(s0.z, s0.w); pk.z = pk2(s1.x, s1.y); pk.w = pk2(s1.z, s1.w);
            *(u32x4*)(Sb + off) = pk;
            const f32x4 u0 = __builtin_nontemporal_load((const f32x4*)(U + off)), u1 = __builtin_nontemporal_load((const f32x4*)(U + off + 4));
            s0 = s0 * g128 + u0; s1 = s1 * g128 + u1; }
        float* o = p.out + O_RETP + ((size_t)bh * 128 + d) * 256 + e8 * 8;
        *(f32x4*)o = s0; *(f32x4*)(o + 4) = s1;
    }
}
DEV void ret_C_item(const Params& p, LAS unsigned char* lds, int item) {
    const int tid = otid(), lane = tid & 63, w = tid >> 6, g = lane >> 4, col = lane & 15;
    const int c = item & 15, bh = item >> 4, h = bh & 3, b = bh >> 2;
    const size_t row0 = (size_t)b * 2048 + c * 128;
    bf16_t* P = (bf16_t*)(p.ws + OFF_P);
    const bf16_t* Sb = (const bf16_t*)(p.ws + OFF_R2) + (size_t)item * 32768;
    const float lg = log_gamma(h);
    LAS unsigned char* Kt = lds; LAS unsigned char* Vh = lds + 34816; LAS unsigned char* Sh = lds + 69632; LAS unsigned char* Sc = lds + 104448 + w * 4352;
#pragma unroll
    for (int k_ = 0; k_ < 4; ++k_) { const int i = tid + 512 * k_; const int s = i >> 4, ch = i & 15;
        *(LAS u32x4*)(Kt + s * 272 + ch * 16) = *(const u32x4*)(P + (row0 + s) * INC + C_K + h * 128 + ch * 8); }
    bf16x8 qf[4];
    { const bf16_t* qp = P + (row0 + 16 * w + col) * INC + C_Q + h * 128 + 8 * g;
#pragma unroll
      for (int ks = 0; ks < 4; ++ks) qf[ks] = *(const bf16x8*)(qp + 32 * ks); }
    f32x4 o[16];
    float sg[16][4];
#pragma unroll
    for (int j = 0; j < 4; ++j)
#pragma unroll
        for (int t = 0; t < 16; ++t) sg[t][j] = bf2f(P[(row0 + 16 * w + 4 * g + j) * INC + C_G + h * 256 + (t >> 3) * 128 + (t & 7) * 16 + col]);
    LAS const unsigned char* shb = tr_lane_base(Sh, 272, lane); LAS const unsigned char* vhb = tr_lane_base(Vh, 272, lane);
    bf16x8 scf[4];
    static_for<0, 2>([&](auto hh_) { constexpr int hh = decltype(hh_)::value;
        if (hh == 1) __syncthreads();
#pragma unroll
        for (int k_ = 0; k_ < 4; ++k_) { const int i = tid + 512 * k_; const int s = i >> 4, ch = i & 15;
            *(LAS u32x4*)(Vh + s * 272 + ch * 16) = *(const u32x4*)(P + (row0 + s) * INC + C_V + h * 256 + hh * 128 + ch * 8);
            *(LAS u32x4*)(Sh + s * 272 + ch * 16) = *(const u32x4*)(Sb + s * 256 + hh * 128 + ch * 8); }
        __syncthreads();
        if (hh == 0) {
            static_for<0, 8>([&](auto st_) { constexpr int st = decltype(st_)::value; f32x4 a = (f32x4){0.f, 0.f, 0.f, 0.f};
#pragma unroll
                for (int ks = 0; ks < 4; ++ks) a = mfma16(qf[ks], lds_frag(Kt, 272, 16 * st, 32 * ks, lane), a);
#pragma unroll
                for (int j = 0; j < 4; ++j) { const int diff = (16 * w + 4 * g + j) - (16 * st + col);
                    const float v = diff >= 0 ? a[j] * __expf((float)diff * lg) : 0.f;
                    *(LAS bf16_t*)(Sc + (4 * g + j) * 272 + (16 * st + col) * 2) = f2bf(v); }
                SCHEDB; });
#pragma unroll
            for (int ks = 0; ks < 4; ++ks) scf[ks] = lds_frag(Sc, 272, 0, 32 * ks, lane);
        }
        static_for<0, 8>([&](auto et_) { constexpr int et = decltype(et_)::value; f32x4 a = (f32x4){0.f, 0.f, 0.f, 0.f};
            bf16x8 f[4]; tr_read4<272, 0, 16 * et>(shb, f);
#pragma unroll
            for (int ks = 0; ks < 4; ++ks) a = mfma16(qf[ks], f[ks], a);
#pragma unroll
            for (int j = 0; j < 4; ++j) a[j] *= __expf((float)(16 * w + 4 * g + j + 1) * lg);
            tr_read4<272, 0, 16 * et>(vhb, f);
#pragma unroll
            for (int ks = 0; ks < 4; ++ks) a = mfma16(scf[ks], f[ks], a);
            o[hh * 8 + et] = a; SCHEDB; });
    });
    float gnv[16];
#pragma unroll
    for (int t = 0; t < 16; ++t) gnv[t] = p.ret_gn_g[h * 256 + (t >> 3) * 128 + (t & 7) * 16 + col];
#pragma unroll
    for (int j = 0; j < 4; ++j) {
        float s = 0.f;
#pragma unroll
        for (int t = 0; t < 16; ++t) s += o[t][j];
        const float mean = g16_sum(s) * (1.f / 256.f);
        float s2 = 0.f;
#pragma unroll
        for (int t = 0; t < 16; ++t) { const float dd = o[t][j] - mean; s2 += dd * dd; }
        const float rstd = rsqrtf(g16_sum(s2) * (1.f / 256.f) + EPS);
        bf16_t* gp = P + (row0 + 16 * w + 4 * g + j) * INC + C_G + h * 256;
#pragma unroll
        for (int t = 0; t < 16; ++t) { const int e = (t >> 3) * 128 + (t & 7) * 16 + col;
            gp[e] = f2bf((o[t][j] - mean) * rstd * gnv[t] * sg[t][j]); }
    }
    __syncthreads();
}
DEV void sgu_item(const Params& p, LAS unsigned char* lds, int item) {
    const int tid = otid(), lane = tid & 63, w = tid >> 6, g = lane >> 4, col = lane & 15;
    const int gq = item & 3, bn = item >> 2; const size_t row0 = (size_t)bn * 128;
    bf16_t* P = (bf16_t*)(p.ws + OFF_P);
    LAS unsigned char* VN = lds;
#pragma unroll
    for (int rr = 0; rr < 16; ++rr) { const int s = 16 * w + rr;
        const u32x4 v = *(const u32x4*)(P + (row0 + s) * INC + C_SV + lane * 8);
        float x[8] = {bf_lo(v.x), bf_hi(v.x), bf_lo(v.y), bf_hi(v.y), bf_lo(v.z), bf_hi(v.z), bf_lo(v.w), bf_hi(v.w)};
        float sm = 0.f;
#pragma unroll
        for (int i = 0; i < 8; ++i) sm += x[i];
        const float mean = wave_sum(sm) * (1.f / 512.f); float s2 = 0.f;
#pragma unroll
        for (int i = 0; i < 8; ++i) { x[i] -= mean; s2 += x[i] * x[i]; }
        const float rstd = rsqrtf(wave_sum(s2) * (1.f / 512.f) + EPS);
        if (g == gq) { const float* lg = p.sg_ln_g + lane * 8; u32x4 o;
            o.x = pk2(x[0] * rstd * lg[0], x[1] * rstd * lg[1]); o.y = pk2(x[2] * rstd * lg[2], x[3] * rstd * lg[3]);
            o.z = pk2(x[4] * rstd * lg[4], x[5] * rstd * lg[5]); o.w = pk2(x[6] * rstd * lg[6], x[7] * rstd * lg[7]);
            *(LAS u32x4*)(VN + s * 272 + col * 16) = o; } }
    bf16x8 af[4];
    { const bf16_t* wp = (const bf16_t*)(p.ws + OFF_WTRIL) + (size_t)(gq * 128 + 16 * w + col) * 128 + 8 * g;
#pragma unroll
      for (int ks = 0; ks < 4; ++ks) af[ks] = *(const bf16x8*)(wp + 32 * ks); }
    __syncthreads();
    LAS const unsigned char* vnb = tr_lane_base(VN, 272, lane);
    float uv[8][4], bsv[4];
#pragma unroll
    for (int j = 0; j < 4; ++j) { bsv[j] = p.sg_bs[gq * 128 + 16 * w + 4 * g + j];
#pragma unroll
        for (int ct = 0; ct < 8; ++ct) uv[ct][j] = bf2f(P[(row0 + 16 * w + 4 * g + j) * INC + C_SU + gq * 128 + 16 * ct + col]); }
    static_for<0, 8>([&](auto ct_) { constexpr int ct = decltype(ct_)::value; f32x4 a = (f32x4){0.f, 0.f, 0.f, 0.f};
        bf16x8 f[4]; tr_read4<272, 0, 16 * ct>(vnb, f);
#pragma unroll
        for (int ks = 0; ks < 4; ++ks) a = mfma16(af[ks], f[ks], a);
#pragma unroll
        for (int j = 0; j < 4; ++j) P[(row0 + 16 * w + 4 * g + j) * INC + C_SU + gq * 128 + 16 * ct + col] = f2bf(uv[ct][j] * (a[j] + bsv[j])); });
    __syncthreads();
}
DEV void xattn_item(const Params& p, LAS unsigned char* lds, int item) {
    const int tid = otid(), lane = tid & 63, w = tid >> 6, g = lane >> 4, col = lane & 15;
    const int qt = item & 15, bh = item >> 4, h = bh & 3, b = bh >> 2; const size_t row0 = (size_t)b * 2048 + qt * 128;
    bf16_t* P = (bf16_t*)(p.ws + OFF_P); const bf16_t* mkb = (const bf16_t*)(p.ws + OFF_MKB);
    LAS unsigned char* KV = lds; LAS unsigned char* Pw = lds + 69632 + w * 8448;
#pragma unroll
    for (int k_ = 0; k_ < 8; ++k_) { const int i = tid + 512 * k_; const int m = i >> 4, ch = i & 15;
        *(LAS u32x4*)(KV + m * 272 + ch * 16) = *(const u32x4*)(mkb + (size_t)(b * 256 + m) * 1024 + h * 128 + ch * 8); }
    bf16x8 qf[4];
    { const bf16_t* qp = P + (row0 + 16 * w + col) * INC + C_XQ + h * 128 + 8 * g;
#pragma unroll
      for (int ks = 0; ks < 4; ++ks) qf[ks] = *(const bf16x8*)(qp + 32 * ks); }
    __syncthreads();
    f32x4 sc[16];
    static_for<0, 16>([&](auto mt_) { constexpr int mt = decltype(mt_)::value; f32x4 a = (f32x4){0.f, 0.f, 0.f, 0.f};
#pragma unroll
        for (int ks = 0; ks < 4; ++ks) a = mfma16(qf[ks], lds_frag(KV, 272, 16 * mt, 32 * ks, lane), a);
        sc[mt] = a * 0.08838834764831845f; SCHEDB; });
#pragma unroll
    for (int j = 0; j < 4; ++j) { float mx = -3.0e38f;
#pragma unroll
        for (int mt = 0; mt < 16; ++mt) mx = fmaxf(mx, sc[mt][j]);
        mx = g16_max(mx); float sm = 0.f;
#pragma unroll
        for (int mt = 0; mt < 16; ++mt) { const float e = __expf(sc[mt][j] - mx); sc[mt][j] = e; sm += e; }
        const float inv = 1.f / g16_sum(sm);
#pragma unroll
        for (int mt = 0; mt < 16; ++mt) *(LAS bf16_t*)(Pw + (4 * g + j) * 528 + (16 * mt + col) * 2) = f2bf(sc[mt][j] * inv); }
    __syncthreads();
#pragma unroll
    for (int k_ = 0; k_ < 8; ++k_) { const int i = tid + 512 * k_; const int m = i >> 4, ch = i & 15;
        *(LAS u32x4*)(KV + m * 272 + ch * 16) = *(const u32x4*)(mkb + (size_t)(b * 256 + m) * 1024 + 512 + h * 128 + ch * 8); }
    __syncthreads();
    LAS const unsigned char* kvb = tr_lane_base(KV, 272, lane);
    bf16x8 pf[8];
#pragma unroll
    for (int ks = 0; ks < 8; ++ks) pf[ks] = lds_frag(Pw, 528, 0, 32 * ks, lane);
    static_for<0, 8>([&](auto dt_) { constexpr int dt = decltype(dt_)::value; f32x4 a = (f32x4){0.f, 0.f, 0.f, 0.f};
        bf16x8 f[4]; tr_read4<272, 0, 16 * dt>(kvb, f);
#pragma unroll
        for (int ks = 0; ks < 4; ++ks) a = mfma16(pf[ks], f[ks], a);
        tr_read4<272, 128, 16 * dt>(kvb, f);
#pragma unroll
        for (int ks = 0; ks < 4; ++ks) a = mfma16(pf[4 + ks], f[ks], a);
#pragma unroll
        for (int j = 0; j < 4; ++j) P[(row0 + 16 * w + 4 * g + j) * INC + C_XQ + h * 128 + 16 * dt + col] = f2bf(a[j]); });
    __syncthreads();
}
DEV void xattn_s_item(const Params& p, LAS unsigned char* lds, int item) {
    const int tid = otid(), lane = tid & 63, w = tid >> 6, l32 = lane & 31, slot = w * 2 + (lane >> 5);
    const int h = item & 3, b = item >> 2; const size_t rowb = (size_t)NP + b * 4;
    bf16_t* P = (bf16_t*)(p.ws + OFF_P);
    LAS float* sc = (LAS float*)lds; LAS float* red = (LAS float*)(lds + 4096);
    float q[4][4];
#pragma unroll
    for (int l = 0; l < 4; ++l) { const u32x2 v = *(const u32x2*)(P + (rowb + l) * INC + C_XQ + h * 128 + 4 * l32); q[l][0] = bf_lo(v.x); q[l][1] = bf_hi(v.x); q[l][2] = bf_lo(v.y); q[l][3] = bf_hi(v.y); }
#pragma unroll
    for (int it = 0; it < 16; ++it) { const int m = it * 16 + slot;
        const f32x4 kv = *(const f32x4*)(p.cache_k + (((size_t)b * 256 + m) * 4 + h) * 128 + 4 * l32);
        float d[4];
#pragma unroll
        for (int l = 0; l < 4; ++l) d[l] = q[l][0] * kv.x + q[l][1] * kv.y + q[l][2] * kv.z + q[l][3] * kv.w;
        const bool b0 = l32 & 1, b1 = l32 & 2;
        float a0 = b0 ? d[2] : d[0], a1 = b0 ? d[3] : d[1];
        a0 += __shfl_xor(b0 ? d[0] : d[2], 1); a1 += __shfl_xor(b0 ? d[1] : d[3], 1);
        float r = b1 ? a1 : a0; r += __shfl_xor(b1 ? a0 : a1, 2);
        r += __shfl_xor(r, 4); r += __shfl_xor(r, 8); r += __shfl_xor(r, 16);
        if (l32 < 4) sc[((l32 & 1) * 2 + (l32 >> 1)) * 256 + m] = r * 0.08838834764831845f; }
    __syncthreads();
    if (w < 4) { float v[4]; float mx = -3.0e38f;
#pragma unroll
        for (int i = 0; i < 4; ++i) { v[i] = sc[w * 256 + lane + 64 * i]; mx = fmaxf(mx, v[i]); }
        mx = wave_max(mx); float sm = 0.f;
#pragma unroll
        for (int i = 0; i < 4; ++i) { v[i] = __expf(v[i] - mx); sm += v[i]; }
        const float inv = 1.f / wave_sum(sm);
#pragma unroll
        for (int i = 0; i < 4; ++i) sc[w * 256 + lane + 64 * i] = v[i] * inv; }
    __syncthreads();
    f32x4 o[4];
#pragma unroll
    for (int l = 0; l < 4; ++l) o[l] = (f32x4){0.f, 0.f, 0.f, 0.f};
#pragma unroll
    for (int it = 0; it < 16; ++it) { const int m = it * 16 + slot;
        const f32x4 vv = *(const f32x4*)(p.cache_v + (((size_t)b * 256 + m) * 4 + h) * 128 + 4 * l32);
#pragma unroll
        for (int l = 0; l < 4; ++l) o[l] += vv * sc[l * 256 + m]; }
#pragma unroll
    for (int l = 0; l < 4; ++l) *(LAS f32x4*)(red + (slot * 4 + l) * 128 + 4 * l32) = o[l];
    __syncthreads();
    { const int l = tid >> 7, d = tid & 127; float s = 0.f;
#pragma unroll
      for (int k = 0; k < 16; ++k) s += red[(k * 4 + l) * 128 + d];
      P[(rowb + l) * INC + C_XQ + h * 128 + d] = f2bf(s); }
    __syncthreads();
}
DEV void ret_s_item(const Params& p, LAS unsigned char* lds, int item) {
    const int tid = otid(), lane = tid & 63, w = tid >> 6;
    const int h = item & 3, b = item >> 2; const size_t rowb = (size_t)NP + b * 4;
    bf16_t* P = (bf16_t*)(p.ws + OFF_P);
    const float lg = log_gamma(h);
    LAS float* qs = (LAS float*)lds;
    LAS float* kr = qs + 512;
    LAS float* vs = kr + 512;
    LAS float* ob = vs + 1024;
    LAS float* scm = ob + 1024;
    LAS float* red = scm + 16;
    { const int t = tid >> 7, d = tid & 127;
      qs[t * 128 + d] = bf2f(P[(rowb + t) * INC + C_Q + h * 128 + d]); kr[t * 128 + d] = bf2f(P[(rowb + t) * INC + C_K + h * 128 + d]);
      vs[t * 256 + d] = bf2f(P[(rowb + t) * INC + C_V + h * 256 + d]); vs[t * 256 + 128 + d] = bf2f(P[(rowb + t) * INC + C_V + h * 256 + 128 + d]); }
    __syncthreads();
    { const int pr = tid >> 5, t = pr >> 2, s2 = pr & 3, l32 = tid & 31;
      const f32x4 qa = *(LAS f32x4*)(qs + t * 128 + 4 * l32), kb = *(LAS f32x4*)(kr + s2 * 128 + 4 * l32);
      float d = qa.x * kb.x + qa.y * kb.y + qa.z * kb.z + qa.w * kb.w;
#pragma unroll
      for (int o = 1; o < 32; o <<= 1) d += __shfl_xor(d, o);
      if (l32 == 0) scm[pr] = (t >= s2) ? d * __expf((float)(t - s2) * lg) : 0.f; }
    f32x4 v[4], cr[4];
#pragma unroll
    for (int s = 0; s < 4; ++s) { v[s] = *(LAS f32x4*)(vs + s * 256 + 4 * lane); cr[s] = (f32x4){0.f, 0.f, 0.f, 0.f}; }
    const float g4 = __expf(4.f * lg), kd0 = __expf(3.f * lg), kd1 = __expf(2.f * lg), kd2 = __expf(lg);
    const float* S0 = p.state_ret + ((size_t)item * 128) * 256; float* Sn = p.out + O_RETS + ((size_t)item * 128) * 256;
#pragma unroll
    for (int dd = 0; dd < 16; ++dd) { const int d = 16 * w + dd;
        const f32x4 s0 = *(const f32x4*)(S0 + d * 256 + 4 * lane);
#pragma unroll
        for (int t = 0; t < 4; ++t) cr[t] += s0 * qs[t * 128 + d];
        f32x4 sn = s0 * g4 + v[0] * (kr[d] * kd0) + v[1] * (kr[128 + d] * kd1) + v[2] * (kr[256 + d] * kd2) + v[3] * kr[384 + d];
        *(f32x4*)(Sn + d * 256 + 4 * lane) = sn; }
#pragma unroll
    for (int t = 0; t < 4; ++t) *(LAS f32x4*)(red + (w * 4 + t) * 256 + 4 * lane) = cr[t];
    __syncthreads();
    { const int t = tid >> 7, e2 = (tid & 127) * 2; const float qd = __expf((float)(t + 1) * lg);
#pragma unroll
      for (int i = 0; i < 2; ++i) { const int e = e2 + i; float c = 0.f;
#pragma unroll
          for (int k = 0; k < 8; ++k) c += red[(k * 4 + t) * 256 + e];
          float in = 0.f;
#pragma unroll
          for (int s = 0; s < 4; ++s) in += scm[t * 4 + s] * vs[s * 256 + e];
          ob[t * 256 + e] = in + c * qd; } }
    __syncthreads();
    if (w < 4) { float x[4]; float sm = 0.f;
#pragma unroll
        for (int i = 0; i < 4; ++i) { x[i] = ob[w * 256 + lane + 64 * i]; sm += x[i]; }
        const float mean = wave_sum(sm) * (1.f / 256.f); float s2 = 0.f;
#pragma unroll
        for (int i = 0; i < 4; ++i) { x[i] -= mean; s2 += x[i] * x[i]; }
        const float rstd = rsqrtf(wave_sum(s2) * (1.f / 256.f) + EPS);
        bf16_t* gp = P + (rowb + w) * INC + C_G + h * 256;
#pragma unroll
        for (int i = 0; i < 4; ++i) { const int e = lane + 64 * i; gp[e] = f2bf(x[i] * rstd * p.ret_gn_g[h * 256 + e] * bf2f(gp[e])); } }
    __syncthreads();
}
DEV void sgu_s_item(const Params& p, LAS unsigned char* lds, int b) {
    const int tid = otid(), lane = tid & 63, w = tid >> 6;
    const size_t rowb = (size_t)NP + b * 4;
    bf16_t* P = (bf16_t*)(p.ws + OFF_P);
    LAS float* part = (LAS float*)lds;
    float x[4];
#pragma unroll
    for (int r = 0; r < 4; ++r) { x[r] = bf2f(P[(rowb + r) * INC + C_SV + tid]); const float s = wave_sum(x[r]); if (lane == 0) part[w * 4 + r] = s; }
    __syncthreads();
    float mean[4];
#pragma unroll
    for (int r = 0; r < 4; ++r) { float s = 0.f;
#pragma unroll
        for (int k = 0; k < 8; ++k) s += part[k * 4 + r];
        mean[r] = s * (1.f / 512.f); }
    __syncthreads();
#pragma unroll
    for (int r = 0; r < 4; ++r) { x[r] -= mean[r]; const float s = wave_sum(x[r] * x[r]); if (lane == 0) part[w * 4 + r] = s; }
    __syncthreads();
    const float lng = p.sg_ln_g[tid]; const int gq = tid >> 7;
    float vn[4];
#pragma unroll
    for (int r = 0; r < 4; ++r) { float s = 0.f;
#pragma unroll
        for (int k = 0; k < 8; ++k) s += part[k * 4 + r];
        vn[r] = x[r] * rsqrtf(s * (1.f / 512.f) + EPS) * lng;
        p.out[O_SGV + ((size_t)b * 4 + r) * 512 + tid] = vn[r]; }
#pragma unroll
    for (int t = 0; t < 4; ++t) { float mx = p.sg_bs[gq * 128 + t];
#pragma unroll
        for (int s = 0; s < 4; ++s) if (s <= t) mx += p.sg_ws[(size_t)(gq * 128 + t) * 128 + s] * vn[s];
        bf16_t* up = P + (rowb + t) * INC + C_SU + tid; *up = f2bf(bf2f(*up) * mx); }
    __syncthreads();
}


DEV float rl_bf(unsigned packed, int d) { return (d & 1) ? bf_hi(packed) : bf_lo(packed); }
DEV void ret_s_wave(const Params& p, int item, int lane) {
    const int h = item & 3, b = item >> 2; const size_t rowb = (size_t)NP + b * 4;
    bf16_t* P = (bf16_t*)(p.ws + OFF_P);
    const float lg = log_gamma(h);
    unsigned qp[4], kp[4]; f32x4 v[4];
#pragma unroll
    for (int t = 0; t < 4; ++t) { qp[t] = *(const unsigned*)(P + (rowb + t) * INC + C_Q + h * 128 + 2 * lane); kp[t] = *(const unsigned*)(P + (rowb + t) * INC + C_K + h * 128 + 2 * lane);
        const u32x2 x = *(const u32x2*)(P + (rowb + t) * INC + C_V + h * 256 + 4 * lane); v[t] = (f32x4){bf_lo(x.x), bf_hi(x.x), bf_lo(x.y), bf_hi(x.y)}; }
    float sc[4][4];
#pragma unroll
    for (int t = 0; t < 4; ++t)
#pragma unroll
        for (int s2 = 0; s2 < 4; ++s2) { if (s2 <= t) sc[t][s2] = wave_sum(bf_lo(qp[t]) * bf_lo(kp[s2]) + bf_hi(qp[t]) * bf_hi(kp[s2])) * __expf((float)(t - s2) * lg); else sc[t][s2] = 0.f; }
    const float g4 = __expf(4.f * lg), kdec[4] = {__expf(3.f * lg), __expf(2.f * lg), __expf(lg), 1.f};
    f32x4 cr[4];
#pragma unroll
    for (int t = 0; t < 4; ++t) cr[t] = (f32x4){0.f, 0.f, 0.f, 0.f};
    const float* S0 = p.state_ret + (size_t)item * 32768 + 4 * lane; float* Sn = p.out + O_RETS + (size_t)item * 32768 + 4 * lane;
    f32x4 sA[8], sB[8];
#pragma unroll
    for (int i = 0; i < 8; ++i) sA[i] = __builtin_nontemporal_load((const f32x4*)(S0 + i * 256));
#define RETS_PROC(buf, d0) _Pragma("unroll") for (int i = 0; i < 8; ++i) { const int src = ((d0) + i) >> 1; f32x4 sn = buf[i] * g4; \
        _Pragma("unroll") for (int t = 0; t < 4; ++t) { const float qd = rl_bf((unsigned)__builtin_amdgcn_readlane((int)qp[t], src), i), kd = rl_bf((unsigned)__builtin_amdgcn_readlane((int)kp[t], src), i) * kdec[t]; \
            cr[t] += buf[i] * qd; sn += v[t] * kd; } \
        *(f32x4*)(Sn + ((d0) + i) * 256) = sn; }
    for (int d0 = 0; d0 < 128; d0 += 16) {
#pragma unroll
        for (int i = 0; i < 8; ++i) sB[i] = __builtin_nontemporal_load((const f32x4*)(S0 + (d0 + 8 + i) * 256));
        RETS_PROC(sA, d0)
        if (d0 + 16 < 128) {
#pragma unroll
            for (int i = 0; i < 8; ++i) sA[i] = __builtin_nontemporal_load((const f32x4*)(S0 + (d0 + 16 + i) * 256)); }
        RETS_PROC(sB, d0 + 8)
    }
#undef RETS_PROC
    const f32x4 gn4 = *(const f32x4*)(p.ret_gn_g + h * 256 + 4 * lane);
#pragma unroll
    for (int t = 0; t < 4; ++t) {
        f32x4 o = cr[t] * __expf((float)(t + 1) * lg);
#pragma unroll
        for (int s2 = 0; s2 < 4; ++s2) o += v[s2] * sc[t][s2];
        const float mean = wave_sum(o.x + o.y + o.z + o.w) * (1.f / 256.f);
        o = o - mean;
        const float rstd = rsqrtf(wave_sum(o.x * o.x + o.y * o.y + o.z * o.z + o.w * o.w) * (1.f / 256.f) + EPS);
        bf16_t* gp = P + (rowb + t) * INC + C_G + h * 256 + 4 * lane;
        const u32x2 gg = *(const u32x2*)gp;
        u32x2 ov; ov.x = pk2(o.x * rstd * gn4.x * bf_lo(gg.x), o.y * rstd * gn4.y * bf_hi(gg.x)); ov.y = pk2(o.z * rstd * gn4.z * bf_lo(gg.y), o.w * rstd * gn4.w * bf_hi(gg.y));
        *(u32x2*)gp = ov; }
}
DEV void xattn_s_wave(const Params& p, LAS float* sc  , int item, int lane) {
    const int l32 = lane & 31, hf = lane >> 5;
    const int h = item & 3, b = item >> 2; const size_t rowb = (size_t)NP + b * 4;
    bf16_t* P = (bf16_t*)(p.ws + OFF_P);
    float q[4][4];
#pragma unroll
    for (int l = 0; l < 4; ++l) { const u32x2 x = *(const u32x2*)(P + (rowb + l) * INC + C_XQ + h * 128 + 4 * l32); q[l][0] = bf_lo(x.x); q[l][1] = bf_hi(x.x); q[l][2] = bf_lo(x.y); q[l][3] = bf_hi(x.y); }
    const float* Kb = p.cache_k + (((size_t)b * 256 + hf) * 4 + h) * 128 + 4 * l32;
    const float* Vb = p.cache_v + (((size_t)b * 256 + hf) * 4 + h) * 128 + 4 * l32;
    const bool b0 = l32 & 1, b1 = l32 & 2; const int lmap = (l32 & 1) * 2 + ((l32 >> 1) & 1);
    for (int it0 = 0; it0 < 128; it0 += 16) {
        f32x4 kv[16];
#pragma unroll
        for (int i = 0; i < 16; ++i) kv[i] = __builtin_nontemporal_load((const f32x4*)(Kb + (size_t)(it0 + i) * 1024));
#pragma unroll
        for (int i = 0; i < 16; ++i) { float d[4];
#pragma unroll
            for (int l = 0; l < 4; ++l) d[l] = q[l][0] * kv[i].x + q[l][1] * kv[i].y + q[l][2] * kv[i].z + q[l][3] * kv[i].w;
            float a0 = b0 ? d[2] : d[0], a1 = b0 ? d[3] : d[1];
            a0 += dpp_f<0xB1>(b0 ? d[0] : d[2]); a1 += dpp_f<0xB1>(b0 ? d[1] : d[3]);
            float r = b1 ? a1 : a0; r += dpp_f<0x4E>(b1 ? a0 : a1);
            r += dpp_f<0x124>(r); r += dpp_f<0x128>(r);
            r += __shfl_xor(r, 16);
            if (l32 < 4) sc[lmap * 256 + 2 * (it0 + i) + hf] = r * 0.08838834764831845f; }
    }
#pragma unroll
    for (int l = 0; l < 4; ++l) { float vv[4]; float mx = -3.0e38f;
#pragma unroll
        for (int i = 0; i < 4; ++i) { vv[i] = sc[l * 256 + lane + 64 * i]; mx = fmaxf(mx, vv[i]); }
        mx = wave_max(mx); float sm = 0.f;
#pragma unroll
        for (int i = 0; i < 4; ++i) { vv[i] = __expf(vv[i] - mx); sm += vv[i]; }
        const float inv = 1.f / wave_sum(sm);
#pragma unroll
        for (int i = 0; i < 4; ++i) sc[l * 256 + lane + 64 * i] = vv[i] * inv; }
    f32x4 o[4];
#pragma unroll
    for (int l = 0; l < 4; ++l) o[l] = (f32x4){0.f, 0.f, 0.f, 0.f};
    for (int it0 = 0; it0 < 128; it0 += 16) {
        f32x4 vv[16];
#pragma unroll
        for (int i = 0; i < 16; ++i) vv[i] = __builtin_nontemporal_load((const f32x4*)(Vb + (size_t)(it0 + i) * 1024));
#pragma unroll
        for (int i = 0; i < 16; ++i) { const int m = 2 * (it0 + i) + hf;
#pragma unroll
            for (int l = 0; l < 4; ++l) o[l] += vv[i] * sc[l * 256 + m]; }
    }
#pragma unroll
    for (int l = 0; l < 4; ++l) { f32x4 t = o[l];
        t.x += __shfl_xor(t.x, 32); t.y += __shfl_xor(t.y, 32); t.z += __shfl_xor(t.z, 32); t.w += __shfl_xor(t.w, 32);
        if (hf == 0) { u32x2 ov; ov.x = pk2(t.x, t.y); ov.y = pk2(t.z, t.w); *(u32x2*)(P + (rowb + l) * INC + C_XQ + h * 128 + 4 * l32) = ov; } }
}
DEV void sgu_s_wave(const Params& p, int b, int lane) {
    const size_t rowb = (size_t)NP + b * 4;
    bf16_t* P = (bf16_t*)(p.ws + OFF_P);
    const int gq = lane >> 4;
    float vn[4][8];
    const f32x4 l0 = *(const f32x4*)(p.sg_ln_g + 8 * lane), l1 = *(const f32x4*)(p.sg_ln_g + 8 * lane + 4);
    const float lng[8] = {l0.x, l0.y, l0.z, l0.w, l1.x, l1.y, l1.z, l1.w};
#pragma unroll
    for (int r = 0; r < 4; ++r) { float x[8]; unpack8(*(const u32x4*)(P + (rowb + r) * INC + C_SV + 8 * lane), x);
        float sm = 0.f;
#pragma unroll
        for (int i = 0; i < 8; ++i) sm += x[i];
        const float mean = wave_sum(sm) * (1.f / 512.f); float s2 = 0.f;
#pragma unroll
        for (int i = 0; i < 8; ++i) { x[i] -= mean; s2 += x[i] * x[i]; }
        const float rstd = rsqrtf(wave_sum(s2) * (1.f / 512.f) + EPS);
#pragma unroll
        for (int i = 0; i < 8; ++i) vn[r][i] = x[i] * rstd * lng[i];
        float* o = p.out + O_SGV + ((size_t)b * 4 + r) * 512 + 8 * lane;
        *(f32x4*)o = (f32x4){vn[r][0], vn[r][1], vn[r][2], vn[r][3]}; *(f32x4*)(o + 4) = (f32x4){vn[r][4], vn[r][5], vn[r][6], vn[r][7]}; }
#pragma unroll
    for (int t = 0; t < 4; ++t) { float mx[8];
#pragma unroll
        for (int i = 0; i < 8; ++i) mx[i] = p.sg_bs[gq * 128 + t];
#pragma unroll
        for (int s2 = 0; s2 < 4; ++s2) if (s2 <= t) { const float wv = p.sg_ws[(size_t)(gq * 128 + t) * 128 + s2];
#pragma unroll
            for (int i = 0; i < 8; ++i) mx[i] += wv * vn[s2][i]; }
        bf16_t* up = P + (rowb + t) * INC + C_SU + 8 * lane; float u[8]; unpack8(*(const u32x4*)up, u);
        u32x4 ov; ov.x = pk2(u[0] * mx[0], u[1] * mx[1]); ov.y = pk2(u[2] * mx[2], u[3] * mx[3]); ov.z = pk2(u[4] * mx[4], u[5] * mx[5]); ov.w = pk2(u[6] * mx[6], u[7] * mx[7]);
        *(u32x4*)up = ov; }
}

DEV void rms_phase(const Params& p, bool final_) {
    const int lane = otid() & 63, gw = obid() * 8 + (otid() >> 6), NGW = gridDim.x * 8;
    const float* g = final_ ? p.norm_final_g : p.norm_ffn_g;
    const float* part = (const float*)(p.ws + (final_ ? OFF_PART10 : OFF_PART6)); const int npart = final_ ? 22 : 8;
    for (int r = gw; r < MT; r += NGW) {
        float* xr = p.out + (size_t)r * 1024;
        f32x4 v[4]; float s = 0.f;
        if (r < NP) {
            const float* xin = p.x_prompt + (size_t)r * 1024; const bf16_t* sc = (const bf16_t*)xr;
            u32x2 mx[4], fx[4];
#pragma unroll
            for (int j = 0; j < 4; ++j) { v[j] = __builtin_nontemporal_load((const f32x4*)(xin + 4 * lane + 256 * j)); mx[j] = __builtin_nontemporal_load((const u32x2*)(sc + 1024 + 4 * lane + 256 * j)); fx[j] = final_ ? __builtin_nontemporal_load((const u32x2*)(sc + 4 * lane + 256 * j)) : (u32x2){0u, 0u}; }
#pragma unroll
            for (int j = 0; j < 4; ++j) { v[j].x += bf_lo(mx[j].x) + bf_lo(fx[j].x); v[j].y += bf_hi(mx[j].x) + bf_hi(fx[j].x); v[j].z += bf_lo(mx[j].y) + bf_lo(fx[j].y); v[j].w += bf_hi(mx[j].y) + bf_hi(fx[j].y); }
        } else {
            const float* base = final_ ? xr : p.x_sample + (size_t)(r - NP) * 1024;
#pragma unroll
            for (int j = 0; j < 4; ++j) v[j] = *(const f32x4*)(base + 4 * lane + 256 * j);
            for (int k = 0; k < npart; ++k) { const float* pr = part + (size_t)k * SROWS + (size_t)(r - NP) * 1024;
#pragma unroll
                for (int j = 0; j < 4; ++j) v[j] += *(const f32x4*)(pr + 4 * lane + 256 * j); }
            if (!final_) {
#pragma unroll
                for (int j = 0; j < 4; ++j) *(f32x4*)(xr + 4 * lane + 256 * j) = v[j]; }
        }
#pragma unroll
        for (int j = 0; j < 4; ++j) s += v[j].x * v[j].x + v[j].y * v[j].y + v[j].z * v[j].z + v[j].w * v[j].w;
        s = wave_sum(s); const float rr = rsqrtf(s * (1.f / 1024.f) + EPS);
        if (final_) {
#pragma unroll
            for (int j = 0; j < 4; ++j) { const f32x4 gv = *(const f32x4*)(g + 4 * lane + 256 * j); *(f32x4*)(xr + 4 * lane + 256 * j) = v[j] * rr * gv; }
        } else { bf16_t* orow = (bf16_t*)(p.ws + OFF_R2) + (size_t)r * 1024;
#pragma unroll
            for (int j = 0; j < 4; ++j) { const f32x4 gv = *(const f32x4*)(g + 4 * lane + 256 * j);
                u32x2 o; o.x = pk2(v[j].x * rr * gv.x, v[j].y * rr * gv.y); o.y = pk2(v[j].z * rr * gv.z, v[j].w * rr * gv.w);
                *(u32x2*)(orow + 4 * lane + 256 * j) = o; } }
    }
}
DEV void conv_phase(const Params& p) {
    const bf16_t* z = (const bf16_t*)(p.ws + OFF_Z); bf16_t* act = (bf16_t*)(p.ws + OFF_ACT);
    const int gtid = obid() * 512 + otid(), NT = gridDim.x * 512;
    for (int idx = gtid; idx < (NP / 8) * 352; idx += NT) {
        const int rb = idx / 352, ch = idx - rb * 352, c = ch * 8, r0 = rb * 8;
        float wa[3][8], wb[3][8], ba[8], bb[8];
#pragma unroll
        for (int j = 0; j < 3; ++j) { const f32x4 a0 = *(const f32x4*)(p.conv_w + j * FF2 + c), a1 = *(const f32x4*)(p.conv_w + j * FF2 + c + 4), b0 = *(const f32x4*)(p.conv_w + j * FF2 + FF + c), b1 = *(const f32x4*)(p.conv_w + j * FF2 + FF + c + 4);
#pragma unroll
            for (int i = 0; i < 4; ++i) { wa[j][i] = a0[i]; wa[j][4 + i] = a1[i]; wb[j][i] = b0[i]; wb[j][4 + i] = b1[i]; } }
        { const f32x4 a0 = *(const f32x4*)(p.conv_b + c), a1 = *(const f32x4*)(p.conv_b + c + 4), b0 = *(const f32x4*)(p.conv_b + FF + c), b1 = *(const f32x4*)(p.conv_b + FF + c + 4);
#pragma unroll
          for (int i = 0; i < 4; ++i) { ba[i] = a0[i]; ba[4 + i] = a1[i]; bb[i] = b0[i]; bb[4 + i] = b1[i]; } }
        u32x4 ra[10], rbq[10];
        const bool first = (r0 & 2047) == 0;
#pragma unroll
        for (int k = 0; k < 10; ++k) { const int rr = r0 - 2 + k;
            if (k < 2 && first) { ra[k] = (u32x4){0u, 0u, 0u, 0u}; rbq[k] = ra[k]; }
            else { ra[k] = *(const u32x4*)(z + (size_t)rr * FF2 + c); rbq[k] = *(const u32x4*)(z + (size_t)rr * FF2 + FF + c); } }
        float xa[3][8], xb[3][8];
        unpack8(ra[0], xa[0]); unpack8(rbq[0], xb[0]); unpack8(ra[1], xa[1]); unpack8(rbq[1], xb[1]);
#pragma unroll
        for (int k = 0; k < 8; ++k) {
            unpack8(ra[k + 2], xa[(k + 2) % 3]); unpack8(rbq[k + 2], xb[(k + 2) % 3]);
            float o[8];
#pragma unroll
            for (int i = 0; i < 8; ++i) {
                const float za = ba[i] + wa[0][i] * xa[k % 3][i] + wa[1][i] * xa[(k + 1) % 3][i] + wa[2][i] * xa[(k + 2) % 3][i];
                const float zb = bb[i] + wb[0][i] * xb[k % 3][i] + wb[1][i] * xb[(k + 1) % 3][i] + wb[2][i] * xb[(k + 2) % 3][i];
                o[i] = gelu_t(za) * zb; }
            u32x4 ov; ov.x = pk2(o[0], o[1]); ov.y = pk2(o[2], o[3]); ov.z = pk2(o[4], o[5]); ov.w = pk2(o[6], o[7]);
            *(u32x4*)(act + (size_t)(r0 + k) * FF + c) = ov; }
    }
    for (int idx = gtid; idx < NS * 352; idx += NT) {
        const int rs = idx / 352, ch = idx - rs * 352, c = ch * 8, r = NP + rs, tpos = rs & 3;
        float za[8], zb[8];
#pragma unroll
        for (int i = 0; i < 8; ++i) { za[i] = p.conv_b[c + i]; zb[i] = p.conv_b[FF + c + i]; }
#pragma unroll
        for (int j = 0; j < 3; ++j) {
            const int tp = tpos - 2 + j;
            float xa[8], xb[8];
            if (tp >= 0) { unpack8(*(const u32x4*)(z + (size_t)(r - 2 + j) * FF2 + c), xa); unpack8(*(const u32x4*)(z + (size_t)(r - 2 + j) * FF2 + FF + c), xb); }
            else { const float* sp = p.state_conv + ((size_t)(rs >> 2) * 2 + (tp + 2)) * FF2;
#pragma unroll
                for (int i = 0; i < 8; ++i) { xa[i] = sp[c + i]; xb[i] = sp[FF + c + i]; } }
#pragma unroll
            for (int i = 0; i < 8; ++i) { za[i] += p.conv_w[j * FF2 + c + i] * xa[i]; zb[i] += p.conv_w[j * FF2 + FF + c + i] * xb[i]; }
        }
        u32x4 o; o.x = pk2(gelu_t(za[0]) * zb[0], gelu_t(za[1]) * zb[1]); o.y = pk2(gelu_t(za[2]) * zb[2], gelu_t(za[3]) * zb[3]);
        o.z = pk2(gelu_t(za[4]) * zb[4], gelu_t(za[5]) * zb[5]); o.w = pk2(gelu_t(za[6]) * zb[6], gelu_t(za[7]) * zb[7]);
        *(u32x4*)(act + (size_t)r * FF + c) = o;
    }
}

#define XB_TMO      128
#define XB_XCNT(j)  (256  + 64 * (j))
#define XB_XSUB(j)  (1280 + 64 * (j))
#define XB_XGEN(j)  (2304 + 64 * (j))
#define XB_TOP      3328
#define XB_TOPGEN   3392
#define XCD_BAR_WORDS 3456
#define XB_SPIN_CAP (1u << 18)
DEV unsigned xb_ld(unsigned* p)              { return __hip_atomic_load(p, __ATOMIC_RELAXED, __HIP_MEMORY_SCOPE_AGENT); }
DEV unsigned xb_add(unsigned* p, unsigned v) { return __hip_atomic_fetch_add(p, v, __ATOMIC_RELAXED, __HIP_MEMORY_SCOPE_AGENT); }
DEV unsigned xb_xcc_id() { return (unsigned)__builtin_amdgcn_s_getreg((3 << 11) | 20) & 0xFu; }
#define XB_SPIN(cond, bar) do { unsigned _sp = 0; while (cond) { __builtin_amdgcn_s_sleep(1); \
    if ((++_sp & 255u) == 0u) { if (xb_ld(&(bar)[XB_TMO])) break; if (_sp > XB_SPIN_CAP) { atomicAdd(&(bar)[XB_TMO], 1u); break; } } } } while (0)
struct XcdBarrier { unsigned* bar; unsigned x; volatile LAS unsigned* st; };
DEV XcdBarrier xcd_barrier_post(unsigned* bar, volatile LAS unsigned* st) {
    XcdBarrier b; b.bar = bar; b.x = xb_xcc_id(); b.st = st;
    if (threadIdx.x == 0) (void)xb_add(&bar[XB_XCNT(b.x)], 1u);
    return b; }
DEV void xcd_barrier_complete(unsigned* bar, unsigned x, unsigned& nloc, unsigned& nx) {
    const unsigned G = gridDim.x * gridDim.y * gridDim.z;
    unsigned sum, cnt, mine, sp = 0u;
    for (;;) {
        sum = 0u; cnt = 0u; mine = 0u;
#pragma unroll
        for (unsigned j = 0; j < 16; ++j) { const unsigned c = xb_ld(&bar[XB_XCNT(j)]); sum += c; cnt += (c > 0u) ? 1u : 0u; mine = (j == x) ? c : mine; }
        if (sum == G) break;
        __builtin_amdgcn_s_sleep(1);
        if ((++sp & 255u) == 0u) { if (xb_ld(&bar[XB_TMO])) break; if (sp > XB_SPIN_CAP) { atomicAdd(&bar[XB_TMO], 1u); break; } }
    }
    nloc = mine > 0u ? mine : 1u; nx = cnt > 0u ? cnt : 1u; }
DEV void xcd_barrier(unsigned* bar_, volatile LAS unsigned* st_) {
    XcdBarrier b; b.bar = bar_; b.x = xb_xcc_id(); b.st = st_;
    asm volatile("s_waitcnt vmcnt(0)" ::: "memory");
    __syncthreads();
    if (threadIdx.x == 0) {
        unsigned* bar = b.bar;
        __builtin_amdgcn_s_waitcnt(0);
        unsigned nloc = b.st[0], nx = b.st[1];
        if (nloc == 0u) { xcd_barrier_complete(bar, b.x, nloc, nx); b.st[0] = nloc; b.st[1] = nx; }
        const unsigned old = xb_add(&bar[XB_XSUB(b.x)], 1u);
        const unsigned gen = old / nloc;
        if (old + 1u == (gen + 1u) * nloc) {
            __builtin_amdgcn_fence(__ATOMIC_RELEASE, "agent");
            asm volatile("s_waitcnt vmcnt(0)" ::: "memory");
            const unsigned og = xb_add(&bar[XB_TOP], 1u);
            const unsigned tg = og / nx;
            if (og + 1u == (tg + 1u) * nx) xb_add(&bar[XB_TOPGEN], 1u);
            else XB_SPIN(xb_ld(&bar[XB_TOPGEN]) == tg, bar);
            __builtin_amdgcn_fence(__ATOMIC_ACQUIRE, "agent");
            xb_add(&bar[XB_XGEN(b.x)], 1u);
            asm volatile("s_waitcnt vmcnt(0)" ::: "memory");
        } else {
            XB_SPIN(xb_ld(&bar[XB_XGEN(b.x)]) == gen, bar);
            __builtin_amdgcn_fence(__ATOMIC_ACQUIRE, "agent");
            asm volatile("s_waitcnt vmcnt(0)" ::: "memory");
        }
    }
    __syncthreads();
}

DEV Params kp_load() { Params r{};
#if defined(__HIP_DEVICE_COMPILE__)
    typedef const unsigned long long __attribute__((address_space(4))) KA;
    KA* q = (KA*)__builtin_amdgcn_kernarg_segment_ptr(); asm volatile("" : "+s"(q));
    unsigned long long t[28];
#pragma unroll
    for (int i = 0; i < 28; ++i) t[i] = q[i];
    __builtin_memcpy(&r, t, sizeof(Params));
#endif
    return r; }
__global__ __launch_bounds__(512, 2) void mega(Params p_arg, int ph0, int ph1) {
    extern __shared__ __attribute__((aligned(16))) unsigned char shm[];
    LAS unsigned char* lds = (LAS unsigned char*)shm;
    cg::grid_group grid = cg::this_grid();
#ifndef TIME_SEL
#define TIME_SEL 0
#endif
    unsigned long long tacc = 0;
    const int G = gridDim.x, c = obid();
    volatile LAS unsigned* xst = (volatile LAS unsigned*)(lds + LDS_BYTES - 16);
    if (threadIdx.x == 0) { xst[0] = 0u; xst[1] = 0u; }
    __syncthreads();
    (void)xcd_barrier_post((unsigned*)(kp_load().ws + OFF_BAR), xst);
#ifndef DUP_PH
#define DUP_PH -1
#endif
#ifndef PH_TIME_MASK
#define PH_TIME_MASK 0
#endif
#define PH_BEGIN(k) if (ph0 <= (k) && (k) < ph1) { const unsigned long long tph_ = ((PH_TIME_MASK) >> (k)) & 1 ? __builtin_amdgcn_s_memrealtime() : 0ull; if (PHON(k)) { for (int rep_ = 0; rep_ < ((k) == DUP_PH ? 2 : 1); ++rep_) { const Params p = kp_load(); unsigned char* ws = p.ws;
#define PH_END(k) } } if ((k) + 1 < ph1) { if ((k) == 0) grid.sync(); else xcd_barrier((unsigned*)(kp_load().ws + OFF_BAR), (volatile LAS unsigned*)(lds + LDS_BYTES - 16)); } if (((PH_TIME_MASK) >> (k)) & 1) tacc += __builtin_amdgcn_s_memrealtime() - tph_; }
    PH_BEGIN(0) phase_prep(p, lds); PH_END(0)
    PH_BEGIN(1)
            Sched1 S{G, c, (const char*)(ws + OFF_R2), (const char*)(ws + OFF_HM), (const char*)(ws + OFF_BTIN), (const char*)(ws + OFF_BTKV)};
            Epi1 E{(bf16_t*)(ws + OFF_P), (bf16_t*)(ws + OFF_MKB), p.out, (const float*)(ws + OFF_ROPEC), (const float*)(ws + OFF_ROPES), p.b_gate};
            pg8::gemm_phase(lds, 1024, 1024, S, E);
    PH_END(1)
    PH_BEGIN(2)
            for (int it = c; it < 1536; it += G) {
                if (it < 512) ret_A_item(p, lds, it);
                else if (it < 1024) xattn_item(p, lds, it - 512);
                else sgu_item(p, lds, it - 1024);
            }
            {
                const int tid2 = otid(), w2 = __builtin_amdgcn_readfirstlane(tid2 >> 6), lane2 = tid2 & 63;
                if (w2 < 2) ret_s_wave(p, c + 256 * w2, lane2);
                else if (w2 < 4) xattn_s_wave(p, (LAS float*)(lds + 4096 * w2), c + 256 * (w2 - 2), lane2);
                else if (w2 == 4 && c < 128) sgu_s_wave(p, c, lane2);
            }
    PH_END(2)
    PH_BEGIN(3)
            scan_phase(p);
            SchedMgS S{c, (const char*)(ws + OFF_P), (const char*)(ws + OFF_BTMG)};
            EpiMgS E{(const bf16_t*)(ws + OFF_P), (float*)(ws + OFF_MG32)};
            pg8::gemm_phase(lds, INC, 2048, S, E);
    PH_END(3)
    PH_BEGIN(4) for (int it = c; it < 512; it += G) ret_C_item(p, lds, it); PH_END(4)
    PH_BEGIN(5)
            {
                const int i = obid() * 512 + otid();
                if (i < 131072) { f32x4 m = ((const f32x4*)(ws + OFF_MG32))[i];
#pragma unroll
                    for (int k = 1; k < 8; ++k) m += ((const f32x4*)(ws + OFF_MG32))[(size_t)k * 131072 + i];
                    u32x2 o; o.x = pk2(m.x, m.y); o.y = pk2(m.z, m.w);
                    ((u32x2*)((bf16_t*)(ws + OFF_R2) + (size_t)NP * 1024))[i] = o; } }
            SchedMg S{G, c, (const char*)(ws + OFF_P), (const char*)(ws + OFF_BTMG)};
            EpiMg E{(const bf16_t*)(ws + OFF_P), (bf16_t*)(ws + OFF_R2)};
            pg8::gemm_phase(lds, INC, 2048, S, E);
    PH_END(5)
    PH_BEGIN(6)
            SchedPS<16, 64, 8, 524288, 524288> S{G, c, (const char*)(ws + OFF_R2), (const char*)(ws + OFF_BTO)};
            EpiWo E{p.x_prompt, p.x_sample, p.out, (float*)(ws + OFF_PART6)};
            pg8::gemm_phase(lds, 1024, 1024, S, E);
    PH_END(6)
    PH_BEGIN(7) rms_phase(p, false); PH_END(7)
    PH_BEGIN(8)
            SchedPlain S{G, c, 66, 22, 16, (const char*)(ws + OFF_R2), (const char*)(ws + OFF_BTUP), (size_t)524288, (size_t)524288};
            EpiUp E{(bf16_t*)(ws + OFF_Z), p.out};
            pg8::gemm_phase(lds, 1024, 1024, S, E);
    PH_END(8)
    PH_BEGIN(9) conv_phase(p); PH_END(9)
    PH_BEGIN(10)
            SchedPS<44, 176, 22, 256 * FF * 2, 256 * FF * 2> S{G, c, (const char*)(ws + OFF_ACT), (const char*)(ws + OFF_BTDN)};
            EpiDn E{p.out, (float*)(ws + OFF_PART10)};
            pg8::gemm_phase(lds, FF, FF, S, E);
    PH_END(10)
    PH_BEGIN(11) rms_phase(p, true); PH_END(11)
    if (((TIME_SEL) || (PH_TIME_MASK)) && blockIdx.x == 0 && ph1 > 1) { const unsigned long long t0_ = __builtin_amdgcn_s_memrealtime(); while (__builtin_amdgcn_s_memrealtime() - t0_ < tacc) __builtin_amdgcn_s_sleep(8); }
}

extern "C" void kernel_launch(void* const* d_in, const int* in_sizes, int n_in, void* d_out, int out_size, void* d_ws, size_t ws_size, hipStream_t stream) {
    static int grid = 0;
    if (grid == 0) {
        if (n_in != 26 || out_size != 39018496 || ws_size < WS_END2) { fprintf(stderr, "kernel_launch: unexpected shapes n_in %d out %d ws %zu (need %zu)\n", n_in, out_size, ws_size, (size_t)WS_END2); grid = -1; return; }
        int dev = 0, cus = 0, per_cu = 0;
        hipGetDevice(&dev); hipDeviceGetAttribute(&cus, hipDeviceAttributeMultiprocessorCount, dev);
        if (hipFuncSetAttribute((const void*)mega, hipFuncAttributeMaxDynamicSharedMemorySize, LDS_BYTES) != hipSuccess) { fprintf(stderr, "kernel_launch: hipFuncSetAttribute failed\n"); grid = -1; return; }
        if (hipOccupancyMaxActiveBlocksPerMultiprocessor(&per_cu, (const void*)mega, 512, LDS_BYTES) != hipSuccess || per_cu < 1) { fprintf(stderr, "kernel_launch: occupancy query gave %d\n", per_cu); grid = -1; return; }
        if (cus != 256) { fprintf(stderr, "kernel_launch: built for 256 CUs, got %d\n", cus); grid = -1; return; }
        grid = cus;
    }
    if (grid < 0) return;
    Params p{};
    const float** f = (const float**)&p;
    for (int i = 0; i < 26; ++i) f[i] = (const float*)d_in[i];
    p.out = (float*)d_out; p.ws = (unsigned char*)d_ws;
#ifndef DBG_NPH
#define DBG_NPH 12
#endif
#ifndef MK_MULTI
#define MK_MULTI 0
#endif
#if MK_MULTI
#ifndef PH_SEQ
#define PH_SEQ 0,1,2,3,4,5,6,7,8,9,10,11
#endif
    { const int seq[] = {PH_SEQ}; for (int ph : seq) hipLaunchKernelGGL(mega, dim3(grid), dim3(512), LDS_BYTES, stream, p, ph, ph + 1); }
    hipError_t e = hipSuccess;
#else
    (void)hipMemsetAsync((unsigned char*)d_ws + OFF_BAR, 0, 16384, stream);
    int ph0 = 0, ph1 = NPHASE;
    void* args[] = {&p, &ph0, &ph1};
    hipError_t e = hipLaunchCooperativeKernel((const void*)mega, dim3(grid), dim3(512), args, LDS_BYTES, stream);
#endif
    if (e != hipSuccess) fprintf(stderr, "cooperative launch failed: %s (grid %d)\n", hipGetErrorString(e), grid);
}
```

```cpp
#include <hip/hip_runtime.h>
#include <hip/hip_cooperative_groups.h>
#include <cstdio>
#include <cstdint>
namespace cg = cooperative_groups;

#define LAS __attribute__((address_space(3)))
#define DEV __device__ __forceinline__
typedef unsigned short bf16_t;
typedef short bf16x8 __attribute__((ext_vector_type(8)));
typedef short s16x4 __attribute__((ext_vector_type(4)));
typedef float f32x4 __attribute__((ext_vector_type(4)));
typedef unsigned u32x4 __attribute__((ext_vector_type(4)));
typedef unsigned u32x2 __attribute__((ext_vector_type(2)));

constexpr int NP = 16384, NS = 512, MT = 16896, INC = 7680, FF = 2816, FF2 = 5632;
constexpr int C_Q = 0, C_K = 512, C_V = 1024, C_G = 2048, C_SU = 3072, C_XQ = 3584, C_SV = 4096, C_GT = 4608;
constexpr float EPS = 1e-6f;
constexpr size_t OFF_BTIN = 0;
constexpr size_t OFF_BTKV = OFF_BTIN + 15728640;
constexpr size_t OFF_BTMG = OFF_BTKV + 2097152;
constexpr size_t OFF_BTO = OFF_BTMG + 4194304;
constexpr size_t OFF_BTUP = OFF_BTO + 2097152;
constexpr size_t OFF_BTDN = OFF_BTUP + 11534336;
constexpr size_t OFF_ROPEC = OFF_BTDN + 5767168;
constexpr size_t OFF_ROPES = OFF_ROPEC + 525312;
constexpr size_t OFF_WTRIL = OFF_ROPES + 525312;
constexpr size_t OFF_HM = OFF_WTRIL + 131072;
constexpr size_t OFF_MKB = OFF_HM + 4194304;
constexpr size_t OFF_P = OFF_MKB + 4194304;
constexpr size_t OFF_R2 = OFF_P + 259522560;
constexpr size_t OFF_MG32 = OFF_R2 + 34603008;
constexpr size_t WS_END = OFF_MG32 + 8 * 2097152;
constexpr size_t OFF_BAR = WS_END;
constexpr size_t WS_END2 = OFF_BAR + 16384;
constexpr size_t OFF_PART6 = OFF_P, OFF_PART10 = OFF_P;
constexpr int SROWS = 512 * 1024;
constexpr size_t OFF_Z = OFF_P;
constexpr size_t OFF_ACT = OFF_P + 190316544;
constexpr size_t O_Y = 0, O_RETP = 17301504, O_CONVP = 18350080, O_MK = 18440192, O_MV = 19488768, O_RETS = 20537344, O_CONVS = 37314560, O_SGV = 38756352;
constexpr int LDS_BYTES = 147456;
constexpr int NPHASE = 12;
#ifndef DBG_XA
#define DBG_XA 3
#endif
#ifndef ONLY_PH
#define ONLY_PH -1
#endif
#ifndef SKIP_PH
#define SKIP_PH -2
#endif
#define PHON(n) ((ONLY_PH < 0 || ONLY_PH == (n)) && SKIP_PH != (n))

struct Params {
    const float *x_prompt, *x_sample, *mem_prompt, *state_ret, *state_conv, *cache_k, *cache_v, *norm_mix_g, *w_in, *b_gate, *ret_gn_g, *sg_ln_g, *sg_ws, *sg_bs,
        *mem_norm_g, *w_mem_kv, *w_br_ret, *w_br_sg, *w_br_x, *w_o, *norm_ffn_g, *w_up, *conv_w, *conv_b, *w_down, *norm_final_g;
    float* out; unsigned char* ws;
};

typedef __bf16 bf16v2_t __attribute__((ext_vector_type(2)));
typedef float f32x2_t __attribute__((ext_vector_type(2)));
DEV unsigned pk2(float lo, float hi) { const f32x2_t f = {lo, hi}; const bf16v2_t v = __builtin_convertvector(f, bf16v2_t); return __builtin_bit_cast(unsigned, v); }
DEV bf16_t f2bf(float v) { return (bf16_t)(pk2(v, 0.f) & 0xffffu); }
DEV float bf_lo(unsigned u) { return __uint_as_float(u << 16); }
DEV float bf_hi(unsigned u) { return __uint_as_float(u & 0xffff0000u); }
DEV float bf2f(bf16_t b) { return __uint_as_float(((unsigned)b) << 16); }
DEV void unpack8(const u32x4 a, float (&x)[8]) { x[0] = bf_lo(a.x); x[1] = bf_hi(a.x); x[2] = bf_lo(a.y); x[3] = bf_hi(a.y); x[4] = bf_lo(a.z); x[5] = bf_hi(a.z); x[6] = bf_lo(a.w); x[7] = bf_hi(a.w); }
template <int CTRL> DEV float dpp_f(float v) { return __int_as_float(__builtin_amdgcn_update_dpp(0, __float_as_int(v), CTRL, 0xF, 0xF, true)); }
DEV float rdl(float v, int l) { return __int_as_float(__builtin_amdgcn_readlane(__float_as_int(v), l)); }
DEV float g16_sum(float v) { v += dpp_f<0xB1>(v); v += dpp_f<0x4E>(v); v += dpp_f<0x141>(v); v += dpp_f<0x140>(v); return v; }
DEV float g16_max(float v) { v = fmaxf(v, dpp_f<0xB1>(v)); v = fmaxf(v, dpp_f<0x4E>(v)); v = fmaxf(v, dpp_f<0x141>(v)); v = fmaxf(v, dpp_f<0x140>(v)); return v; }
DEV float wave_sum(float v) { v = g16_sum(v); return (rdl(v, 0) + rdl(v, 16)) + (rdl(v, 32) + rdl(v, 48)); }
DEV float wave_max(float v) { v = g16_max(v); return fmaxf(fmaxf(rdl(v, 0), rdl(v, 16)), fmaxf(rdl(v, 32), rdl(v, 48))); }
DEV float sigm_f(float x) { return __builtin_amdgcn_rcpf(1.f + __builtin_amdgcn_exp2f(-1.4426950408889634f * x)); }
DEV float silu_f(float x) { return x * sigm_f(x); }
DEV float gelu_t(float x) { const float u = x * (2.3022081646f + 0.1029432406f * x * x); return x * __builtin_amdgcn_rcpf(1.f + __builtin_amdgcn_exp2f(-u)); }
DEV float log_gamma(int h) { return log1pf(-exp2f(-5.f - (float)h)); }
DEV int otid() { int t = threadIdx.x; asm volatile("" : "+v"(t)); return t; }
DEV int obid() { int t = blockIdx.x; asm volatile("" : "+s"(t)); return t; }
DEV unsigned ldsaddr(LAS const void* p) { return (unsigned)(uintptr_t)p; }
DEV f32x4 mfma16(bf16x8 a, bf16x8 b, f32x4 c) { return __builtin_amdgcn_mfma_f32_16x16x32_bf16(a, b, c, 0, 0, 0); }
DEV bf16x8 lds_frag(LAS const unsigned char* base, int pitch, int row0, int k0, int lane) {
    return *(LAS const bf16x8*)(base + (row0 + (lane & 15)) * pitch + (k0 + 8 * (lane >> 4)) * 2); }
DEV LAS const unsigned char* tr_lane_base(LAS const unsigned char* base, int pitch, int lane) { const int g = lane >> 4, q = (lane & 15) >> 2, pp = lane & 3; return base + ((8 * g + q) * pitch + 8 * pp); }
template <int PITCH, int KB, int X0> DEV void tr_read4(LAS const unsigned char* a, bf16x8 (&f)[4]) {
    constexpr int o0 = KB * PITCH + X0 * 2;
    static_assert(o0 + 100 * PITCH < 65536, "ds offset field");
#pragma unroll
    for (int ks = 0; ks < 4; ++ks) {
        const s16x4 lo = __builtin_amdgcn_ds_read_tr16_b64_v4i16((LAS s16x4*)(a + o0 + ks * 32 * PITCH));
        const s16x4 hi = __builtin_amdgcn_ds_read_tr16_b64_v4i16((LAS s16x4*)(a + o0 + ks * 32 * PITCH + 4 * PITCH));
        f[ks] = (bf16x8){lo[0], lo[1], lo[2], lo[3], hi[0], hi[1], hi[2], hi[3]}; } }
template <int V> struct IC { static constexpr int value = V; };
template <int I, int N, class F> DEV void static_for(F&& f) { if constexpr (I < N) { f(IC<I>{}); static_for<I + 1, N>(f); } }
#define SCHEDB __builtin_amdgcn_sched_barrier(0)

namespace pg8 {
constexpr int BM = 256, BK = 64, HALF = 128, HTB = HALF * BK * 2, NXCD = 8, WGM = 8;
DEV int lds_byte(int r, int c) { const int st = (r >> 4) * 2 + (c >> 5), rr = r & 15, cc = c & 31, ob = rr * 64 + cc * 2; return st * 1024 + (ob ^ (((ob >> 9) & 1) << 5)); }
DEV void stage_rc(int b, int& R, int& C) { const int st = b / 1024, sb = b % 1024, swz = sb ^ (((sb >> 9) & 1) << 5); R = (st >> 1) * 16 + swz / 64; C = (st & 1) * 32 + (swz % 64) / 2; }
DEV int perm32(int rho) { const int n = rho >> 4, i = rho & 15; return 8 * (i >> 2) + 4 * n + (i & 3); }
struct Unit { int pm, pn, kind, nt; const char* A; const char* B; };
DEV void tile_map(int L, int nM, int nN, int& pm, int& pn) {
    const int nwg = nM * nN; int wgid = L; { const int q = nwg / NXCD, r = nwg % NXCD, xcd = wgid % NXCD, off = wgid / NXCD; wgid = (xcd < r ? xcd * (q + 1) : r * (q + 1) + (xcd - r) * q) + off; }
    const int nig = WGM * nN, gid = wgid / nig, fm = gid * WGM, gsz = (nM - fm) < WGM ? (nM - fm) : WGM;
    pm = fm + ((wgid % nig) % gsz); pn = (wgid % nig) / gsz; }

template <class Epi, class Sched>
DEV void gemm_phase(LAS unsigned char* lds, int lda, int ldb, const Sched& S, const Epi& E) {
    const int tid = otid(), wid = __builtin_amdgcn_readfirstlane(tid >> 6), lane = tid & 63, wr = wid >> 2, wc = wid & 3, fr = lane & 15, fq = lane >> 4;
    unsigned voffA[2], voffB[2];
#pragma unroll
    for (int i = 0; i < 2; ++i) { int R, C; stage_rc(tid * 16 + i * 8192, R, C); const int Rb = (R & ~31) + perm32(R & 31);
        voffA[i] = (unsigned)(R * lda + C) * 2u; voffB[i] = (unsigned)(Rb * ldb + C) * 2u; }
    const size_t kstep = (size_t)(BK * 2);
    const size_t hstepA = (size_t)HALF * lda * 2, hstepB = (size_t)HALF * ldb * 2;
    const unsigned ldsw = (unsigned)wid * 1024u;
    const int aoff = lds_byte(wr * 64 + fr, fq * 8), boff = lds_byte(wc * 32 + fr, fq * 8);
#define PG8_SA(b, h) (((b) * 2 + (h)) * HTB)
#define PG8_SB(b, h) ((4 + (b) * 2 + (h)) * HTB)
#define PG8_STAGE(bufoff, gbase, voff) do { _Pragma("unroll") for (int _i = 0; _i < 2; ++_i) \
        __builtin_amdgcn_global_load_lds((const unsigned*)((const char*)(gbase) + (voff)[_i]), (LAS unsigned*)(lds + (bufoff) + ldsw + _i * 8192), 16, 0, 0); } while (0)
#define PG8_LDA(dst, b, h) do { _Pragma("unroll") for (int m = 0; m < 4; ++m) _Pragma("unroll") for (int k = 0; k < 2; ++k) dst[m][k] = *(const LAS bf16x8*)(lds + PG8_SA(b, h) + aoff + m * 2048 + k * 1024); } while (0)
#define PG8_LDB(dst, b, h) do { _Pragma("unroll") for (int n = 0; n < 2; ++n) _Pragma("unroll") for (int k = 0; k < 2; ++k) dst[n][k] = *(const LAS bf16x8*)(lds + PG8_SB(b, h) + boff + n * 2048 + k * 1024); } while (0)
#define PG8_MMA(ai, bj, At, Bt) do { __builtin_amdgcn_s_setprio(1); _Pragma("unroll") for (int m = 0; m < 4; ++m) _Pragma("unroll") for (int n = 0; n < 2; ++n) _Pragma("unroll") for (int k = 0; k < 2; ++k) \
        acc[ai][bj][m][n] = __builtin_amdgcn_mfma_f32_16x16x32_bf16(Bt[n][k], At[m][k], acc[ai][bj][m][n], 0, 0, 0); __builtin_amdgcn_s_setprio(0); } while (0)
#define PG8_WAIT_V(n) asm volatile("s_waitcnt vmcnt(" #n ")" ::: "memory")
#define PG8_WAIT_L(n) asm volatile("s_waitcnt lgkmcnt(" #n ")" ::: "memory")
#define PG8_BAR __builtin_amdgcn_s_barrier()
#define PG8_SCHED __builtin_amdgcn_sched_barrier(0)
    Unit cur, nxt; int ui = 0;
    if (!S.next(0, cur)) return;
    f32x4 acc[2][2][4][2];
#pragma unroll
    for (int a = 0; a < 2; ++a)
#pragma unroll
        for (int b = 0; b < 2; ++b)
#pragma unroll
            for (int m = 0; m < 4; ++m)
#pragma unroll
                for (int n = 0; n < 2; ++n) acc[a][b][m][n] = (f32x4){0.f, 0.f, 0.f, 0.f};
    bf16x8 At[4][2], B0[2][2], B1[2][2];
    const char* cA = cur.A; const char* cB = cur.B;
    PG8_STAGE(PG8_SB(0, 0), cB, voffB); PG8_STAGE(PG8_SA(0, 0), cA, voffA); PG8_STAGE(PG8_SB(0, 1), cB + hstepB, voffB); PG8_STAGE(PG8_SA(0, 1), cA + hstepA, voffA);
    if (wr == 1) PG8_BAR;
    PG8_WAIT_V(4); PG8_BAR;
    PG8_STAGE(PG8_SB(1, 0), cB + kstep, voffB); PG8_STAGE(PG8_SA(1, 0), cA + kstep, voffA); PG8_STAGE(PG8_SB(1, 1), cB + hstepB + kstep, voffB);
    PG8_WAIT_V(6); PG8_BAR;
    for (;;) {
        const bool has_next = S.next(ui + 1, nxt);
        const char* nA = has_next ? nxt.A : cA; const char* nB = has_next ? nxt.B : cB;
        const int nt = cur.nt;
        for (int t = 0; t < nt; t += 2) {
            const bool last = (t == nt - 2);
            const char* a1 = cA + (size_t)(t + 1) * kstep;
            const char* a2 = last ? nA : cA + (size_t)(t + 2) * kstep; const char* b2 = last ? nB : cB + (size_t)(t + 2) * kstep;
            const char* a3 = a2 + kstep; const char* b3 = b2 + kstep;
            PG8_LDB(B0, 0, 0); PG8_SCHED; PG8_LDA(At, 0, 0); PG8_STAGE(PG8_SA(1, 1), a1 + hstepA, voffA);
            PG8_WAIT_L(8); PG8_BAR; PG8_WAIT_L(0); PG8_MMA(0, 0, At, B0); PG8_BAR; PG8_SCHED;
            PG8_LDB(B1, 0, 1); PG8_STAGE(PG8_SB(0, 0), b2, voffB);
            PG8_BAR; PG8_WAIT_L(0); PG8_MMA(0, 1, At, B1); PG8_BAR;
            PG8_LDA(At, 0, 1); PG8_STAGE(PG8_SA(0, 0), a2, voffA);
            PG8_BAR; PG8_WAIT_L(0); PG8_MMA(1, 0, At, B0); PG8_BAR; PG8_SCHED;
            PG8_STAGE(PG8_SB(0, 1), b2 + hstepB, voffB);
            PG8_WAIT_V(6); PG8_BAR; PG8_MMA(1, 1, At, B1); PG8_BAR;
            PG8_LDB(B0, 1, 0); PG8_SCHED; PG8_LDA(At, 1, 0); PG8_STAGE(PG8_SA(0, 1), a2 + hstepA, voffA);
            PG8_WAIT_L(8); PG8_BAR; PG8_WAIT_L(0); PG8_MMA(0, 0, At, B0); PG8_BAR; PG8_SCHED;
            PG8_LDB(B1, 1, 1); PG8_STAGE(PG8_SB(1, 0), b3, voffB);
            PG8_BAR; PG8_WAIT_L(0); PG8_MMA(0, 1, At, B1); PG8_BAR;
            PG8_LDA(At, 1, 1); PG8_STAGE(PG8_SA(1, 0), a3, voffA);
            PG8_BAR; PG8_WAIT_L(0); PG8_MMA(1, 0, At, B0); PG8_BAR; PG8_SCHED;
            PG8_STAGE(PG8_SB(1, 1), b3 + hstepB, voffB);
            PG8_WAIT_V(6); PG8_BAR; PG8_MMA(1, 1, At, B1); PG8_BAR;
        }
        const bool keep = E(acc, cur, wr, wc, fr, fq);
        if (!has_next) break;
        if (!keep)
#pragma unroll
        for (int a = 0; a < 2; ++a)
#pragma unroll
            for (int b = 0; b < 2; ++b)
#pragma unroll
                for (int m = 0; m < 4; ++m)
#pragma unroll
                    for (int n = 0; n < 2; ++n) acc[a][b][m][n] = (f32x4){0.f, 0.f, 0.f, 0.f};
        cur = nxt; cA = nA; cB = nB; ++ui;
    }
    PG8_WAIT_V(0);
    if (wr == 0) PG8_BAR;
    PG8_BAR;
#undef PG8_SA
#undef PG8_SB
#undef PG8_STAGE
#undef PG8_LDA
#undef PG8_LDB
#undef PG8_MMA
#undef PG8_WAIT_V
#undef PG8_WAIT_L
#undef PG8_BAR
#undef PG8_SCHED
}
#define EPI_LOOP_BEGIN \
    _Pragma("unroll") for (int ai = 0; ai < 2; ++ai) _Pragma("unroll") for (int m = 0; m < 4; ++m) { const int row = u.pm * 256 + ai * 128 + wr * 64 + m * 16 + fr; \
    _Pragma("unroll") for (int bj = 0; bj < 2; ++bj) { const int col0 = u.pn * 256 + bj * 128 + wc * 32 + fq * 8; const f32x4 v0 = acc[ai][bj][m][0], v1 = acc[ai][bj][m][1];
#define EPI_LOOP_END } }
#define EPI_AI_BEGIN _Pragma("unroll") for (int ai = 0; ai < 2; ++ai) {
#define EPI_AI_END }
#define EPI_G_BEGIN _Pragma("unroll") for (int m = 0; m < 4; ++m) { const int row = u.pm * 256 + ai * 128 + wr * 64 + m * 16 + fr; \
    _Pragma("unroll") for (int bj = 0; bj < 2; ++bj) { const int col0 = u.pn * 256 + bj * 128 + wc * 32 + fq * 8; const int gi = m * 2 + bj; (void)gi; (void)row; (void)col0;
#define EPI_G_END } }
}
using pg8::Unit;
typedef f32x4 AccT[2][2][4][2];

struct Sched1 { int G, c; const char *h, *hm, *btin, *btkv;
    DEV bool next(int i, Unit& u) const {
        long L = (long)i * G + c;
        if (L < 1980) { pg8::tile_map((int)L, 66, 30, u.pm, u.pn); u.kind = 0; u.nt = 16; u.A = h + (size_t)u.pm * 524288; u.B = btin + (size_t)u.pn * 524288; return true; }
        L -= 1980; if (L < 32) { u.pm = (int)(L & 7); u.pn = (int)(L >> 3); u.kind = 1; u.nt = 16; u.A = hm + (size_t)u.pm * 524288; u.B = btkv + (size_t)u.pn * 524288; return true; }
        return false; } };
struct Epi1 { bf16_t* P; bf16_t* mkb; float* out; const float *ropeC, *ropeS, *b_gate;
    DEV bool operator()(AccT& acc, const Unit& u, int wr, int wc, int fr, int fq) const {
        if (u.kind == 1) {
            EPI_LOOP_BEGIN
                float* o = (col0 < 512) ? out + O_MK + (size_t)row * 512 + col0 : out + O_MV + (size_t)row * 512 + (col0 - 512);
                *(f32x4*)o = v0; *(f32x4*)(o + 4) = v1;
                u32x4 pk; pk.x = pk2(v0.x, v0.y); pk.y = pk2(v0.z, v0.w); pk.z = pk2(v1.x, v1.y); pk.w = pk2(v1.z, v1.w);
                *(u32x4*)(mkb + (size_t)row * 1024 + col0) = pk;
            EPI_LOOP_END
            return false; }
        const int pn = u.pn;
        if (pn < 4) {
            const float sc = (pn >= 2) ? 0.08838834764831845f : 1.f;
            EPI_AI_BEGIN
                f32x4 cs[8], sn[8];
                EPI_G_BEGIN
                    const int pidx = row < NP ? (row & 2047) : 2048 + ((row - NP) & 3); const int uu = (col0 & 127) >> 3;
                    cs[gi] = *(const f32x4*)(ropeC + pidx * 64 + 4 * uu); sn[gi] = *(const f32x4*)(ropeS + pidx * 64 + 4 * uu);
                EPI_G_END
                EPI_G_BEGIN
                    const f32x4 v0 = acc[ai][bj][m][0], v1 = acc[ai][bj][m][1];
                    const int uu = (col0 & 127) >> 3, hb = col0 & ~127;
                    const f32x4 o1 = (v0 * cs[gi] - v1 * sn[gi]) * sc, o2 = (v0 * sn[gi] + v1 * cs[gi]) * sc;
                    u32x2 a; a.x = pk2(o1.x, o1.y); a.y = pk2(o1.z, o1.w); u32x2 b; b.x = pk2(o2.x, o2.y); b.y = pk2(o2.z, o2.w);
                    *(u32x2*)(P + (size_t)row * INC + hb + 4 * uu) = a; *(u32x2*)(P + (size_t)row * INC + hb + 64 + 4 * uu) = b;
                EPI_G_END
            EPI_AI_END
            return false; }
        const int mode = pn < 8 ? 0 : pn < 12 ? 1 : pn < 14 ? 2 : pn < 16 ? 0 : pn < 18 ? 2 : 3;
        f32x4 bg[2][2];
#pragma unroll
        for (int bj = 0; bj < 2; ++bj) { const int cg = (mode == 3) ? u.pn * 256 + bj * 128 + wc * 32 + fq * 8 - C_GT : 0; bg[bj][0] = *(const f32x4*)(b_gate + cg); bg[bj][1] = *(const f32x4*)(b_gate + cg + 4); }
        EPI_LOOP_BEGIN
            f32x4 a = v0, b = v1;
            if (mode == 1) { for (int i = 0; i < 4; ++i) { a[i] = silu_f(a[i]); b[i] = silu_f(b[i]); } }
            else if (mode == 2) { for (int i = 0; i < 4; ++i) { a[i] = gelu_t(a[i]); b[i] = gelu_t(b[i]); } }
            else if (mode == 3) { for (int i = 0; i < 4; ++i) { a[i] = sigm_f(a[i] + bg[bj][0][i]); b[i] = sigm_f(b[i] + bg[bj][1][i]); } }
            u32x4 pk; pk.x = pk2(a.x, a.y); pk.y = pk2(a.z, a.w); pk.z = pk2(b.x, b.y); pk.w = pk2(b.z, b.w);
            *(u32x4*)(P + (size_t)row * INC + col0) = pk;
        EPI_LOOP_END
        return false;
    } };

struct SchedMg { int G, c; const char *P, *bt;
    DEV bool next(int i, Unit& u) const {
        const int T = i / 3, br = i - 3 * T; const long L = (long)T * G + c; if (L >= 256) return false;
        pg8::tile_map((int)L, 64, 4, u.pm, u.pn); u.kind = br; u.nt = br == 0 ? 16 : 8;
        const int koff = br == 0 ? 0 : br == 1 ? 1024 : 1536;
        u.A = P + (size_t)u.pm * 256 * INC * 2 + (size_t)(C_G + koff) * 2; u.B = bt + (size_t)u.pn * 256 * 2048 * 2 + (size_t)koff * 2; return true; } };
struct SchedMgS { int c; const char *P, *bt;
    DEV bool next(int i, Unit& u) const {
        if (i > 0 || c >= 64) return false;
        const int tile = c >> 3, ch = c & 7; u.pm = 64 + (tile >> 2); u.pn = tile & 3; u.kind = ch; u.nt = 4;
        const int koff = ch * 256;
        u.A = P + (size_t)u.pm * 256 * INC * 2 + (size_t)(C_G + koff) * 2; u.B = bt + (size_t)u.pn * 256 * 2048 * 2 + (size_t)koff * 2; return true; } };
struct EpiMg { const bf16_t* P; bf16_t* mg;
    DEV bool operator()(AccT& acc, const Unit& u, int wr, int wc, int fr, int fq) const {
        const int br = u.kind;
        EPI_AI_BEGIN
            u32x4 gg[8], hh[8];
            EPI_G_BEGIN
                const bf16_t* gp = P + (size_t)row * INC + C_GT + br * 1024 + col0;
                gg[gi] = *(const u32x4*)gp; hh[gi] = (br < 2) ? *(const u32x4*)(gp + 1024) : gg[gi];
            EPI_G_END
            EPI_G_BEGIN
                float s8[8], d8[8]; unpack8(gg[gi], s8);
                if (br < 2) { unpack8(hh[gi], d8);
#pragma unroll
                    for (int i = 0; i < 8; ++i) s8[i] *= __builtin_amdgcn_rcpf(d8[i]); }
                f32x4& v0 = acc[ai][bj][m][0]; f32x4& v1 = acc[ai][bj][m][1];
                v0.x *= s8[0]; v0.y *= s8[1]; v0.z *= s8[2]; v0.w *= s8[3]; v1.x *= s8[4]; v1.y *= s8[5]; v1.z *= s8[6]; v1.w *= s8[7];
                if (br == 2) { u32x4 pk; pk.x = pk2(v0.x, v0.y); pk.y = pk2(v0.z, v0.w); pk.z = pk2(v1.x, v1.y); pk.w = pk2(v1.z, v1.w); *(u32x4*)(mg + (size_t)row * 1024 + col0) = pk; }
            EPI_G_END
        EPI_AI_END
        return br < 2;
    } };
struct EpiMgS { const bf16_t* P; float* part;
    DEV bool operator()(AccT& acc, const Unit& u, int wr, int wc, int fr, int fq) const {
        const int ch = u.kind, br = ch < 4 ? 0 : ch < 6 ? 1 : 2;
        const bf16_t* gp = P + C_GT + br * 1024; float* tp = part + (size_t)ch * SROWS - (size_t)NP * 1024;
        EPI_AI_BEGIN
            u32x4 gg[8];
            EPI_G_BEGIN
                gg[gi] = *(const u32x4*)(gp + (size_t)row * INC + col0);
            EPI_G_END
            EPI_G_BEGIN
                float s8[8]; unpack8(gg[gi], s8); const f32x4 v0 = acc[ai][bj][m][0], v1 = acc[ai][bj][m][1];
                float* t = tp + (size_t)row * 1024 + col0;
                *(f32x4*)t = (f32x4){s8[0] * v0.x, s8[1] * v0.y, s8[2] * v0.z, s8[3] * v0.w}; *(f32x4*)(t + 4) = (f32x4){s8[4] * v1.x, s8[5] * v1.y, s8[6] * v1.z, s8[7] * v1.w};
            EPI_G_END
        EPI_AI_END
        return false;
    } };
template <int nt, int nsub, int nchunk, int astep, int bstep> struct SchedPS { int G, c; const char *A, *B;
    DEV bool next(int i, Unit& u) const {
        const long L = (long)i * G + c;
        if (L < 256) { pg8::tile_map((int)L, 64, 4, u.pm, u.pn); u.kind = 0; u.nt = nt; u.A = A + (size_t)u.pm * astep; u.B = B + (size_t)u.pn * bstep; return true; }
        const int s = (int)(L - 256); if (s >= nsub) return false;
        const int tile = s / nchunk, ch = s - tile * nchunk; u.pm = 64 + (tile >> 2); u.pn = tile & 3; u.kind = 1 + ch; u.nt = 2;
        u.A = A + (size_t)u.pm * astep + (size_t)ch * 256; u.B = B + (size_t)u.pn * bstep + (size_t)ch * 256; return true; } };
struct SchedPlain { int G, c, nM, nN, nt; const char *A, *B; size_t astep, bstep;
    DEV bool next(int i, Unit& u) const {
        const long L = (long)i * G + c; if (L >= (long)nM * nN) return false;
        pg8::tile_map((int)L, nM, nN, u.pm, u.pn); u.kind = 0; u.nt = nt; u.A = A + (size_t)u.pm * astep; u.B = B + (size_t)u.pn * bstep; return true; } };
struct EpiWo { const float *xp, *xs; float* out; float* part;
    DEV bool operator()(AccT& acc, const Unit& u, int wr, int wc, int fr, int fq) const {
        if (u.kind >= 1) {
            EPI_LOOP_BEGIN
                float* t = part + (size_t)(u.kind - 1) * SROWS + (size_t)(row - NP) * 1024 + col0; *(f32x4*)t = v0; *(f32x4*)(t + 4) = v1;
            EPI_LOOP_END
            return false; }
        EPI_LOOP_BEGIN
            u32x4 pk; pk.x = pk2(v0.x, v0.y); pk.y = pk2(v0.z, v0.w); pk.z = pk2(v1.x, v1.y); pk.w = pk2(v1.z, v1.w);
            *(u32x4*)((bf16_t*)out + (size_t)row * 2048 + 1024 + col0) = pk;
        EPI_LOOP_END
        return false;
    } };
struct EpiUp { bf16_t* z; float* out;
    DEV bool operator()(AccT& acc, const Unit& u, int wr, int wc, int fr, int fq) const {
        EPI_LOOP_BEGIN
            u32x4 pk; pk.x = pk2(v0.x, v0.y); pk.y = pk2(v0.z, v0.w); pk.z = pk2(v1.x, v1.y); pk.w = pk2(v1.z, v1.w);
            *(u32x4*)(z + (size_t)row * FF2 + col0) = pk;
            float* o = nullptr;
            if (row < NP) { const int t = row & 2047; if (t >= 2046) o = out + O_CONVP + ((size_t)(row >> 11) * 2 + (t - 2046)) * FF2 + col0; }
            else { const int rs = row - NP, t = rs & 3; if (t >= 2) o = out + O_CONVS + ((size_t)(rs >> 2) * 2 + (t - 2)) * FF2 + col0; }
            if (o) { *(f32x4*)o = v0; *(f32x4*)(o + 4) = v1; }
        EPI_LOOP_END
        return false;
    } };
struct EpiDn { float* out; float* part;
    DEV bool operator()(AccT& acc, const Unit& u, int wr, int wc, int fr, int fq) const {
        if (u.kind >= 1) {
            EPI_LOOP_BEGIN
                float* t = part + (size_t)(u.kind - 1) * SROWS + (size_t)(row - NP) * 1024 + col0; *(f32x4*)t = v0; *(f32x4*)(t + 4) = v1;
            EPI_LOOP_END
            return false; }
        EPI_LOOP_BEGIN
            u32x4 pk; pk.x = pk2(v0.x, v0.y); pk.y = pk2(v0.z, v0.w); pk.z = pk2(v1.x, v1.y); pk.w = pk2(v1.z, v1.w);
            *(u32x4*)((bf16_t*)out + (size_t)row * 2048 + col0) = pk;
        EPI_LOOP_END
        return false;
    } };

DEV int srccol_in(int p) {
    if (p < 1024) { const int hb = p & ~127, pp = p & 127, uu = pp >> 3, v = pp & 7; return hb + ((v < 4) ? 4 * uu + v : 64 + 4 * uu + (v - 4)); }
    if (p >= C_XQ && p < C_SV) return p + 512;
    if (p >= C_SV && p < C_GT) return p - 512;
    return p; }
DEV void transpose_item(const float* W, int N, bf16_t* WT, int ldk, int koff, LAS float* scr, int k0, int n0, int srccol, int lane) {
    float tv[32];
#pragma unroll
    for (int i = 0; i < 32; ++i) tv[i] = __builtin_nontemporal_load(W + (size_t)(k0 + 2 * i + (lane >> 5)) * N + srccol);
#pragma unroll
    for (int i = 0; i < 32; ++i) scr[(2 * i + (lane >> 5)) * 33 + (lane & 31)] = tv[i];
    const int c = lane & 7;
#pragma unroll
    for (int j = 0; j < 4; ++j) { const int n = (lane >> 3) + 8 * j; const LAS float* s = scr + (8 * c) * 33 + n;
        u32x4 o; o.x = pk2(s[0 * 33], s[1 * 33]); o.y = pk2(s[2 * 33], s[3 * 33]); o.z = pk2(s[4 * 33], s[5 * 33]); o.w = pk2(s[6 * 33], s[7 * 33]);
        *(u32x4*)(WT + (size_t)(n0 + n) * ldk + koff + k0 + 8 * c) = o; }
}
DEV void rms_row(const float* xrow, const float* g, bf16_t* orow, int lane) {
    f32x4 v[4]; float s = 0.f;
#pragma unroll
    for (int j = 0; j < 4; ++j) { v[j] = __builtin_nontemporal_load((const f32x4*)(xrow + 4 * lane + 256 * j)); s += v[j].x * v[j].x + v[j].y * v[j].y + v[j].z * v[j].z + v[j].w * v[j].w; }
    s = wave_sum(s); const float r = rsqrtf(s * (1.f / 1024.f) + EPS);
#pragma unroll
    for (int j = 0; j < 4; ++j) { const f32x4 gv = *(const f32x4*)(g + 4 * lane + 256 * j);
        u32x2 o; o.x = pk2(v[j].x * r * gv.x, v[j].y * r * gv.y); o.y = pk2(v[j].z * r * gv.z, v[j].w * r * gv.w);
        *(u32x2*)(orow + 4 * lane + 256 * j) = o; }
}
DEV void phase_prep(const Params& p, LAS unsigned char* lds) {
    const int tid = otid(), lane = tid & 63, wave = tid >> 6;
    const int gw = obid() * 8 + wave, NGW = gridDim.x * 8;
    LAS float* scr = (LAS float*)(lds + wave * 8448);
    unsigned char* ws = p.ws;
    constexpr int I_IN = 16 * 240, I_KV = 16 * 32, I_MR = 16 * 32, I_MS = 8 * 32, I_MX = 8 * 32, I_O = 16 * 32, I_UP = 16 * 176, I_DN = 44 * 32;
    constexpr int N_TR = I_IN + I_KV + I_MR + I_MS + I_MX + I_O + I_UP + I_DN;
    constexpr int N_RMS = MT + 2048, N_ROPE = 2052, N_TRIL = 512;
    constexpr int N_ALL = N_TR + N_RMS + N_ROPE + N_TRIL;
    for (int it = gw; it < N_ALL; it += NGW) {
        int r = it;
        if (r < N_TR) {
            const int l31 = lane & 31;
            if (r < I_IN) { const int kb = r / 240, nb = r % 240; transpose_item(p.w_in, INC, (bf16_t*)(ws + OFF_BTIN), 1024, 0, scr, 64 * kb, 32 * nb, srccol_in(32 * nb + l31), lane); continue; } r -= I_IN;
            if (r < I_KV) { const int kb = r / 32, nb = r % 32; transpose_item(p.w_mem_kv, 1024, (bf16_t*)(ws + OFF_BTKV), 1024, 0, scr, 64 * kb, 32 * nb, 32 * nb + l31, lane); continue; } r -= I_KV;
            if (r < I_MR) { const int kb = r / 32, nb = r % 32; transpose_item(p.w_br_ret, 1024, (bf16_t*)(ws + OFF_BTMG), 2048, 0, scr, 64 * kb, 32 * nb, 32 * nb + l31, lane); continue; } r -= I_MR;
            if (r < I_MS) { const int kb = r / 32, nb = r % 32; transpose_item(p.w_br_sg, 1024, (bf16_t*)(ws + OFF_BTMG), 2048, 1024, scr, 64 * kb, 32 * nb, 32 * nb + l31, lane); continue; } r -= I_MS;
            if (r < I_MX) { const int kb = r / 32, nb = r % 32; transpose_item(p.w_br_x, 1024, (bf16_t*)(ws + OFF_BTMG), 2048, 1536, scr, 64 * kb, 32 * nb, 32 * nb + l31, lane); continue; } r -= I_MX;
            if (r < I_O) { const int kb = r / 32, nb = r % 32; transpose_item(p.w_o, 1024, (bf16_t*)(ws + OFF_BTO), 1024, 0, scr, 64 * kb, 32 * nb, 32 * nb + l31, lane); continue; } r -= I_O;
            if (r < I_UP) { const int kb = r / 176, nb = r % 176; transpose_item(p.w_up, FF2, (bf16_t*)(ws + OFF_BTUP), 1024, 0, scr, 64 * kb, 32 * nb, 32 * nb + l31, lane); continue; } r -= I_UP;
            { const int kb = r / 32, nb = r % 32; transpose_item(p.w_down, 1024, (bf16_t*)(ws + OFF_BTDN), FF, 0, scr, 64 * kb, 32 * nb, 32 * nb + l31, lane); continue; }
        }
        r -= N_TR;
        if (r < N_RMS) {
            if (r < NP) rms_row(p.x_prompt + (size_t)r * 1024, p.norm_mix_g, (bf16_t*)(ws + OFF_R2) + (size_t)r * 1024, lane);
            else if (r < MT) rms_row(p.x_sample + (size_t)(r - NP) * 1024, p.norm_mix_g, (bf16_t*)(ws + OFF_R2) + (size_t)r * 1024, lane);
            else rms_row(p.mem_prompt + (size_t)(r - MT) * 1024, p.mem_norm_g, (bf16_t*)(ws + OFF_HM) + (size_t)(r - MT) * 1024, lane);
            continue; }
        r -= N_RMS;
        if (r < N_ROPE) {
            const int pos = r < 2048 ? r : 16384 + (r - 2048);
            double inv = 1.0;
            if (lane & 1) inv *= 0.8659643233600653; if (lane & 2) inv *= 0.7498942093324559; if (lane & 4) inv *= 0.5623413251903491;
            if (lane & 8) inv *= 0.31622776601683794; if (lane & 16) inv *= 0.1; if (lane & 32) inv *= 0.01;
            double t = (double)pos * inv * 0.15915494309189535; t -= __builtin_rint(t);
            const float tf = (float)t;
            ((float*)(ws + OFF_ROPEC))[r * 64 + lane] = __builtin_amdgcn_cosf(tf);
            ((float*)(ws + OFF_ROPES))[r * 64 + lane] = __builtin_amdgcn_sinf(tf);
            continue; }
        r -= N_ROPE;
        { const int t = r & 127; const float* src = p.sg_ws + (size_t)r * 128 + 2 * lane;
          const float a = (2 * lane <= t) ? src[0] : 0.f, b = (2 * lane + 1 <= t) ? src[1] : 0.f;
          *(unsigned*)((bf16_t*)(ws + OFF_WTRIL) + (size_t)r * 128 + 2 * lane) = pk2(a, b); }
    }
}

DEV void ret_A_item(const Params& p, LAS unsigned char* lds, int item) {
    const int tid = otid(), lane = tid & 63, w = tid >> 6;
    const int c = item & 15, bh = item >> 4, h = bh & 3, b = bh >> 2;
    const size_t row0 = (size_t)b * 2048 + c * 128;
    const bf16_t* P = (const bf16_t*)(p.ws + OFF_P);
    const float lg = log_gamma(h);
    LAS unsigned char* Kt = lds; LAS unsigned char* Vt = lds + 34816;
#pragma unroll
    for (int k_ = 0; k_ < 4; ++k_) { const int i = tid + 512 * k_; const int s = i >> 4, ch = i & 15;
        u32x4 v = *(const u32x4*)(P + (row0 + s) * INC + C_K + h * 128 + ch * 8);
        const float dec = __expf((float)(127 - s) * lg);
        v.x = pk2(bf_lo(v.x) * dec, bf_hi(v.x) * dec); v.y = pk2(bf_lo(v.y) * dec, bf_hi(v.y) * dec); v.z = pk2(bf_lo(v.z) * dec, bf_hi(v.z) * dec); v.w = pk2(bf_lo(v.w) * dec, bf_hi(v.w) * dec);
        *(LAS u32x4*)(Kt + s * 272 + ch * 16) = v; }
#pragma unroll
    for (int k_ = 0; k_ < 8; ++k_) { const int i = tid + 512 * k_; const int s = i >> 5, ch = i & 31;
        *(LAS u32x4*)(Vt + s * 528 + ch * 16) = *(const u32x4*)(P + (row0 + s) * INC + C_V + h * 256 + ch * 8); }
    __syncthreads();
    f32x4 acc[16];
#pragma unroll
    for (int i = 0; i < 16; ++i) acc[i] = (f32x4){0.f, 0.f, 0.f, 0.f};
    LAS const unsigned char* kb = tr_lane_base(Kt, 272, lane) + 32 * w; LAS const unsigned char* vb = tr_lane_base(Vt, 528, lane);
    bf16x8 af[4]; tr_read4<272, 0, 0>(kb, af);
    static_for<0, 16>([&](auto et_) { constexpr int et = decltype(et_)::value; bf16x8 bf[4]; tr_read4<528, 0, 16 * et>(vb, bf);
#pragma unroll
        for (int ks = 0; ks < 4; ++ks) acc[et] = mfma16(af[ks], bf[ks], acc[et]); });
    float* U = p.out + (size_t)item * 32768;
    const int g = lane >> 4, col = lane & 15;
#pragma unroll
    for (int et = 0; et < 16; ++et)
#pragma unroll
        for (int j = 0; j < 4; ++j) U[(16 * w + 4 * g + j) * 256 + 16 * et + col] = acc[et][j];
    __syncthreads();
}
DEV void scan_phase(const Params& p) {
    const float* U = p.out; bf16_t* Sb = (bf16_t*)(p.ws + OFF_R2);
    for (int idx = obid() * 512 + otid(); idx < 131072; idx += gridDim.x * 512) {
        const int e8 = idx & 31, d = (idx >> 5) & 127, bh = idx >> 12, h = bh & 3;
        const float g128 = __expf(128.f * log_gamma(h));
        f32x4 s0 = (f32x4){0.f, 0.f, 0.f, 0.f}, s1 = s0;
#pragma unroll
        for (int c = 0; c < 16; ++c) {
            const size_t off = (((size_t)bh * 16 + c) * 128 + d) * 256 + e8 * 8;
            u32x4 pk; pk.x = pk2(s0.x, s0.y); pk.y = pk2(s0.z, s0.w); pk.z = pk2(s1.x, s1.y); pk.w = pk2(s1.z, s1.w);
            *(u32x4*)(Sb + off) = pk;
            const f32x4 u0 = __builtin_nontemporal_load((const f32x4*)(U + off)), u1 = __builtin_nontemporal_load((const f32x4*)(U + off + 4));
            s0 = s0 * g128 + u0; s1 = s1 * g128 + u1; }
        float* o = p.out + O_RETP + ((size_t)bh * 128 + d) * 256 + e8 * 8;
        *(f32x4*)o = s0; *(f32x4*)(o + 4) = s1;
    }
}
DEV void ret_C_item(const Params& p, LAS unsigned char* lds, int item) {
    const int tid = otid(), lane = tid & 63, w = tid >> 6, g = lane >> 4, col = lane & 15;
    const int c = item & 15, bh = item >> 4, h = bh & 3, b = bh >> 2;
    const size_t row0 = (size_t)b * 2048 + c * 128;
    bf16_t* P = (bf16_t*)(p.ws + OFF_P);
    const bf16_t* Sb = (const bf16_t*)(p.ws + OFF_R2) + (size_t)item * 32768;
    const float lg = log_gamma(h);
    LAS unsigned char* Kt = lds; LAS unsigned char* Vh = lds + 34816; LAS unsigned char* Sh = lds + 69632; LAS unsigned char* Sc = lds + 104448 + w * 4352;
#pragma unroll
    for (int k_ = 0; k_ < 4; ++k_) { const int i = tid + 512 * k_; const int s = i >> 4, ch = i & 15;
        *(LAS u32x4*)(Kt + s * 272 + ch * 16) = *(const u32x4*)(P + (row0 + s) * INC + C_K + h * 128 + ch * 8); }
    bf16x8 qf[4];
    { const bf16_t* qp = P + (row0 + 16 * w + col) * INC + C_Q + h * 128 + 8 * g;
#pragma unroll
      for (int ks = 0; ks < 4; ++ks) qf[ks] = *(const bf16x8*)(qp + 32 * ks); }
    f32x4 o[16];
    float sg[16][4];
#pragma unroll
    for (int j = 0; j < 4; ++j)
#pragma unroll
        for (int t = 0; t < 16; ++t) sg[t][j] = bf2f(P[(row0 + 16 * w + 4 * g + j) * INC + C_G + h * 256 + (t >> 3) * 128 + (t & 7) * 16 + col]);
    LAS const unsigned char* shb = tr_lane_base(Sh, 272, lane); LAS const unsigned char* vhb = tr_lane_base(Vh, 272, lane);
    bf16x8 scf[4];
    static_for<0, 2>([&](auto hh_) { constexpr int hh = decltype(hh_)::value;
        if (hh == 1) __syncthreads();
#pragma unroll
        for (int k_ = 0; k_ < 4; ++k_) { const int i = tid + 512 * k_; const int s = i >> 4, ch = i & 15;
            *(LAS u32x4*)(Vh + s * 272 + ch * 16) = *(const u32x4*)(P + (row0 + s) * INC + C_V + h * 256 + hh * 128 + ch * 8);
            *(LAS u32x4*)(Sh + s * 272 + ch * 16) = __builtin_nontemporal_load((const u32x4*)(Sb + s * 256 + hh * 128 + ch * 8)); }
        __syncthreads();
        if (hh == 0) {
            static_for<0, 8>([&](auto st_) { constexpr int st = decltype(st_)::value; f32x4 a = (f32x4){0.f, 0.f, 0.f, 0.f};
#pragma unroll
                for (int ks = 0; ks < 4; ++ks) a = mfma16(qf[ks], lds_frag(Kt, 272, 16 * st, 32 * ks, lane), a);
#pragma unroll
                for (int j = 0; j < 4; ++j) { const int diff = (16 * w + 4 * g + j) - (16 * st + col);
                    const float v = diff >= 0 ? a[j] * __expf((float)diff * lg) : 0.f;
                    *(LAS bf16_t*)(Sc + (4 * g + j) * 272 + (16 * st + col) * 2) = f2bf(v); }
                SCHEDB; });
#pragma unroll
            for (int ks = 0; ks < 4; ++ks) scf[ks] = lds_frag(Sc, 272, 0, 32 * ks, lane);
        }
        static_for<0, 8>([&](auto et_) { constexpr int et = decltype(et_)::value; f32x4 a = (f32x4){0.f, 0.f, 0.f, 0.f};
            bf16x8 f[4]; tr_read4<272, 0, 16 * et>(shb, f);
#pragma unroll
            for (int ks = 0; ks < 4; ++ks) a = mfma16(qf[ks], f[ks], a);
#pragma unroll
            for (int j = 0; j < 4; ++j) a[j] *= __expf((float)(16 * w + 4 * g + j + 1) * lg);
            tr_read4<272, 0, 16 * et>(vhb, f);
#pragma unroll
            for (int ks = 0; ks < 4; ++ks) a = mfma16(scf[ks], f[ks], a);
            o[hh * 8 + et] = a; SCHEDB; });
    });
    float gnv[16];
#pragma unroll
    for (int t = 0; t < 16; ++t) gnv[t] = p.ret_gn_g[h * 256 + (t >> 3) * 128 + (t & 7) * 16 + col];
#pragma unroll
    for (int j = 0; j < 4; ++j) {
        float s = 0.f;
#pragma unroll
        for (int t = 0; t < 16; ++t) s += o[t][j];
        const float mean = g16_sum(s) * (1.f / 256.f);
        float s2 = 0.f;
#pragma unroll
        for (int t = 0; t < 16; ++t) { const float dd = o[t][j] - mean; s2 += dd * dd; }
        const float rstd = rsqrtf(g16_sum(s2) * (1.f / 256.f) + EPS);
        bf16_t* gp = P + (row0 + 16 * w + 4 * g + j) * INC + C_G + h * 256;
#pragma unroll
        for (int t = 0; t < 16; ++t) { const int e = (t >> 3) * 128 + (t & 7) * 16 + col;
            gp[e] = f2bf((o[t][j] - mean) * rstd * gnv[t] * sg[t][j]); }
    }
    __syncthreads();
}
DEV void sgu_item(const Params& p, LAS unsigned char* lds, int item) {
    const int tid = otid(), lane = tid & 63, w = tid >> 6, g = lane >> 4, col = lane & 15;
    const int gq = item & 3, bn = item >> 2; const size_t row0 = (size_t)bn * 128;
    bf16_t* P = (bf16_t*)(p.ws + OFF_P);
    LAS unsigned char* VN = lds;
#pragma unroll
    for (int rr = 0; rr < 16; ++rr) { const int s = 16 * w + rr;
        const u32x4 v = *(const u32x4*)(P + (row0 + s) * INC + C_SV + lane * 8);
        float x[8] = {bf_lo(v.x), bf_hi(v.x), bf_lo(v.y), bf_hi(v.y), bf_lo(v.z), bf_hi(v.z), bf_lo(v.w), bf_hi(v.w)};
        float sm = 0.f;
#pragma unroll
        for (int i = 0; i < 8; ++i) sm += x[i];
        const float mean = wave_sum(sm) * (1.f / 512.f); float s2 = 0.f;
#pragma unroll
        for (int i = 0; i < 8; ++i) { x[i] -= mean; s2 += x[i] * x[i]; }
        const float rstd = rsqrtf(wave_sum(s2) * (1.f / 512.f) + EPS);
        if (g == gq) { const float* lg = p.sg_ln_g + lane * 8; u32x4 o;
            o.x = pk2(x[0] * rstd * lg[0], x[1] * rstd * lg[1]); o.y = pk2(x[2] * rstd * lg[2], x[3] * rstd * lg[3]);
            o.z = pk2(x[4] * rstd * lg[4], x[5] * rstd * lg[5]); o.w = pk2(x[6] * rstd * lg[6], x[7] * rstd * lg[7]);
            *(LAS u32x4*)(VN + s * 272 + col * 16) = o; } }
    bf16x8 af[4];
    { const bf16_t* wp = (const bf16_t*)(p.ws + OFF_WTRIL) + (size_t)(gq * 128 + 16 * w + col) * 128 + 8 * g;
#pragma unroll
      for (int ks = 0; ks < 4; ++ks) af[ks] = *(const bf16x8*)(wp + 32 * ks); }
    __syncthreads();
    LAS const unsigned char* vnb = tr_lane_base(VN, 272, lane);
    float uv[8][4], bsv[4];
#pragma unroll
    for (int j = 0; j < 4; ++j) { bsv[j] = p.sg_bs[gq * 128 + 16 * w + 4 * g + j];
#pragma unroll
        for (int ct = 0; ct < 8; ++ct) uv[ct][j] = bf2f(P[(row0 + 16 * w + 4 * g + j) * INC + C_SU + gq * 128 + 16 * ct + col]); }
    static_for<0, 8>([&](auto ct_) { constexpr int ct = decltype(ct_)::value; f32x4 a = (f32x4){0.f, 0.f, 0.f, 0.f};
        bf16x8 f[4]; tr_read4<272, 0, 16 * ct>(vnb, f);
#pragma unroll
        for (int ks = 0; ks < 4; ++ks) a = mfma16(af[ks], f[ks], a);
#pragma unroll
        for (int j = 0; j < 4; ++j) P[(row0 + 16 * w + 4 * g + j) * INC + C_SU + gq * 128 + 16 * ct + col] = f2bf(uv[ct][j] * (a[j] + bsv[j])); });
    __syncthreads();
}
DEV void xattn_item(const Params& p, LAS unsigned char* lds, int item) {
    const int tid = otid(), lane = tid & 63, w = tid >> 6, g = lane >> 4, col = lane & 15;
    const int qt = item & 15, bh = item >> 4, h = bh & 3, b = bh >> 2; const size_t row0 = (size_t)b * 2048 + qt * 128;
    bf16_t* P = (bf16_t*)(p.ws + OFF_P); const bf16_t* mkb = (const bf16_t*)(p.ws + OFF_MKB);
    LAS unsigned char* KV = lds; LAS unsigned char* Pw = lds + 69632 + w * 8448;
#pragma unroll
    for (int k_ = 0; k_ < 8; ++k_) { const int i = tid + 512 * k_; const int m = i >> 4, ch = i & 15;
        *(LAS u32x4*)(KV + m * 272 + ch * 16) = *(const u32x4*)(mkb + (size_t)(b * 256 + m) * 1024 + h * 128 + ch * 8); }
    bf16x8 qf[4];
    { const bf16_t* qp = P + (row0 + 16 * w + col) * INC + C_XQ + h * 128 + 8 * g;
#pragma unroll
      for (int ks = 0; ks < 4; ++ks) qf[ks] = *(const bf16x8*)(qp + 32 * ks); }
    __syncthreads();
    f32x4 sc[16];
    static_for<0, 16>([&](auto mt_) { constexpr int mt = decltype(mt_)::value; f32x4 a = (f32x4){0.f, 0.f, 0.f, 0.f};
#pragma unroll
        for (int ks = 0; ks < 4; ++ks) a = mfma16(qf[ks], lds_frag(KV, 272, 16 * mt, 32 * ks, lane), a);
        sc[mt] = a * 0.08838834764831845f; SCHEDB; });
#pragma unroll
    for (int j = 0; j < 4; ++j) { float mx = -3.0e38f;
#pragma unroll
        for (int mt = 0; mt < 16; ++mt) mx = fmaxf(mx, sc[mt][j]);
        mx = g16_max(mx); float sm = 0.f;
#pragma unroll
        for (int mt = 0; mt < 16; ++mt) { const float e = __expf(sc[mt][j] - mx); sc[mt][j] = e; sm += e; }
        const float inv = 1.f / g16_sum(sm);
#pragma unroll
        for (int mt = 0; mt < 16; ++mt) *(LAS bf16_t*)(Pw + (4 * g + j) * 528 + (16 * mt + col) * 2) = f2bf(sc[mt][j] * inv); }
    __syncthreads();
#pragma unroll
    for (int k_ = 0; k_ < 8; ++k_) { const int i = tid + 512 * k_; const int m = i >> 4, ch = i & 15;
        *(LAS u32x4*)(KV + m * 272 + ch * 16) = *(const u32x4*)(mkb + (size_t)(b * 256 + m) * 1024 + 512 + h * 128 + ch * 8); }
    __syncthreads();
    LAS const unsigned char* kvb = tr_lane_base(KV, 272, lane);
    bf16x8 pf[8];
#pragma unroll
    for (int ks = 0; ks < 8; ++ks) pf[ks] = lds_frag(Pw, 528, 0, 32 * ks, lane);
    static_for<0, 8>([&](auto dt_) { constexpr int dt = decltype(dt_)::value; f32x4 a = (f32x4){0.f, 0.f, 0.f, 0.f};
        bf16x8 f[4]; tr_read4<272, 0, 16 * dt>(kvb, f);
#pragma unroll
        for (int ks = 0; ks < 4; ++ks) a = mfma16(pf[ks], f[ks], a);
        tr_read4<272, 128, 16 * dt>(kvb, f);
#pragma unroll
        for (int ks = 0; ks < 4; ++ks) a = mfma16(pf[4 + ks], f[ks], a);
#pragma unroll
        for (int j = 0; j < 4; ++j) P[(row0 + 16 * w + 4 * g + j) * INC + C_XQ + h * 128 + 16 * dt + col] = f2bf(a[j]); });
    __syncthreads();
}
DEV void xattn_s_item(const Params& p, LAS unsigned char* lds, int item) {
    const int tid = otid(), lane = tid & 63, w = tid >> 6, l32 = lane & 31, slot = w * 2 + (lane >> 5);
    const int h = item & 3, b = item >> 2; const size_t rowb = (size_t)NP + b * 4;
    bf16_t* P = (bf16_t*)(p.ws + OFF_P);
    LAS float* sc = (LAS float*)lds; LAS float* red = (LAS float*)(lds + 4096);
    float q[4][4];
#pragma unroll
    for (int l = 0; l < 4; ++l) { const u32x2 v = *(const u32x2*)(P + (rowb + l) * INC + C_XQ + h * 128 + 4 * l32); q[l][0] = bf_lo(v.x); q[l][1] = bf_hi(v.x); q[l][2] = bf_lo(v.y); q[l][3] = bf_hi(v.y); }
#pragma unroll
    for (int it = 0; it < 16; ++it) { const int m = it * 16 + slot;
        const f32x4 kv = *(const f32x4*)(p.cache_k + (((size_t)b * 256 + m) * 4 + h) * 128 + 4 * l32);
        float d[4];
#pragma unroll
        for (int l = 0; l < 4; ++l) d[l] = q[l][0] * kv.x + q[l][1] * kv.y + q[l][2] * kv.z + q[l][3] * kv.w;
        const bool b0 = l32 & 1, b1 = l32 & 2;
        float a0 = b0 ? d[2] : d[0], a1 = b0 ? d[3] : d[1];
        a0 += __shfl_xor(b0 ? d[0] : d[2], 1); a1 += __shfl_xor(b0 ? d[1] : d[3], 1);
        float r = b1 ? a1 : a0; r += __shfl_xor(b1 ? a0 : a1, 2);
        r += __shfl_xor(r, 4); r += __shfl_xor(r, 8); r += __shfl_xor(r, 16);
        if (l32 < 4) sc[((l32 & 1) * 2 + (l32 >> 1)) * 256 + m] = r * 0.08838834764831845f; }
    __syncthreads();
    if (w < 4) { float v[4]; float mx = -3.0e38f;
#pragma unroll
        for (int i = 0; i < 4; ++i) { v[i] = sc[w * 256 + lane + 64 * i]; mx = fmaxf(mx, v[i]); }
        mx = wave_max(mx); float sm = 0.f;
#pragma unroll
        for (int i = 0; i < 4; ++i) { v[i] = __expf(v[i] - mx); sm += v[i]; }
        const float inv = 1.f / wave_sum(sm);
#pragma unroll
        for (int i = 0; i < 4; ++i) sc[w * 256 + lane + 64 * i] = v[i] * inv; }
    __syncthreads();
    f32x4 o[4];
#pragma unroll
    for (int l = 0; l < 4; ++l) o[l] = (f32x4){0.f, 0.f, 0.f, 0.f};
#pragma unroll
    for (int it = 0; it < 16; ++it) { const int m = it * 16 + slot;
        const f32x4 vv = *(const f32x4*)(p.cache_v + (((size_t)b * 256 + m) * 4 + h) * 128 + 4 * l32);
#pragma unroll
        for (int l = 0; l < 4; ++l) o[l] += vv * sc[l * 256 + m]; }
#pragma unroll
    for (int l = 0; l < 4; ++l) *(LAS f32x4*)(red + (slot * 4 + l) * 128 + 4 * l32) = o[l];
    __syncthreads();
    { const int l = tid >> 7, d = tid & 127; float s = 0.f;
#pragma unroll
      for (int k = 0; k < 16; ++k) s += red[(k * 4 + l) * 128 + d];
      P[(rowb + l) * INC + C_XQ + h * 128 + d] = f2bf(s); }
    __syncthreads();
}
DEV void ret_s_item(const Params& p, LAS unsigned char* lds, int item) {
    const int tid = otid(), lane = tid & 63, w = tid >> 6;
    const int h = item & 3, b = item >> 2; const size_t rowb = (size_t)NP + b * 4;
    bf16_t* P = (bf16_t*)(p.ws + OFF_P);
    const float lg = log_gamma(h);
    LAS float* qs = (LAS float*)lds;
    LAS float* kr = qs + 512;
    LAS float* vs = kr + 512;
    LAS float* ob = vs + 1024;
    LAS float* scm = ob + 1024;
    LAS float* red = scm + 16;
    { const int t = tid >> 7, d = tid & 127;
      qs[t * 128 + d] = bf2f(P[(rowb + t) * INC + C_Q + h * 128 + d]); kr[t * 128 + d] = bf2f(P[(rowb + t) * INC + C_K + h * 128 + d]);
      vs[t * 256 + d] = bf2f(P[(rowb + t) * INC + C_V + h * 256 + d]); vs[t * 256 + 128 + d] = bf2f(P[(rowb + t) * INC + C_V + h * 256 + 128 + d]); }
    __syncthreads();
    { const int pr = tid >> 5, t = pr >> 2, s2 = pr & 3, l32 = tid & 31;
      const f32x4 qa = *(LAS f32x4*)(qs + t * 128 + 4 * l32), kb = *(LAS f32x4*)(kr + s2 * 128 + 4 * l32);
      float d = qa.x * kb.x + qa.y * kb.y + qa.z * kb.z + qa.w * kb.w;
#pragma unroll
      for (int o = 1; o < 32; o <<= 1) d += __shfl_xor(d, o);
      if (l32 == 0) scm[pr] = (t >= s2) ? d * __expf((float)(t - s2) * lg) : 0.f; }
    f32x4 v[4], cr[4];
#pragma unroll
    for (int s = 0; s < 4; ++s) { v[s] = *(LAS f32x4*)(vs + s * 256 + 4 * lane); cr[s] = (f32x4){0.f, 0.f, 0.f, 0.f}; }
    const float g4 = __expf(4.f * lg), kd0 = __expf(3.f * lg), kd1 = __expf(2.f * lg), kd2 = __expf(lg);
    const float* S0 = p.state_ret + ((size_t)item * 128) * 256; float* Sn = p.out + O_RETS + ((size_t)item * 128) * 256;
#pragma unroll
    for (int dd = 0; dd < 16; ++dd) { const int d = 16 * w + dd;
        const f32x4 s0 = *(const f32x4*)(S0 + d * 256 + 4 * lane);
#pragma unroll
        for (int t = 0; t < 4; ++t) cr[t] += s0 * qs[t * 128 + d];
        f32x4 sn = s0 * g4 + v[0] * (kr[d] * kd0) + v[1] * (kr[128 + d] * kd1) + v[2] * (kr[256 + d] * kd2) + v[3] * kr[384 + d];
        *(f32x4*)(Sn + d * 256 + 4 * lane) = sn; }
#pragma unroll
    for (int t = 0; t < 4; ++t) *(LAS f32x4*)(red + (w * 4 + t) * 256 + 4 * lane) = cr[t];
    __syncthreads();
    { const int t = tid >> 7, e2 = (tid & 127) * 2; const float qd = __expf((float)(t + 1) * lg);
#pragma unroll
      for (int i = 0; i < 2; ++i) { const int e = e2 + i; float c = 0.f;
#pragma unroll
          for (int k = 0; k < 8; ++k) c += red[(k * 4 + t) * 256 + e];
          float in = 0.f;
#pragma unroll
          for (int s = 0; s < 4; ++s) in += scm[t * 4 + s] * vs[s * 256 + e];
          ob[t * 256 + e] = in + c * qd; } }
    __syncthreads();
    if (w < 4) { float x[4]; float sm = 0.f;
#pragma unroll
        for (int i = 0; i < 4; ++i) { x[i] = ob[w * 256 + lane + 64 * i]; sm += x[i]; }
        const float mean = wave_sum(sm) * (1.f / 256.f); float s2 = 0.f;
#pragma unroll
        for (int i = 0; i < 4; ++i) { x[i] -= mean; s2 += x[i] * x[i]; }
        const float rstd = rsqrtf(wave_sum(s2) * (1.f / 256.f) + EPS);
        bf16_t* gp = P + (rowb + w) * INC + C_G + h * 256;
#pragma unroll
        for (int i = 0; i < 4; ++i) { const int e = lane + 64 * i; gp[e] = f2bf(x[i] * rstd * p.ret_gn_g[h * 256 + e] * bf2f(gp[e])); } }
    __syncthreads();
}
DEV void sgu_s_item(const Params& p, LAS unsigned char* lds, int b) {
    const int tid = otid(), lane = tid & 63, w = tid >> 6;
    const size_t rowb = (size_t)NP + b * 4;
    bf16_t* P = (bf16_t*)(p.ws + OFF_P);
    LAS float* part = (LAS float*)lds;
    float x[4];
#pragma unroll
    for (int r = 0; r < 4; ++r) { x[r] = bf2f(P[(rowb + r) * INC + C_SV + tid]); const float s = wave_sum(x[r]); if (lane == 0) part[w * 4 + r] = s; }
    __syncthreads();
    float mean[4];
#pragma unroll
    for (int r = 0; r < 4; ++r) { float s = 0.f;
#pragma unroll
        for (int k = 0; k < 8; ++k) s += part[k * 4 + r];
        mean[r] = s * (1.f / 512.f); }
    __syncthreads();
#pragma unroll
    for (int r = 0; r < 4; ++r) { x[r] -= mean[r]; const float s = wave_sum(x[r] * x[r]); if (lane == 0) part[w * 4 + r] = s; }
    __syncthreads();
    const float lng = p.sg_ln_g[tid]; const int gq = tid >> 7;
    float vn[4];
#pragma unroll
    for (int r = 0; r < 4; ++r) { float s = 0.f;
#pragma unroll
        for (int k = 0; k < 8; ++k) s += part[k * 4 + r];
        vn[r] = x[r] * rsqrtf(s * (1.f / 512.f) + EPS) * lng;
        p.out[O_SGV + ((size_t)b * 4 + r) * 512 + tid] = vn[r]; }
#pragma unroll
    for (int t = 0; t < 4; ++t) { float mx = p.sg_bs[gq * 128 + t];
#pragma unroll
        for (int s = 0; s < 4; ++s) if (s <= t) mx += p.sg_ws[(size_t)(gq * 128 + t) * 128 + s] * vn[s];
        bf16_t* up = P + (rowb + t) * INC + C_SU + tid; *up = f2bf(bf2f(*up) * mx); }
    __syncthreads();
}


DEV float rl_bf(unsigned packed, int d) { return (d & 1) ? bf_hi(packed) : bf_lo(packed); }
DEV void ret_s_wave(const Params& p, int item, int lane) {
    const int h = item & 3, b = item >> 2; const size_t rowb = (size_t)NP + b * 4;
    bf16_t* P = (bf16_t*)(p.ws + OFF_P);
    const float lg = log_gamma(h);
    unsigned qp[4], kp[4]; f32x4 v[4];
#pragma unroll
    for (int t = 0; t < 4; ++t) { qp[t] = *(const unsigned*)(P + (rowb + t) * INC + C_Q + h * 128 + 2 * lane); kp[t] = *(const unsigned*)(P + (rowb + t) * INC + C_K + h * 128 + 2 * lane);
        const u32x2 x = *(const u32x2*)(P + (rowb + t) * INC + C_V + h * 256 + 4 * lane); v[t] = (f32x4){bf_lo(x.x), bf_hi(x.x), bf_lo(x.y), bf_hi(x.y)}; }
    float sc[4][4];
#pragma unroll
    for (int t = 0; t < 4; ++t)
#pragma unroll
        for (int s2 = 0; s2 < 4; ++s2) { if (s2 <= t) sc[t][s2] = wave_sum(bf_lo(qp[t]) * bf_lo(kp[s2]) + bf_hi(qp[t]) * bf_hi(kp[s2])) * __expf((float)(t - s2) * lg); else sc[t][s2] = 0.f; }
    const float g4 = __expf(4.f * lg), kdec[4] = {__expf(3.f * lg), __expf(2.f * lg), __expf(lg), 1.f};
    f32x4 cr[4];
#pragma unroll
    for (int t = 0; t < 4; ++t) cr[t] = (f32x4){0.f, 0.f, 0.f, 0.f};
    const float* S0 = p.state_ret + (size_t)item * 32768 + 4 * lane; float* Sn = p.out + O_RETS + (size_t)item * 32768 + 4 * lane;
    f32x4 sA[8], sB[8];
#pragma unroll
    for (int i = 0; i < 8; ++i) sA[i] = __builtin_nontemporal_load((const f32x4*)(S0 + i * 256));
#define RETS_PROC(buf, d0) _Pragma("unroll") for (int i = 0; i < 8; ++i) { const int src = ((d0) + i) >> 1; f32x4 sn = buf[i] * g4; \
        _Pragma("unroll") for (int t = 0; t < 4; ++t) { const float qd = rl_bf((unsigned)__builtin_amdgcn_readlane((int)qp[t], src), i), kd = rl_bf((unsigned)__builtin_amdgcn_readlane((int)kp[t], src), i) * kdec[t]; \
            cr[t] += buf[i] * qd; sn += v[t] * kd; } \
        *(f32x4*)(Sn + ((d0) + i) * 256) = sn; }
    for (int d0 = 0; d0 < 128; d0 += 16) {
#pragma unroll
        for (int i = 0; i < 8; ++i) sB[i] = __builtin_nontemporal_load((const f32x4*)(S0 + (d0 + 8 + i) * 256));
        RETS_PROC(sA, d0)
        if (d0 + 16 < 128) {
#pragma unroll
            for (int i = 0; i < 8; ++i) sA[i] = __builtin_nontemporal_load((const f32x4*)(S0 + (d0 + 16 + i) * 256)); }
        RETS_PROC(sB, d0 + 8)
    }
#undef RETS_PROC
    const f32x4 gn4 = *(const f32x4*)(p.ret_gn_g + h * 256 + 4 * lane);
#pragma unroll
    for (int t = 0; t < 4; ++t) {
        f32x4 o = cr[t] * __expf((float)(t + 1) * lg);
#pragma unroll
        for (int s2 = 0; s2 < 4; ++s2) o += v[s2] * sc[t][s2];
        const float mean = wave_sum(o.x + o.y + o.z + o.w) * (1.f / 256.f);
        o = o - mean;
        const float rstd = rsqrtf(wave_sum(o.x * o.x + o.y * o.y + o.z * o.z + o.w * o.w) * (1.f / 256.f) + EPS);
        bf16_t* gp = P + (rowb + t) * INC + C_G + h * 256 + 4 * lane;
        const u32x2 gg = *(const u32x2*)gp;
        u32x2 ov; ov.x = pk2(o.x * rstd * gn4.x * bf_lo(gg.x), o.y * rstd * gn4.y * bf_hi(gg.x)); ov.y = pk2(o.z * rstd * gn4.z * bf_lo(gg.y), o.w * rstd * gn4.w * bf_hi(gg.y));
        *(u32x2*)gp = ov; }
}
DEV void xattn_s_wave(const Params& p, LAS float* sc  , int item, int lane) {
    const int l32 = lane & 31, hf = lane >> 5;
    const int h = item & 3, b = item >> 2; const size_t rowb = (size_t)NP + b * 4;
    bf16_t* P = (bf16_t*)(p.ws + OFF_P);
    float q[4][4];
#pragma unroll
    for (int l = 0; l < 4; ++l) { const u32x2 x = *(const u32x2*)(P + (rowb + l) * INC + C_XQ + h * 128 + 4 * l32); q[l][0] = bf_lo(x.x); q[l][1] = bf_hi(x.x); q[l][2] = bf_lo(x.y); q[l][3] = bf_hi(x.y); }
    const float* Kb = p.cache_k + (((size_t)b * 256 + hf) * 4 + h) * 128 + 4 * l32;
    const float* Vb = p.cache_v + (((size_t)b * 256 + hf) * 4 + h) * 128 + 4 * l32;
    const bool b0 = l32 & 1, b1 = l32 & 2; const int lmap = (l32 & 1) * 2 + ((l32 >> 1) & 1);
    for (int it0 = 0; it0 < 128; it0 += 16) {
        f32x4 kv[16];
#pragma unroll
        for (int i = 0; i < 16; ++i) kv[i] = __builtin_nontemporal_load((const f32x4*)(Kb + (size_t)(it0 + i) * 1024));
#pragma unroll
        for (int i = 0; i < 16; ++i) { float d[4];
#pragma unroll
            for (int l = 0; l < 4; ++l) d[l] = q[l][0] * kv[i].x + q[l][1] * kv[i].y + q[l][2] * kv[i].z + q[l][3] * kv[i].w;
            float a0 = b0 ? d[2] : d[0], a1 = b0 ? d[3] : d[1];
            a0 += dpp_f<0xB1>(b0 ? d[0] : d[2]); a1 += dpp_f<0xB1>(b0 ? d[1] : d[3]);
            float r = b1 ? a1 : a0; r += dpp_f<0x4E>(b1 ? a0 : a1);
            r += dpp_f<0x124>(r); r += dpp_f<0x128>(r);
            r += __shfl_xor(r, 16);
            if (l32 < 4) sc[lmap * 256 + 2 * (it0 + i) + hf] = r * 0.08838834764831845f; }
    }
#pragma unroll
    for (int l = 0; l < 4; ++l) { float vv[4]; float mx = -3.0e38f;
#pragma unroll
        for (int i = 0; i < 4; ++i) { vv[i] = sc[l * 256 + lane + 64 * i]; mx = fmaxf(mx, vv[i]); }
        mx = wave_max(mx); float sm = 0.f;
#pragma unroll
        for (int i = 0; i < 4; ++i) { vv[i] = __expf(vv[i] - mx); sm += vv[i]; }
        const float inv = 1.f / wave_sum(sm);
#pragma unroll
        for (int i = 0; i < 4; ++i) sc[l * 256 + lane + 64 * i] = vv[i] * inv; }
    f32x4 o[4];
#pragma unroll
    for (int l = 0; l < 4; ++l) o[l] = (f32x4){0.f, 0.f, 0.f, 0.f};
    for (int it0 = 0; it0 < 128; it0 += 16) {
        f32x4 vv[16];
#pragma unroll
        for (int i = 0; i < 16; ++i) vv[i] = __builtin_nontemporal_load((const f32x4*)(Vb + (size_t)(it0 + i) * 1024));
#pragma unroll
        for (int i = 0; i < 16; ++i) { const int m = 2 * (it0 + i) + hf;
#pragma unroll
            for (int l = 0; l < 4; ++l) o[l] += vv[i] * sc[l * 256 + m]; }
    }
#pragma unroll
    for (int l = 0; l < 4; ++l) { f32x4 t = o[l];
        t.x += __shfl_xor(t.x, 32); t.y += __shfl_xor(t.y, 32); t.z += __shfl_xor(t.z, 32); t.w += __shfl_xor(t.w, 32);
        if (hf == 0) { u32x2 ov; ov.x = pk2(t.x, t.y); ov.y = pk2(t.z, t.w); *(u32x2*)(P + (rowb + l) * INC + C_XQ + h * 128 + 4 * l32) = ov; } }
}
DEV void sgu_s_wave(const Params& p, int b, int lane) {
    const size_t rowb = (size_t)NP + b * 4;
    bf16_t* P = (bf16_t*)(p.ws + OFF_P);
    const int gq = lane >> 4;
    float vn[4][8];
    const f32x4 l0 = *(const f32x4*)(p.sg_ln_g + 8 * lane), l1 = *(const f32x4*)(p.sg_ln_g + 8 * lane + 4);
    const float lng[8] = {l0.x, l0.y, l0.z, l0.w, l1.x, l1.y, l1.z, l1.w};
#pragma unroll
    for (int r = 0; r < 4; ++r) { float x[8]; unpack8(*(const u32x4*)(P + (rowb + r) * INC + C_SV + 8 * lane), x);
        float sm = 0.f;
#pragma unroll
        for (int i = 0; i < 8; ++i) sm += x[i];
        const float mean = wave_sum(sm) * (1.f / 512.f); float s2 = 0.f;
#pragma unroll
        for (int i = 0; i < 8; ++i) { x[i] -= mean; s2 += x[i] * x[i]; }
        const float rstd = rsqrtf(wave_sum(s2) * (1.f / 512.f) + EPS);
#pragma unroll
        for (int i = 0; i < 8; ++i) vn[r][i] = x[i] * rstd * lng[i];
        float* o = p.out + O_SGV + ((size_t)b * 4 + r) * 512 + 8 * lane;
        *(f32x4*)o = (f32x4){vn[r][0], vn[r][1], vn[r][2], vn[r][3]}; *(f32x4*)(o + 4) = (f32x4){vn[r][4], vn[r][5], vn[r][6], vn[r][7]}; }
#pragma unroll
    for (int t = 0; t < 4; ++t) { float mx[8];
#pragma unroll
        for (int i = 0; i < 8; ++i) mx[i] = p.sg_bs[gq * 128 + t];
#pragma unroll
        for (int s2 = 0; s2 < 4; ++s2) if (s2 <= t) { const float wv = p.sg_ws[(size_t)(gq * 128 + t) * 128 + s2];
#pragma unroll
            for (int i = 0; i < 8; ++i) mx[i] += wv * vn[s2][i]; }
        bf16_t* up = P + (rowb + t) * INC + C_SU + 8 * lane; float u[8]; unpack8(*(const u32x4*)up, u);
        u32x4 ov; ov.x = pk2(u[0] * mx[0], u[1] * mx[1]); ov.y = pk2(u[2] * mx[2], u[3] * mx[3]); ov.z = pk2(u[4] * mx[4], u[5] * mx[5]); ov.w = pk2(u[6] * mx[6], u[7] * mx[7]);
        *(u32x4*)up = ov; }
}

DEV void rms_phase(const Params& p, bool final_) {
    const int lane = otid() & 63, gw = obid() * 8 + (otid() >> 6), NGW = gridDim.x * 8;
    const float* g = final_ ? p.norm_final_g : p.norm_ffn_g;
    const float* part = (const float*)(p.ws + (final_ ? OFF_PART10 : OFF_PART6)); const int npart = final_ ? 22 : 8;
    for (int r = gw; r < MT; r += NGW) {
        float* xr = p.out + (size_t)r * 1024;
        f32x4 v[4]; float s = 0.f;
        if (r < NP) {
            const float* xin = p.x_prompt + (size_t)r * 1024; const bf16_t* sc = (const bf16_t*)xr;
            u32x2 mx[4], fx[4];
#pragma unroll
            for (int j = 0; j < 4; ++j) { v[j] = __builtin_nontemporal_load((const f32x4*)(xin + 4 * lane + 256 * j)); mx[j] = __builtin_nontemporal_load((const u32x2*)(sc + 1024 + 4 * lane + 256 * j)); fx[j] = final_ ? __builtin_nontemporal_load((const u32x2*)(sc + 4 * lane + 256 * j)) : (u32x2){0u, 0u}; }
#pragma unroll
            for (int j = 0; j < 4; ++j) { v[j].x += bf_lo(mx[j].x) + bf_lo(fx[j].x); v[j].y += bf_hi(mx[j].x) + bf_hi(fx[j].x); v[j].z += bf_lo(mx[j].y) + bf_lo(fx[j].y); v[j].w += bf_hi(mx[j].y) + bf_hi(fx[j].y); }
        } else {
            const float* base = final_ ? xr : p.x_sample + (size_t)(r - NP) * 1024;
#pragma unroll
            for (int j = 0; j < 4; ++j) v[j] = *(const f32x4*)(base + 4 * lane + 256 * j);
            for (int k = 0; k < npart; ++k) { const float* pr = part + (size_t)k * SROWS + (size_t)(r - NP) * 1024;
#pragma unroll
                for (int j = 0; j < 4; ++j) v[j] += *(const f32x4*)(pr + 4 * lane + 256 * j); }
            if (!final_) {
#pragma unroll
                for (int j = 0; j < 4; ++j) *(f32x4*)(xr + 4 * lane + 256 * j) = v[j]; }
        }
#pragma unroll
        for (int j = 0; j < 4; ++j) s += v[j].x * v[j].x + v[j].y * v[j].y + v[j].z * v[j].z + v[j].w * v[j].w;
        s = wave_sum(s); const float rr = rsqrtf(s * (1.f / 1024.f) + EPS);
        if (final_) {
#pragma unroll
            for (int j = 0; j < 4; ++j) { const f32x4 gv = *(const f32x4*)(g + 4 * lane + 256 * j); *(f32x4*)(xr + 4 * lane + 256 * j) = v[j] * rr * gv; }
        } else { bf16_t* orow = (bf16_t*)(p.ws + OFF_R2) + (size_t)r * 1024;
#pragma unroll
            for (int j = 0; j < 4; ++j) { const f32x4 gv = *(const f32x4*)(g + 4 * lane + 256 * j);
                u32x2 o; o.x = pk2(v[j].x * rr * gv.x, v[j].y * rr * gv.y); o.y = pk2(v[j].z * rr * gv.z, v[j].w * rr * gv.w);
                *(u32x2*)(orow + 4 * lane + 256 * j) = o; } }
    }
}
DEV void conv_phase(const Params& p) {
    const bf16_t* z = (const bf16_t*)(p.ws + OFF_Z); bf16_t* act = (bf16_t*)(p.ws + OFF_ACT);
    const int gtid = obid() * 512 + otid(), NT = gridDim.x * 512;
    for (int idx = gtid; idx < (NP / 8) * 352; idx += NT) {
        const int rb = idx / 352, ch = idx - rb * 352, c = ch * 8, r0 = rb * 8;
        float wa[3][8], wb[3][8], ba[8], bb[8];
#pragma unroll
        for (int j = 0; j < 3; ++j) { const f32x4 a0 = *(const f32x4*)(p.conv_w + j * FF2 + c), a1 = *(const f32x4*)(p.conv_w + j * FF2 + c + 4), b0 = *(const f32x4*)(p.conv_w + j * FF2 + FF + c), b1 = *(const f32x4*)(p.conv_w + j * FF2 + FF + c + 4);
#pragma unroll
            for (int i = 0; i < 4; ++i) { wa[j][i] = a0[i]; wa[j][4 + i] = a1[i]; wb[j][i] = b0[i]; wb[j][4 + i] = b1[i]; } }
        { const f32x4 a0 = *(const f32x4*)(p.conv_b + c), a1 = *(const f32x4*)(p.conv_b + c + 4), b0 = *(const f32x4*)(p.conv_b + FF + c), b1 = *(const f32x4*)(p.conv_b + FF + c + 4);
#pragma unroll
          for (int i = 0; i < 4; ++i) { ba[i] = a0[i]; ba[4 + i] = a1[i]; bb[i] = b0[i]; bb[4 + i] = b1[i]; } }
        u32x4 ra[10], rbq[10];
        const bool first = (r0 & 2047) == 0;
#pragma unroll
        for (int k = 0; k < 10; ++k) { const int rr = r0 - 2 + k;
            if (k < 2 && first) { ra[k] = (u32x4){0u, 0u, 0u, 0u}; rbq[k] = ra[k]; }
            else { ra[k] = __builtin_nontemporal_load((const u32x4*)(z + (size_t)rr * FF2 + c)); rbq[k] = __builtin_nontemporal_load((const u32x4*)(z + (size_t)rr * FF2 + FF + c)); } }
        float xa[3][8], xb[3][8];
        unpack8(ra[0], xa[0]); unpack8(rbq[0], xb[0]); unpack8(ra[1], xa[1]); unpack8(rbq[1], xb[1]);
#pragma unroll
        for (int k = 0; k < 8; ++k) {
            unpack8(ra[k + 2], xa[(k + 2) % 3]); unpack8(rbq[k + 2], xb[(k + 2) % 3]);
            float o[8];
#pragma unroll
            for (int i = 0; i < 8; ++i) {
                const float za = ba[i] + wa[0][i] * xa[k % 3][i] + wa[1][i] * xa[(k + 1) % 3][i] + wa[2][i] * xa[(k + 2) % 3][i];
                const float zb = bb[i] + wb[0][i] * xb[k % 3][i] + wb[1][i] * xb[(k + 1) % 3][i] + wb[2][i] * xb[(k + 2) % 3][i];
                o[i] = gelu_t(za) * zb; }
            u32x4 ov; ov.x = pk2(o[0], o[1]); ov.y = pk2(o[2], o[3]); ov.z = pk2(o[4], o[5]); ov.w = pk2(o[6], o[7]);
            *(u32x4*)(act + (size_t)(r0 + k) * FF + c) = ov; }
    }
    for (int idx = gtid; idx < NS * 352; idx += NT) {
        const int rs = idx / 352, ch = idx - rs * 352, c = ch * 8, r = NP + rs, tpos = rs & 3;
        float za[8], zb[8];
#pragma unroll
        for (int i = 0; i < 8; ++i) { za[i] = p.conv_b[c + i]; zb[i] = p.conv_b[FF + c + i]; }
#pragma unroll
        for (int j = 0; j < 3; ++j) {
            const int tp = tpos - 2 + j;
            float xa[8], xb[8];
            if (tp >= 0) { unpack8(*(const u32x4*)(z + (size_t)(r - 2 + j) * FF2 + c), xa); unpack8(*(const u32x4*)(z + (size_t)(r - 2 + j) * FF2 + FF + c), xb); }
            else { const float* sp = p.state_conv + ((size_t)(rs >> 2) * 2 + (tp + 2)) * FF2;
#pragma unroll
                for (int i = 0; i < 8; ++i) { xa[i] = sp[c + i]; xb[i] = sp[FF + c + i]; } }
#pragma unroll
            for (int i = 0; i < 8; ++i) { za[i] += p.conv_w[j * FF2 + c + i] * xa[i]; zb[i] += p.conv_w[j * FF2 + FF + c + i] * xb[i]; }
        }
        u32x4 o; o.x = pk2(gelu_t(za[0]) * zb[0], gelu_t(za[1]) * zb[1]); o.y = pk2(gelu_t(za[2]) * zb[2], gelu_t(za[3]) * zb[3]);
        o.z = pk2(gelu_t(za[4]) * zb[4], gelu_t(za[5]) * zb[5]); o.w = pk2(gelu_t(za[6]) * zb[6], gelu_t(za[7]) * zb[7]);
        *(u32x4*)(act + (size_t)r * FF + c) = o;
    }
}

#define XB_TMO      128
#define XB_XCNT(j)  (256  + 64 * (j))
#define XB_XSUB(j)  (1280 + 64 * (j))
#define XB_XGEN(j)  (2304 + 64 * (j))
#define XB_TOP      3328
#define XB_TOPGEN   3392
#define XCD_BAR_WORDS 3456
#define XB_SPIN_CAP (1u << 18)
DEV unsigned xb_ld(unsigned* p)              { return __hip_atomic_load(p, __ATOMIC_RELAXED, __HIP_MEMORY_SCOPE_AGENT); }
DEV unsigned xb_add(unsigned* p, unsigned v) { return __hip_atomic_fetch_add(p, v, __ATOMIC_RELAXED, __HIP_MEMORY_SCOPE_AGENT); }
DEV unsigned xb_xcc_id() { return (unsigned)__builtin_amdgcn_s_getreg((3 << 11) | 20) & 0xFu; }
#define XB_SPIN(cond, bar) do { unsigned _sp = 0; while (cond) { __builtin_amdgcn_s_sleep(1); \
    if ((++_sp & 255u) == 0u) { if (xb_ld(&(bar)[XB_TMO])) break; if (_sp > XB_SPIN_CAP) { atomicAdd(&(bar)[XB_TMO], 1u); break; } } } } while (0)
struct XcdBarrier { unsigned* bar; unsigned x; volatile LAS unsigned* st; };
DEV XcdBarrier xcd_barrier_post(unsigned* bar, volatile LAS unsigned* st) {
    XcdBarrier b; b.bar = bar; b.x = xb_xcc_id(); b.st = st;
    if (threadIdx.x == 0) (void)xb_add(&bar[XB_XCNT(b.x)], 1u);
    return b; }
DEV void xcd_barrier_complete(unsigned* bar, unsigned x, unsigned& nloc, unsigned& nx) {
    const unsigned G = gridDim.x * gridDim.y * gridDim.z;
    unsigned sum, cnt, mine, sp = 0u;
    for (;;) {
        sum = 0u; cnt = 0u; mine = 0u;
#pragma unroll
        for (unsigned j = 0; j < 16; ++j) { const unsigned c = xb_ld(&bar[XB_XCNT(j)]); sum += c; cnt += (c > 0u) ? 1u : 0u; mine = (j == x) ? c : mine; }
        if (sum == G) break;
        __builtin_amdgcn_s_sleep(1);
        if ((++sp & 255u) == 0u) { if (xb_ld(&bar[XB_TMO])) break; if (sp > XB_SPIN_CAP) { atomicAdd(&bar[XB_TMO], 1u); break; } }
    }
    nloc = mine > 0u ? mine : 1u; nx = cnt > 0u ? cnt : 1u; }
DEV void xcd_barrier(unsigned* bar_, volatile LAS unsigned* st_) {
    XcdBarrier b; b.bar = bar_; b.x = xb_xcc_id(); b.st = st_;
    asm volatile("s_waitcnt vmcnt(0)" ::: "memory");
    __syncthreads();
    if (threadIdx.x == 0) {
        unsigned* bar = b.bar;
        __builtin_amdgcn_s_waitcnt(0);
        unsigned nloc = b.st[0], nx = b.st[1];
        if (nloc == 0u) { xcd_barrier_complete(bar, b.x, nloc, nx); b.st[0] = nloc; b.st[1] = nx; }
        const unsigned old = xb_add(&bar[XB_XSUB(b.x)], 1u);
        const unsigned gen = old / nloc;
        if (old + 1u == (gen + 1u) * nloc) {
            __builtin_amdgcn_fence(__ATOMIC_RELEASE, "agent");
            asm volatile("s_waitcnt vmcnt(0)" ::: "memory");
            const unsigned og = xb_add(&bar[XB_TOP], 1u);
            const unsigned tg = og / nx;
            if (og + 1u == (tg + 1u) * nx) xb_add(&bar[XB_TOPGEN], 1u);
            else XB_SPIN(xb_ld(&bar[XB_TOPGEN]) == tg, bar);
            __builtin_amdgcn_fence(__ATOMIC_ACQUIRE, "agent");
            xb_add(&bar[XB_XGEN(b.x)], 1u);
            asm volatile("s_waitcnt vmcnt(0)" ::: "memory");
        } else {
            XB_SPIN(xb_ld(&bar[XB_XGEN(b.x)]) == gen, bar);
            __builtin_amdgcn_fence(__ATOMIC_ACQUIRE, "agent");
            asm volatile("s_waitcnt vmcnt(0)" ::: "memory");
        }
    }
    __syncthreads();
}

DEV Params kp_load() { Params r{};
#if defined(__HIP_DEVICE_COMPILE__)
    typedef const unsigned long long __attribute__((address_space(4))) KA;
    KA* q = (KA*)__builtin_amdgcn_kernarg_segment_ptr(); asm volatile("" : "+s"(q));
    unsigned long long t[28];
#pragma unroll
    for (int i = 0; i < 28; ++i) t[i] = q[i];
    __builtin_memcpy(&r, t, sizeof(Params));
#endif
    return r; }
__global__ __launch_bounds__(512, 2) void mega(Params p_arg, int ph0, int ph1) {
    extern __shared__ __attribute__((aligned(16))) unsigned char shm[];
    LAS unsigned char* lds = (LAS unsigned char*)shm;
    cg::grid_group grid = cg::this_grid();
#ifndef TIME_SEL
#define TIME_SEL 0
#endif
    unsigned long long tacc = 0;
    const int G = gridDim.x, c = obid();
    volatile LAS unsigned* xst = (volatile LAS unsigned*)(lds + LDS_BYTES - 16);
    if (threadIdx.x == 0) { xst[0] = 0u; xst[1] = 0u; }
    __syncthreads();
    (void)xcd_barrier_post((unsigned*)(kp_load().ws + OFF_BAR), xst);
#ifndef DUP_PH
#define DUP_PH -1
#endif
#ifndef PH_TIME_MASK
#define PH_TIME_MASK 0
#endif
#define PH_BEGIN(k) if (ph0 <= (k) && (k) < ph1) { const unsigned long long tph_ = ((PH_TIME_MASK) >> (k)) & 1 ? __builtin_amdgcn_s_memrealtime() : 0ull; if (PHON(k)) { for (int rep_ = 0; rep_ < ((k) == DUP_PH ? 2 : 1); ++rep_) { const Params p = kp_load(); unsigned char* ws = p.ws;
#define PH_END(k) } } if ((k) + 1 < ph1) { if ((k) == 0) grid.sync(); else xcd_barrier((unsigned*)(kp_load().ws + OFF_BAR), (volatile LAS unsigned*)(lds + LDS_BYTES - 16)); } if (((PH_TIME_MASK) >> (k)) & 1) tacc += __builtin_amdgcn_s_memrealtime() - tph_; }
    PH_BEGIN(0) phase_prep(p, lds); PH_END(0)
    PH_BEGIN(1)
            Sched1 S{G, c, (const char*)(ws + OFF_R2), (const char*)(ws + OFF_HM), (const char*)(ws + OFF_BTIN), (const char*)(ws + OFF_BTKV)};
            Epi1 E{(bf16_t*)(ws + OFF_P), (bf16_t*)(ws + OFF_MKB), p.out, (const float*)(ws + OFF_ROPEC), (const float*)(ws + OFF_ROPES), p.b_gate};
            pg8::gemm_phase(lds, 1024, 1024, S, E);
    PH_END(1)
    PH_BEGIN(2)
            for (int it = c; it < 1536; it += G) {
                if (it < 512) ret_A_item(p, lds, it);
                else if (it < 1024) xattn_item(p, lds, it - 512);
                else sgu_item(p, lds, it - 1024);
            }
            {
                const int tid2 = otid(), w2 = __builtin_amdgcn_readfirstlane(tid2 >> 6), lane2 = tid2 & 63;
                if (w2 < 2) ret_s_wave(p, c + 256 * w2, lane2);
                else if (w2 < 4) xattn_s_wave(p, (LAS float*)(lds + 4096 * w2), c + 256 * (w2 - 2), lane2);
                else if (w2 == 4 && c < 128) sgu_s_wave(p, c, lane2);
            }
    PH_END(2)
    PH_BEGIN(3)
            scan_phase(p);
            SchedMgS S{c, (const char*)(ws + OFF_P), (const char*)(ws + OFF_BTMG)};
            EpiMgS E{(const bf16_t*)(ws + OFF_P), (float*)(ws + OFF_MG32)};
            pg8::gemm_phase(lds, INC, 2048, S, E);
    PH_END(3)
    PH_BEGIN(4) for (int it = c; it < 512; it += G) ret_C_item(p, lds, it); PH_END(4)
    PH_BEGIN(5)
            {
                const int i = obid() * 512 + otid();
                if (i < 131072) { f32x4 m = __builtin_nontemporal_load((const f32x4*)(ws + OFF_MG32) + i);
#pragma unroll
                    for (int k = 1; k < 8; ++k) m += __builtin_nontemporal_load((const f32x4*)(ws + OFF_MG32) + (size_t)k * 131072 + i);
                    u32x2 o; o.x = pk2(m.x, m.y); o.y = pk2(m.z, m.w);
                    ((u32x2*)((bf16_t*)(ws + OFF_R2) + (size_t)NP * 1024))[i] = o; } }
            SchedMg S{G, c, (const char*)(ws + OFF_P), (const char*)(ws + OFF_BTMG)};
            EpiMg E{(const bf16_t*)(ws + OFF_P), (bf16_t*)(ws + OFF_R2)};
            pg8::gemm_phase(lds, INC, 2048, S, E);
    PH_END(5)
    PH_BEGIN(6)
            SchedPS<16, 64, 8, 524288, 524288> S{G, c, (const char*)(ws + OFF_R2), (const char*)(ws + OFF_BTO)};
            EpiWo E{p.x_prompt, p.x_sample, p.out, (float*)(ws + OFF_PART6)};
            pg8::gemm_phase(lds, 1024, 1024, S, E);
    PH_END(6)
    PH_BEGIN(7) rms_phase(p, false); PH_END(7)
    PH_BEGIN(8)
            SchedPlain S{G, c, 66, 22, 16, (const char*)(ws + OFF_R2), (const char*)(ws + OFF_BTUP), (size_t)524288, (size_t)524288};
            EpiUp E{(bf16_t*)(ws + OFF_Z), p.out};
            pg8::gemm_phase(lds, 1024, 1024, S, E);
    PH_END(8)
    PH_BEGIN(9) conv_phase(p); PH_END(9)
    PH_BEGIN(10)
            SchedPS<44, 176, 22, 256 * FF * 2, 256 * FF * 2> S{G, c, (const char*)(ws + OFF_ACT), (const char*)(ws + OFF_BTDN)};
            EpiDn E{p.out, (float*)(ws + OFF_PART10)};
            pg8::gemm_phase(lds, FF, FF, S, E);
    PH_END(10)
    PH_BEGIN(11) rms_phase(p, true); PH_END(11)
    if (((TIME_SEL) || (PH_TIME_MASK)) && blockIdx.x == 0 && ph1 > 1) { const unsigned long long t0_ = __builtin_amdgcn_s_memrealtime(); while (__builtin_amdgcn_s_memrealtime() - t0_ < tacc) __builtin_amdgcn_s_sleep(8); }
}

extern "C" void kernel_launch(void* const* d_in, const int* in_sizes, int n_in, void* d_out, int out_size, void* d_ws, size_t ws_size, hipStream_t stream) {
    static int grid = 0;
    if (grid == 0) {
        if (n_in != 26 || out_size != 39018496 || ws_size < WS_END2) { fprintf(stderr, "kernel_launch: unexpected shapes n_in %d out %d ws %zu (need %zu)\n", n_in, out_size, ws_size, (size_t)WS_END2); grid = -1; return; }
        int dev = 0, cus = 0, per_cu = 0;
        hipGetDevice(&dev); hipDeviceGetAttribute(&cus, hipDeviceAttributeMultiprocessorCount, dev);
        if (hipFuncSetAttribute((const void*)mega, hipFuncAttributeMaxDynamicSharedMemorySize, LDS_BYTES) != hipSuccess) { fprintf(stderr, "kernel_launch: hipFuncSetAttribute failed\n"); grid = -1; return; }
        if (hipOccupancyMaxActiveBlocksPerMultiprocessor(&per_cu, (const void*)mega, 512, LDS_BYTES) != hipSuccess || per_cu < 1) { fprintf(stderr, "kernel_launch: occupancy query gave %d\n", per_cu); grid = -1; return; }
        if (cus != 256) { fprintf(stderr, "kernel_launch: built for 256 CUs, got %d\n", cus); grid = -1; return; }
        grid = cus;
    }
    if (grid < 0) return;
    Params p{};
    const float** f = (const float**)&p;
    for (int i = 0; i < 26; ++i) f[i] = (const float*)d_in[i];
    p.out = (float*)d_out; p.ws = (unsigned char*)d_ws;
#ifndef DBG_NPH
#define DBG_NPH 12
#endif
#ifndef MK_MULTI
#define MK_MULTI 0
#endif
#if MK_MULTI
#ifndef PH_SEQ
#define PH_SEQ 0,1,2,3,4,5,6,7,8,9,10,11
#endif
    { const int seq[] = {PH_SEQ}; for (int ph : seq) hipLaunchKernelGGL(mega, dim3(grid), dim3(512), LDS_BYTES, stream, p, ph, ph + 1); }
    hipError_t e = hipSuccess;
#else
    (void)hipMemsetAsync((unsigned char*)d_ws + OFF_BAR, 0, 16384, stream);
    int ph0 = 0, ph1 = NPHASE;
    void* args[] = {&p, &ph0, &ph1};
    hipError_t e = hipLaunchCooperativeKernel((const void*)mega, dim3(grid), dim3(512), args, LDS_BYTES, stream);
#endif
    if (e != hipSuccess) fprintf(stderr, "cooperative launch failed: %s (grid %d)\n", hipGetErrorString(e), grid);
}
```

```cpp
#include <hip/hip_runtime.h>
#include <hip/hip_cooperative_groups.h>
#include <cstdio>
#include <cstdint>
namespace cg = cooperative_groups;

#define LAS __attribute__((address_space(3)))
#define DEV __device__ __forceinline__
typedef unsigned short bf16_t;
typedef short bf16x8 __attribute__((ext_vector_type(8)));
typedef short s16x4 __attribute__((ext_vector_type(4)));
typedef float f32x4 __attribute__((ext_vector_type(4)));
typedef unsigned u32x4 __attribute__((ext_vector_type(4)));
typedef unsigned u32x2 __attribute__((ext_vector_type(2)));

constexpr int NP = 16384, NS = 512, MT = 16896, INC = 7680, FF = 2816, FF2 = 5632;
constexpr int C_Q = 0, C_K = 512, C_V = 1024, C_G = 2048, C_SU = 3072, C_XQ = 3584, C_SV = 4096, C_GT = 4608;
constexpr float EPS = 1e-6f;
constexpr size_t OFF_BTIN = 0;
constexpr size_t OFF_BTKV = OFF_BTIN + 15728640;
constexpr size_t OFF_BTMG = OFF_BTKV + 2097152;
constexpr size_t OFF_BTO = OFF_BTMG + 4194304;
constexpr size_t OFF_BTUP = OFF_BTO + 2097152;
constexpr size_t OFF_BTDN = OFF_BTUP + 11534336;
constexpr size_t OFF_ROPEC = OFF_BTDN + 5767168;
constexpr size_t OFF_ROPES = OFF_ROPEC + 525312;
constexpr size_t OFF_WTRIL = OFF_ROPES + 525312;
constexpr size_t OFF_HM = OFF_WTRIL + 131072;
constexpr size_t OFF_MKB = OFF_HM + 4194304;
constexpr size_t OFF_P = OFF_MKB + 4194304;
constexpr size_t OFF_R2 = OFF_P + 259522560;
constexpr size_t OFF_MG32 = OFF_R2 + 34603008;
constexpr size_t WS_END = OFF_MG32 + 8 * 2097152;
constexpr size_t OFF_BAR = WS_END;
constexpr size_t WS_END2 = OFF_BAR + 16384;
constexpr size_t OFF_PART6 = OFF_P, OFF_PART10 = OFF_P;
constexpr int SROWS = 512 * 1024;
constexpr size_t OFF_Z = OFF_P;
constexpr size_t OFF_ACT = OFF_P + 190316544;
constexpr size_t O_Y = 0, O_RETP = 17301504, O_CONVP = 18350080, O_MK = 18440192, O_MV = 19488768, O_RETS = 20537344, O_CONVS = 37314560, O_SGV = 38756352;
constexpr int LDS_BYTES = 147456;
constexpr int NPHASE = 12;
#ifndef DBG_XA
#define DBG_XA 3
#endif
#ifndef ONLY_PH
#define ONLY_PH -1
#endif
#ifndef SKIP_PH
#define SKIP_PH -2
#endif
#define PHON(n) ((ONLY_PH < 0 || ONLY_PH == (n)) && SKIP_PH != (n))

struct Params {
    const float *x_prompt, *x_sample, *mem_prompt, *state_ret, *state_conv, *cache_k, *cache_v, *norm_mix_g, *w_in, *b_gate, *ret_gn_g, *sg_ln_g, *sg_ws, *sg_bs,
        *mem_norm_g, *w_mem_kv, *w_br_ret, *w_br_sg, *w_br_x, *w_o, *norm_ffn_g, *w_up, *conv_w, *conv_b, *w_down, *norm_final_g;
    float* out; unsigned char* ws;
};

typedef __bf16 bf16v2_t __attribute__((ext_vector_type(2)));
typedef float f32x2_t __attribute__((ext_vector_type(2)));
DEV unsigned pk2(float lo, float hi) { const f32x2_t f = {lo, hi}; const bf16v2_t v = __builtin_convertvector(f, bf16v2_t); return __builtin_bit_cast(unsigned, v); }
DEV bf16_t f2bf(float v) { return (bf16_t)(pk2(v, 0.f) & 0xffffu); }
DEV float bf_lo(unsigned u) { return __uint_as_float(u << 16); }
DEV float bf_hi(unsigned u) { return __uint_as_float(u & 0xffff0000u); }
DEV float bf2f(bf16_t b) { return __uint_as_float(((unsigned)b) << 16); }
DEV void unpack8(const u32x4 a, float (&x)[8]) { x[0] = bf_lo(a.x); x[1] = bf_hi(a.x); x[2] = bf_lo(a.y); x[3] = bf_hi(a.y); x[4] = bf_lo(a.z); x[5] = bf_hi(a.z); x[6] = bf_lo(a.w); x[7] = bf_hi(a.w); }
template <int CTRL> DEV float dpp_f(float v) { return __int_as_float(__builtin_amdgcn_update_dpp(0, __float_as_int(v), CTRL, 0xF, 0xF, true)); }
DEV float rdl(float v, int l) { return __int_as_float(__builtin_amdgcn_readlane(__float_as_int(v), l)); }
DEV float g16_sum(float v) { v += dpp_f<0xB1>(v); v += dpp_f<0x4E>(v); v += dpp_f<0x141>(v); v += dpp_f<0x140>(v); return v; }
DEV float g16_max(float v) { v = fmaxf(v, dpp_f<0xB1>(v)); v = fmaxf(v, dpp_f<0x4E>(v)); v = fmaxf(v, dpp_f<0x141>(v)); v = fmaxf(v, dpp_f<0x140>(v)); return v; }
DEV float wave_sum(float v) { v = g16_sum(v); return (rdl(v, 0) + rdl(v, 16)) + (rdl(v, 32) + rdl(v, 48)); }
DEV float wave_max(float v) { v = g16_max(v); return fmaxf(fmaxf(rdl(v, 0), rdl(v, 16)), fmaxf(rdl(v, 32), rdl(v, 48))); }
DEV float sigm_f(float x) { return __builtin_amdgcn_rcpf(1.f + __builtin_amdgcn_exp2f(-1.4426950408889634f * x)); }
DEV float silu_f(float x) { return x * sigm_f(x); }
DEV float gelu_t(float x) { const float u = x * (2.3022081646f + 0.1029432406f * x * x); return x * __builtin_amdgcn_rcpf(1.f + __builtin_amdgcn_exp2f(-u)); }
DEV float log_gamma(int h) { return log1pf(-exp2f(-5.f - (float)h)); }
DEV int otid() { int t = threadIdx.x; asm volatile("" : "+v"(t)); return t; }
DEV int obid() { int t = blockIdx.x; asm volatile("" : "+s"(t)); return t; }
DEV unsigned ldsaddr(LAS const void* p) { return (unsigned)(uintptr_t)p; }
DEV f32x4 mfma16(bf16x8 a, bf16x8 b, f32x4 c) { return __builtin_amdgcn_mfma_f32_16x16x32_bf16(a, b, c, 0, 0, 0); }
DEV bf16x8 lds_frag(LAS const unsigned char* base, int pitch, int row0, int k0, int lane) {
    return *(LAS const bf16x8*)(base + (row0 + (lane & 15)) * pitch + (k0 + 8 * (lane >> 4)) * 2); }
DEV LAS const unsigned char* tr_lane_base(LAS const unsigned char* base, int pitch, int lane) { const int g = lane >> 4, q = (lane & 15) >> 2, pp = lane & 3; return base + ((8 * g + q) * pitch + 8 * pp); }
template <int PITCH, int KB, int X0> DEV void tr_read4(LAS const unsigned char* a, bf16x8 (&f)[4]) {
    constexpr int o0 = KB * PITCH + X0 * 2;
    static_assert(o0 + 100 * PITCH < 65536, "ds offset field");
#pragma unroll
    for (int ks = 0; ks < 4; ++ks) {
        const s16x4 lo = __builtin_amdgcn_ds_read_tr16_b64_v4i16((LAS s16x4*)(a + o0 + ks * 32 * PITCH));
        const s16x4 hi = __builtin_amdgcn_ds_read_tr16_b64_v4i16((LAS s16x4*)(a + o0 + ks * 32 * PITCH + 4 * PITCH));
        f[ks] = (bf16x8){lo[0], lo[1], lo[2], lo[3], hi[0], hi[1], hi[2], hi[3]}; } }
template <int V> struct IC { static constexpr int value = V; };
template <int I, int N, class F> DEV void static_for(F&& f) { if constexpr (I < N) { f(IC<I>{}); static_for<I + 1, N>(f); } }
#define SCHEDB __builtin_amdgcn_sched_barrier(0)

namespace pg8 {
constexpr int BM = 256, BK = 64, HALF = 128, HTB = HALF * BK * 2, NXCD = 8, WGM = 8;
DEV int lds_byte(int r, int c) { const int st = (r >> 4) * 2 + (c >> 5), rr = r & 15, cc = c & 31, ob = rr * 64 + cc * 2; return st * 1024 + (ob ^ (((ob >> 9) & 1) << 5)); }
DEV void stage_rc(int b, int& R, int& C) { const int st = b / 1024, sb = b % 1024, swz = sb ^ (((sb >> 9) & 1) << 5); R = (st >> 1) * 16 + swz / 64; C = (st & 1) * 32 + (swz % 64) / 2; }
DEV int perm32(int rho) { const int n = rho >> 4, i = rho & 15; return 8 * (i >> 2) + 4 * n + (i & 3); }
struct Unit { int pm, pn, kind, nt; const char* A; const char* B; };
DEV void tile_map(int L, int nM, int nN, int& pm, int& pn) {
    const int nwg = nM * nN; int wgid = L; { const int q = nwg / NXCD, r = nwg % NXCD, xcd = wgid % NXCD, off = wgid / NXCD; wgid = (xcd < r ? xcd * (q + 1) : r * (q + 1) + (xcd - r) * q) + off; }
    const int nig = WGM * nN, gid = wgid / nig, fm = gid * WGM, gsz = (nM - fm) < WGM ? (nM - fm) : WGM;
    pm = fm + ((wgid % nig) % gsz); pn = (wgid % nig) / gsz; }

template <class Epi, class Sched>
DEV void gemm_phase(LAS unsigned char* lds, int lda, int ldb, const Sched& S, const Epi& E) {
    const int tid = otid(), wid = __builtin_amdgcn_readfirstlane(tid >> 6), lane = tid & 63, wr = wid >> 2, wc = wid & 3, fr = lane & 15, fq = lane >> 4;
    unsigned voffA[2], voffB[2];
#pragma unroll
    for (int i = 0; i < 2; ++i) { int R, C; stage_rc(tid * 16 + i * 8192, R, C); const int Rb = (R & ~31) + perm32(R & 31);
        voffA[i] = (unsigned)(R * lda + C) * 2u; voffB[i] = (unsigned)(Rb * ldb + C) * 2u; }
    const size_t kstep = (size_t)(BK * 2);
    const size_t hstepA = (size_t)HALF * lda * 2, hstepB = (size_t)HALF * ldb * 2;
    const unsigned ldsw = (unsigned)wid * 1024u;
    const int aoff = lds_byte(wr * 64 + fr, fq * 8), boff = lds_byte(wc * 32 + fr, fq * 8);
#define PG8_SA(b, h) (((b) * 2 + (h)) * HTB)
#define PG8_SB(b, h) ((4 + (b) * 2 + (h)) * HTB)
#define PG8_STAGE(bufoff, gbase, voff) do { _Pragma("unroll") for (int _i = 0; _i < 2; ++_i) \
        __builtin_amdgcn_global_load_lds((const unsigned*)((const char*)(gbase) + (voff)[_i]), (LAS unsigned*)(lds + (bufoff) + ldsw + _i * 8192), 16, 0, 0); } while (0)
#define PG8_LDA(dst, b, h) do { _Pragma("unroll") for (int m = 0; m < 4; ++m) _Pragma("unroll") for (int k = 0; k < 2; ++k) dst[m][k] = *(const LAS bf16x8*)(lds + PG8_SA(b, h) + aoff + m * 2048 + k * 1024); } while (0)
#define PG8_LDB(dst, b, h) do { _Pragma("unroll") for (int n = 0; n < 2; ++n) _Pragma("unroll") for (int k = 0; k < 2; ++k) dst[n][k] = *(const LAS bf16x8*)(lds + PG8_SB(b, h) + boff + n * 2048 + k * 1024); } while (0)
#define PG8_MMA(ai, bj, At, Bt) do { __builtin_amdgcn_s_setprio(1); _Pragma("unroll") for (int m = 0; m < 4; ++m) _Pragma("unroll") for (int n = 0; n < 2; ++n) _Pragma("unroll") for (int k = 0; k < 2; ++k) \
        acc[ai][bj][m][n] = __builtin_amdgcn_mfma_f32_16x16x32_bf16(Bt[n][k], At[m][k], acc[ai][bj][m][n], 0, 0, 0); __builtin_amdgcn_s_setprio(0); } while (0)
#define PG8_WAIT_V(n) asm volatile("s_waitcnt vmcnt(" #n ")" ::: "memory")
#define PG8_WAIT_L(n) asm volatile("s_waitcnt lgkmcnt(" #n ")" ::: "memory")
#define PG8_BAR __builtin_amdgcn_s_barrier()
#define PG8_SCHED __builtin_amdgcn_sched_barrier(0)
    Unit cur, nxt; int ui = 0;
    if (!S.next(0, cur)) return;
    f32x4 acc[2][2][4][2];
#pragma unroll
    for (int a = 0; a < 2; ++a)
#pragma unroll
        for (int b = 0; b < 2; ++b)
#pragma unroll
            for (int m = 0; m < 4; ++m)
#pragma unroll
                for (int n = 0; n < 2; ++n) acc[a][b][m][n] = (f32x4){0.f, 0.f, 0.f, 0.f};
    bf16x8 At[4][2], B0[2][2], B1[2][2];
    const char* cA = cur.A; const char* cB = cur.B;
    PG8_STAGE(PG8_SB(0, 0), cB, voffB); PG8_STAGE(PG8_SA(0, 0), cA, voffA); PG8_STAGE(PG8_SB(0, 1), cB + hstepB, voffB); PG8_STAGE(PG8_SA(0, 1), cA + hstepA, voffA);
    if (wr == 1) PG8_BAR;
    PG8_WAIT_V(4); PG8_BAR;
    PG8_STAGE(PG8_SB(1, 0), cB + kstep, voffB); PG8_STAGE(PG8_SA(1, 0), cA + kstep, voffA); PG8_STAGE(PG8_SB(1, 1), cB + hstepB + kstep, voffB);
    PG8_WAIT_V(6); PG8_BAR;
    for (;;) {
        const bool has_next = S.next(ui + 1, nxt);
        const char* nA = has_next ? nxt.A : cA; const char* nB = has_next ? nxt.B : cB;
        const int nt = cur.nt;
        for (int t = 0; t < nt; t += 2) {
            const bool last = (t == nt - 2);
            const char* a1 = cA + (size_t)(t + 1) * kstep;
            const char* a2 = last ? nA : cA + (size_t)(t + 2) * kstep; const char* b2 = last ? nB : cB + (size_t)(t + 2) * kstep;
            const char* a3 = a2 + kstep; const char* b3 = b2 + kstep;
            PG8_LDB(B0, 0, 0); PG8_SCHED; PG8_LDA(At, 0, 0); PG8_STAGE(PG8_SA(1, 1), a1 + hstepA, voffA);
            PG8_WAIT_L(8); PG8_BAR; PG8_WAIT_L(0); PG8_MMA(0, 0, At, B0); PG8_BAR; PG8_SCHED;
            PG8_LDB(B1, 0, 1); PG8_STAGE(PG8_SB(0, 0), b2, voffB);
            PG8_BAR; PG8_WAIT_L(0); PG8_MMA(0, 1, At, B1); PG8_BAR;
            PG8_LDA(At, 0, 1); PG8_STAGE(PG8_SA(0, 0), a2, voffA);
            PG8_BAR; PG8_WAIT_L(0); PG8_MMA(1, 0, At, B0); PG8_BAR; PG8_SCHED;
            PG8_STAGE(PG8_SB(0, 1), b2 + hstepB, voffB);
            PG8_WAIT_V(6); PG8_BAR; PG8_MMA(1, 1, At, B1); PG8_BAR;
            PG8_LDB(B0, 1, 0); PG8_SCHED; PG8_LDA(At, 1, 0); PG8_STAGE(PG8_SA(0, 1), a2 + hstepA, voffA);
            PG8_WAIT_L(8); PG8_BAR; PG8_WAIT_L(0); PG8_MMA(0, 0, At, B0); PG8_BAR; PG8_SCHED;
            PG8_LDB(B1, 1, 1); PG8_STAGE(PG8_SB(1, 0), b3, voffB);
            PG8_BAR; PG8_WAIT_L(0); PG8_MMA(0, 1, At, B1); PG8_BAR;
            PG8_LDA(At, 1, 1); PG8_STAGE(PG8_SA(1, 0), a3, voffA);
            PG8_BAR; PG8_WAIT_L(0); PG8_MMA(1, 0, At, B0); PG8_BAR; PG8_SCHED;
            PG8_STAGE(PG8_SB(1, 1), b3 + hstepB, voffB);
            PG8_WAIT_V(6); PG8_BAR; PG8_MMA(1, 1, At, B1); PG8_BAR;
        }
        const bool keep = E(acc, cur, wr, wc, fr, fq);
        if (!has_next) break;
        if (!keep)
#pragma unroll
        for (int a = 0; a < 2; ++a)
#pragma unroll
            for (int b = 0; b < 2; ++b)
#pragma unroll
                for (int m = 0; m < 4; ++m)
#pragma unroll
                    for (int n = 0; n < 2; ++n) acc[a][b][m][n] = (f32x4){0.f, 0.f, 0.f, 0.f};
        cur = nxt; cA = nA; cB = nB; ++ui;
    }
    PG8_WAIT_V(0);
    if (wr == 0) PG8_BAR;
    PG8_BAR;
#undef PG8_SA
#undef PG8_SB
#undef PG8_STAGE
#undef PG8_LDA
#undef PG8_LDB
#undef PG8_MMA
#undef PG8_WAIT_V
#undef PG8_WAIT_L
#undef PG8_BAR
#undef PG8_SCHED
}
#define EPI_LOOP_BEGIN \
    _Pragma("unroll") for (int ai = 0; ai < 2; ++ai) _Pragma("unroll") for (int m = 0; m < 4; ++m) { const int row = u.pm * 256 + ai * 128 + wr * 64 + m * 16 + fr; \
    _Pragma("unroll") for (int bj = 0; bj < 2; ++bj) { const int col0 = u.pn * 256 + bj * 128 + wc * 32 + fq * 8; const f32x4 v0 = acc[ai][bj][m][0], v1 = acc[ai][bj][m][1];
#define EPI_LOOP_END } }
#define EPI_AI_BEGIN _Pragma("unroll") for (int ai = 0; ai < 2; ++ai) {
#define EPI_AI_END }
#define EPI_G_BEGIN _Pragma("unroll") for (int m = 0; m < 4; ++m) { const int row = u.pm * 256 + ai * 128 + wr * 64 + m * 16 + fr; \
    _Pragma("unroll") for (int bj = 0; bj < 2; ++bj) { const int col0 = u.pn * 256 + bj * 128 + wc * 32 + fq * 8; const int gi = m * 2 + bj; (void)gi; (void)row; (void)col0;
#define EPI_G_END } }
}
using pg8::Unit;
typedef f32x4 AccT[2][2][4][2];

struct Sched1 { int G, c; const char *h, *hm, *btin, *btkv;
    DEV bool next(int i, Unit& u) const {
        long L = (long)i * G + c;
        if (L < 1980) { pg8::tile_map((int)L, 66, 30, u.pm, u.pn); u.kind = 0; u.nt = 16; u.A = h + (size_t)u.pm * 524288; u.B = btin + (size_t)u.pn * 524288; return true; }
        L -= 1980; if (L < 32) { u.pm = (int)(L & 7); u.pn = (int)(L >> 3); u.kind = 1; u.nt = 16; u.A = hm + (size_t)u.pm * 524288; u.B = btkv + (size_t)u.pn * 524288; return true; }
        return false; } };
struct Epi1 { bf16_t* P; bf16_t* mkb; float* out; const float *ropeC, *ropeS, *b_gate;
    DEV bool operator()(AccT& acc, const Unit& u, int wr, int wc, int fr, int fq) const {
        if (u.kind == 1) {
            EPI_LOOP_BEGIN
                float* o = (col0 < 512) ? out + O_MK + (size_t)row * 512 + col0 : out + O_MV + (size_t)row * 512 + (col0 - 512);
                *(f32x4*)o = v0; *(f32x4*)(o + 4) = v1;
                u32x4 pk; pk.x = pk2(v0.x, v0.y); pk.y = pk2(v0.z, v0.w); pk.z = pk2(v1.x, v1.y); pk.w = pk2(v1.z, v1.w);
                *(u32x4*)(mkb + (size_t)row * 1024 + col0) = pk;
            EPI_LOOP_END
            return false; }
        const int pn = u.pn;
        if (pn < 4) {
            const float sc = (pn >= 2) ? 0.08838834764831845f : 1.f;
            EPI_AI_BEGIN
                f32x4 cs[8], sn[8];
                EPI_G_BEGIN
                    const int pidx = row < NP ? (row & 2047) : 2048 + ((row - NP) & 3); const int uu = (col0 & 127) >> 3;
                    cs[gi] = *(const f32x4*)(ropeC + pidx * 64 + 4 * uu); sn[gi] = *(const f32x4*)(ropeS + pidx * 64 + 4 * uu);
                EPI_G_END
                EPI_G_BEGIN
                    const f32x4 v0 = acc[ai][bj][m][0], v1 = acc[ai][bj][m][1];
                    const int uu = (col0 & 127) >> 3, hb = col0 & ~127;
                    const f32x4 o1 = (v0 * cs[gi] - v1 * sn[gi]) * sc, o2 = (v0 * sn[gi] + v1 * cs[gi]) * sc;
                    u32x2 a; a.x = pk2(o1.x, o1.y); a.y = pk2(o1.z, o1.w); u32x2 b; b.x = pk2(o2.x, o2.y); b.y = pk2(o2.z, o2.w);
                    *(u32x2*)(P + (size_t)row * INC + hb + 4 * uu) = a; *(u32x2*)(P + (size_t)row * INC + hb + 64 + 4 * uu) = b;
                EPI_G_END
            EPI_AI_END
            return false; }
        const int mode = pn < 8 ? 0 : pn < 12 ? 1 : pn < 14 ? 2 : pn < 16 ? 0 : pn < 18 ? 2 : 3;
        f32x4 bg[2][2];
#pragma unroll
        for (int bj = 0; bj < 2; ++bj) { const int cg = (mode == 3) ? u.pn * 256 + bj * 128 + wc * 32 + fq * 8 - C_GT : 0; bg[bj][0] = *(const f32x4*)(b_gate + cg); bg[bj][1] = *(const f32x4*)(b_gate + cg + 4); }
        EPI_LOOP_BEGIN
            f32x4 a = v0, b = v1;
            if (mode == 1) { for (int i = 0; i < 4; ++i) { a[i] = silu_f(a[i]); b[i] = silu_f(b[i]); } }
            else if (mode == 2) { for (int i = 0; i < 4; ++i) { a[i] = gelu_t(a[i]); b[i] = gelu_t(b[i]); } }
            else if (mode == 3) { for (int i = 0; i < 4; ++i) { a[i] = sigm_f(a[i] + bg[bj][0][i]); b[i] = sigm_f(b[i] + bg[bj][1][i]); } }
            u32x4 pk; pk.x = pk2(a.x, a.y); pk.y = pk2(a.z, a.w); pk.z = pk2(b.x, b.y); pk.w = pk2(b.z, b.w);
            *(u32x4*)(P + (size_t)row * INC + col0) = pk;
        EPI_LOOP_END
        return false;
    } };

struct SchedMg { int G, c; const char *P, *bt;
    DEV bool next(int i, Unit& u) const {
        const int T = i / 3, br = i - 3 * T; const long L = (long)T * G + c; if (L >= 256) return false;
        pg8::tile_map((int)L, 64, 4, u.pm, u.pn); u.kind = br; u.nt = br == 0 ? 16 : 8;
        const int koff = br == 0 ? 0 : br == 1 ? 1024 : 1536;
        u.A = P + (size_t)u.pm * 256 * INC * 2 + (size_t)(C_G + koff) * 2; u.B = bt + (size_t)u.pn * 256 * 2048 * 2 + (size_t)koff * 2; return true; } };
struct SchedMgS { int c; const char *P, *bt;
    DEV bool next(int i, Unit& u) const {
        if (i > 0 || c >= 64) return false;
        const int tile = c >> 3, ch = c & 7; u.pm = 64 + (tile >> 2); u.pn = tile & 3; u.kind = ch; u.nt = 4;
        const int koff = ch * 256;
        u.A = P + (size_t)u.pm * 256 * INC * 2 + (size_t)(C_G + koff) * 2; u.B = bt + (size_t)u.pn * 256 * 2048 * 2 + (size_t)koff * 2; return true; } };
struct EpiMg { const bf16_t* P; bf16_t* mg;
    DEV bool operator()(AccT& acc, const Unit& u, int wr, int wc, int fr, int fq) const {
        const int br = u.kind;
        EPI_AI_BEGIN
            u32x4 gg[8], hh[8];
            EPI_G_BEGIN
                const bf16_t* gp = P + (size_t)row * INC + C_GT + br * 1024 + col0;
                gg[gi] = *(const u32x4*)gp; hh[gi] = (br < 2) ? *(const u32x4*)(gp + 1024) : gg[gi];
            EPI_G_END
            EPI_G_BEGIN
                float s8[8], d8[8]; unpack8(gg[gi], s8);
                if (br < 2) { unpack8(hh[gi], d8);
#pragma unroll
                    for (int i = 0; i < 8; ++i) s8[i] *= __builtin_amdgcn_rcpf(d8[i]); }
                f32x4& v0 = acc[ai][bj][m][0]; f32x4& v1 = acc[ai][bj][m][1];
                v0.x *= s8[0]; v0.y *= s8[1]; v0.z *= s8[2]; v0.w *= s8[3]; v1.x *= s8[4]; v1.y *= s8[5]; v1.z *= s8[6]; v1.w *= s8[7];
                if (br == 2) { u32x4 pk; pk.x = pk2(v0.x, v0.y); pk.y = pk2(v0.z, v0.w); pk.z = pk2(v1.x, v1.y); pk.w = pk2(v1.z, v1.w); *(u32x4*)(mg + (size_t)row * 1024 + col0) = pk; }
            EPI_G_END
        EPI_AI_END
        return br < 2;
    } };
struct EpiMgS { const bf16_t* P; float* part;
    DEV bool operator()(AccT& acc, const Unit& u, int wr, int wc, int fr, int fq) const {
        const int ch = u.kind, br = ch < 4 ? 0 : ch < 6 ? 1 : 2;
        const bf16_t* gp = P + C_GT + br * 1024; float* tp = part + (size_t)ch * SROWS - (size_t)NP * 1024;
        EPI_AI_BEGIN
            u32x4 gg[8];
            EPI_G_BEGIN
                gg[gi] = *(const u32x4*)(gp + (size_t)row * INC + col0);
            EPI_G_END
            EPI_G_BEGIN
                float s8[8]; unpack8(gg[gi], s8); const f32x4 v0 = acc[ai][bj][m][0], v1 = acc[ai][bj][m][1];
                float* t = tp + (size_t)row * 1024 + col0;
                *(f32x4*)t = (f32x4){s8[0] * v0.x, s8[1] * v0.y, s8[2] * v0.z, s8[3] * v0.w}; *(f32x4*)(t + 4) = (f32x4){s8[4] * v1.x, s8[5] * v1.y, s8[6] * v1.z, s8[7] * v1.w};
            EPI_G_END
        EPI_AI_END
        return false;
    } };
template <int nt, int nsub, int nchunk, int astep, int bstep> struct SchedPS { int G, c; const char *A, *B;
    DEV bool next(int i, Unit& u) const {
        const long L = (long)i * G + c;
        if (L < 256) { pg8::tile_map((int)L, 64, 4, u.pm, u.pn); u.kind = 0; u.nt = nt; u.A = A + (size_t)u.pm * astep; u.B = B + (size_t)u.pn * bstep; return true; }
        const int s = (int)(L - 256); if (s >= nsub) return false;
        const int tile = s / nchunk, ch = s - tile * nchunk; u.pm = 64 + (tile >> 2); u.pn = tile & 3; u.kind = 1 + ch; u.nt = 2;
        u.A = A + (size_t)u.pm * astep + (size_t)ch * 256; u.B = B + (size_t)u.pn * bstep + (size_t)ch * 256; return true; } };
struct SchedPlain { int G, c, nM, nN, nt; const char *A, *B; size_t astep, bstep;
    DEV bool next(int i, Unit& u) const {
        const long L = (long)i * G + c; if (L >= (long)nM * nN) return false;
        pg8::tile_map((int)L, nM, nN, u.pm, u.pn); u.kind = 0; u.nt = nt; u.A = A + (size_t)u.pm * astep; u.B = B + (size_t)u.pn * bstep; return true; } };
struct EpiWo { const float *xp, *xs; float* out; float* part;
    DEV bool operator()(AccT& acc, const Unit& u, int wr, int wc, int fr, int fq) const {
        if (u.kind >= 1) {
            EPI_LOOP_BEGIN
                float* t = part + (size_t)(u.kind - 1) * SROWS + (size_t)(row - NP) * 1024 + col0; *(f32x4*)t = v0; *(f32x4*)(t + 4) = v1;
            EPI_LOOP_END
            return false; }
        EPI_LOOP_BEGIN
            u32x4 pk; pk.x = pk2(v0.x, v0.y); pk.y = pk2(v0.z, v0.w); pk.z = pk2(v1.x, v1.y); pk.w = pk2(v1.z, v1.w);
            *(u32x4*)((bf16_t*)out + (size_t)row * 2048 + 1024 + col0) = pk;
        EPI_LOOP_END
        return false;
    } };
struct EpiUp { bf16_t* z; float* out;
    DEV bool operator()(AccT& acc, const Unit& u, int wr, int wc, int fr, int fq) const {
        EPI_LOOP_BEGIN
            u32x4 pk; pk.x = pk2(v0.x, v0.y); pk.y = pk2(v0.z, v0.w); pk.z = pk2(v1.x, v1.y); pk.w = pk2(v1.z, v1.w);
            *(u32x4*)(z + (size_t)row * FF2 + col0) = pk;
            float* o = nullptr;
            if (row < NP) { const int t = row & 2047; if (t >= 2046) o = out + O_CONVP + ((size_t)(row >> 11) * 2 + (t - 2046)) * FF2 + col0; }
            else { const int rs = row - NP, t = rs & 3; if (t >= 2) o = out + O_CONVS + ((size_t)(rs >> 2) * 2 + (t - 2)) * FF2 + col0; }
            if (o) { *(f32x4*)o = v0; *(f32x4*)(o + 4) = v1; }
        EPI_LOOP_END
        return false;
    } };
struct EpiDn { float* out; float* part;
    DEV bool operator()(AccT& acc, const Unit& u, int wr, int wc, int fr, int fq) const {
        if (u.kind >= 1) {
            EPI_LOOP_BEGIN
                float* t = part + (size_t)(u.kind - 1) * SROWS + (size_t)(row - NP) * 1024 + col0; *(f32x4*)t = v0; *(f32x4*)(t + 4) = v1;
            EPI_LOOP_END
            return false; }
        EPI_LOOP_BEGIN
            u32x4 pk; pk.x = pk2(v0.x, v0.y); pk.y = pk2(v0.z, v0.w); pk.z = pk2(v1.x, v1.y); pk.w = pk2(v1.z, v1.w);
            *(u32x4*)((bf16_t*)out + (size_t)row * 2048 + col0) = pk;
        EPI_LOOP_END
        return false;
    } };

DEV int srccol_in(int p) {
    if (p < 1024) { const int hb = p & ~127, pp = p & 127, uu = pp >> 3, v = pp & 7; return hb + ((v < 4) ? 4 * uu + v : 64 + 4 * uu + (v - 4)); }
    if (p >= C_XQ && p < C_SV) return p + 512;
    if (p >= C_SV && p < C_GT) return p - 512;
    return p; }
DEV void transpose_item(const float* W, int N, bf16_t* WT, int ldk, int koff, LAS float* scr, int k0, int n0, int srccol, int lane) {
    float tv[32];
#pragma unroll
    for (int i = 0; i < 32; ++i) tv[i] = __builtin_nontemporal_load(W + (size_t)(k0 + 2 * i + (lane >> 5)) * N + srccol);
#pragma unroll
    for (int i = 0; i < 32; ++i) scr[(2 * i + (lane >> 5)) * 33 + (lane & 31)] = tv[i];
    const int c = lane & 7;
#pragma unroll
    for (int j = 0; j < 4; ++j) { const int n = (lane >> 3) + 8 * j; const LAS float* s = scr + (8 * c) * 33 + n;
        u32x4 o; o.x = pk2(s[0 * 33], s[1 * 33]); o.y = pk2(s[2 * 33], s[3 * 33]); o.z = pk2(s[4 * 33], s[5 * 33]); o.w = pk2(s[6 * 33], s[7 * 33]);
        *(u32x4*)(WT + (size_t)(n0 + n) * ldk + koff + k0 + 8 * c) = o; }
}
DEV void rms_row(const float* xrow, const float* g, bf16_t* orow, int lane) {
    f32x4 v[4]; float s = 0.f;
#pragma unroll
    for (int j = 0; j < 4; ++j) { v[j] = __builtin_nontemporal_load((const f32x4*)(xrow + 4 * lane + 256 * j)); s += v[j].x * v[j].x + v[j].y * v[j].y + v[j].z * v[j].z + v[j].w * v[j].w; }
    s = wave_sum(s); const float r = rsqrtf(s * (1.f / 1024.f) + EPS);
#pragma unroll
    for (int j = 0; j < 4; ++j) { const f32x4 gv = *(const f32x4*)(g + 4 * lane + 256 * j);
        u32x2 o; o.x = pk2(v[j].x * r * gv.x, v[j].y * r * gv.y); o.y = pk2(v[j].z * r * gv.z, v[j].w * r * gv.w);
        *(u32x2*)(orow + 4 * lane + 256 * j) = o; }
}
DEV void phase_prep(const Params& p, LAS unsigned char* lds) {
    const int tid = otid(), lane = tid & 63, wave = tid >> 6;
    const int gw = obid() * 8 + wave, NGW = gridDim.x * 8;
    LAS float* scr = (LAS float*)(lds + wave * 8448);
    unsigned char* ws = p.ws;
    constexpr int I_IN = 16 * 240, I_KV = 16 * 32, I_MR = 16 * 32, I_MS = 8 * 32, I_MX = 8 * 32, I_O = 16 * 32, I_UP = 16 * 176, I_DN = 44 * 32;
    constexpr int N_TR = I_IN + I_KV + I_MR + I_MS + I_MX + I_O + I_UP + I_DN;
    constexpr int N_RMS = MT + 2048, N_ROPE = 2052, N_TRIL = 512;
    constexpr int N_ALL = N_TR + N_RMS + N_ROPE + N_TRIL;
    for (int it = gw; it < N_ALL; it += NGW) {
        int r = it;
        if (r < N_TR) {
            const int l31 = lane & 31;
            if (r < I_IN) { const int kb = r / 240, nb = r % 240; transpose_item(p.w_in, INC, (bf16_t*)(ws + OFF_BTIN), 1024, 0, scr, 64 * kb, 32 * nb, srccol_in(32 * nb + l31), lane); continue; } r -= I_IN;
            if (r < I_KV) { const int kb = r / 32, nb = r % 32; transpose_item(p.w_mem_kv, 1024, (bf16_t*)(ws + OFF_BTKV), 1024, 0, scr, 64 * kb, 32 * nb, 32 * nb + l31, lane); continue; } r -= I_KV;
            if (r < I_MR) { const int kb = r / 32, nb = r % 32; transpose_item(p.w_br_ret, 1024, (bf16_t*)(ws + OFF_BTMG), 2048, 0, scr, 64 * kb, 32 * nb, 32 * nb + l31, lane); continue; } r -= I_MR;
            if (r < I_MS) { const int kb = r / 32, nb = r % 32; transpose_item(p.w_br_sg, 1024, (bf16_t*)(ws + OFF_BTMG), 2048, 1024, scr, 64 * kb, 32 * nb, 32 * nb + l31, lane); continue; } r -= I_MS;
            if (r < I_MX) { const int kb = r / 32, nb = r % 32; transpose_item(p.w_br_x, 1024, (bf16_t*)(ws + OFF_BTMG), 2048, 1536, scr, 64 * kb, 32 * nb, 32 * nb + l31, lane); continue; } r -= I_MX;
            if (r < I_O) { const int kb = r / 32, nb = r % 32; transpose_item(p.w_o, 1024, (bf16_t*)(ws + OFF_BTO), 1024, 0, scr, 64 * kb, 32 * nb, 32 * nb + l31, lane); continue; } r -= I_O;
            if (r < I_UP) { const int kb = r / 176, nb = r % 176; transpose_item(p.w_up, FF2, (bf16_t*)(ws + OFF_BTUP), 1024, 0, scr, 64 * kb, 32 * nb, 32 * nb + l31, lane); continue; } r -= I_UP;
            { const int kb = r / 32, nb = r % 32; transpose_item(p.w_down, 1024, (bf16_t*)(ws + OFF_BTDN), FF, 0, scr, 64 * kb, 32 * nb, 32 * nb + l31, lane); continue; }
        }
        r -= N_TR;
        if (r < N_RMS) {
            if (r < NP) rms_row(p.x_prompt + (size_t)r * 1024, p.norm_mix_g, (bf16_t*)(ws + OFF_R2) + (size_t)r * 1024, lane);
            else if (r < MT) rms_row(p.x_sample + (size_t)(r - NP) * 1024, p.norm_mix_g, (bf16_t*)(ws + OFF_R2) + (size_t)r * 1024, lane);
            else rms_row(p.mem_prompt + (size_t)(r - MT) * 1024, p.mem_norm_g, (bf16_t*)(ws + OFF_HM) + (size_t)(r - MT) * 1024, lane);
            continue; }
        r -= N_RMS;
        if (r < N_ROPE) {
            const int pos = r < 2048 ? r : 16384 + (r - 2048);
            double inv = 1.0;
            if (lane & 1) inv *= 0.8659643233600653; if (lane & 2) inv *= 0.7498942093324559; if (lane & 4) inv *= 0.5623413251903491;
            if (lane & 8) inv *= 0.31622776601683794; if (lane & 16) inv *= 0.1; if (lane & 32) inv *= 0.01;
            double t = (double)pos * inv * 0.15915494309189535; t -= __builtin_rint(t);
            const float tf = (float)t;
            ((float*)(ws + OFF_ROPEC))[r * 64 + lane] = __builtin_amdgcn_cosf(tf);
            ((float*)(ws + OFF_ROPES))[r * 64 + lane] = __builtin_amdgcn_sinf(tf);
            continue; }
        r -= N_ROPE;
        { const int t = r & 127; const float* src = p.sg_ws + (size_t)r * 128 + 2 * lane;
          const float a = (2 * lane <= t) ? src[0] : 0.f, b = (2 * lane + 1 <= t) ? src[1] : 0.f;
          *(unsigned*)((bf16_t*)(ws + OFF_WTRIL) + (size_t)r * 128 + 2 * lane) = pk2(a, b); }
    }
}

DEV void ret_A_item(const Params& p, LAS unsigned char* lds, int item) {
    const int tid = otid(), lane = tid & 63, w = tid >> 6;
    const int c = item & 15, bh = item >> 4, h = bh & 3, b = bh >> 2;
    const size_t row0 = (size_t)b * 2048 + c * 128;
    const bf16_t* P = (const bf16_t*)(p.ws + OFF_P);
    const float lg = log_gamma(h);
    LAS unsigned char* Kt = lds; LAS unsigned char* Vt = lds + 34816;
#pragma unroll
    for (int k_ = 0; k_ < 4; ++k_) { const int i = tid + 512 * k_; const int s = i >> 4, ch = i & 15;
        u32x4 v = __builtin_nontemporal_load((const u32x4*)(P + (row0 + s) * INC + C_K + h * 128 + ch * 8));
        const float dec = __expf((float)(127 - s) * lg);
        v.x = pk2(bf_lo(v.x) * dec, bf_hi(v.x) * dec); v.y = pk2(bf_lo(v.y) * dec, bf_hi(v.y) * dec); v.z = pk2(bf_lo(v.z) * dec, bf_hi(v.z) * dec); v.w = pk2(bf_lo(v.w) * dec, bf_hi(v.w) * dec);
        *(LAS u32x4*)(Kt + s * 272 + ch * 16) = v; }
#pragma unroll
    for (int k_ = 0; k_ < 8; ++k_) { const int i = tid + 512 * k_; const int s = i >> 5, ch = i & 31;
        *(LAS u32x4*)(Vt + s * 528 + ch * 16) = __builtin_nontemporal_load((const u32x4*)(P + (row0 + s) * INC + C_V + h * 256 + ch * 8)); }
    __syncthreads();
    f32x4 acc[16];
#pragma unroll
    for (int i = 0; i < 16; ++i) acc[i] = (f32x4){0.f, 0.f, 0.f, 0.f};
    LAS const unsigned char* kb = tr_lane_base(Kt, 272, lane) + 32 * w; LAS const unsigned char* vb = tr_lane_base(Vt, 528, lane);
    bf16x8 af[4]; tr_read4<272, 0, 0>(kb, af);
    static_for<0, 16>([&](auto et_) { constexpr int et = decltype(et_)::value; bf16x8 bf[4]; tr_read4<528, 0, 16 * et>(vb, bf);
#pragma unroll
        for (int ks = 0; ks < 4; ++ks) acc[et] = mfma16(af[ks], bf[ks], acc[et]); });
    float* U = p.out + (size_t)item * 32768;
    const int g = lane >> 4, col = lane & 15;
#pragma unroll
    for (int et = 0; et < 16; ++et)
#pragma unroll
        for (int j = 0; j < 4; ++j) U[(16 * w + 4 * g + j) * 256 + 16 * et + col] = acc[et][j];
    __syncthreads();
}
DEV void scan_phase(const Params& p) {
    const float* U = p.out; bf16_t* Sb = (bf16_t*)(p.ws + OFF_R2);
    for (int idx = obid() * 512 + otid(); idx < 131072; idx += gridDim.x * 512) {
        const int e8 = idx & 31, d = (idx >> 5) & 127, bh = idx >> 12, h = bh & 3;
        const float g128 = __expf(128.f * log_gamma(h));
        f32x4 s0 = (f32x4){0.f, 0.f, 0.f, 0.f}, s1 = s0;
#pragma unroll
        for (int c = 0; c < 16; ++c) {
            const size_t off = (((size_t)bh * 16 + c) * 128 + d) * 256 + e8 * 8;
            u32x4 pk; pk.x = pk2(s0.x, s0.y); pk.y = pk2(s0.z, s0.w); pk.z = pk2(s1.x, s1.y); pk.w = pk2(s1.z, s1.w);
            *(u32x4*)(Sb + off) = pk;
            const f32x4 u0 = __builtin_nontemporal_load((const f32x4*)(U + off)), u1 = __builtin_nontemporal_load((const f32x4*)(U + off + 4));
            s0 = s0 * g128 + u0; s1 = s1 * g128 + u1; }
        float* o = p.out + O_RETP + ((size_t)bh * 128 + d) * 256 + e8 * 8;
        *(f32x4*)o = s0; *(f32x4*)(o + 4) = s1;
    }
}
DEV void ret_C_item(const Params& p, LAS unsigned char* lds, int item) {
    const int tid = otid(), lane = tid & 63, w = tid >> 6, g = lane >> 4, col = lane & 15;
    const int c = item & 15, bh = item >> 4, h = bh & 3, b = bh >> 2;
    const size_t row0 = (size_t)b * 2048 + c * 128;
    bf16_t* P = (bf16_t*)(p.ws + OFF_P);
    const bf16_t* Sb = (const bf16_t*)(p.ws + OFF_R2) + (size_t)item * 32768;
    const float lg = log_gamma(h);
    LAS unsigned char* Kt = lds; LAS unsigned char* Vh = lds + 34816; LAS unsigned char* Sh = lds + 69632; LAS unsigned char* Sc = lds + 104448 + w * 4352;
#pragma unroll
    for (int k_ = 0; k_ < 4; ++k_) { const int i = tid + 512 * k_; const int s = i >> 4, ch = i & 15;
        *(LAS u32x4*)(Kt + s * 272 + ch * 16) = __builtin_nontemporal_load((const u32x4*)(P + (row0 + s) * INC + C_K + h * 128 + ch * 8)); }
    bf16x8 qf[4];
    { const bf16_t* qp = P + (row0 + 16 * w + col) * INC + C_Q + h * 128 + 8 * g;
#pragma unroll
      for (int ks = 0; ks < 4; ++ks) qf[ks] = *(const bf16x8*)(qp + 32 * ks); }
    f32x4 o[16];
    float sg[16][4];
#pragma unroll
    for (int j = 0; j < 4; ++j)
#pragma unroll
        for (int t = 0; t < 16; ++t) sg[t][j] = bf2f(P[(row0 + 16 * w + 4 * g + j) * INC + C_G + h * 256 + (t >> 3) * 128 + (t & 7) * 16 + col]);
    LAS const unsigned char* shb = tr_lane_base(Sh, 272, lane); LAS const unsigned char* vhb = tr_lane_base(Vh, 272, lane);
    bf16x8 scf[4];
    static_for<0, 2>([&](auto hh_) { constexpr int hh = decltype(hh_)::value;
        if (hh == 1) __syncthreads();
#pragma unroll
        for (int k_ = 0; k_ < 4; ++k_) { const int i = tid + 512 * k_; const int s = i >> 4, ch = i & 15;
            *(LAS u32x4*)(Vh + s * 272 + ch * 16) = __builtin_nontemporal_load((const u32x4*)(P + (row0 + s) * INC + C_V + h * 256 + hh * 128 + ch * 8));
            *(LAS u32x4*)(Sh + s * 272 + ch * 16) = __builtin_nontemporal_load((const u32x4*)(Sb + s * 256 + hh * 128 + ch * 8)); }
        __syncthreads();
        if (hh == 0) {
            static_for<0, 8>([&](auto st_) { constexpr int st = decltype(st_)::value; f32x4 a = (f32x4){0.f, 0.f, 0.f, 0.f};
#pragma unroll
                for (int ks = 0; ks < 4; ++ks) a = mfma16(qf[ks], lds_frag(Kt, 272, 16 * st, 32 * ks, lane), a);
#pragma unroll
                for (int j = 0; j < 4; ++j) { const int diff = (16 * w + 4 * g + j) - (16 * st + col);
                    const float v = diff >= 0 ? a[j] * __expf((float)diff * lg) : 0.f;
                    *(LAS bf16_t*)(Sc + (4 * g + j) * 272 + (16 * st + col) * 2) = f2bf(v); }
                SCHEDB; });
#pragma unroll
            for (int ks = 0; ks < 4; ++ks) scf[ks] = lds_frag(Sc, 272, 0, 32 * ks, lane);
        }
        static_for<0, 8>([&](auto et_) { constexpr int et = decltype(et_)::value; f32x4 a = (f32x4){0.f, 0.f, 0.f, 0.f};
            bf16x8 f[4]; tr_read4<272, 0, 16 * et>(shb, f);
#pragma unroll
            for (int ks = 0; ks < 4; ++ks) a = mfma16(qf[ks], f[ks], a);
#pragma unroll
            for (int j = 0; j < 4; ++j) a[j] *= __expf((float)(16 * w + 4 * g + j + 1) * lg);
            tr_read4<272, 0, 16 * et>(vhb, f);
#pragma unroll
            for (int ks = 0; ks < 4; ++ks) a = mfma16(scf[ks], f[ks], a);
            o[hh * 8 + et] = a; SCHEDB; });
    });
    float gnv[16];
#pragma unroll
    for (int t = 0; t < 16; ++t) gnv[t] = p.ret_gn_g[h * 256 + (t >> 3) * 128 + (t & 7) * 16 + col];
#pragma unroll
    for (int j = 0; j < 4; ++j) {
        float s = 0.f;
#pragma unroll
        for (int t = 0; t < 16; ++t) s += o[t][j];
        const float mean = g16_sum(s) * (1.f / 256.f);
        float s2 = 0.f;
#pragma unroll
        for (int t = 0; t < 16; ++t) { const float dd = o[t][j] - mean; s2 += dd * dd; }
        const float rstd = rsqrtf(g16_sum(s2) * (1.f / 256.f) + EPS);
        bf16_t* gp = P + (row0 + 16 * w + 4 * g + j) * INC + C_G + h * 256;
#pragma unroll
        for (int t = 0; t < 16; ++t) { const int e = (t >> 3) * 128 + (t & 7) * 16 + col;
            gp[e] = f2bf((o[t][j] - mean) * rstd * gnv[t] * sg[t][j]); }
    }
    __syncthreads();
}
DEV void sgu_item(const Params& p, LAS unsigned char* lds, int item) {
    const int tid = otid(), lane = tid & 63, w = tid >> 6, g = lane >> 4, col = lane & 15;
    const int gq = item & 3, bn = item >> 2; const size_t row0 = (size_t)bn * 128;
    bf16_t* P = (bf16_t*)(p.ws + OFF_P);
    LAS unsigned char* VN = lds;
#pragma unroll
    for (int rr = 0; rr < 16; ++rr) { const int s = 16 * w + rr;
        const u32x4 v = __builtin_nontemporal_load((const u32x4*)(P + (row0 + s) * INC + C_SV + lane * 8));
        float x[8] = {bf_lo(v.x), bf_hi(v.x), bf_lo(v.y), bf_hi(v.y), bf_lo(v.z), bf_hi(v.z), bf_lo(v.w), bf_hi(v.w)};
        float sm = 0.f;
#pragma unroll
        for (int i = 0; i < 8; ++i) sm += x[i];
        const float mean = wave_sum(sm) * (1.f / 512.f); float s2 = 0.f;
#pragma unroll
        for (int i = 0; i < 8; ++i) { x[i] -= mean; s2 += x[i] * x[i]; }
        const float rstd = rsqrtf(wave_sum(s2) * (1.f / 512.f) + EPS);
        if (g == gq) { const float* lg = p.sg_ln_g + lane * 8; u32x4 o;
            o.x = pk2(x[0] * rstd * lg[0], x[1] * rstd * lg[1]); o.y = pk2(x[2] * rstd * lg[2], x[3] * rstd * lg[3]);
            o.z = pk2(x[4] * rstd * lg[4], x[5] * rstd * lg[5]); o.w = pk2(x[6] * rstd * lg[6], x[7] * rstd * lg[7]);
            *(LAS u32x4*)(VN + s * 272 + col * 16) = o; } }
    bf16x8 af[4];
    { const bf16_t* wp = (const bf16_t*)(p.ws + OFF_WTRIL) + (size_t)(gq * 128 + 16 * w + col) * 128 + 8 * g;
#pragma unroll
      for (int ks = 0; ks < 4; ++ks) af[ks] = *(const bf16x8*)(wp + 32 * ks); }
    __syncthreads();
    LAS const unsigned char* vnb = tr_lane_base(VN, 272, lane);
    float uv[8][4], bsv[4];
#pragma unroll
    for (int j = 0; j < 4; ++j) { bsv[j] = p.sg_bs[gq * 128 + 16 * w + 4 * g + j];
#pragma unroll
        for (int ct = 0; ct < 8; ++ct) uv[ct][j] = bf2f(P[(row0 + 16 * w + 4 * g + j) * INC + C_SU + gq * 128 + 16 * ct + col]); }
    static_for<0, 8>([&](auto ct_) { constexpr int ct = decltype(ct_)::value; f32x4 a = (f32x4){0.f, 0.f, 0.f, 0.f};
        bf16x8 f[4]; tr_read4<272, 0, 16 * ct>(vnb, f);
#pragma unroll
        for (int ks = 0; ks < 4; ++ks) a = mfma16(af[ks], f[ks], a);
#pragma unroll
        for (int j = 0; j < 4; ++j) P[(row0 + 16 * w + 4 * g + j) * INC + C_SU + gq * 128 + 16 * ct + col] = f2bf(uv[ct][j] * (a[j] + bsv[j])); });
    __syncthreads();
}
DEV void xattn_item(const Params& p, LAS unsigned char* lds, int item) {
    const int tid = otid(), lane = tid & 63, w = tid >> 6, g = lane >> 4, col = lane & 15;
    const int qt = item & 15, bh = item >> 4, h = bh & 3, b = bh >> 2; const size_t row0 = (size_t)b * 2048 + qt * 128;
    bf16_t* P = (bf16_t*)(p.ws + OFF_P); const bf16_t* mkb = (const bf16_t*)(p.ws + OFF_MKB);
    LAS unsigned char* KV = lds; LAS unsigned char* Pw = lds + 69632 + w * 8448;
#pragma unroll
    for (int k_ = 0; k_ < 8; ++k_) { const int i = tid + 512 * k_; const int m = i >> 4, ch = i & 15;
        *(LAS u32x4*)(KV + m * 272 + ch * 16) = *(const u32x4*)(mkb + (size_t)(b * 256 + m) * 1024 + h * 128 + ch * 8); }
    bf16x8 qf[4];
    { const bf16_t* qp = P + (row0 + 16 * w + col) * INC + C_XQ + h * 128 + 8 * g;
#pragma unroll
      for (int ks = 0; ks < 4; ++ks) qf[ks] = *(const bf16x8*)(qp + 32 * ks); }
    __syncthreads();
    f32x4 sc[16];
    static_for<0, 16>([&](auto mt_) { constexpr int mt = decltype(mt_)::value; f32x4 a = (f32x4){0.f, 0.f, 0.f, 0.f};
#pragma unroll
        for (int ks = 0; ks < 4; ++ks) a = mfma16(qf[ks], lds_frag(KV, 272, 16 * mt, 32 * ks, lane), a);
        sc[mt] = a * 0.08838834764831845f; SCHEDB; });
#pragma unroll
    for (int j = 0; j < 4; ++j) { float mx = -3.0e38f;
#pragma unroll
        for (int mt = 0; mt < 16; ++mt) mx = fmaxf(mx, sc[mt][j]);
        mx = g16_max(mx); float sm = 0.f;
#pragma unroll
        for (int mt = 0; mt < 16; ++mt) { const float e = __expf(sc[mt][j] - mx); sc[mt][j] = e; sm += e; }
        const float inv = 1.f / g16_sum(sm);
#pragma unroll
        for (int mt = 0; mt < 16; ++mt) *(LAS bf16_t*)(Pw + (4 * g + j) * 528 + (16 * mt + col) * 2) = f2bf(sc[mt][j] * inv); }
    __syncthreads();
#pragma unroll
    for (int k_ = 0; k_ < 8; ++k_) { const int i = tid + 512 * k_; const int m = i >> 4, ch = i & 15;
        *(LAS u32x4*)(KV + m * 272 + ch * 16) = *(const u32x4*)(mkb + (size_t)(b * 256 + m) * 1024 + 512 + h * 128 + ch * 8); }
    __syncthreads();
    LAS const unsigned char* kvb = tr_lane_base(KV, 272, lane);
    bf16x8 pf[8];
#pragma unroll
    for (int ks = 0; ks < 8; ++ks) pf[ks] = lds_frag(Pw, 528, 0, 32 * ks, lane);
    static_for<0, 8>([&](auto dt_) { constexpr int dt = decltype(dt_)::value; f32x4 a = (f32x4){0.f, 0.f, 0.f, 0.f};
        bf16x8 f[4]; tr_read4<272, 0, 16 * dt>(kvb, f);
#pragma unroll
        for (int ks = 0; ks < 4; ++ks) a = mfma16(pf[ks], f[ks], a);
        tr_read4<272, 128, 16 * dt>(kvb, f);
#pragma unroll
        for (int ks = 0; ks < 4; ++ks) a = mfma16(pf[4 + ks], f[ks], a);
#pragma unroll
        for (int j = 0; j < 4; ++j) P[(row0 + 16 * w + 4 * g + j) * INC + C_XQ + h * 128 + 16 * dt + col] = f2bf(a[j]); });
    __syncthreads();
}
DEV void xattn_s_item(const Params& p, LAS unsigned char* lds, int item) {
    const int tid = otid(), lane = tid & 63, w = tid >> 6, l32 = lane & 31, slot = w * 2 + (lane >> 5);
    const int h = item & 3, b = item >> 2; const size_t rowb = (size_t)NP + b * 4;
    bf16_t* P = (bf16_t*)(p.ws + OFF_P);
    LAS float* sc = (LAS float*)lds; LAS float* red = (LAS float*)(lds + 4096);
    float q[4][4];
#pragma unroll
    for (int l = 0; l < 4; ++l) { const u32x2 v = *(const u32x2*)(P + (rowb + l) * INC + C_XQ + h * 128 + 4 * l32); q[l][0] = bf_lo(v.x); q[l][1] = bf_hi(v.x); q[l][2] = bf_lo(v.y); q[l][3] = bf_hi(v.y); }
#pragma unroll
    for (int it = 0; it < 16; ++it) { const int m = it * 16 + slot;
        const f32x4 kv = *(const f32x4*)(p.cache_k + (((size_t)b * 256 + m) * 4 + h) * 128 + 4 * l32);
        float d[4];
#pragma unroll
        for (int l = 0; l < 4; ++l) d[l] = q[l][0] * kv.x + q[l][1] * kv.y + q[l][2] * kv.z + q[l][3] * kv.w;
        const bool b0 = l32 & 1, b1 = l32 & 2;
        float a0 = b0 ? d[2] : d[0], a1 = b0 ? d[3] : d[1];
        a0 += __shfl_xor(b0 ? d[0] : d[2], 1); a1 += __shfl_xor(b0 ? d[1] : d[3], 1);
        float r = b1 ? a1 : a0; r += __shfl_xor(b1 ? a0 : a1, 2);
        r += __shfl_xor(r, 4); r += __shfl_xor(r, 8); r += __shfl_xor(r, 16);
        if (l32 < 4) sc[((l32 & 1) * 2 + (l32 >> 1)) * 256 + m] = r * 0.08838834764831845f; }
    __syncthreads();
    if (w < 4) { float v[4]; float mx = -3.0e38f;
#pragma unroll
        for (int i = 0; i < 4; ++i) { v[i] = sc[w * 256 + lane + 64 * i]; mx = fmaxf(mx, v[i]); }
        mx = wave_max(mx); float sm = 0.f;
#pragma unroll
        for (int i = 0; i < 4; ++i) { v[i] = __expf(v[i] - mx); sm += v[i]; }
        const float inv = 1.f / wave_sum(sm);
#pragma unroll
        for (int i = 0; i < 4; ++i) sc[w * 256 + lane + 64 * i] = v[i] * inv; }
    __syncthreads();
    f32x4 o[4];
#pragma unroll
    for (int l = 0; l < 4; ++l) o[l] = (f32x4){0.f, 0.f, 0.f, 0.f};
#pragma unroll
    for (int it = 0; it < 16; ++it) { const int m = it * 16 + slot;
        const f32x4 vv = *(const f32x4*)(p.cache_v + (((size_t)b * 256 + m) * 4 + h) * 128 + 4 * l32);
#pragma unroll
        for (int l = 0; l < 4; ++l) o[l] += vv * sc[l * 256 + m]; }
#pragma unroll
    for (int l = 0; l < 4; ++l) *(LAS f32x4*)(red + (slot * 4 + l) * 128 + 4 * l32) = o[l];
    __syncthreads();
    { const int l = tid >> 7, d = tid & 127; float s = 0.f;
#pragma unroll
      for (int k = 0; k < 16; ++k) s += red[(k * 4 + l) * 128 + d];
      P[(rowb + l) * INC + C_XQ + h * 128 + d] = f2bf(s); }
    __syncthreads();
}
DEV void ret_s_item(const Params& p, LAS unsigned char* lds, int item) {
    const int tid = otid(), lane = tid & 63, w = tid >> 6;
    const int h = item & 3, b = item >> 2; const size_t rowb = (size_t)NP + b * 4;
    bf16_t* P = (bf16_t*)(p.ws + OFF_P);
    const float lg = log_gamma(h);
    LAS float* qs = (LAS float*)lds;
    LAS float* kr = qs + 512;
    LAS float* vs = kr + 512;
    LAS float* ob = vs + 1024;
    LAS float* scm = ob + 1024;
    LAS float* red = scm + 16;
    { const int t = tid >> 7, d = tid & 127;
      qs[t * 128 + d] = bf2f(P[(rowb + t) * INC + C_Q + h * 128 + d]); kr[t * 128 + d] = bf2f(P[(rowb + t) * INC + C_K + h * 128 + d]);
      vs[t * 256 + d] = bf2f(P[(rowb + t) * INC + C_V + h * 256 + d]); vs[t * 256 + 128 + d] = bf2f(P[(rowb + t) * INC + C_V + h * 256 + 128 + d]); }
    __syncthreads();
    { const int pr = tid >> 5, t = pr >> 2, s2 = pr & 3, l32 = tid & 31;
      const f32x4 qa = *(LAS f32x4*)(qs + t * 128 + 4 * l32), kb = *(LAS f32x4*)(kr + s2 * 128 + 4 * l32);
      float d = qa.x * kb.x + qa.y * kb.y + qa.z * kb.z + qa.w * kb.w;
#pragma unroll
      for (int o = 1; o < 32; o <<= 1) d += __shfl_xor(d, o);
      if (l32 == 0) scm[pr] = (t >= s2) ? d * __expf((float)(t - s2) * lg) : 0.f; }
    f32x4 v[4], cr[4];
#pragma unroll
    for (int s = 0; s < 4; ++s) { v[s] = *(LAS f32x4*)(vs + s * 256 + 4 * lane); cr[s] = (f32x4){0.f, 0.f, 0.f, 0.f}; }
    const float g4 = __expf(4.f * lg), kd0 = __expf(3.f * lg), kd1 = __expf(2.f * lg), kd2 = __expf(lg);
    const float* S0 = p.state_ret + ((size_t)item * 128) * 256; float* Sn = p.out + O_RETS + ((size_t)item * 128) * 256;
#pragma unroll
    for (int dd = 0; dd < 16; ++dd) { const int d = 16 * w + dd;
        const f32x4 s0 = *(const f32x4*)(S0 + d * 256 + 4 * lane);
#pragma unroll
        for (int t = 0; t < 4; ++t) cr[t] += s0 * qs[t * 128 + d];
        f32x4 sn = s0 * g4 + v[0] * (kr[d] * kd0) + v[1] * (kr[128 + d] * kd1) + v[2] * (kr[256 + d] * kd2) + v[3] * kr[384 + d];
        *(f32x4*)(Sn + d * 256 + 4 * lane) = sn; }
#pragma unroll
    for (int t = 0; t < 4; ++t) *(LAS f32x4*)(red + (w * 4 + t) * 256 + 4 * lane) = cr[t];
    __syncthreads();
    { const int t = tid >> 7, e2 = (tid & 127) * 2; const float qd = __expf((float)(t + 1) * lg);
#pragma unroll
      for (int i = 0; i < 2; ++i) { const int e = e2 + i; float c = 0.f;
#pragma unroll
          for (int k = 0; k < 8; ++k) c += red[(k * 4 + t) * 256 + e];
          float in = 0.f;
#pragma unroll
          for (int s = 0; s < 4; ++s) in += scm[t * 4 + s] * vs[s * 256 + e];
          ob[t * 256 + e] = in + c * qd; } }
    __syncthreads();
    if (w < 4) { float x[4]; float sm = 0.f;
#pragma unroll
        for (int i = 0; i < 4; ++i) { x[i] = ob[w * 256 + lane + 64 * i]; sm += x[i]; }
        const float mean = wave_sum(sm) * (1.f / 256.f); float s2 = 0.f;
#pragma unroll
        for (int i = 0; i < 4; ++i) { x[i] -= mean; s2 += x[i] * x[i]; }
        const float rstd = rsqrtf(wave_sum(s2) * (1.f / 256.f) + EPS);
        bf16_t* gp = P + (rowb + w) * INC + C_G + h * 256;
#pragma unroll
        for (int i = 0; i < 4; ++i) { const int e = lane + 64 * i; gp[e] = f2bf(x[i] * rstd * p.ret_gn_g[h * 256 + e] * bf2f(gp[e])); } }
    __syncthreads();
}
DEV void sgu_s_item(const Params& p, LAS unsigned char* lds, int b) {
    const int tid = otid(), lane = tid & 63, w = tid >> 6;
    const size_t rowb = (size_t)NP + b * 4;
    bf16_t* P = (bf16_t*)(p.ws + OFF_P);
    LAS float* part = (LAS float*)lds;
    float x[4];
#pragma unroll
    for (int r = 0; r < 4; ++r) { x[r] = bf2f(P[(rowb + r) * INC + C_SV + tid]); const float s = wave_sum(x[r]); if (lane == 0) part[w * 4 + r] = s; }
    __syncthreads();
    float mean[4];
#pragma unroll
    for (int r = 0; r < 4; ++r) { float s = 0.f;
#pragma unroll
        for (int k = 0; k < 8; ++k) s += part[k * 4 + r];
        mean[r] = s * (1.f / 512.f); }
    __syncthreads();
#pragma unroll
    for (int r = 0; r < 4; ++r) { x[r] -= mean[r]; const float s = wave_sum(x[r] * x[r]); if (lane == 0) part[w * 4 + r] = s; }
    __syncthreads();
    const float lng = p.sg_ln_g[tid]; const int gq = tid >> 7;
    float vn[4];
#pragma unroll
    for (int r = 0; r < 4; ++r) { float s = 0.f;
#pragma unroll
        for (int k = 0; k < 8; ++k) s += part[k * 4 + r];
        vn[r] = x[r] * rsqrtf(s * (1.f / 512.f) + EPS) * lng;
        p.out[O_SGV + ((size_t)b * 4 + r) * 512 + tid] = vn[r]; }
#pragma unroll
    for (int t = 0; t < 4; ++t) { float mx = p.sg_bs[gq * 128 + t];
#pragma unroll
        for (int s = 0; s < 4; ++s) if (s <= t) mx += p.sg_ws[(size_t)(gq * 128 + t) * 128 + s] * vn[s];
        bf16_t* up = P + (rowb + t) * INC + C_SU + tid; *up = f2bf(bf2f(*up) * mx); }
    __syncthreads();
}


DEV float rl_bf(unsigned packed, int d) { return (d & 1) ? bf_hi(packed) : bf_lo(packed); }
DEV void ret_s_wave(const Params& p, int item, int lane) {
    const int h = item & 3, b = item >> 2; const size_t rowb = (size_t)NP + b * 4;
    bf16_t* P = (bf16_t*)(p.ws + OFF_P);
    const float lg = log_gamma(h);
    unsigned qp[4], kp[4]; f32x4 v[4];
#pragma unroll
    for (int t = 0; t < 4; ++t) { qp[t] = *(const unsigned*)(P + (rowb + t) * INC + C_Q + h * 128 + 2 * lane); kp[t] = *(const unsigned*)(P + (rowb + t) * INC + C_K + h * 128 + 2 * lane);
        const u32x2 x = *(const u32x2*)(P + (rowb + t) * INC + C_V + h * 256 + 4 * lane); v[t] = (f32x4){bf_lo(x.x), bf_hi(x.x), bf_lo(x.y), bf_hi(x.y)}; }
    float sc[4][4];
#pragma unroll
    for (int t = 0; t < 4; ++t)
#pragma unroll
        for (int s2 = 0; s2 < 4; ++s2) { if (s2 <= t) sc[t][s2] = wave_sum(bf_lo(qp[t]) * bf_lo(kp[s2]) + bf_hi(qp[t]) * bf_hi(kp[s2])) * __expf((float)(t - s2) * lg); else sc[t][s2] = 0.f; }
    const float g4 = __expf(4.f * lg), kdec[4] = {__expf(3.f * lg), __expf(2.f * lg), __expf(lg), 1.f};
    f32x4 cr[4];
#pragma unroll
    for (int t = 0; t < 4; ++t) cr[t] = (f32x4){0.f, 0.f, 0.f, 0.f};
    const float* S0 = p.state_ret + (size_t)item * 32768 + 4 * lane; float* Sn = p.out + O_RETS + (size_t)item * 32768 + 4 * lane;
    f32x4 sA[8], sB[8];
#pragma unroll
    for (int i = 0; i < 8; ++i) sA[i] = __builtin_nontemporal_load((const f32x4*)(S0 + i * 256));
#define RETS_PROC(buf, d0) _Pragma("unroll") for (int i = 0; i < 8; ++i) { const int src = ((d0) + i) >> 1; f32x4 sn = buf[i] * g4; \
        _Pragma("unroll") for (int t = 0; t < 4; ++t) { const float qd = rl_bf((unsigned)__builtin_amdgcn_readlane((int)qp[t], src), i), kd = rl_bf((unsigned)__builtin_amdgcn_readlane((int)kp[t], src), i) * kdec[t]; \
            cr[t] += buf[i] * qd; sn += v[t] * kd; } \
        *(f32x4*)(Sn + ((d0) + i) * 256) = sn; }
    for (int d0 = 0; d0 < 128; d0 += 16) {
#pragma unroll
        for (int i = 0; i < 8; ++i) sB[i] = __builtin_nontemporal_load((const f32x4*)(S0 + (d0 + 8 + i) * 256));
        RETS_PROC(sA, d0)
        if (d0 + 16 < 128) {
#pragma unroll
            for (int i = 0; i < 8; ++i) sA[i] = __builtin_nontemporal_load((const f32x4*)(S0 + (d0 + 16 + i) * 256)); }
        RETS_PROC(sB, d0 + 8)
    }
#undef RETS_PROC
    const f32x4 gn4 = *(const f32x4*)(p.ret_gn_g + h * 256 + 4 * lane);
#pragma unroll
    for (int t = 0; t < 4; ++t) {
        f32x4 o = cr[t] * __expf((float)(t + 1) * lg);
#pragma unroll
        for (int s2 = 0; s2 < 4; ++s2) o += v[s2] * sc[t][s2];
        const float mean = wave_sum(o.x + o.y + o.z + o.w) * (1.f / 256.f);
        o = o - mean;
        const float rstd = rsqrtf(wave_sum(o.x * o.x + o.y * o.y + o.z * o.z + o.w * o.w) * (1.f / 256.f) + EPS);
        bf16_t* gp = P + (rowb + t) * INC + C_G + h * 256 + 4 * lane;
        const u32x2 gg = *(const u32x2*)gp;
        u32x2 ov; ov.x = pk2(o.x * rstd * gn4.x * bf_lo(gg.x), o.y * rstd * gn4.y * bf_hi(gg.x)); ov.y = pk2(o.z * rstd * gn4.z * bf_lo(gg.y), o.w * rstd * gn4.w * bf_hi(gg.y));
        *(u32x2*)gp = ov; }
}
DEV void xattn_s_wave(const Params& p, LAS float* sc  , int item, int lane) {
    const int l32 = lane & 31, hf = lane >> 5;
    const int h = item & 3, b = item >> 2; const size_t rowb = (size_t)NP + b * 4;
    bf16_t* P = (bf16_t*)(p.ws + OFF_P);
    float q[4][4];
#pragma unroll
    for (int l = 0; l < 4; ++l) { const u32x2 x = *(const u32x2*)(P + (rowb + l) * INC + C_XQ + h * 128 + 4 * l32); q[l][0] = bf_lo(x.x); q[l][1] = bf_hi(x.x); q[l][2] = bf_lo(x.y); q[l][3] = bf_hi(x.y); }
    const float* Kb = p.cache_k + (((size_t)b * 256 + hf) * 4 + h) * 128 + 4 * l32;
    const float* Vb = p.cache_v + (((size_t)b * 256 + hf) * 4 + h) * 128 + 4 * l32;
    const bool b0 = l32 & 1, b1 = l32 & 2; const int lmap = (l32 & 1) * 2 + ((l32 >> 1) & 1);
    for (int it0 = 0; it0 < 128; it0 += 16) {
        f32x4 kv[16];
#pragma unroll
        for (int i = 0; i < 16; ++i) kv[i] = __builtin_nontemporal_load((const f32x4*)(Kb + (size_t)(it0 + i) * 1024));
#pragma unroll
        for (int i = 0; i < 16; ++i) { float d[4];
#pragma unroll
            for (int l = 0; l < 4; ++l) d[l] = q[l][0] * kv[i].x + q[l][1] * kv[i].y + q[l][2] * kv[i].z + q[l][3] * kv[i].w;
            float a0 = b0 ? d[2] : d[0], a1 = b0 ? d[3] : d[1];
            a0 += dpp_f<0xB1>(b0 ? d[0] : d[2]); a1 += dpp_f<0xB1>(b0 ? d[1] : d[3]);
            float r = b1 ? a1 : a0; r += dpp_f<0x4E>(b1 ? a0 : a1);
            r += dpp_f<0x124>(r); r += dpp_f<0x128>(r);
            r += __shfl_xor(r, 16);
            if (l32 < 4) sc[lmap * 256 + 2 * (it0 + i) + hf] = r * 0.08838834764831845f; }
    }
#pragma unroll
    for (int l = 0; l < 4; ++l) { float vv[4]; float mx = -3.0e38f;
#pragma unroll
        for (int i = 0; i < 4; ++i) { vv[i] = sc[l * 256 + lane + 64 * i]; mx = fmaxf(mx, vv[i]); }
        mx = wave_max(mx); float sm = 0.f;
#pragma unroll
        for (int i = 0; i < 4; ++i) { vv[i] = __expf(vv[i] - mx); sm += vv[i]; }
        const float inv = 1.f / wave_sum(sm);
#pragma unroll
        for (int i = 0; i < 4; ++i) sc[l * 256 + lane + 64 * i] = vv[i] * inv; }
    f32x4 o[4];
#pragma unroll
    for (int l = 0; l < 4; ++l) o[l] = (f32x4){0.f, 0.f, 0.f, 0.f};
    for (int it0 = 0; it0 < 128; it0 += 16) {
        f32x4 vv[16];
#pragma unroll
        for (int i = 0; i < 16; ++i) vv[i] = __builtin_nontemporal_load((const f32x4*)(Vb + (size_t)(it0 + i) * 1024));
#pragma unroll
        for (int i = 0; i < 16; ++i) { const int m = 2 * (it0 + i) + hf;
#pragma unroll
            for (int l = 0; l < 4; ++l) o[l] += vv[i] * sc[l * 256 + m]; }
    }
#pragma unroll
    for (int l = 0; l < 4; ++l) { f32x4 t = o[l];
        t.x += __shfl_xor(t.x, 32); t.y += __shfl_xor(t.y, 32); t.z += __shfl_xor(t.z, 32); t.w += __shfl_xor(t.w, 32);
        if (hf == 0) { u32x2 ov; ov.x = pk2(t.x, t.y); ov.y = pk2(t.z, t.w); *(u32x2*)(P + (rowb + l) * INC + C_XQ + h * 128 + 4 * l32) = ov; } }
}
DEV void sgu_s_wave(const Params& p, int b, int lane) {
    const size_t rowb = (size_t)NP + b * 4;
    bf16_t* P = (bf16_t*)(p.ws + OFF_P);
    const int gq = lane >> 4;
    float vn[4][8];
    const f32x4 l0 = *(const f32x4*)(p.sg_ln_g + 8 * lane), l1 = *(const f32x4*)(p.sg_ln_g + 8 * lane + 4);
    const float lng[8] = {l0.x, l0.y, l0.z, l0.w, l1.x, l1.y, l1.z, l1.w};
#pragma unroll
    for (int r = 0; r < 4; ++r) { float x[8]; unpack8(*(const u32x4*)(P + (rowb + r) * INC + C_SV + 8 * lane), x);
        float sm = 0.f;
#pragma unroll
        for (int i = 0; i < 8; ++i) sm += x[i];
        const float mean = wave_sum(sm) * (1.f / 512.f); float s2 = 0.f;
#pragma unroll
        for (int i = 0; i < 8; ++i) { x[i] -= mean; s2 += x[i] * x[i]; }
        const float rstd = rsqrtf(wave_sum(s2) * (1.f / 512.f) + EPS);
#pragma unroll
        for (int i = 0; i < 8; ++i) vn[r][i] = x[i] * rstd * lng[i];
        float* o = p.out + O_SGV + ((size_t)b * 4 + r) * 512 + 8 * lane;
        *(f32x4*)o = (f32x4){vn[r][0], vn[r][1], vn[r][2], vn[r][3]}; *(f32x4*)(o + 4) = (f32x4){vn[r][4], vn[r][5], vn[r][6], vn[r][7]}; }
#pragma unroll
    for (int t = 0; t < 4; ++t) { float mx[8];
#pragma unroll
        for (int i = 0; i < 8; ++i) mx[i] = p.sg_bs[gq * 128 + t];
#pragma unroll
        for (int s2 = 0; s2 < 4; ++s2) if (s2 <= t) { const float wv = p.sg_ws[(size_t)(gq * 128 + t) * 128 + s2];
#pragma unroll
            for (int i = 0; i < 8; ++i) mx[i] += wv * vn[s2][i]; }
        bf16_t* up = P + (rowb + t) * INC + C_SU + 8 * lane; float u[8]; unpack8(*(const u32x4*)up, u);
        u32x4 ov; ov.x = pk2(u[0] * mx[0], u[1] * mx[1]); ov.y = pk2(u[2] * mx[2], u[3] * mx[3]); ov.z = pk2(u[4] * mx[4], u[5] * mx[5]); ov.w = pk2(u[6] * mx[6], u[7] * mx[7]);
        *(u32x4*)up = ov; }
}

DEV void rms_phase(const Params& p, bool final_) {
    const int lane = otid() & 63, gw = obid() * 8 + (otid() >> 6), NGW = gridDim.x * 8;
    const float* g = final_ ? p.norm_final_g : p.norm_ffn_g;
    const float* part = (const float*)(p.ws + (final_ ? OFF_PART10 : OFF_PART6)); const int npart = final_ ? 22 : 8;
    for (int r = gw; r < MT; r += NGW) {
        float* xr = p.out + (size_t)r * 1024;
        f32x4 v[4]; float s = 0.f;
        if (r < NP) {
            const float* xin = p.x_prompt + (size_t)r * 1024; const bf16_t* sc = (const bf16_t*)xr;
            u32x2 mx[4], fx[4];
#pragma unroll
            for (int j = 0; j < 4; ++j) { v[j] = __builtin_nontemporal_load((const f32x4*)(xin + 4 * lane + 256 * j)); mx[j] = __builtin_nontemporal_load((const u32x2*)(sc + 1024 + 4 * lane + 256 * j)); fx[j] = final_ ? __builtin_nontemporal_load((const u32x2*)(sc + 4 * lane + 256 * j)) : (u32x2){0u, 0u}; }
#pragma unroll
            for (int j = 0; j < 4; ++j) { v[j].x += bf_lo(mx[j].x) + bf_lo(fx[j].x); v[j].y += bf_hi(mx[j].x) + bf_hi(fx[j].x); v[j].z += bf_lo(mx[j].y) + bf_lo(fx[j].y); v[j].w += bf_hi(mx[j].y) + bf_hi(fx[j].y); }
        } else {
            const float* base = final_ ? xr : p.x_sample + (size_t)(r - NP) * 1024;
#pragma unroll
            for (int j = 0; j < 4; ++j) v[j] = *(const f32x4*)(base + 4 * lane + 256 * j);
            for (int k = 0; k < npart; ++k) { const float* pr = part + (size_t)k * SROWS + (size_t)(r - NP) * 1024;
#pragma unroll
                for (int j = 0; j < 4; ++j) v[j] += *(const f32x4*)(pr + 4 * lane + 256 * j); }
            if (!final_) {
#pragma unroll
                for (int j = 0; j < 4; ++j) *(f32x4*)(xr + 4 * lane + 256 * j) = v[j]; }
        }
#pragma unroll
        for (int j = 0; j < 4; ++j) s += v[j].x * v[j].x + v[j].y * v[j].y + v[j].z * v[j].z + v[j].w * v[j].w;
        s = wave_sum(s); const float rr = rsqrtf(s * (1.f / 1024.f) + EPS);
        if (final_) {
#pragma unroll
            for (int j = 0; j < 4; ++j) { const f32x4 gv = *(const f32x4*)(g + 4 * lane + 256 * j); *(f32x4*)(xr + 4 * lane + 256 * j) = v[j] * rr * gv; }
        } else { bf16_t* orow = (bf16_t*)(p.ws + OFF_R2) + (size_t)r * 1024;
#pragma unroll
            for (int j = 0; j < 4; ++j) { const f32x4 gv = *(const f32x4*)(g + 4 * lane + 256 * j);
                u32x2 o; o.x = pk2(v[j].x * rr * gv.x, v[j].y * rr * gv.y); o.y = pk2(v[j].z * rr * gv.z, v[j].w * rr * gv.w);
                *(u32x2*)(orow + 4 * lane + 256 * j) = o; } }
    }
}
DEV void conv_phase(const Params& p) {
    const bf16_t* z = (const bf16_t*)(p.ws + OFF_Z); bf16_t* act = (bf16_t*)(p.ws + OFF_ACT);
    const int gtid = obid() * 512 + otid(), NT = gridDim.x * 512;
    for (int idx = gtid; idx < (NP / 8) * 352; idx += NT) {
        const int rb = idx / 352, ch = idx - rb * 352, c = ch * 8, r0 = rb * 8;
        float wa[3][8], wb[3][8], ba[8], bb[8];
#pragma unroll
        for (int j = 0; j < 3; ++j) { const f32x4 a0 = *(const f32x4*)(p.conv_w + j * FF2 + c), a1 = *(const f32x4*)(p.conv_w + j * FF2 + c + 4), b0 = *(const f32x4*)(p.conv_w + j * FF2 + FF + c), b1 = *(const f32x4*)(p.conv_w + j * FF2 + FF + c + 4);
#pragma unroll
            for (int i = 0; i < 4; ++i) { wa[j][i] = a0[i]; wa[j][4 + i] = a1[i]; wb[j][i] = b0[i]; wb[j][4 + i] = b1[i]; } }
        { const f32x4 a0 = *(const f32x4*)(p.conv_b + c), a1 = *(const f32x4*)(p.conv_b + c + 4), b0 = *(const f32x4*)(p.conv_b + FF + c), b1 = *(const f32x4*)(p.conv_b + FF + c + 4);
#pragma unroll
          for (int i = 0; i < 4; ++i) { ba[i] = a0[i]; ba[4 + i] = a1[i]; bb[i] = b0[i]; bb[4 + i] = b1[i]; } }
        u32x4 ra[10], rbq[10];
        const bool first = (r0 & 2047) == 0;
#pragma unroll
        for (int k = 0; k < 10; ++k) { const int rr = r0 - 2 + k;
            if (k < 2 && first) { ra[k] = (u32x4){0u, 0u, 0u, 0u}; rbq[k] = ra[k]; }
            else { ra[k] = __builtin_nontemporal_load((const u32x4*)(z + (size_t)rr * FF2 + c)); rbq[k] = __builtin_nontemporal_load((const u32x4*)(z + (size_t)rr * FF2 + FF + c)); } }
        float xa[3][8], xb[3][8];
        unpack8(ra[0], xa[0]); unpack8(rbq[0], xb[0]); unpack8(ra[1], xa[1]); unpack8(rbq[1], xb[1]);
#pragma unroll
        for (int k = 0; k < 8; ++k) {
            unpack8(ra[k + 2], xa[(k + 2) % 3]); unpack8(rbq[k + 2], xb[(k + 2) % 3]);
            float o[8];
#pragma unroll
            for (int i = 0; i < 8; ++i) {
                const float za = ba[i] + wa[0][i] * xa[k % 3][i] + wa[1][i] * xa[(k + 1) % 3][i] + wa[2][i] * xa[(k + 2) % 3][i];
                const float zb = bb[i] + wb[0][i] * xb[k % 3][i] + wb[1][i] * xb[(k + 1) % 3][i] + wb[2][i] * xb[(k + 2) % 3][i];
                o[i] = gelu_t(za) * zb; }
            u32x4 ov; ov.x = pk2(o[0], o[1]); ov.y = pk2(o[2], o[3]); ov.z = pk2(o[4], o[5]); ov.w = pk2(o[6], o[7]);
            *(u32x4*)(act + (size_t)(r0 + k) * FF + c) = ov; }
    }
    for (int idx = gtid; idx < NS * 352; idx += NT) {
        const int rs = idx / 352, ch = idx - rs * 352, c = ch * 8, r = NP + rs, tpos = rs & 3;
        float za[8], zb[8];
#pragma unroll
        for (int i = 0; i < 8; ++i) { za[i] = p.conv_b[c + i]; zb[i] = p.conv_b[FF + c + i]; }
#pragma unroll
        for (int j = 0; j < 3; ++j) {
            const int tp = tpos - 2 + j;
            float xa[8], xb[8];
            if (tp >= 0) { unpack8(*(const u32x4*)(z + (size_t)(r - 2 + j) * FF2 + c), xa); unpack8(*(const u32x4*)(z + (size_t)(r - 2 + j) * FF2 + FF + c), xb); }
            else { const float* sp = p.state_conv + ((size_t)(rs >> 2) * 2 + (tp + 2)) * FF2;
#pragma unroll
                for (int i = 0; i < 8; ++i) { xa[i] = sp[c + i]; xb[i] = sp[FF + c + i]; } }
#pragma unroll
            for (int i = 0; i < 8; ++i) { za[i] += p.conv_w[j * FF2 + c + i] * xa[i]; zb[i] += p.conv_w[j * FF2 + FF + c + i] * xb[i]; }
        }
        u32x4 o; o.x = pk2(gelu_t(za[0]) * zb[0], gelu_t(za[1]) * zb[1]); o.y = pk2(gelu_t(za[2]) * zb[2], gelu_t(za[3]) * zb[3]);
        o.z = pk2(gelu_t(za[4]) * zb[4], gelu_t(za[5]) * zb[5]); o.w = pk2(gelu_t(za[6]) * zb[6], gelu_t(za[7]) * zb[7]);
        *(u32x4*)(act + (size_t)r * FF + c) = o;
    }
}

#define XB_TMO      128
#define XB_XCNT(j)  (256  + 64 * (j))
#define XB_XSUB(j)  (1280 + 64 * (j))
#define XB_XGEN(j)  (2304 + 64 * (j))
#define XB_TOP      3328
#define XB_TOPGEN   3392
#define XCD_BAR_WORDS 3456
#define XB_SPIN_CAP (1u << 18)
DEV unsigned xb_ld(unsigned* p)              { return __hip_atomic_load(p, __ATOMIC_RELAXED, __HIP_MEMORY_SCOPE_AGENT); }
DEV unsigned xb_add(unsigned* p, unsigned v) { return __hip_atomic_fetch_add(p, v, __ATOMIC_RELAXED, __HIP_MEMORY_SCOPE_AGENT); }
DEV unsigned xb_xcc_id() { return (unsigned)__builtin_amdgcn_s_getreg((3 << 11) | 20) & 0xFu; }
#define XB_SPIN(cond, bar) do { unsigned _sp = 0; while (cond) { __builtin_amdgcn_s_sleep(1); \
    if ((++_sp & 255u) == 0u) { if (xb_ld(&(bar)[XB_TMO])) break; if (_sp > XB_SPIN_CAP) { atomicAdd(&(bar)[XB_TMO], 1u); break; } } } } while (0)
struct XcdBarrier { unsigned* bar; unsigned x; volatile LAS unsigned* st; };
DEV XcdBarrier xcd_barrier_post(unsigned* bar, volatile LAS unsigned* st) {
    XcdBarrier b; b.bar = bar; b.x = xb_xcc_id(); b.st = st;
    if (threadIdx.x == 0) (void)xb_add(&bar[XB_XCNT(b.x)], 1u);
    return b; }
DEV void xcd_barrier_complete(unsigned* bar, unsigned x, unsigned& nloc, unsigned& nx) {
    const unsigned G = gridDim.x * gridDim.y * gridDim.z;
    unsigned sum, cnt, mine, sp = 0u;
    for (;;) {
        sum = 0u; cnt = 0u; mine = 0u;
#pragma unroll
        for (unsigned j = 0; j < 16; ++j) { const unsigned c = xb_ld(&bar[XB_XCNT(j)]); sum += c; cnt += (c > 0u) ? 1u : 0u; mine = (j == x) ? c : mine; }
        if (sum == G) break;
        __builtin_amdgcn_s_sleep(1);
        if ((++sp & 255u) == 0u) { if (xb_ld(&bar[XB_TMO])) break; if (sp > XB_SPIN_CAP) { atomicAdd(&bar[XB_TMO], 1u); break; } }
    }
    nloc = mine > 0u ? mine : 1u; nx = cnt > 0u ? cnt : 1u; }
DEV void xcd_barrier(unsigned* bar_, volatile LAS unsigned* st_) {
    XcdBarrier b; b.bar = bar_; b.x = xb_xcc_id(); b.st = st_;
    asm volatile("s_waitcnt vmcnt(0)" ::: "memory");
    __syncthreads();
    if (threadIdx.x == 0) {
        unsigned* bar = b.bar;
        __builtin_amdgcn_s_waitcnt(0);
        unsigned nloc = b.st[0], nx = b.st[1];
        if (nloc == 0u) { xcd_barrier_complete(bar, b.x, nloc, nx); b.st[0] = nloc; b.st[1] = nx; }
        const unsigned old = xb_add(&bar[XB_XSUB(b.x)], 1u);
        const unsigned gen = old / nloc;
        if (old + 1u == (gen + 1u) * nloc) {
            __builtin_amdgcn_fence(__ATOMIC_RELEASE, "agent");
            asm volatile("s_waitcnt vmcnt(0)" ::: "memory");
            const unsigned og = xb_add(&bar[XB_TOP], 1u);
            const unsigned tg = og / nx;
            if (og + 1u == (tg + 1u) * nx) xb_add(&bar[XB_TOPGEN], 1u);
            else XB_SPIN(xb_ld(&bar[XB_TOPGEN]) == tg, bar);
            __builtin_amdgcn_fence(__ATOMIC_ACQUIRE, "agent");
            xb_add(&bar[XB_XGEN(b.x)], 1u);
            asm volatile("s_waitcnt vmcnt(0)" ::: "memory");
        } else {
            XB_SPIN(xb_ld(&bar[XB_XGEN(b.x)]) == gen, bar);
            __builtin_amdgcn_fence(__ATOMIC_ACQUIRE, "agent");
            asm volatile("s_waitcnt vmcnt(0)" ::: "memory");
        }
    }
    __syncthreads();
}

DEV Params kp_load() { Params r{};
#if defined(__HIP_DEVICE_COMPILE__)
    typedef const unsigned long long __attribute__((address_space(4))) KA;
    KA* q = (KA*)__builtin_amdgcn_kernarg_segment_ptr(); asm volatile("" : "+s"(q));
    unsigned long long t[28];
#pragma unroll
    for (int i = 0; i < 28; ++i) t[i] = q[i];
    __builtin_memcpy(&r, t, sizeof(Params));
#endif
    return r; }
__global__ __launch_bounds__(512, 2) void mega(Params p_arg, int ph0, int ph1) {
    extern __shared__ __attribute__((aligned(16))) unsigned char shm[];
    LAS unsigned char* lds = (LAS unsigned char*)shm;
    cg::grid_group grid = cg::this_grid();
#ifndef TIME_SEL
#define TIME_SEL 0
#endif
    unsigned long long tacc = 0;
    const int G = gridDim.x, c = obid();
    volatile LAS unsigned* xst = (volatile LAS unsigned*)(lds + LDS_BYTES - 16);
    if (threadIdx.x == 0) { xst[0] = 0u; xst[1] = 0u; }
    __syncthreads();
    (void)xcd_barrier_post((unsigned*)(kp_load().ws + OFF_BAR), xst);
#ifndef DUP_PH
#define DUP_PH -1
#endif
#ifndef PH_TIME_MASK
#define PH_TIME_MASK 0
#endif
#define PH_BEGIN(k) if (ph0 <= (k) && (k) < ph1) { const unsigned long long tph_ = ((PH_TIME_MASK) >> (k)) & 1 ? __builtin_amdgcn_s_memrealtime() : 0ull; if (PHON(k)) { for (int rep_ = 0; rep_ < ((k) == DUP_PH ? 2 : 1); ++rep_) { const Params p = kp_load(); unsigned char* ws = p.ws;
#define PH_END(k) } } if ((k) + 1 < ph1) { if ((k) == 0) grid.sync(); else xcd_barrier((unsigned*)(kp_load().ws + OFF_BAR), (volatile LAS unsigned*)(lds + LDS_BYTES - 16)); } if (((PH_TIME_MASK) >> (k)) & 1) tacc += __builtin_amdgcn_s_memrealtime() - tph_; }
    PH_BEGIN(0) phase_prep(p, lds); PH_END(0)
    PH_BEGIN(1)
            Sched1 S{G, c, (const char*)(ws + OFF_R2), (const char*)(ws + OFF_HM), (const char*)(ws + OFF_BTIN), (const char*)(ws + OFF_BTKV)};
            Epi1 E{(bf16_t*)(ws + OFF_P), (bf16_t*)(ws + OFF_MKB), p.out, (const float*)(ws + OFF_ROPEC), (const float*)(ws + OFF_ROPES), p.b_gate};
            pg8::gemm_phase(lds, 1024, 1024, S, E);
    PH_END(1)
    PH_BEGIN(2)
            for (int it = c; it < 1536; it += G) {
                if (it < 512) ret_A_item(p, lds, it);
                else if (it < 1024) xattn_item(p, lds, it - 512);
                else sgu_item(p, lds, it - 1024);
            }
            {
                const int tid2 = otid(), w2 = __builtin_amdgcn_readfirstlane(tid2 >> 6), lane2 = tid2 & 63;
                if (w2 < 2) ret_s_wave(p, c + 256 * w2, lane2);
                else if (w2 < 4) xattn_s_wave(p, (LAS float*)(lds + 4096 * w2), c + 256 * (w2 - 2), lane2);
                else if (w2 == 4 && c < 128) sgu_s_wave(p, c, lane2);
            }
    PH_END(2)
    PH_BEGIN(3)
            scan_phase(p);
            SchedMgS S{c, (const char*)(ws + OFF_P), (const char*)(ws + OFF_BTMG)};
            EpiMgS E{(const bf16_t*)(ws + OFF_P), (float*)(ws + OFF_MG32)};
            pg8::gemm_phase(lds, INC, 2048, S, E);
    PH_END(3)
    PH_BEGIN(4) for (int it = c; it < 512; it += G) ret_C_item(p, lds, it); PH_END(4)
    PH_BEGIN(5)
            {
                const int i = obid() * 512 + otid();
                if (i < 131072) { f32x4 m = __builtin_nontemporal_load((const f32x4*)(ws + OFF_MG32) + i);
#pragma unroll
                    for (int k = 1; k < 8; ++k) m += __builtin_nontemporal_load((const f32x4*)(ws + OFF_MG32) + (size_t)k * 131072 + i);
                    u32x2 o; o.x = pk2(m.x, m.y); o.y = pk2(m.z, m.w);
                    ((u32x2*)((bf16_t*)(ws + OFF_R2) + (size_t)NP * 1024))[i] = o; } }
            SchedMg S{G, c, (const char*)(ws + OFF_P), (const char*)(ws + OFF_BTMG)};
            EpiMg E{(const bf16_t*)(ws + OFF_P), (bf16_t*)(ws + OFF_R2)};
            pg8::gemm_phase(lds, INC, 2048, S, E);
    PH_END(5)
    PH_BEGIN(6)
            SchedPS<16, 64, 8, 524288, 524288> S{G, c, (const char*)(ws + OFF_R2), (const char*)(ws + OFF_BTO)};
            EpiWo E{p.x_prompt, p.x_sample, p.out, (float*)(ws + OFF_PART6)};
            pg8::gemm_phase(lds, 1024, 1024, S, E);
    PH_END(6)
    PH_BEGIN(7) rms_phase(p, false); PH_END(7)
    PH_BEGIN(8)
            SchedPlain S{G, c, 66, 22, 16, (const char*)(ws + OFF_R2), (const char*)(ws + OFF_BTUP), (size_t)524288, (size_t)524288};
            EpiUp E{(bf16_t*)(ws + OFF_Z), p.out};
            pg8::gemm_phase(lds, 1024, 1024, S, E);
    PH_END(8)
    PH_BEGIN(9) conv_phase(p); PH_END(9)
    PH_BEGIN(10)
            SchedPS<44, 176, 22, 256 * FF * 2, 256 * FF * 2> S{G, c, (const char*)(ws + OFF_ACT), (const char*)(ws + OFF_BTDN)};
            EpiDn E{p.out, (float*)(ws + OFF_PART10)};
            pg8::gemm_phase(lds, FF, FF, S, E);
    PH_END(10)
    PH_BEGIN(11) rms_phase(p, true); PH_END(11)
    if (((TIME_SEL) || (PH_TIME_MASK)) && blockIdx.x == 0 && ph1 > 1) { const unsigned long long t0_ = __builtin_amdgcn_s_memrealtime(); while (__builtin_amdgcn_s_memrealtime() - t0_ < tacc) __builtin_amdgcn_s_sleep(8); }
}

extern "C" void kernel_launch(void* const* d_in, const int* in_sizes, int n_in, void* d_out, int out_size, void* d_ws, size_t ws_size, hipStream_t stream) {
    static int grid = 0;
    if (grid == 0) {
        if (n_in != 26 || out_size != 39018496 || ws_size < WS_END2) { fprintf(stderr, "kernel_launch: unexpected shapes n_in %d out %d ws %zu (need %zu)\n", n_in, out_size, ws_size, (size_t)WS_END2); grid = -1; return; }
        int dev = 0, cus = 0, per_cu = 0;
        hipGetDevice(&dev); hipDeviceGetAttribute(&cus, hipDeviceAttributeMultiprocessorCount, dev);
        if (hipFuncSetAttribute((const void*)mega, hipFuncAttributeMaxDynamicSharedMemorySize, LDS_BYTES) != hipSuccess) { fprintf(stderr, "kernel_launch: hipFuncSetAttribute failed\n"); grid = -1; return; }
        if (hipOccupancyMaxActiveBlocksPerMultiprocessor(&per_cu, (const void*)mega, 512, LDS_BYTES) != hipSuccess || per_cu < 1) { fprintf(stderr, "kernel_launch: occupancy query gave %d\n", per_cu); grid = -1; return; }
        if (cus != 256) { fprintf(stderr, "kernel_launch: built for 256 CUs, got %d\n", cus); grid = -1; return; }
        grid = cus;
    }
    if (grid < 0) return;
    Params p{};
    const float** f = (const float**)&p;
    for (int i = 0; i < 26; ++i) f[i] = (const float*)d_in[i];
    p.out = (float*)d_out; p.ws = (unsigned char*)d_ws;
#ifndef DBG_NPH
#define DBG_NPH 12
#endif
#ifndef MK_MULTI
#define MK_MULTI 0
#endif
#if MK_MULTI
#ifndef PH_SEQ
#define PH_SEQ 0,1,2,3,4,5,6,7,8,9,10,11
#endif
    { const int seq[] = {PH_SEQ}; for (int ph : seq) hipLaunchKernelGGL(mega, dim3(grid), dim3(512), LDS_BYTES, stream, p, ph, ph + 1); }
    hipError_t e = hipSuccess;
#else
    (void)hipMemsetAsync((unsigned char*)d_ws + OFF_BAR, 0, 16384, stream);
    int ph0 = 0, ph1 = NPHASE;
    void* args[] = {&p, &ph0, &ph1};
    hipError_t e = hipLaunchCooperativeKernel((const void*)mega, dim3(grid), dim3(512), args, LDS_BYTES, stream);
#endif
    if (e != hipSuccess) fprintf(stderr, "cooperative launch failed: %s (grid %d)\n", hipGetErrorString(e), grid);
}
```

```cpp
#include <hip/hip_runtime.h>
#include <hip/hip_cooperative_groups.h>
#include <cstdio>
#include <cstdint>
namespace cg = cooperative_groups;

#define LAS __attribute__((address_space(3)))
#define DEV __device__ __forceinline__
typedef unsigned short bf16_t;
typedef short bf16x8 __attribute__((ext_vector_type(8)));
typedef short s16x4 __attribute__((ext_vector_type(4)));
typedef float f32x4 __attribute__((ext_vector_type(4)));
typedef unsigned u32x4 __attribute__((ext_vector_type(4)));
typedef unsigned u32x2 __attribute__((ext_vector_type(2)));

constexpr int NP = 16384, NS = 512, MT = 16896, INC = 7680, FF = 2816, FF2 = 5632;
constexpr int C_Q = 0, C_K = 512, C_V = 1024, C_G = 2048, C_SU = 3072, C_XQ = 3584, C_SV = 4096, C_GT = 4608;
constexpr float EPS = 1e-6f;
constexpr size_t OFF_BTIN = 0;
constexpr size_t OFF_BTKV = OFF_BTIN + 15728640;
constexpr size_t OFF_BTMG = OFF_BTKV + 2097152;
constexpr size_t OFF_BTO = OFF_BTMG + 4194304;
constexpr size_t OFF_BTUP = OFF_BTO + 2097152;
constexpr size_t OFF_BTDN = OFF_BTUP + 11534336;
constexpr size_t OFF_ROPEC = OFF_BTDN + 5767168;
constexpr size_t OFF_ROPES = OFF_ROPEC + 525312;
constexpr size_t OFF_WTRIL = OFF_ROPES + 525312;
constexpr size_t OFF_HM = OFF_WTRIL + 131072;
constexpr size_t OFF_MKB = OFF_HM + 4194304;
constexpr size_t OFF_P = OFF_MKB + 4194304;
constexpr size_t OFF_R2 = OFF_P + 259522560;
constexpr size_t OFF_MG32 = OFF_R2 + 34603008;
constexpr size_t WS_END = OFF_MG32 + 8 * 2097152;
constexpr size_t OFF_BAR = WS_END;
constexpr size_t WS_END2 = OFF_BAR + 16384;
constexpr size_t OFF_PART6 = OFF_P, OFF_PART10 = OFF_P;
constexpr int SROWS = 512 * 1024;
constexpr size_t OFF_Z = OFF_P;
constexpr size_t OFF_ACT = OFF_P + 190316544;
constexpr size_t O_Y = 0, O_RETP = 17301504, O_CONVP = 18350080, O_MK = 18440192, O_MV = 19488768, O_RETS = 20537344, O_CONVS = 37314560, O_SGV = 38756352;
constexpr int LDS_BYTES = 147456;
constexpr int NPHASE = 12;
#ifndef DBG_XA
#define DBG_XA 3
#endif
#ifndef ONLY_PH
#define ONLY_PH -1
#endif
#ifndef SKIP_PH
#define SKIP_PH -2
#endif
#define PHON(n) ((ONLY_PH < 0 || ONLY_PH == (n)) && SKIP_PH != (n))

struct Params {
    const float *x_prompt, *x_sample, *mem_prompt, *state_ret, *state_conv, *cache_k, *cache_v, *norm_mix_g, *w_in, *b_gate, *ret_gn_g, *sg_ln_g, *sg_ws, *sg_bs,
        *mem_norm_g, *w_mem_kv, *w_br_ret, *w_br_sg, *w_br_x, *w_o, *norm_ffn_g, *w_up, *conv_w, *conv_b, *w_down, *norm_final_g;
    float* out; unsigned char* ws;
};

typedef __bf16 bf16v2_t __attribute__((ext_vector_type(2)));
typedef float f32x2_t __attribute__((ext_vector_type(2)));
DEV unsigned pk2(float lo, float hi) { const f32x2_t f = {lo, hi}; const bf16v2_t v = __builtin_convertvector(f, bf16v2_t); return __builtin_bit_cast(unsigned, v); }
DEV bf16_t f2bf(float v) { return (bf16_t)(pk2(v, 0.f) & 0xffffu); }
DEV float bf_lo(unsigned u) { return __uint_as_float(u << 16); }
DEV float bf_hi(unsigned u) { return __uint_as_float(u & 0xffff0000u); }
DEV float bf2f(bf16_t b) { return __uint_as_float(((unsigned)b) << 16); }
DEV void unpack8(const u32x4 a, float (&x)[8]) { x[0] = bf_lo(a.x); x[1] = bf_hi(a.x); x[2] = bf_lo(a.y); x[3] = bf_hi(a.y); x[4] = bf_lo(a.z); x[5] = bf_hi(a.z); x[6] = bf_lo(a.w); x[7] = bf_hi(a.w); }
template <int CTRL> DEV float dpp_f(float v) { return __int_as_float(__builtin_amdgcn_update_dpp(0, __float_as_int(v), CTRL, 0xF, 0xF, true)); }
DEV float rdl(float v, int l) { return __int_as_float(__builtin_amdgcn_readlane(__float_as_int(v), l)); }
DEV float g16_sum(float v) { v += dpp_f<0xB1>(v); v += dpp_f<0x4E>(v); v += dpp_f<0x141>(v); v += dpp_f<0x140>(v); return v; }
DEV float g16_max(float v) { v = fmaxf(v, dpp_f<0xB1>(v)); v = fmaxf(v, dpp_f<0x4E>(v)); v = fmaxf(v, dpp_f<0x141>(v)); v = fmaxf(v, dpp_f<0x140>(v)); return v; }
DEV float wave_sum(float v) { v = g16_sum(v); return (rdl(v, 0) + rdl(v, 16)) + (rdl(v, 32) + rdl(v, 48)); }
DEV float wave_max(float v) { v = g16_max(v); return fmaxf(fmaxf(rdl(v, 0), rdl(v, 16)), fmaxf(rdl(v, 32), rdl(v, 48))); }
DEV float sigm_f(float x) { return __builtin_amdgcn_rcpf(1.f + __builtin_amdgcn_exp2f(-1.4426950408889634f * x)); }
DEV float silu_f(float x) { return x * sigm_f(x); }
DEV float gelu_t(float x) { const float u = x * (2.3022081646f + 0.1029432406f * x * x); return x * __builtin_amdgcn_rcpf(1.f + __builtin_amdgcn_exp2f(-u)); }
DEV float log_gamma(int h) { return log1pf(-exp2f(-5.f - (float)h)); }
DEV int otid() { int t = threadIdx.x; asm volatile("" : "+v"(t)); return t; }
DEV int obid() { int t = blockIdx.x; asm volatile("" : "+s"(t)); return t; }
DEV unsigned ldsaddr(LAS const void* p) { return (unsigned)(uintptr_t)p; }
DEV f32x4 mfma16(bf16x8 a, bf16x8 b, f32x4 c) { return __builtin_amdgcn_mfma_f32_16x16x32_bf16(a, b, c, 0, 0, 0); }
DEV bf16x8 lds_frag(LAS const unsigned char* base, int pitch, int row0, int k0, int lane) {
    return *(LAS const bf16x8*)(base + (row0 + (lane & 15)) * pitch + (k0 + 8 * (lane >> 4)) * 2); }
DEV LAS const unsigned char* tr_lane_base(LAS const unsigned char* base, int pitch, int lane) { const int g = lane >> 4, q = (lane & 15) >> 2, pp = lane & 3; return base + ((8 * g + q) * pitch + 8 * pp); }
template <int PITCH, int KB, int X0> DEV void tr_read4(LAS const unsigned char* a, bf16x8 (&f)[4]) {
    constexpr int o0 = KB * PITCH + X0 * 2;
    static_assert(o0 + 100 * PITCH < 65536, "ds offset field");
#pragma unroll
    for (int ks = 0; ks < 4; ++ks) {
        const s16x4 lo = __builtin_amdgcn_ds_read_tr16_b64_v4i16((LAS s16x4*)(a + o0 + ks * 32 * PITCH));
        const s16x4 hi = __builtin_amdgcn_ds_read_tr16_b64_v4i16((LAS s16x4*)(a + o0 + ks * 32 * PITCH + 4 * PITCH));
        f[ks] = (bf16x8){lo[0], lo[1], lo[2], lo[3], hi[0], hi[1], hi[2], hi[3]}; } }
template <int V> struct IC { static constexpr int value = V; };
template <int I, int N, class F> DEV void static_for(F&& f) { if constexpr (I < N) { f(IC<I>{}); static_for<I + 1, N>(f); } }
#define SCHEDB __builtin_amdgcn_sched_barrier(0)

namespace pg8 {
constexpr int BM = 256, BK = 64, HALF = 128, HTB = HALF * BK * 2, NXCD = 8, WGM = 8;
DEV int lds_byte(int r, int c) { const int st = (r >> 4) * 2 + (c >> 5), rr = r & 15, cc = c & 31, ob = rr * 64 + cc * 2; return st * 1024 + (ob ^ (((ob >> 9) & 1) << 5)); }
DEV void stage_rc(int b, int& R, int& C) { const int st = b / 1024, sb = b % 1024, swz = sb ^ (((sb >> 9) & 1) << 5); R = (st >> 1) * 16 + swz / 64; C = (st & 1) * 32 + (swz % 64) / 2; }
DEV int perm32(int rho) { const int n = rho >> 4, i = rho & 15; return 8 * (i >> 2) + 4 * n + (i & 3); }
struct Unit { int pm, pn, kind, nt; const char* A; const char* B; };
DEV void tile_map(int L, int nM, int nN, int& pm, int& pn) {
    const int nwg = nM * nN; int wgid = L; { const int q = nwg / NXCD, r = nwg % NXCD, xcd = wgid % NXCD, off = wgid / NXCD; wgid = (xcd < r ? xcd * (q + 1) : r * (q + 1) + (xcd - r) * q) + off; }
    const int nig = WGM * nN, gid = wgid / nig, fm = gid * WGM, gsz = (nM - fm) < WGM ? (nM - fm) : WGM;
    pm = fm + ((wgid % nig) % gsz); pn = (wgid % nig) / gsz; }

template <class Epi, class Sched>
DEV void gemm_phase(LAS unsigned char* lds, int lda, int ldb, const Sched& S, const Epi& E) {
    const int tid = otid(), wid = __builtin_amdgcn_readfirstlane(tid >> 6), lane = tid & 63, wr = wid >> 2, wc = wid & 3, fr = lane & 15, fq = lane >> 4;
    unsigned voffA[2], voffB[2];
#pragma unroll
    for (int i = 0; i < 2; ++i) { int R, C; stage_rc(tid * 16 + i * 8192, R, C); const int Rb = (R & ~31) + perm32(R & 31);
        voffA[i] = (unsigned)(R * lda + C) * 2u; voffB[i] = (unsigned)(Rb * ldb + C) * 2u; }
    const size_t kstep = (size_t)(BK * 2);
    const size_t hstepA = (size_t)HALF * lda * 2, hstepB = (size_t)HALF * ldb * 2;
    const unsigned ldsw = (unsigned)wid * 1024u;
    const int aoff = lds_byte(wr * 64 + fr, fq * 8), boff = lds_byte(wc * 32 + fr, fq * 8);
#define PG8_SA(b, h) (((b) * 2 + (h)) * HTB)
#define PG8_SB(b, h) ((4 + (b) * 2 + (h)) * HTB)
#define PG8_STAGE(bufoff, gbase, voff) do { _Pragma("unroll") for (int _i = 0; _i < 2; ++_i) \
        __builtin_amdgcn_global_load_lds((const unsigned*)((const char*)(gbase) + (voff)[_i]), (LAS unsigned*)(lds + (bufoff) + ldsw + _i * 8192), 16, 0, 0); } while (0)
#define PG8_LDA(dst, b, h) do { _Pragma("unroll") for (int m = 0; m < 4; ++m) _Pragma("unroll") for (int k = 0; k < 2; ++k) dst[m][k] = *(const LAS bf16x8*)(lds + PG8_SA(b, h) + aoff + m * 2048 + k * 1024); } while (0)
#define PG8_LDB(dst, b, h) do { _Pragma("unroll") for (int n = 0; n < 2; ++n) _Pragma("unroll") for (int k = 0; k < 2; ++k) dst[n][k] = *(const LAS bf16x8*)(lds + PG8_SB(b, h) + boff + n * 2048 + k * 1024); } while (0)
#define PG8_MMA(ai, bj, At, Bt) do { __builtin_amdgcn_s_setprio(1); _Pragma("unroll") for (int m = 0; m < 4; ++m) _Pragma("unroll") for (int n = 0; n < 2; ++n) _Pragma("unroll") for (int k = 0; k < 2; ++k) \
        acc[ai][bj][m][n] = __builtin_amdgcn_mfma_f32_16x16x32_bf16(Bt[n][k], At[m][k], acc[ai][bj][m][n], 0, 0, 0); __builtin_amdgcn_s_setprio(0); } while (0)
#define PG8_WAIT_V(n) asm volatile("s_waitcnt vmcnt(" #n ")" ::: "memory")
#define PG8_WAIT_L(n) asm volatile("s_waitcnt lgkmcnt(" #n ")" ::: "memory")
#define PG8_BAR __builtin_amdgcn_s_barrier()
#define PG8_SCHED __builtin_amdgcn_sched_barrier(0)
    Unit cur, nxt; int ui = 0;
    if (!S.next(0, cur)) return;
    f32x4 acc[2][2][4][2];
#pragma unroll
    for (int a = 0; a < 2; ++a)
#pragma unroll
        for (int b = 0; b < 2; ++b)
#pragma unroll
            for (int m = 0; m < 4; ++m)
#pragma unroll
                for (int n = 0; n < 2; ++n) acc[a][b][m][n] = (f32x4){0.f, 0.f, 0.f, 0.f};
    bf16x8 At[4][2], B0[2][2], B1[2][2];
    const char* cA = cur.A; const char* cB = cur.B;
    PG8_STAGE(PG8_SB(0, 0), cB, voffB); PG8_STAGE(PG8_SA(0, 0), cA, voffA); PG8_STAGE(PG8_SB(0, 1), cB + hstepB, voffB); PG8_STAGE(PG8_SA(0, 1), cA + hstepA, voffA);
    if (wr == 1) PG8_BAR;
    PG8_WAIT_V(4); PG8_BAR;
    PG8_STAGE(PG8_SB(1, 0), cB + kstep, voffB); PG8_STAGE(PG8_SA(1, 0), cA + kstep, voffA); PG8_STAGE(PG8_SB(1, 1), cB + hstepB + kstep, voffB);
    PG8_WAIT_V(6); PG8_BAR;
    for (;;) {
        const bool has_next = S.next(ui + 1, nxt);
        const char* nA = has_next ? nxt.A : cA; const char* nB = has_next ? nxt.B : cB;
        const int nt = cur.nt;
        for (int t = 0; t < nt; t += 2) {
            const bool last = (t == nt - 2);
            const char* a1 = cA + (size_t)(t + 1) * kstep;
            const char* a2 = last ? nA : cA + (size_t)(t + 2) * kstep; const char* b2 = last ? nB : cB + (size_t)(t + 2) * kstep;
            const char* a3 = a2 + kstep; const char* b3 = b2 + kstep;
            PG8_LDB(B0, 0, 0); PG8_SCHED; PG8_LDA(At, 0, 0); PG8_STAGE(PG8_SA(1, 1), a1 + hstepA, voffA);
            PG8_WAIT_L(8); PG8_BAR; PG8_WAIT_L(0); PG8_MMA(0, 0, At, B0); PG8_BAR; PG8_SCHED;
            PG8_LDB(B1, 0, 1); PG8_STAGE(PG8_SB(0, 0), b2, voffB);
            PG8_BAR; PG8_WAIT_L(0); PG8_MMA(0, 1, At, B1); PG8_BAR;
            PG8_LDA(At, 0, 1); PG8_STAGE(PG8_SA(0, 0), a2, voffA);
            PG8_BAR; PG8_WAIT_L(0); PG8_MMA(1, 0, At, B0); PG8_BAR; PG8_SCHED;
            PG8_STAGE(PG8_SB(0, 1), b2 + hstepB, voffB);
            PG8_WAIT_V(6); PG8_BAR; PG8_MMA(1, 1, At, B1); PG8_BAR;
            PG8_LDB(B0, 1, 0); PG8_SCHED; PG8_LDA(At, 1, 0); PG8_STAGE(PG8_SA(0, 1), a2 + hstepA, voffA);
            PG8_WAIT_L(8); PG8_BAR; PG8_WAIT_L(0); PG8_MMA(0, 0, At, B0); PG8_BAR; PG8_SCHED;
            PG8_LDB(B1, 1, 1); PG8_STAGE(PG8_SB(1, 0), b3, voffB);
            PG8_BAR; PG8_WAIT_L(0); PG8_MMA(0, 1, At, B1); PG8_BAR;
            PG8_LDA(At, 1, 1); PG8_STAGE(PG8_SA(1, 0), a3, voffA);
            PG8_BAR; PG8_WAIT_L(0); PG8_MMA(1, 0, At, B0); PG8_BAR; PG8_SCHED;
            PG8_STAGE(PG8_SB(1, 1), b3 + hstepB, voffB);
            PG8_WAIT_V(6); PG8_BAR; PG8_MMA(1, 1, At, B1); PG8_BAR;
        }
        const bool keep = E(acc, cur, wr, wc, fr, fq);
        if (!has_next) break;
        if (!keep)
#pragma unroll
        for (int a = 0; a < 2; ++a)
#pragma unroll
            for (int b = 0; b < 2; ++b)
#pragma unroll
                for (int m = 0; m < 4; ++m)
#pragma unroll
                    for (int n = 0; n < 2; ++n) acc[a][b][m][n] = (f32x4){0.f, 0.f, 0.f, 0.f};
        cur = nxt; cA = nA; cB = nB; ++ui;
    }
    PG8_WAIT_V(0);
    if (wr == 0) PG8_BAR;
    PG8_BAR;
#undef PG8_SA
#undef PG8_SB
#undef PG8_STAGE
#undef PG8_LDA
#undef PG8_LDB
#undef PG8_MMA
#undef PG8_WAIT_V
#undef PG8_WAIT_L
#undef PG8_BAR
#undef PG8_SCHED
}
#define EPI_LOOP_BEGIN \
    _Pragma("unroll") for (int ai = 0; ai < 2; ++ai) _Pragma("unroll") for (int m = 0; m < 4; ++m) { const int row = u.pm * 256 + ai * 128 + wr * 64 + m * 16 + fr; \
    _Pragma("unroll") for (int bj = 0; bj < 2; ++bj) { const int col0 = u.pn * 256 + bj * 128 + wc * 32 + fq * 8; const f32x4 v0 = acc[ai][bj][m][0], v1 = acc[ai][bj][m][1];
#define EPI_LOOP_END } }
#define EPI_AI_BEGIN _Pragma("unroll") for (int ai = 0; ai < 2; ++ai) {
#define EPI_AI_END }
#define EPI_G_BEGIN _Pragma("unroll") for (int m = 0; m < 4; ++m) { const int row = u.pm * 256 + ai * 128 + wr * 64 + m * 16 + fr; \
    _Pragma("unroll") for (int bj = 0; bj < 2; ++bj) { const int col0 = u.pn * 256 + bj * 128 + wc * 32 + fq * 8; const int gi = m * 2 + bj; (void)gi; (void)row; (void)col0;
#define EPI_G_END } }
}
using pg8::Unit;
typedef f32x4 AccT[2][2][4][2];

struct Sched1 { int G, c; const char *h, *hm, *btin, *btkv;
    DEV bool next(int i, Unit& u) const {
        long L = (long)i * G + c;
        if (L < 1980) { pg8::tile_map((int)L, 66, 30, u.pm, u.pn); u.kind = 0; u.nt = 16; u.A = h + (size_t)u.pm * 524288; u.B = btin + (size_t)u.pn * 524288; return true; }
        L -= 1980; if (L < 32) { u.pm = (int)(L & 7); u.pn = (int)(L >> 3); u.kind = 1; u.nt = 16; u.A = hm + (size_t)u.pm * 524288; u.B = btkv + (size_t)u.pn * 524288; return true; }
        return false; } };
struct Epi1 { bf16_t* P; bf16_t* mkb; float* out; const float *ropeC, *ropeS, *b_gate;
    DEV bool operator()(AccT& acc, const Unit& u, int wr, int wc, int fr, int fq) const {
        if (u.kind == 1) {
            EPI_LOOP_BEGIN
                float* o = (col0 < 512) ? out + O_MK + (size_t)row * 512 + col0 : out + O_MV + (size_t)row * 512 + (col0 - 512);
                *(f32x4*)o = v0; *(f32x4*)(o + 4) = v1;
                u32x4 pk; pk.x = pk2(v0.x, v0.y); pk.y = pk2(v0.z, v0.w); pk.z = pk2(v1.x, v1.y); pk.w = pk2(v1.z, v1.w);
                *(u32x4*)(mkb + (size_t)row * 1024 + col0) = pk;
            EPI_LOOP_END
            return false; }
        const int pn = u.pn;
        if (pn < 4) {
            const float sc = (pn >= 2) ? 0.08838834764831845f : 1.f;
            EPI_AI_BEGIN
                f32x4 cs[8], sn[8];
                EPI_G_BEGIN
                    const int pidx = row < NP ? (row & 2047) : 2048 + ((row - NP) & 3); const int uu = (col0 & 127) >> 3;
                    cs[gi] = *(const f32x4*)(ropeC + pidx * 64 + 4 * uu); sn[gi] = *(const f32x4*)(ropeS + pidx * 64 + 4 * uu);
                EPI_G_END
                EPI_G_BEGIN
                    const f32x4 v0 = acc[ai][bj][m][0], v1 = acc[ai][bj][m][1];
                    const int uu = (col0 & 127) >> 3, hb = col0 & ~127;
                    const f32x4 o1 = (v0 * cs[gi] - v1 * sn[gi]) * sc, o2 = (v0 * sn[gi] + v1 * cs[gi]) * sc;
                    u32x2 a; a.x = pk2(o1.x, o1.y); a.y = pk2(o1.z, o1.w); u32x2 b; b.x = pk2(o2.x, o2.y); b.y = pk2(o2.z, o2.w);
                    *(u32x2*)(P + (size_t)row * INC + hb + 4 * uu) = a; *(u32x2*)(P + (size_t)row * INC + hb + 64 + 4 * uu) = b;
                EPI_G_END
            EPI_AI_END
            return false; }
        const int mode = pn < 8 ? 0 : pn < 12 ? 1 : pn < 14 ? 2 : pn < 16 ? 0 : pn < 18 ? 2 : 3;
        f32x4 bg[2][2];
#pragma unroll
        for (int bj = 0; bj < 2; ++bj) { const int cg = (mode == 3) ? u.pn * 256 + bj * 128 + wc * 32 + fq * 8 - C_GT : 0; bg[bj][0] = *(const f32x4*)(b_gate + cg); bg[bj][1] = *(const f32x4*)(b_gate + cg + 4); }
        EPI_LOOP_BEGIN
            f32x4 a = v0, b = v1;
            if (mode == 1) { for (int i = 0; i < 4; ++i) { a[i] = silu_f(a[i]); b[i] = silu_f(b[i]); } }
            else if (mode == 2) { for (int i = 0; i < 4; ++i) { a[i] = gelu_t(a[i]); b[i] = gelu_t(b[i]); } }
            else if (mode == 3) { for (int i = 0; i < 4; ++i) { a[i] = sigm_f(a[i] + bg[bj][0][i]); b[i] = sigm_f(b[i] + bg[bj][1][i]); } }
            u32x4 pk; pk.x = pk2(a.x, a.y); pk.y = pk2(a.z, a.w); pk.z = pk2(b.x, b.y); pk.w = pk2(b.z, b.w);
            *(u32x4*)(P + (size_t)row * INC + col0) = pk;
        EPI_LOOP_END
        return false;
    } };

struct SchedMg { int G, c; const char *P, *bt;
    DEV bool next(int i, Unit& u) const {
        const int T = i / 3, br = i - 3 * T; const long L = (long)T * G + c; if (L >= 256) return false;
        pg8::tile_map((int)L, 64, 4, u.pm, u.pn); u.kind = br; u.nt = br == 0 ? 16 : 8;
        const int koff = br == 0 ? 0 : br == 1 ? 1024 : 1536;
        u.A = P + (size_t)u.pm * 256 * INC * 2 + (size_t)(C_G + koff) * 2; u.B = bt + (size_t)u.pn * 256 * 2048 * 2 + (size_t)koff * 2; return true; } };
struct SchedMgS { int c; const char *P, *bt;
    DEV bool next(int i, Unit& u) const {
        if (i > 0 || c >= 64) return false;
        const int tile = c >> 3, ch = c & 7; u.pm = 64 + (tile >> 2); u.pn = tile & 3; u.kind = ch; u.nt = 4;
        const int koff = ch * 256;
        u.A = P + (size_t)u.pm * 256 * INC * 2 + (size_t)(C_G + koff) * 2; u.B = bt + (size_t)u.pn * 256 * 2048 * 2 + (size_t)koff * 2; return true; } };
struct EpiMg { const bf16_t* P; bf16_t* mg;
    DEV bool operator()(AccT& acc, const Unit& u, int wr, int wc, int fr, int fq) const {
        const int br = u.kind;
        EPI_AI_BEGIN
            u32x4 gg[8], hh[8];
            EPI_G_BEGIN
                const bf16_t* gp = P + (size_t)row * INC + C_GT + br * 1024 + col0;
                gg[gi] = *(const u32x4*)gp; hh[gi] = (br < 2) ? *(const u32x4*)(gp + 1024) : gg[gi];
            EPI_G_END
            EPI_G_BEGIN
                float s8[8], d8[8]; unpack8(gg[gi], s8);
                if (br < 2) { unpack8(hh[gi], d8);
#pragma unroll
                    for (int i = 0; i < 8; ++i) s8[i] *= __builtin_amdgcn_rcpf(d8[i]); }
                f32x4& v0 = acc[ai][bj][m][0]; f32x4& v1 = acc[ai][bj][m][1];
                v0.x *= s8[0]; v0.y *= s8[1]; v0.z *= s8[2]; v0.w *= s8[3]; v1.x *= s8[4]; v1.y *= s8[5]; v1.z *= s8[6]; v1.w *= s8[7];
                if (br == 2) { u32x4 pk; pk.x = pk2(v0.x, v0.y); pk.y = pk2(v0.z, v0.w); pk.z = pk2(v1.x, v1.y); pk.w = pk2(v1.z, v1.w); *(u32x4*)(mg + (size_t)row * 1024 + col0) = pk; }
            EPI_G_END
        EPI_AI_END
        return br < 2;
    } };
struct EpiMgS { const bf16_t* P; float* part;
    DEV bool operator()(AccT& acc, const Unit& u, int wr, int wc, int fr, int fq) const {
        const int ch = u.kind, br = ch < 4 ? 0 : ch < 6 ? 1 : 2;
        const bf16_t* gp = P + C_GT + br * 1024; float* tp = part + (size_t)ch * SROWS - (size_t)NP * 1024;
        EPI_AI_BEGIN
            u32x4 gg[8];
            EPI_G_BEGIN
                gg[gi] = *(const u32x4*)(gp + (size_t)row * INC + col0);
            EPI_G_END
            EPI_G_BEGIN
                float s8[8]; unpack8(gg[gi], s8); const f32x4 v0 = acc[ai][bj][m][0], v1 = acc[ai][bj][m][1];
                float* t = tp + (size_t)row * 1024 + col0;
                *(f32x4*)t = (f32x4){s8[0] * v0.x, s8[1] * v0.y, s8[2] * v0.z, s8[3] * v0.w}; *(f32x4*)(t + 4) = (f32x4){s8[4] * v1.x, s8[5] * v1.y, s8[6] * v1.z, s8[7] * v1.w};
            EPI_G_END
        EPI_AI_END
        return false;
    } };
template <int nt, int nsub, int nchunk, int astep, int bstep> struct SchedPS { int G, c; const char *A, *B;
    DEV bool next(int i, Unit& u) const {
        const long L = (long)i * G + c;
        if (L < 256) { pg8::tile_map((int)L, 64, 4, u.pm, u.pn); u.kind = 0; u.nt = nt; u.A = A + (size_t)u.pm * astep; u.B = B + (size_t)u.pn * bstep; return true; }
        const int s = (int)(L - 256); if (s >= nsub) return false;
        const int tile = s / nchunk, ch = s - tile * nchunk; u.pm = 64 + (tile >> 2); u.pn = tile & 3; u.kind = 1 + ch; u.nt = 2;
        u.A = A + (size_t)u.pm * astep + (size_t)ch * 256; u.B = B + (size_t)u.pn * bstep + (size_t)ch * 256; return true; } };
struct SchedPlain { int G, c, nM, nN, nt; const char *A, *B; size_t astep, bstep;
    DEV bool next(int i, Unit& u) const {
        const long L = (long)i * G + c; if (L >= (long)nM * nN) return false;
        pg8::tile_map((int)L, nM, nN, u.pm, u.pn); u.kind = 0; u.nt = nt; u.A = A + (size_t)u.pm * astep; u.B = B + (size_t)u.pn * bstep; return true; } };
struct EpiWo { const float *xp, *xs; float* out; float* part;
    DEV bool operator()(AccT& acc, const Unit& u, int wr, int wc, int fr, int fq) const {
        if (u.kind >= 1) {
            EPI_LOOP_BEGIN
                float* t = part + (size_t)(u.kind - 1) * SROWS + (size_t)(row - NP) * 1024 + col0; *(f32x4*)t = v0; *(f32x4*)(t + 4) = v1;
            EPI_LOOP_END
            return false; }
        EPI_LOOP_BEGIN
            u32x4 pk; pk.x = pk2(v0.x, v0.y); pk.y = pk2(v0.z, v0.w); pk.z = pk2(v1.x, v1.y); pk.w = pk2(v1.z, v1.w);
            *(u32x4*)((bf16_t*)out + (size_t)row * 2048 + 1024 + col0) = pk;
        EPI_LOOP_END
        return false;
    } };
struct EpiUp { bf16_t* z; float* out;
    DEV bool operator()(AccT& acc, const Unit& u, int wr, int wc, int fr, int fq) const {
        EPI_LOOP_BEGIN
            u32x4 pk; pk.x = pk2(v0.x, v0.y); pk.y = pk2(v0.z, v0.w); pk.z = pk2(v1.x, v1.y); pk.w = pk2(v1.z, v1.w);
            *(u32x4*)(z + (size_t)row * FF2 + col0) = pk;
            float* o = nullptr;
            if (row < NP) { const int t = row & 2047; if (t >= 2046) o = out + O_CONVP + ((size_t)(row >> 11) * 2 + (t - 2046)) * FF2 + col0; }
            else { const int rs = row - NP, t = rs & 3; if (t >= 2) o = out + O_CONVS + ((size_t)(rs >> 2) * 2 + (t - 2)) * FF2 + col0; }
            if (o) { *(f32x4*)o = v0; *(f32x4*)(o + 4) = v1; }
        EPI_LOOP_END
        return false;
    } };
struct EpiDn { float* out; float* part;
    DEV bool operator()(AccT& acc, const Unit& u, int wr, int wc, int fr, int fq) const {
        if (u.kind >= 1) {
            EPI_LOOP_BEGIN
                float* t = part + (size_t)(u.kind - 1) * SROWS + (size_t)(row - NP) * 1024 + col0; *(f32x4*)t = v0; *(f32x4*)(t + 4) = v1;
            EPI_LOOP_END
            return false; }
        EPI_LOOP_BEGIN
            u32x4 pk; pk.x = pk2(v0.x, v0.y); pk.y = pk2(v0.z, v0.w); pk.z = pk2(v1.x, v1.y); pk.w = pk2(v1.z, v1.w);
            *(u32x4*)((bf16_t*)out + (size_t)row * 2048 + col0) = pk;
        EPI_LOOP_END
        return false;
    } };

DEV int srccol_in(int p) {
    if (p < 1024) { const int hb = p & ~127, pp = p & 127, uu = pp >> 3, v = pp & 7; return hb + ((v < 4) ? 4 * uu + v : 64 + 4 * uu + (v - 4)); }
    if (p >= C_XQ && p < C_SV) return p + 512;
    if (p >= C_SV && p < C_GT) return p - 512;
    return p; }
DEV void transpose_item(const float* W, int N, bf16_t* WT, int ldk, int koff, LAS float* scr, int k0, int n0, int srccol, int lane) {
    float tv[32];
#pragma unroll
    for (int i = 0; i < 32; ++i) tv[i] = __builtin_nontemporal_load(W + (size_t)(k0 + 2 * i + (lane >> 5)) * N + srccol);
#pragma unroll
    for (int i = 0; i < 32; ++i) scr[(2 * i + (lane >> 5)) * 33 + (lane & 31)] = tv[i];
    const int c = lane & 7;
#pragma unroll
    for (int j = 0; j < 4; ++j) { const int n = (lane >> 3) + 8 * j; const LAS float* s = scr + (8 * c) * 33 + n;
        u32x4 o; o.x = pk2(s[0 * 33], s[1 * 33]); o.y = pk2(s[2 * 33], s[3 * 33]); o.z = pk2(s[4 * 33], s[5 * 33]); o.w = pk2(s[6 * 33], s[7 * 33]);
        *(u32x4*)(WT + (size_t)(n0 + n) * ldk + koff + k0 + 8 * c) = o; }
}
DEV void rms_row(const float* xrow, const float* g, bf16_t* orow, int lane) {
    f32x4 v[4]; float s = 0.f;
#pragma unroll
    for (int j = 0; j < 4; ++j) { v[j] = __builtin_nontemporal_load((const f32x4*)(xrow + 4 * lane + 256 * j)); s += v[j].x * v[j].x + v[j].y * v[j].y + v[j].z * v[j].z + v[j].w * v[j].w; }
    s = wave_sum(s); const float r = rsqrtf(s * (1.f / 1024.f) + EPS);
#pragma unroll
    for (int j = 0; j < 4; ++j) { const f32x4 gv = *(const f32x4*)(g + 4 * lane + 256 * j);
        u32x2 o; o.x = pk2(v[j].x * r * gv.x, v[j].y * r * gv.y); o.y = pk2(v[j].z * r * gv.z, v[j].w * r * gv.w);
        *(u32x2*)(orow + 4 * lane + 256 * j) = o; }
}
DEV void phase_prep(const Params& p, LAS unsigned char* lds) {
    const int tid = otid(), lane = tid & 63, wave = tid >> 6;
    const int gw = obid() * 8 + wave, NGW = gridDim.x * 8;
    LAS float* scr = (LAS float*)(lds + wave * 8448);
    unsigned char* ws = p.ws;
    constexpr int I_IN = 16 * 240, I_KV = 16 * 32, I_MR = 16 * 32, I_MS = 8 * 32, I_MX = 8 * 32, I_O = 16 * 32, I_UP = 16 * 176, I_DN = 44 * 32;
    constexpr int N_TR = I_IN + I_KV + I_MR + I_MS + I_MX + I_O + I_UP + I_DN;
    constexpr int N_RMS = MT + 2048, N_ROPE = 2052, N_TRIL = 512;
    constexpr int N_ALL = N_TR + N_RMS + N_ROPE + N_TRIL;
    for (int it = gw; it < N_ALL; it += NGW) {
        int r = it;
        if (r < N_TR) {
            const int l31 = lane & 31;
            if (r < I_IN) { const int kb = r / 240, nb = r % 240; transpose_item(p.w_in, INC, (bf16_t*)(ws + OFF_BTIN), 1024, 0, scr, 64 * kb, 32 * nb, srccol_in(32 * nb + l31), lane); continue; } r -= I_IN;
            if (r < I_KV) { const int kb = r / 32, nb = r % 32; transpose_item(p.w_mem_kv, 1024, (bf16_t*)(ws + OFF_BTKV), 1024, 0, scr, 64 * kb, 32 * nb, 32 * nb + l31, lane); continue; } r -= I_KV;
            if (r < I_MR) { const int kb = r / 32, nb = r % 32; transpose_item(p.w_br_ret, 1024, (bf16_t*)(ws + OFF_BTMG), 2048, 0, scr, 64 * kb, 32 * nb, 32 * nb + l31, lane); continue; } r -= I_MR;
            if (r < I_MS) { const int kb = r / 32, nb = r % 32; transpose_item(p.w_br_sg, 1024, (bf16_t*)(ws + OFF_BTMG), 2048, 1024, scr, 64 * kb, 32 * nb, 32 * nb + l31, lane); continue; } r -= I_MS;
            if (r < I_MX) { const int kb = r / 32, nb = r % 32; transpose_item(p.w_br_x, 1024, (bf16_t*)(ws + OFF_BTMG), 2048, 1536, scr, 64 * kb, 32 * nb, 32 * nb + l31, lane); continue; } r -= I_MX;
            if (r < I_O) { const int kb = r / 32, nb = r % 32; transpose_item(p.w_o, 1024, (bf16_t*)(ws + OFF_BTO), 1024, 0, scr, 64 * kb, 32 * nb, 32 * nb + l31, lane); continue; } r -= I_O;
            if (r < I_UP) { const int kb = r / 176, nb = r % 176; transpose_item(p.w_up, FF2, (bf16_t*)(ws + OFF_BTUP), 1024, 0, scr, 64 * kb, 32 * nb, 32 * nb + l31, lane); continue; } r -= I_UP;
            { const int kb = r / 32, nb = r % 32; transpose_item(p.w_down, 1024, (bf16_t*)(ws + OFF_BTDN), FF, 0, scr, 64 * kb, 32 * nb, 32 * nb + l31, lane); continue; }
        }
        r -= N_TR;
        if (r < N_RMS) {
            if (r < NP) rms_row(p.x_prompt + (size_t)r * 1024, p.norm_mix_g, (bf16_t*)(ws + OFF_R2) + (size_t)r * 1024, lane);
            else if (r < MT) rms_row(p.x_sample + (size_t)(r - NP) * 1024, p.norm_mix_g, (bf16_t*)(ws + OFF_R2) + (size_t)r * 1024, lane);
            else rms_row(p.mem_prompt + (size_t)(r - MT) * 1024, p.mem_norm_g, (bf16_t*)(ws + OFF_HM) + (size_t)(r - MT) * 1024, lane);
            continue; }
        r -= N_RMS;
        if (r < N_ROPE) {
            const int pos = r < 2048 ? r : 16384 + (r - 2048);
            double inv = 1.0;
            if (lane & 1) inv *= 0.8659643233600653; if (lane & 2) inv *= 0.7498942093324559; if (lane & 4) inv *= 0.5623413251903491;
            if (lane & 8) inv *= 0.31622776601683794; if (lane & 16) inv *= 0.1; if (lane & 32) inv *= 0.01;
            double t = (double)pos * inv * 0.15915494309189535; t -= __builtin_rint(t);
            const float tf = (float)t;
            ((float*)(ws + OFF_ROPEC))[r * 64 + lane] = __builtin_amdgcn_cosf(tf);
            ((float*)(ws + OFF_ROPES))[r * 64 + lane] = __builtin_amdgcn_sinf(tf);
            continue; }
        r -= N_ROPE;
        { const int t = r & 127; const float* src = p.sg_ws + (size_t)r * 128 + 2 * lane;
          const float a = (2 * lane <= t) ? src[0] : 0.f, b = (2 * lane + 1 <= t) ? src[1] : 0.f;
          *(unsigned*)((bf16_t*)(ws + OFF_WTRIL) + (size_t)r * 128 + 2 * lane) = pk2(a, b); }
    }
}

DEV void ret_A_item(const Params& p, LAS unsigned char* lds, int item) {
    const int tid = otid(), lane = tid & 63, w = tid >> 6;
    const int c = item & 15, bh = item >> 4, h = bh & 3, b = bh >> 2;
    const size_t row0 = (size_t)b * 2048 + c * 128;
    const bf16_t* P = (const bf16_t*)(p.ws + OFF_P);
    const float lg = log_gamma(h);
    LAS unsigned char* Kt = lds; LAS unsigned char* Vt = lds + 34816;
#pragma unroll
    for (int k_ = 0; k_ < 4; ++k_) { const int i = tid + 512 * k_; const int s = i >> 4, ch = i & 15;
        u32x4 v = __builtin_nontemporal_load((const u32x4*)(P + (row0 + s) * INC + C_K + h * 128 + ch * 8));
        const float dec = __expf((float)(127 - s) * lg);
        v.x = pk2(bf_lo(v.x) * dec, bf_hi(v.x) * dec); v.y = pk2(bf_lo(v.y) * dec, bf_hi(v.y) * dec); v.z = pk2(bf_lo(v.z) * dec, bf_hi(v.z) * dec); v.w = pk2(bf_lo(v.w) * dec, bf_hi(v.w) * dec);
        *(LAS u32x4*)(Kt + s * 272 + ch * 16) = v; }
#pragma unroll
    for (int k_ = 0; k_ < 8; ++k_) { const int i = tid + 512 * k_; const int s = i >> 5, ch = i & 31;
        *(LAS u32x4*)(Vt + s * 528 + ch * 16) = __builtin_nontemporal_load((const u32x4*)(P + (row0 + s) * INC + C_V + h * 256 + ch * 8)); }
    __syncthreads();
    f32x4 acc[16];
#pragma unroll
    for (int i = 0; i < 16; ++i) acc[i] = (f32x4){0.f, 0.f, 0.f, 0.f};
    LAS const unsigned char* kb = tr_lane_base(Kt, 272, lane) + 32 * w; LAS const unsigned char* vb = tr_lane_base(Vt, 528, lane);
    bf16x8 af[4]; tr_read4<272, 0, 0>(kb, af);
    static_for<0, 16>([&](auto et_) { constexpr int et = decltype(et_)::value; bf16x8 bf[4]; tr_read4<528, 0, 16 * et>(vb, bf);
#pragma unroll
        for (int ks = 0; ks < 4; ++ks) acc[et] = mfma16(af[ks], bf[ks], acc[et]); });
    float* U = p.out + (size_t)item * 32768;
    const int g = lane >> 4, col = lane & 15;
#pragma unroll
    for (int et = 0; et < 16; ++et)
#pragma unroll
        for (int j = 0; j < 4; ++j) U[(16 * w + 4 * g + j) * 256 + 16 * et + col] = acc[et][j];
    __syncthreads();
}
DEV void scan_phase(const Params& p) {
    const float* U = p.out; bf16_t* Sb = (bf16_t*)(p.ws + OFF_R2);
    for (int idx = obid() * 512 + otid(); idx < 131072; idx += gridDim.x * 512) {
        const int e8 = idx & 31, d = (idx >> 5) & 127, bh = idx >> 12, h = bh & 3;
        const float g128 = __expf(128.f * log_gamma(h));
        f32x4 s0 = (f32x4){0.f, 0.f, 0.f, 0.f}, s1 = s0;
#pragma unroll
        for (int c = 0; c < 16; ++c) {
            const size_t off = (((size_t)bh * 16 + c) * 128 + d) * 256 + e8 * 8;
            u32x4 pk; pk.x = pk2(s0.x, s0.y); pk.y = pk2(s0.z, s0.w); pk.z = pk2(s1.x, s1.y); pk.w = pk2(s1.z, s1.w);
            *(u32x4*)(Sb + off) = pk;
            const f32x4 u0 = __builtin_nontemporal_load((const f32x4*)(U + off)), u1 = __builtin_nontemporal_load((const f32x4*)(U + off + 4));
            s0 = s0 * g128 + u0; s1 = s1 * g128 + u1; }
        float* o = p.out + O_RETP + ((size_t)bh * 128 + d) * 256 + e8 * 8;
        *(f32x4*)o = s0; *(f32x4*)(o + 4) = s1;
    }
}
DEV void ret_C_item(const Params& p, LAS unsigned char* lds, int item) {
    const int tid = otid(), lane = tid & 63, w = tid >> 6, g = lane >> 4, col = lane & 15;
    const int c = item & 15, bh = item >> 4, h = bh & 3, b = bh >> 2;
    const size_t row0 = (size_t)b * 2048 + c * 128;
    bf16_t* P = (bf16_t*)(p.ws + OFF_P);
    const bf16_t* Sb = (const bf16_t*)(p.ws + OFF_R2) + (size_t)item * 32768;
    const float lg = log_gamma(h);
    LAS unsigned char* Kt = lds; LAS unsigned char* Vh = lds + 34816; LAS unsigned char* Sh = lds + 69632; LAS unsigned char* Sc = lds + 104448 + w * 4352;
#pragma unroll
    for (int k_ = 0; k_ < 4; ++k_) { const int i = tid + 512 * k_; const int s = i >> 4, ch = i & 15;
        *(LAS u32x4*)(Kt + s * 272 + ch * 16) = __builtin_nontemporal_load((const u32x4*)(P + (row0 + s) * INC + C_K + h * 128 + ch * 8)); }
    bf16x8 qf[4];
    { const bf16_t* qp = P + (row0 + 16 * w + col) * INC + C_Q + h * 128 + 8 * g;
#pragma unroll
      for (int ks = 0; ks < 4; ++ks) qf[ks] = *(const bf16x8*)(qp + 32 * ks); }
    f32x4 o[16];
    float sg[16][4];
#pragma unroll
    for (int j = 0; j < 4; ++j)
#pragma unroll
        for (int t = 0; t < 16; ++t) sg[t][j] = bf2f(P[(row0 + 16 * w + 4 * g + j) * INC + C_G + h * 256 + (t >> 3) * 128 + (t & 7) * 16 + col]);
    LAS const unsigned char* shb = tr_lane_base(Sh, 272, lane); LAS const unsigned char* vhb = tr_lane_base(Vh, 272, lane);
    bf16x8 scf[4];
    static_for<0, 2>([&](auto hh_) { constexpr int hh = decltype(hh_)::value;
        if (hh == 1) __syncthreads();
#pragma unroll
        for (int k_ = 0; k_ < 4; ++k_) { const int i = tid + 512 * k_; const int s = i >> 4, ch = i & 15;
            *(LAS u32x4*)(Vh + s * 272 + ch * 16) = __builtin_nontemporal_load((const u32x4*)(P + (row0 + s) * INC + C_V + h * 256 + hh * 128 + ch * 8));
            *(LAS u32x4*)(Sh + s * 272 + ch * 16) = __builtin_nontemporal_load((const u32x4*)(Sb + s * 256 + hh * 128 + ch * 8)); }
        __syncthreads();
        if (hh == 0) {
            static_for<0, 8>([&](auto st_) { constexpr int st = decltype(st_)::value; f32x4 a = (f32x4){0.f, 0.f, 0.f, 0.f};
#pragma unroll
                for (int ks = 0; ks < 4; ++ks) a = mfma16(qf[ks], lds_frag(Kt, 272, 16 * st, 32 * ks, lane), a);
#pragma unroll
                for (int j = 0; j < 4; ++j) { const int diff = (16 * w + 4 * g + j) - (16 * st + col);
                    const float v = diff >= 0 ? a[j] * __expf((float)diff * lg) : 0.f;
                    *(LAS bf16_t*)(Sc + (4 * g + j) * 272 + (16 * st + col) * 2) = f2bf(v); }
                SCHEDB; });
#pragma unroll
            for (int ks = 0; ks < 4; ++ks) scf[ks] = lds_frag(Sc, 272, 0, 32 * ks, lane);
        }
        static_for<0, 8>([&](auto et_) { constexpr int et = decltype(et_)::value; f32x4 a = (f32x4){0.f, 0.f, 0.f, 0.f};
            bf16x8 f[4]; tr_read4<272, 0, 16 * et>(shb, f);
#pragma unroll
            for (int ks = 0; ks < 4; ++ks) a = mfma16(qf[ks], f[ks], a);
#pragma unroll
            for (int j = 0; j < 4; ++j) a[j] *= __expf((float)(16 * w + 4 * g + j + 1) * lg);
            tr_read4<272, 0, 16 * et>(vhb, f);
#pragma unroll
            for (int ks = 0; ks < 4; ++ks) a = mfma16(scf[ks], f[ks], a);
            o[hh * 8 + et] = a; SCHEDB; });
    });
    float gnv[16];
#pragma unroll
    for (int t = 0; t < 16; ++t) gnv[t] = p.ret_gn_g[h * 256 + (t >> 3) * 128 + (t & 7) * 16 + col];
#pragma unroll
    for (int j = 0; j < 4; ++j) {
        float s = 0.f;
#pragma unroll
        for (int t = 0; t < 16; ++t) s += o[t][j];
        const float mean = g16_sum(s) * (1.f / 256.f);
        float s2 = 0.f;
#pragma unroll
        for (int t = 0; t < 16; ++t) { const float dd = o[t][j] - mean; s2 += dd * dd; }
        const float rstd = rsqrtf(g16_sum(s2) * (1.f / 256.f) + EPS);
        bf16_t* gp = P + (row0 + 16 * w + 4 * g + j) * INC + C_G + h * 256;
#pragma unroll
        for (int t = 0; t < 16; ++t) { const int e = (t >> 3) * 128 + (t & 7) * 16 + col;
            gp[e] = f2bf((o[t][j] - mean) * rstd * gnv[t] * sg[t][j]); }
    }
    __syncthreads();
}
DEV void sgu_item(const Params& p, LAS unsigned char* lds, int item) {
    const int tid = otid(), lane = tid & 63, w = tid >> 6, g = lane >> 4, col = lane & 15;
    const int gq = item & 3, bn = item >> 2; const size_t row0 = (size_t)bn * 128;
    bf16_t* P = (bf16_t*)(p.ws + OFF_P);
    LAS unsigned char* VN = lds;
#pragma unroll
    for (int rr = 0; rr < 16; ++rr) { const int s = 16 * w + rr;
        const u32x4 v = __builtin_nontemporal_load((const u32x4*)(P + (row0 + s) * INC + C_SV + lane * 8));
        float x[8] = {bf_lo(v.x), bf_hi(v.x), bf_lo(v.y), bf_hi(v.y), bf_lo(v.z), bf_hi(v.z), bf_lo(v.w), bf_hi(v.w)};
        float sm = 0.f;
#pragma unroll
        for (int i = 0; i < 8; ++i) sm += x[i];
        const float mean = wave_sum(sm) * (1.f / 512.f); float s2 = 0.f;
#pragma unroll
        for (int i = 0; i < 8; ++i) { x[i] -= mean; s2 += x[i] * x[i]; }
        const float rstd = rsqrtf(wave_sum(s2) * (1.f / 512.f) + EPS);
        if (g == gq) { const float* lg = p.sg_ln_g + lane * 8; u32x4 o;
            o.x = pk2(x[0] * rstd * lg[0], x[1] * rstd * lg[1]); o.y = pk2(x[2] * rstd * lg[2], x[3] * rstd * lg[3]);
            o.z = pk2(x[4] * rstd * lg[4], x[5] * rstd * lg[5]); o.w = pk2(x[6] * rstd * lg[6], x[7] * rstd * lg[7]);
            *(LAS u32x4*)(VN + s * 272 + col * 16) = o; } }
    bf16x8 af[4];
    { const bf16_t* wp = (const bf16_t*)(p.ws + OFF_WTRIL) + (size_t)(gq * 128 + 16 * w + col) * 128 + 8 * g;
#pragma unroll
      for (int ks = 0; ks < 4; ++ks) af[ks] = *(const bf16x8*)(wp + 32 * ks); }
    __syncthreads();
    LAS const unsigned char* vnb = tr_lane_base(VN, 272, lane);
    float uv[8][4], bsv[4];
#pragma unroll
    for (int j = 0; j < 4; ++j) { bsv[j] = p.sg_bs[gq * 128 + 16 * w + 4 * g + j];
#pragma unroll
        for (int ct = 0; ct < 8; ++ct) uv[ct][j] = bf2f(P[(row0 + 16 * w + 4 * g + j) * INC + C_SU + gq * 128 + 16 * ct + col]); }
    static_for<0, 8>([&](auto ct_) { constexpr int ct = decltype(ct_)::value; f32x4 a = (f32x4){0.f, 0.f, 0.f, 0.f};
        bf16x8 f[4]; tr_read4<272, 0, 16 * ct>(vnb, f);
#pragma unroll
        for (int ks = 0; ks < 4; ++ks) a = mfma16(af[ks], f[ks], a);
#pragma unroll
        for (int j = 0; j < 4; ++j) P[(row0 + 16 * w + 4 * g + j) * INC + C_SU + gq * 128 + 16 * ct + col] = f2bf(uv[ct][j] * (a[j] + bsv[j])); });
    __syncthreads();
}
DEV void xattn_item(const Params& p, LAS unsigned char* lds, int item) {
    const int tid = otid(), lane = tid & 63, w = tid >> 6, g = lane >> 4, col = lane & 15;
    const int qt = item & 15, bh = item >> 4, h = bh & 3, b = bh >> 2; const size_t row0 = (size_t)b * 2048 + qt * 128;
    bf16_t* P = (bf16_t*)(p.ws + OFF_P); const bf16_t* mkb = (const bf16_t*)(p.ws + OFF_MKB);
    LAS unsigned char* KV = lds; LAS unsigned char* Pw = lds + 69632 + w * 8448;
#pragma unroll
    for (int k_ = 0; k_ < 8; ++k_) { const int i = tid + 512 * k_; const int m = i >> 4, ch = i & 15;
        *(LAS u32x4*)(KV + m * 272 + ch * 16) = *(const u32x4*)(mkb + (size_t)(b * 256 + m) * 1024 + h * 128 + ch * 8); }
    bf16x8 qf[4];
    { const bf16_t* qp = P + (row0 + 16 * w + col) * INC + C_XQ + h * 128 + 8 * g;
#pragma unroll
      for (int ks = 0; ks < 4; ++ks) qf[ks] = *(const bf16x8*)(qp + 32 * ks); }
    __syncthreads();
    f32x4 sc[16];
    static_for<0, 16>([&](auto mt_) { constexpr int mt = decltype(mt_)::value; f32x4 a = (f32x4){0.f, 0.f, 0.f, 0.f};
#pragma unroll
        for (int ks = 0; ks < 4; ++ks) a = mfma16(qf[ks], lds_frag(KV, 272, 16 * mt, 32 * ks, lane), a);
        sc[mt] = a * 0.08838834764831845f; SCHEDB; });
#pragma unroll
    for (int j = 0; j < 4; ++j) { float mx = -3.0e38f;
#pragma unroll
        for (int mt = 0; mt < 16; ++mt) mx = fmaxf(mx, sc[mt][j]);
        mx = g16_max(mx); float sm = 0.f;
#pragma unroll
        for (int mt = 0; mt < 16; ++mt) { const float e = __expf(sc[mt][j] - mx); sc[mt][j] = e; sm += e; }
        const float inv = 1.f / g16_sum(sm);
#pragma unroll
        for (int mt = 0; mt < 16; ++mt) *(LAS bf16_t*)(Pw + (4 * g + j) * 528 + (16 * mt + col) * 2) = f2bf(sc[mt][j] * inv); }
    __syncthreads();
#pragma unroll
    for (int k_ = 0; k_ < 8; ++k_) { const int i = tid + 512 * k_; const int m = i >> 4, ch = i & 15;
        *(LAS u32x4*)(KV + m * 272 + ch * 16) = *(const u32x4*)(mkb + (size_t)(b * 256 + m) * 1024 + 512 + h * 128 + ch * 8); }
    __syncthreads();
    LAS const unsigned char* kvb = tr_lane_base(KV, 272, lane);
    bf16x8 pf[8];
#pragma unroll
    for (int ks = 0; ks < 8; ++ks) pf[ks] = lds_frag(Pw, 528, 0, 32 * ks, lane);
    static_for<0, 8>([&](auto dt_) { constexpr int dt = decltype(dt_)::value; f32x4 a = (f32x4){0.f, 0.f, 0.f, 0.f};
        bf16x8 f[4]; tr_read4<272, 0, 16 * dt>(kvb, f);
#pragma unroll
        for (int ks = 0; ks < 4; ++ks) a = mfma16(pf[ks], f[ks], a);
        tr_read4<272, 128, 16 * dt>(kvb, f);
#pragma unroll
        for (int ks = 0; ks < 4; ++ks) a = mfma16(pf[4 + ks], f[ks], a);
#pragma unroll
        for (int j = 0; j < 4; ++j) P[(row0 + 16 * w + 4 * g + j) * INC + C_XQ + h * 128 + 16 * dt + col] = f2bf(a[j]); });
    __syncthreads();
}
DEV void xattn_s_item(const Params& p, LAS unsigned char* lds, int item) {
    const int tid = otid(), lane = tid & 63, w = tid >> 6, l32 = lane & 31, slot = w * 2 + (lane >> 5);
    const int h = item & 3, b = item >> 2; const size_t rowb = (size_t)NP + b * 4;
    bf16_t* P = (bf16_t*)(p.ws + OFF_P);
    LAS float* sc = (LAS float*)lds; LAS float* red = (LAS float*)(lds + 4096);
    float q[4][4];
#pragma unroll
    for (int l = 0; l < 4; ++l) { const u32x2 v = *(const u32x2*)(P + (rowb + l) * INC + C_XQ + h * 128 + 4 * l32); q[l][0] = bf_lo(v.x); q[l][1] = bf_hi(v.x); q[l][2] = bf_lo(v.y); q[l][3] = bf_hi(v.y); }
#pragma unroll
    for (int it = 0; it < 16; ++it) { const int m = it * 16 + slot;
        const f32x4 kv = *(const f32x4*)(p.cache_k + (((size_t)b * 256 + m) * 4 + h) * 128 + 4 * l32);
        float d[4];
#pragma unroll
        for (int l = 0; l < 4; ++l) d[l] = q[l][0] * kv.x + q[l][1] * kv.y + q[l][2] * kv.z + q[l][3] * kv.w;
        const bool b0 = l32 & 1, b1 = l32 & 2;
        float a0 = b0 ? d[2] : d[0], a1 = b0 ? d[3] : d[1];
        a0 += __shfl_xor(b0 ? d[0] : d[2], 1); a1 += __shfl_xor(b0 ? d[1] : d[3], 1);
        float r = b1 ? a1 : a0; r += __shfl_xor(b1 ? a0 : a1, 2);
        r += __shfl_xor(r, 4); r += __shfl_xor(r, 8); r += __shfl_xor(r, 16);
        if (l32 < 4) sc[((l32 & 1) * 2 + (l32 >> 1)) * 256 + m] = r * 0.08838834764831845f; }
    __syncthreads();
    if (w < 4) { float v[4]; float mx = -3.0e38f;
#pragma unroll
        for (int i = 0; i < 4; ++i) { v[i] = sc[w * 256 + lane + 64 * i]; mx = fmaxf(mx, v[i]); }
        mx = wave_max(mx); float sm = 0.f;
#pragma unroll
        for (int i = 0; i < 4; ++i) { v[i] = __expf(v[i] - mx); sm += v[i]; }
        const float inv = 1.f / wave_sum(sm);
#pragma unroll
        for (int i = 0; i < 4; ++i) sc[w * 256 + lane + 64 * i] = v[i] * inv; }
    __syncthreads();
    f32x4 o[4];
#pragma unroll
    for (int l = 0; l < 4; ++l) o[l] = (f32x4){0.f, 0.f, 0.f, 0.f};
#pragma unroll
    for (int it = 0; it < 16; ++it) { const int m = it * 16 + slot;
        const f32x4 vv = *(const f32x4*)(p.cache_v + (((size_t)b * 256 + m) * 4 + h) * 128 + 4 * l32);
#pragma unroll
        for (int l = 0; l < 4; ++l) o[l] += vv * sc[l * 256 + m]; }
#pragma unroll
    for (int l = 0; l < 4; ++l) *(LAS f32x4*)(red + (slot * 4 + l) * 128 + 4 * l32) = o[l];
    __syncthreads();
    { const int l = tid >> 7, d = tid & 127; float s = 0.f;
#pragma unroll
      for (int k = 0; k < 16; ++k) s += red[(k * 4 + l) * 128 + d];
      P[(rowb + l) * INC + C_XQ + h * 128 + d] = f2bf(s); }
    __syncthreads();
}
DEV void ret_s_item(const Params& p, LAS unsigned char* lds, int item) {
    const int tid = otid(), lane = tid & 63, w = tid >> 6;
    const int h = item & 3, b = item >> 2; const size_t rowb = (size_t)NP + b * 4;
    bf16_t* P = (bf16_t*)(p.ws + OFF_P);
    const float lg = log_gamma(h);
    LAS float* qs = (LAS float*)lds;
    LAS float* kr = qs + 512;
    LAS float* vs = kr + 512;
    LAS float* ob = vs + 1024;
    LAS float* scm = ob + 1024;
    LAS float* red = scm + 16;
    { const int t = tid >> 7, d = tid & 127;
      qs[t * 128 + d] = bf2f(P[(rowb + t) * INC + C_Q + h * 128 + d]); kr[t * 128 + d] = bf2f(P[(rowb + t) * INC + C_K + h * 128 + d]);
      vs[t * 256 + d] = bf2f(P[(rowb + t) * INC + C_V + h * 256 + d]); vs[t * 256 + 128 + d] = bf2f(P[(rowb + t) * INC + C_V + h * 256 + 128 + d]); }
    __syncthreads();
    { const int pr = tid >> 5, t = pr >> 2, s2 = pr & 3, l32 = tid & 31;
      const f32x4 qa = *(LAS f32x4*)(qs + t * 128 + 4 * l32), kb = *(LAS f32x4*)(kr + s2 * 128 + 4 * l32);
      float d = qa.x * kb.x + qa.y * kb.y + qa.z * kb.z + qa.w * kb.w;
#pragma unroll
      for (int o = 1; o < 32; o <<= 1) d += __shfl_xor(d, o);
      if (l32 == 0) scm[pr] = (t >= s2) ? d * __expf((float)(t - s2) * lg) : 0.f; }
    f32x4 v[4], cr[4];
#pragma unroll
    for (int s = 0; s < 4; ++s) { v[s] = *(LAS f32x4*)(vs + s * 256 + 4 * lane); cr[s] = (f32x4){0.f, 0.f, 0.f, 0.f}; }
    const float g4 = __expf(4.f * lg), kd0 = __expf(3.f * lg), kd1 = __expf(2.f * lg), kd2 = __expf(lg);
    const float* S0 = p.state_ret + ((size_t)item * 128) * 256; float* Sn = p.out + O_RETS + ((size_t)item * 128) * 256;
#pragma unroll
    for (int dd = 0; dd < 16; ++dd) { const int d = 16 * w + dd;
        const f32x4 s0 = *(const f32x4*)(S0 + d * 256 + 4 * lane);
#pragma unroll
        for (int t = 0; t < 4; ++t) cr[t] += s0 * qs[t * 128 + d];
        f32x4 sn = s0 * g4 + v[0] * (kr[d] * kd0) + v[1] * (kr[128 + d] * kd1) + v[2] * (kr[256 + d] * kd2) + v[3] * kr[384 + d];
        *(f32x4*)(Sn + d * 256 + 4 * lane) = sn; }
#pragma unroll
    for (int t = 0; t < 4; ++t) *(LAS f32x4*)(red + (w * 4 + t) * 256 + 4 * lane) = cr[t];
    __syncthreads();
    { const int t = tid >> 7, e2 = (tid & 127) * 2; const float qd = __expf((float)(t + 1) * lg);
#pragma unroll
      for (int i = 0; i < 2; ++i) { const int e = e2 + i; float c = 0.f;
#pragma unroll
          for (int k = 0; k < 8; ++k) c += red[(k * 4 + t) * 256 + e];
          float in = 0.f;
#pragma unroll
          for (int s = 0; s < 4; ++s) in += scm[t * 4 + s] * vs[s * 256 + e];
          ob[t * 256 + e] = in + c * qd; } }
    __syncthreads();
    if (w < 4) { float x[4]; float sm = 0.f;
#pragma unroll
        for (int i = 0; i < 4; ++i) { x[i] = ob[w * 256 + lane + 64 * i]; sm += x[i]; }
        const float mean = wave_sum(sm) * (1.f / 256.f); float s2 = 0.f;
#pragma unroll
        for (int i = 0; i < 4; ++i) { x[i] -= mean; s2 += x[i] * x[i]; }
        const float rstd = rsqrtf(wave_sum(s2) * (1.f / 256.f) + EPS);
        bf16_t* gp = P + (rowb + w) * INC + C_G + h * 256;
#pragma unroll
        for (int i = 0; i < 4; ++i) { const int e = lane + 64 * i; gp[e] = f2bf(x[i] * rstd * p.ret_gn_g[h * 256 + e] * bf2f(gp[e])); } }
    __syncthreads();
}
DEV void sgu_s_item(const Params& p, LAS unsigned char* lds, int b) {
    const int tid = otid(), lane = tid & 63, w = tid >> 6;
    const size_t rowb = (size_t)NP + b * 4;
    bf16_t* P = (bf16_t*)(p.ws + OFF_P);
    LAS float* part = (LAS float*)lds;
    float x[4];
#pragma unroll
    for (int r = 0; r < 4; ++r) { x[r] = bf2f(P[(rowb + r) * INC + C_SV + tid]); const float s = wave_sum(x[r]); if (lane == 0) part[w * 4 + r] = s; }
    __syncthreads();
    float mean[4];
#pragma unroll
    for (int r = 0; r < 4; ++r) { float s = 0.f;
#pragma unroll
        for (int k = 0; k < 8; ++k) s += part[k * 4 + r];
        mean[r] = s * (1.f / 512.f); }
    __syncthreads();
#pragma unroll
    for (int r = 0; r < 4; ++r) { x[r] -= mean[r]; const float s = wave_sum(x[r] * x[r]); if (lane == 0) part[w * 4 + r] = s; }
    __syncthreads();
    const float lng = p.sg_ln_g[tid]; const int gq = tid >> 7;
    float vn[4];
#pragma unroll
    for (int r = 0; r < 4; ++r) { float s = 0.f;
#pragma unroll
        for (int k = 0; k < 8; ++k) s += part[k * 4 + r];
        vn[r] = x[r] * rsqrtf(s * (1.f / 512.f) + EPS) * lng;
        p.out[O_SGV + ((size_t)b * 4 + r) * 512 + tid] = vn[r]; }
#pragma unroll
    for (int t = 0; t < 4; ++t) { float mx = p.sg_bs[gq * 128 + t];
#pragma unroll
        for (int s = 0; s < 4; ++s) if (s <= t) mx += p.sg_ws[(size_t)(gq * 128 + t) * 128 + s] * vn[s];
        bf16_t* up = P + (rowb + t) * INC + C_SU + tid; *up = f2bf(bf2f(*up) * mx); }
    __syncthreads();
}


DEV float rl_bf(unsigned packed, int d) { return (d & 1) ? bf_hi(packed) : bf_lo(packed); }
DEV void ret_s_wave(const Params& p, int item, int lane) {
    const int h = item & 3, b = item >> 2; const size_t rowb = (size_t)NP + b * 4;
    bf16_t* P = (bf16_t*)(p.ws + OFF_P);
    const float lg = log_gamma(h);
    unsigned qp[4], kp[4]; f32x4 v[4];
#pragma unroll
    for (int t = 0; t < 4; ++t) { qp[t] = *(const unsigned*)(P + (rowb + t) * INC + C_Q + h * 128 + 2 * lane); kp[t] = *(const unsigned*)(P + (rowb + t) * INC + C_K + h * 128 + 2 * lane);
        const u32x2 x = *(const u32x2*)(P + (rowb + t) * INC + C_V + h * 256 + 4 * lane); v[t] = (f32x4){bf_lo(x.x), bf_hi(x.x), bf_lo(x.y), bf_hi(x.y)}; }
    float sc[4][4];
#pragma unroll
    for (int t = 0; t < 4; ++t)
#pragma unroll
        for (int s2 = 0; s2 < 4; ++s2) { if (s2 <= t) sc[t][s2] = wave_sum(bf_lo(qp[t]) * bf_lo(kp[s2]) + bf_hi(qp[t]) * bf_hi(kp[s2])) * __expf((float)(t - s2) * lg); else sc[t][s2] = 0.f; }
    const float g4 = __expf(4.f * lg), kdec[4] = {__expf(3.f * lg), __expf(2.f * lg), __expf(lg), 1.f};
    f32x4 cr[4];
#pragma unroll
    for (int t = 0; t < 4; ++t) cr[t] = (f32x4){0.f, 0.f, 0.f, 0.f};
    const float* S0 = p.state_ret + (size_t)item * 32768 + 4 * lane; float* Sn = p.out + O_RETS + (size_t)item * 32768 + 4 * lane;
    f32x4 sA[8], sB[8];
#pragma unroll
    for (int i = 0; i < 8; ++i) sA[i] = __builtin_nontemporal_load((const f32x4*)(S0 + i * 256));
#define RETS_PROC(buf, d0) _Pragma("unroll") for (int i = 0; i < 8; ++i) { const int src = ((d0) + i) >> 1; f32x4 sn = buf[i] * g4; \
        _Pragma("unroll") for (int t = 0; t < 4; ++t) { const float qd = rl_bf((unsigned)__builtin_amdgcn_readlane((int)qp[t], src), i), kd = rl_bf((unsigned)__builtin_amdgcn_readlane((int)kp[t], src), i) * kdec[t]; \
            cr[t] += buf[i] * qd; sn += v[t] * kd; } \
        __builtin_nontemporal_store(sn, (f32x4*)(Sn + ((d0) + i) * 256)); }
    for (int d0 = 0; d0 < 128; d0 += 16) {
#pragma unroll
        for (int i = 0; i < 8; ++i) sB[i] = __builtin_nontemporal_load((const f32x4*)(S0 + (d0 + 8 + i) * 256));
        RETS_PROC(sA, d0)
        if (d0 + 16 < 128) {
#pragma unroll
            for (int i = 0; i < 8; ++i) sA[i] = __builtin_nontemporal_load((const f32x4*)(S0 + (d0 + 16 + i) * 256)); }
        RETS_PROC(sB, d0 + 8)
    }
#undef RETS_PROC
    const f32x4 gn4 = *(const f32x4*)(p.ret_gn_g + h * 256 + 4 * lane);
#pragma unroll
    for (int t = 0; t < 4; ++t) {
        f32x4 o = cr[t] * __expf((float)(t + 1) * lg);
#pragma unroll
        for (int s2 = 0; s2 < 4; ++s2) o += v[s2] * sc[t][s2];
        const float mean = wave_sum(o.x + o.y + o.z + o.w) * (1.f / 256.f);
        o = o - mean;
        const float rstd = rsqrtf(wave_sum(o.x * o.x + o.y * o.y + o.z * o.z + o.w * o.w) * (1.f / 256.f) + EPS);
        bf16_t* gp = P + (rowb + t) * INC + C_G + h * 256 + 4 * lane;
        const u32x2 gg = *(const u32x2*)gp;
        u32x2 ov; ov.x = pk2(o.x * rstd * gn4.x * bf_lo(gg.x), o.y * rstd * gn4.y * bf_hi(gg.x)); ov.y = pk2(o.z * rstd * gn4.z * bf_lo(gg.y), o.w * rstd * gn4.w * bf_hi(gg.y));
        *(u32x2*)gp = ov; }
}
DEV void xattn_s_wave(const Params& p, LAS float* sc  , int item, int lane) {
    const int l32 = lane & 31, hf = lane >> 5;
    const int h = item & 3, b = item >> 2; const size_t rowb = (size_t)NP + b * 4;
    bf16_t* P = (bf16_t*)(p.ws + OFF_P);
    float q[4][4];
#pragma unroll
    for (int l = 0; l < 4; ++l) { const u32x2 x = *(const u32x2*)(P + (rowb + l) * INC + C_XQ + h * 128 + 4 * l32); q[l][0] = bf_lo(x.x); q[l][1] = bf_hi(x.x); q[l][2] = bf_lo(x.y); q[l][3] = bf_hi(x.y); }
    const float* Kb = p.cache_k + (((size_t)b * 256 + hf) * 4 + h) * 128 + 4 * l32;
    const float* Vb = p.cache_v + (((size_t)b * 256 + hf) * 4 + h) * 128 + 4 * l32;
    const bool b0 = l32 & 1, b1 = l32 & 2; const int lmap = (l32 & 1) * 2 + ((l32 >> 1) & 1);
    for (int it0 = 0; it0 < 128; it0 += 16) {
        f32x4 kv[16];
#pragma unroll
        for (int i = 0; i < 16; ++i) kv[i] = __builtin_nontemporal_load((const f32x4*)(Kb + (size_t)(it0 + i) * 1024));
#pragma unroll
        for (int i = 0; i < 16; ++i) { float d[4];
#pragma unroll
            for (int l = 0; l < 4; ++l) d[l] = q[l][0] * kv[i].x + q[l][1] * kv[i].y + q[l][2] * kv[i].z + q[l][3] * kv[i].w;
            float a0 = b0 ? d[2] : d[0], a1 = b0 ? d[3] : d[1];
            a0 += dpp_f<0xB1>(b0 ? d[0] : d[2]); a1 += dpp_f<0xB1>(b0 ? d[1] : d[3]);
            float r = b1 ? a1 : a0; r += dpp_f<0x4E>(b1 ? a0 : a1);
            r += dpp_f<0x124>(r); r += dpp_f<0x128>(r);
            r += __shfl_xor(r, 16);
            if (l32 < 4) sc[lmap * 256 + 2 * (it0 + i) + hf] = r * 0.08838834764831845f; }
    }
#pragma unroll
    for (int l = 0; l < 4; ++l) { float vv[4]; float mx = -3.0e38f;
#pragma unroll
        for (int i = 0; i < 4; ++i) { vv[i] = sc[l * 256 + lane + 64 * i]; mx = fmaxf(mx, vv[i]); }
        mx = wave_max(mx); float sm = 0.f;
#pragma unroll
        for (int i = 0; i < 4; ++i) { vv[i] = __expf(vv[i] - mx); sm += vv[i]; }
        const float inv = 1.f / wave_sum(sm);
#pragma unroll
        for (int i = 0; i < 4; ++i) sc[l * 256 + lane + 64 * i] = vv[i] * inv; }
    f32x4 o[4];
#pragma unroll
    for (int l = 0; l < 4; ++l) o[l] = (f32x4){0.f, 0.f, 0.f, 0.f};
    for (int it0 = 0; it0 < 128; it0 += 16) {
        f32x4 vv[16];
#pragma unroll
        for (int i = 0; i < 16; ++i) vv[i] = __builtin_nontemporal_load((const f32x4*)(Vb + (size_t)(it0 + i) * 1024));
#pragma unroll
        for (int i = 0; i < 16; ++i) { const int m = 2 * (it0 + i) + hf;
#pragma unroll
            for (int l = 0; l < 4; ++l) o[l] += vv[i] * sc[l * 256 + m]; }
    }
#pragma unroll
    for (int l = 0; l < 4; ++l) { f32x4 t = o[l];
        t.x += __shfl_xor(t.x, 32); t.y += __shfl_xor(t.y, 32); t.z += __shfl_xor(t.z, 32); t.w += __shfl_xor(t.w, 32);
        if (hf == 0) { u32x2 ov; ov.x = pk2(t.x, t.y); ov.y = pk2(t.z, t.w); *(u32x2*)(P + (rowb + l) * INC + C_XQ + h * 128 + 4 * l32) = ov; } }
}
DEV void sgu_s_wave(const Params& p, int b, int lane) {
    const size_t rowb = (size_t)NP + b * 4;
    bf16_t* P = (bf16_t*)(p.ws + OFF_P);
    const int gq = lane >> 4;
    float vn[4][8];
    const f32x4 l0 = *(const f32x4*)(p.sg_ln_g + 8 * lane), l1 = *(const f32x4*)(p.sg_ln_g + 8 * lane + 4);
    const float lng[8] = {l0.x, l0.y, l0.z, l0.w, l1.x, l1.y, l1.z, l1.w};
#pragma unroll
    for (int r = 0; r < 4; ++r) { float x[8]; unpack8(*(const u32x4*)(P + (rowb + r) * INC + C_SV + 8 * lane), x);
        float sm = 0.f;
#pragma unroll
        for (int i = 0; i < 8; ++i) sm += x[i];
        const float mean = wave_sum(sm) * (1.f / 512.f); float s2 = 0.f;
#pragma unroll
        for (int i = 0; i < 8; ++i) { x[i] -= mean; s2 += x[i] * x[i]; }
        const float rstd = rsqrtf(wave_sum(s2) * (1.f / 512.f) + EPS);
#pragma unroll
        for (int i = 0; i < 8; ++i) vn[r][i] = x[i] * rstd * lng[i];
        float* o = p.out + O_SGV + ((size_t)b * 4 + r) * 512 + 8 * lane;
        *(f32x4*)o = (f32x4){vn[r][0], vn[r][1], vn[r][2], vn[r][3]}; *(f32x4*)(o + 4) = (f32x4){vn[r][4], vn[r][5], vn[r][6], vn[r][7]}; }
#pragma unroll
    for (int t = 0; t < 4; ++t) { float mx[8];
#pragma unroll
        for (int i = 0; i < 8; ++i) mx[i] = p.sg_bs[gq * 128 + t];
#pragma unroll
        for (int s2 = 0; s2 < 4; ++s2) if (s2 <= t) { const float wv = p.sg_ws[(size_t)(gq * 128 + t) * 128 + s2];
#pragma unroll
            for (int i = 0; i < 8; ++i) mx[i] += wv * vn[s2][i]; }
        bf16_t* up = P + (rowb + t) * INC + C_SU + 8 * lane; float u[8]; unpack8(*(const u32x4*)up, u);
        u32x4 ov; ov.x = pk2(u[0] * mx[0], u[1] * mx[1]); ov.y = pk2(u[2] * mx[2], u[3] * mx[3]); ov.z = pk2(u[4] * mx[4], u[5] * mx[5]); ov.w = pk2(u[6] * mx[6], u[7] * mx[7]);
        *(u32x4*)up = ov; }
}

DEV void rms_phase(const Params& p, bool final_) {
    const int lane = otid() & 63, gw = obid() * 8 + (otid() >> 6), NGW = gridDim.x * 8;
    const float* g = final_ ? p.norm_final_g : p.norm_ffn_g;
    const float* part = (const float*)(p.ws + (final_ ? OFF_PART10 : OFF_PART6)); const int npart = final_ ? 22 : 8;
    for (int r = gw; r < MT; r += NGW) {
        float* xr = p.out + (size_t)r * 1024;
        f32x4 v[4]; float s = 0.f;
        if (r < NP) {
            const float* xin = p.x_prompt + (size_t)r * 1024; const bf16_t* sc = (const bf16_t*)xr;
            u32x2 mx[4], fx[4];
#pragma unroll
            for (int j = 0; j < 4; ++j) { v[j] = __builtin_nontemporal_load((const f32x4*)(xin + 4 * lane + 256 * j)); mx[j] = __builtin_nontemporal_load((const u32x2*)(sc + 1024 + 4 * lane + 256 * j)); fx[j] = final_ ? __builtin_nontemporal_load((const u32x2*)(sc + 4 * lane + 256 * j)) : (u32x2){0u, 0u}; }
#pragma unroll
            for (int j = 0; j < 4; ++j) { v[j].x += bf_lo(mx[j].x) + bf_lo(fx[j].x); v[j].y += bf_hi(mx[j].x) + bf_hi(fx[j].x); v[j].z += bf_lo(mx[j].y) + bf_lo(fx[j].y); v[j].w += bf_hi(mx[j].y) + bf_hi(fx[j].y); }
        } else {
            const float* base = final_ ? xr : p.x_sample + (size_t)(r - NP) * 1024;
#pragma unroll
            for (int j = 0; j < 4; ++j) v[j] = *(const f32x4*)(base + 4 * lane + 256 * j);
            for (int k = 0; k < npart; ++k) { const float* pr = part + (size_t)k * SROWS + (size_t)(r - NP) * 1024;
#pragma unroll
                for (int j = 0; j < 4; ++j) v[j] += *(const f32x4*)(pr + 4 * lane + 256 * j); }
            if (!final_) {
#pragma unroll
                for (int j = 0; j < 4; ++j) *(f32x4*)(xr + 4 * lane + 256 * j) = v[j]; }
        }
#pragma unroll
        for (int j = 0; j < 4; ++j) s += v[j].x * v[j].x + v[j].y * v[j].y + v[j].z * v[j].z + v[j].w * v[j].w;
        s = wave_sum(s); const float rr = rsqrtf(s * (1.f / 1024.f) + EPS);
        if (final_) {
#pragma unroll
            for (int j = 0; j < 4; ++j) { const f32x4 gv = *(const f32x4*)(g + 4 * lane + 256 * j); __builtin_nontemporal_store(v[j] * rr * gv, (f32x4*)(xr + 4 * lane + 256 * j)); }
        } else { bf16_t* orow = (bf16_t*)(p.ws + OFF_R2) + (size_t)r * 1024;
#pragma unroll
            for (int j = 0; j < 4; ++j) { const f32x4 gv = *(const f32x4*)(g + 4 * lane + 256 * j);
                u32x2 o; o.x = pk2(v[j].x * rr * gv.x, v[j].y * rr * gv.y); o.y = pk2(v[j].z * rr * gv.z, v[j].w * rr * gv.w);
                *(u32x2*)(orow + 4 * lane + 256 * j) = o; } }
    }
}
DEV void conv_phase(const Params& p) {
    const bf16_t* z = (const bf16_t*)(p.ws + OFF_Z); bf16_t* act = (bf16_t*)(p.ws + OFF_ACT);
    const int gtid = obid() * 512 + otid(), NT = gridDim.x * 512;
    for (int idx = gtid; idx < (NP / 8) * 352; idx += NT) {
        const int rb = idx / 352, ch = idx - rb * 352, c = ch * 8, r0 = rb * 8;
        float wa[3][8], wb[3][8], ba[8], bb[8];
#pragma unroll
        for (int j = 0; j < 3; ++j) { const f32x4 a0 = *(const f32x4*)(p.conv_w + j * FF2 + c), a1 = *(const f32x4*)(p.conv_w + j * FF2 + c + 4), b0 = *(const f32x4*)(p.conv_w + j * FF2 + FF + c), b1 = *(const f32x4*)(p.conv_w + j * FF2 + FF + c + 4);
#pragma unroll
            for (int i = 0; i < 4; ++i) { wa[j][i] = a0[i]; wa[j][4 + i] = a1[i]; wb[j][i] = b0[i]; wb[j][4 + i] = b1[i]; } }
        { const f32x4 a0 = *(const f32x4*)(p.conv_b + c), a1 = *(const f32x4*)(p.conv_b + c + 4), b0 = *(const f32x4*)(p.conv_b + FF + c), b1 = *(const f32x4*)(p.conv_b + FF + c + 4);
#pragma unroll
          for (int i = 0; i < 4; ++i) { ba[i] = a0[i]; ba[4 + i] = a1[i]; bb[i] = b0[i]; bb[4 + i] = b1[i]; } }
        u32x4 ra[10], rbq[10];
        const bool first = (r0 & 2047) == 0;
#pragma unroll
        for (int k = 0; k < 10; ++k) { const int rr = r0 - 2 + k;
            if (k < 2 && first) { ra[k] = (u32x4){0u, 0u, 0u, 0u}; rbq[k] = ra[k]; }
            else { ra[k] = __builtin_nontemporal_load((const u32x4*)(z + (size_t)rr * FF2 + c)); rbq[k] = __builtin_nontemporal_load((const u32x4*)(z + (size_t)rr * FF2 + FF + c)); } }
        float xa[3][8], xb[3][8];
        unpack8(ra[0], xa[0]); unpack8(rbq[0], xb[0]); unpack8(ra[1], xa[1]); unpack8(rbq[1], xb[1]);
#pragma unroll
        for (int k = 0; k < 8; ++k) {
            unpack8(ra[k + 2], xa[(k + 2) % 3]); unpack8(rbq[k + 2], xb[(k + 2) % 3]);
            float o[8];
#pragma unroll
            for (int i = 0; i < 8; ++i) {
                const float za = ba[i] + wa[0][i] * xa[k % 3][i] + wa[1][i] * xa[(k + 1) % 3][i] + wa[2][i] * xa[(k + 2) % 3][i];
                const float zb = bb[i] + wb[0][i] * xb[k % 3][i] + wb[1][i] * xb[(k + 1) % 3][i] + wb[2][i] * xb[(k + 2) % 3][i];
                o[i] = gelu_t(za) * zb; }
            u32x4 ov; ov.x = pk2(o[0], o[1]); ov.y = pk2(o[2], o[3]); ov.z = pk2(o[4], o[5]); ov.w = pk2(o[6], o[7]);
            *(u32x4*)(act + (size_t)(r0 + k) * FF + c) = ov; }
    }
    for (int idx = gtid; idx < NS * 352; idx += NT) {
        const int rs = idx / 352, ch = idx - rs * 352, c = ch * 8, r = NP + rs, tpos = rs & 3;
        float za[8], zb[8];
#pragma unroll
        for (int i = 0; i < 8; ++i) { za[i] = p.conv_b[c + i]; zb[i] = p.conv_b[FF + c + i]; }
#pragma unroll
        for (int j = 0; j < 3; ++j) {
            const int tp = tpos - 2 + j;
            float xa[8], xb[8];
            if (tp >= 0) { unpack8(*(const u32x4*)(z + (size_t)(r - 2 + j) * FF2 + c), xa); unpack8(*(const u32x4*)(z + (size_t)(r - 2 + j) * FF2 + FF + c), xb); }
            else { const float* sp = p.state_conv + ((size_t)(rs >> 2) * 2 + (tp + 2)) * FF2;
#pragma unroll
                for (int i = 0; i < 8; ++i) { xa[i] = sp[c + i]; xb[i] = sp[FF + c + i]; } }
#pragma unroll
            for (int i = 0; i < 8; ++i) { za[i] += p.conv_w[j * FF2 + c + i] * xa[i]; zb[i] += p.conv_w[j * FF2 + FF + c + i] * xb[i]; }
        }
        u32x4 o; o.x = pk2(gelu_t(za[0]) * zb[0], gelu_t(za[1]) * zb[1]); o.y = pk2(gelu_t(za[2]) * zb[2], gelu_t(za[3]) * zb[3]);
        o.z = pk2(gelu_t(za[4]) * zb[4], gelu_t(za[5]) * zb[5]); o.w = pk2(gelu_t(za[6]) * zb[6], gelu_t(za[7]) * zb[7]);
        *(u32x4*)(act + (size_t)r * FF + c) = o;
    }
}

#define XB_TMO      128
#define XB_XCNT(j)  (256  + 64 * (j))
#define XB_XSUB(j)  (1280 + 64 * (j))
#define XB_XGEN(j)  (2304 + 64 * (j))
#define XB_TOP      3328
#define XB_TOPGEN   3392
#define XCD_BAR_WORDS 3456
#define XB_SPIN_CAP (1u << 18)
DEV unsigned xb_ld(unsigned* p)              { return __hip_atomic_load(p, __ATOMIC_RELAXED, __HIP_MEMORY_SCOPE_AGENT); }
DEV unsigned xb_add(unsigned* p, unsigned v) { return __hip_atomic_fetch_add(p, v, __ATOMIC_RELAXED, __HIP_MEMORY_SCOPE_AGENT); }
DEV unsigned xb_xcc_id() { return (unsigned)__builtin_amdgcn_s_getreg((3 << 11) | 20) & 0xFu; }
#define XB_SPIN(cond, bar) do { unsigned _sp = 0; while (cond) { __builtin_amdgcn_s_sleep(1); \
    if ((++_sp & 255u) == 0u) { if (xb_ld(&(bar)[XB_TMO])) break; if (_sp > XB_SPIN_CAP) { atomicAdd(&(bar)[XB_TMO], 1u); break; } } } } while (0)
struct XcdBarrier { unsigned* bar; unsigned x; volatile LAS unsigned* st; };
DEV XcdBarrier xcd_barrier_post(unsigned* bar, volatile LAS unsigned* st) {
    XcdBarrier b; b.bar = bar; b.x = xb_xcc_id(); b.st = st;
    if (threadIdx.x == 0) (void)xb_add(&bar[XB_XCNT(b.x)], 1u);
    return b; }
DEV void xcd_barrier_complete(unsigned* bar, unsigned x, unsigned& nloc, unsigned& nx) {
    const unsigned G = gridDim.x * gridDim.y * gridDim.z;
    unsigned sum, cnt, mine, sp = 0u;
    for (;;) {
        sum = 0u; cnt = 0u; mine = 0u;
#pragma unroll
        for (unsigned j = 0; j < 16; ++j) { const unsigned c = xb_ld(&bar[XB_XCNT(j)]); sum += c; cnt += (c > 0u) ? 1u : 0u; mine = (j == x) ? c : mine; }
        if (sum == G) break;
        __builtin_amdgcn_s_sleep(1);
        if ((++sp & 255u) == 0u) { if (xb_ld(&bar[XB_TMO])) break; if (sp > XB_SPIN_CAP) { atomicAdd(&bar[XB_TMO], 1u); break; } }
    }
    nloc = mine > 0u ? mine : 1u; nx = cnt > 0u ? cnt : 1u; }
DEV void xcd_barrier(unsigned* bar_, volatile LAS unsigned* st_) {
    XcdBarrier b; b.bar = bar_; b.x = xb_xcc_id(); b.st = st_;
    asm volatile("s_waitcnt vmcnt(0)" ::: "memory");
    __syncthreads();
    if (threadIdx.x == 0) {
        unsigned* bar = b.bar;
        __builtin_amdgcn_s_waitcnt(0);
        unsigned nloc = b.st[0], nx = b.st[1];
        if (nloc == 0u) { xcd_barrier_complete(bar, b.x, nloc, nx); b.st[0] = nloc; b.st[1] = nx; }
        const unsigned old = xb_add(&bar[XB_XSUB(b.x)], 1u);
        const unsigned gen = old / nloc;
        if (old + 1u == (gen + 1u) * nloc) {
            __builtin_amdgcn_fence(__ATOMIC_RELEASE, "agent");
            asm volatile("s_waitcnt vmcnt(0)" ::: "memory");
            const unsigned og = xb_add(&bar[XB_TOP], 1u);
            const unsigned tg = og / nx;
            if (og + 1u == (tg + 1u) * nx) xb_add(&bar[XB_TOPGEN], 1u);
            else XB_SPIN(xb_ld(&bar[XB_TOPGEN]) == tg, bar);
            __builtin_amdgcn_fence(__ATOMIC_ACQUIRE, "agent");
            xb_add(&bar[XB_XGEN(b.x)], 1u);
            asm volatile("s_waitcnt vmcnt(0)" ::: "memory");
        } else {
            XB_SPIN(xb_ld(&bar[XB_XGEN(b.x)]) == gen, bar);
            __builtin_amdgcn_fence(__ATOMIC_ACQUIRE, "agent");
            asm volatile("s_waitcnt vmcnt(0)" ::: "memory");
        }
    }
    __syncthreads();
}

DEV Params kp_load() { Params r{};
#if defined(__HIP_DEVICE_COMPILE__)
    typedef const unsigned long long __attribute__((address_space(4))) KA;
    KA* q = (KA*)__builtin_amdgcn_kernarg_segment_ptr(); asm volatile("" : "+s"(q));
    unsigned long long t[28];
#pragma unroll
    for (int i = 0; i < 28; ++i) t[i] = q[i];
    __builtin_memcpy(&r, t, sizeof(Params));
#endif
    return r; }
__global__ __launch_bounds__(512, 2) void mega(Params p_arg, int ph0, int ph1) {
    extern __shared__ __attribute__((aligned(16))) unsigned char shm[];
    LAS unsigned char* lds = (LAS unsigned char*)shm;
    cg::grid_group grid = cg::this_grid();
#ifndef TIME_SEL
#define TIME_SEL 0
#endif
    unsigned long long tacc = 0;
    const int G = gridDim.x, c = obid();
    volatile LAS unsigned* xst = (volatile LAS unsigned*)(lds + LDS_BYTES - 16);
    if (threadIdx.x == 0) { xst[0] = 0u; xst[1] = 0u; }
    __syncthreads();
    (void)xcd_barrier_post((unsigned*)(kp_load().ws + OFF_BAR), xst);
#ifndef DUP_PH
#define DUP_PH -1
#endif
#ifndef PH_TIME_MASK
#define PH_TIME_MASK 0
#endif
#define PH_BEGIN(k) if (ph0 <= (k) && (k) < ph1) { const unsigned long long tph_ = ((PH_TIME_MASK) >> (k)) & 1 ? __builtin_amdgcn_s_memrealtime() : 0ull; if (PHON(k)) { for (int rep_ = 0; rep_ < ((k) == DUP_PH ? 2 : 1); ++rep_) { const Params p = kp_load(); unsigned char* ws = p.ws;
#define PH_END(k) } } if ((k) + 1 < ph1) { if ((k) == 0) grid.sync(); else xcd_barrier((unsigned*)(kp_load().ws + OFF_BAR), (volatile LAS unsigned*)(lds + LDS_BYTES - 16)); } if (((PH_TIME_MASK) >> (k)) & 1) tacc += __builtin_amdgcn_s_memrealtime() - tph_; }
    PH_BEGIN(0) phase_prep(p, lds); PH_END(0)
    PH_BEGIN(1)
            Sched1 S{G, c, (const char*)(ws + OFF_R2), (const char*)(ws + OFF_HM), (const char*)(ws + OFF_BTIN), (const char*)(ws + OFF_BTKV)};
            Epi1 E{(bf16_t*)(ws + OFF_P), (bf16_t*)(ws + OFF_MKB), p.out, (const float*)(ws + OFF_ROPEC), (const float*)(ws + OFF_ROPES), p.b_gate};
            pg8::gemm_phase(lds, 1024, 1024, S, E);
    PH_END(1)
    PH_BEGIN(2)
            for (int it = c; it < 1536; it += G) {
                if (it < 512) ret_A_item(p, lds, it);
                else if (it < 1024) xattn_item(p, lds, it - 512);
                else sgu_item(p, lds, it - 1024);
            }
            {
                const int tid2 = otid(), w2 = __builtin_amdgcn_readfirstlane(tid2 >> 6), lane2 = tid2 & 63;
                if (w2 < 2) ret_s_wave(p, c + 256 * w2, lane2);
                else if (w2 < 4) xattn_s_wave(p, (LAS float*)(lds + 4096 * w2), c + 256 * (w2 - 2), lane2);
                else if (w2 == 4 && c < 128) sgu_s_wave(p, c, lane2);
            }
    PH_END(2)
    PH_BEGIN(3)
            scan_phase(p);
            SchedMgS S{c, (const char*)(ws + OFF_P), (const char*)(ws + OFF_BTMG)};
            EpiMgS E{(const bf16_t*)(ws + OFF_P), (float*)(ws + OFF_MG32)};
            pg8::gemm_phase(lds, INC, 2048, S, E);
    PH_END(3)
    PH_BEGIN(4) for (int it = c; it < 512; it += G) ret_C_item(p, lds, it); PH_END(4)
    PH_BEGIN(5)
            {
                const int i = obid() * 512 + otid();
                if (i < 131072) { f32x4 m = __builtin_nontemporal_load((const f32x4*)(ws + OFF_MG32) + i);
#pragma unroll
                    for (int k = 1; k < 8; ++k) m += __builtin_nontemporal_load((const f32x4*)(ws + OFF_MG32) + (size_t)k * 131072 + i);
                    u32x2 o; o.x = pk2(m.x, m.y); o.y = pk2(m.z, m.w);
                    ((u32x2*)((bf16_t*)(ws + OFF_R2) + (size_t)NP * 1024))[i] = o; } }
            SchedMg S{G, c, (const char*)(ws + OFF_P), (const char*)(ws + OFF_BTMG)};
            EpiMg E{(const bf16_t*)(ws + OFF_P), (bf16_t*)(ws + OFF_R2)};
            pg8::gemm_phase(lds, INC, 2048, S, E);
    PH_END(5)
    PH_BEGIN(6)
            SchedPS<16, 64, 8, 524288, 524288> S{G, c, (const char*)(ws + OFF_R2), (const char*)(ws + OFF_BTO)};
            EpiWo E{p.x_prompt, p.x_sample, p.out, (float*)(ws + OFF_PART6)};
            pg8::gemm_phase(lds, 1024, 1024, S, E);
    PH_END(6)
    PH_BEGIN(7) rms_phase(p, false); PH_END(7)
    PH_BEGIN(8)
            SchedPlain S{G, c, 66, 22, 16, (const char*)(ws + OFF_R2), (const char*)(ws + OFF_BTUP), (size_t)524288, (size_t)524288};
            EpiUp E{(bf16_t*)(ws + OFF_Z), p.out};
            pg8::gemm_phase(lds, 1024, 1024, S, E);
    PH_END(8)
    PH_BEGIN(9) conv_phase(p); PH_END(9)
    PH_BEGIN(10)
            SchedPS<44, 176, 22, 256 * FF * 2, 256 * FF * 2> S{G, c, (const char*)(ws + OFF_ACT), (const char*)(ws + OFF_BTDN)};
            EpiDn E{p.out, (float*)(ws + OFF_PART10)};
            pg8::gemm_phase(lds, FF, FF, S, E);
    PH_END(10)
    PH_BEGIN(11) rms_phase(p, true); PH_END(11)
    if (((TIME_SEL) || (PH_TIME_MASK)) && blockIdx.x == 0 && ph1 > 1) { const unsigned long long t0_ = __builtin_amdgcn_s_memrealtime(); while (__builtin_amdgcn_s_memrealtime() - t0_ < tacc) __builtin_amdgcn_s_sleep(8); }
}

extern "C" void kernel_launch(void* const* d_in, const int* in_sizes, int n_in, void* d_out, int out_size, void* d_ws, size_t ws_size, hipStream_t stream) {
    static int grid = 0;
    if (grid == 0) {
        if (n_in != 26 || out_size != 39018496 || ws_size < WS_END2) { fprintf(stderr, "kernel_launch: unexpected shapes n_in %d out %d ws %zu (need %zu)\n", n_in, out_size, ws_size, (size_t)WS_END2); grid = -1; return; }
        int dev = 0, cus = 0, per_cu = 0;
        hipGetDevice(&dev); hipDeviceGetAttribute(&cus, hipDeviceAttributeMultiprocessorCount, dev);
        if (hipFuncSetAttribute((const void*)mega, hipFuncAttributeMaxDynamicSharedMemorySize, LDS_BYTES) != hipSuccess) { fprintf(stderr, "kernel_launch: hipFuncSetAttribute failed\n"); grid = -1; return; }
        if (hipOccupancyMaxActiveBlocksPerMultiprocessor(&per_cu, (const void*)mega, 512, LDS_BYTES) != hipSuccess || per_cu < 1) { fprintf(stderr, "kernel_launch: occupancy query gave %d\n", per_cu); grid = -1; return; }
        if (cus != 256) { fprintf(stderr, "kernel_launch: built for 256 CUs, got %d\n", cus); grid = -1; return; }
        grid = cus;
    }
    if (grid < 0) return;
    Params p{};
    const float** f = (const float**)&p;
    for (int i = 0; i < 26; ++i) f[i] = (const float*)d_in[i];
    p.out = (float*)d_out; p.ws = (unsigned char*)d_ws;
#ifndef DBG_NPH
#define DBG_NPH 12
#endif
#ifndef MK_MULTI
#define MK_MULTI 0
#endif
#if MK_MULTI
#ifndef PH_SEQ
#define PH_SEQ 0,1,2,3,4,5,6,7,8,9,10,11
#endif
    { const int seq[] = {PH_SEQ}; for (int ph : seq) hipLaunchKernelGGL(mega, dim3(grid), dim3(512), LDS_BYTES, stream, p, ph, ph + 1); }
    hipError_t e = hipSuccess;
#else
    (void)hipMemsetAsync((unsigned char*)d_ws + OFF_BAR, 0, 16384, stream);
    int ph0 = 0, ph1 = NPHASE;
    void* args[] = {&p, &ph0, &ph1};
    hipError_t e = hipLaunchCooperativeKernel((const void*)mega, dim3(grid), dim3(512), args, LDS_BYTES, stream);
#endif
    if (e != hipSuccess) fprintf(stderr, "cooperative launch failed: %s (grid %d)\n", hipGetErrorString(e), grid);
}
```
